# Optimizing an MI355X kernel written in HIP

```python
import math, functools
import jax, jax.numpy as jnp
from jax import lax
import numpy as np

D_MODEL = 1024
BATCH = 8
SEQ = 2048
DEPTH = 2
DEC_BATCH = 128
DEC_SEQ = 1
PAST_LEN = 16384
PAGE_SIZE = 128

MIX_W = D_MODEL
RWKV_W = MIX_W // 2
CONV_W = MIX_W - RWKV_W
HEAD_SIZE = 64
N_RWKV_HEADS = RWKV_W // HEAD_SIZE
DECAY_LORA = 64
AAA_LORA = 64
MV_LORA = 32
GATE_LORA = 128
CONV_K = 3
N_MEM = 256
N_XHEADS = 4
XHEAD_DIM = D_MODEL // N_XHEADS
FFN_W = ((8 * D_MODEL // 3 + 127) // 128) * 128
FFN_K = 3
EPS = 1e-6
GN_EPS = HEAD_SIZE * 1e-5
RWKV_COLS = 3 * RWKV_W + DECAY_LORA + AAA_LORA + GATE_LORA
IN_COLS = RWKV_COLS + 3 * CONV_W
RWKV_SPLITS = (RWKV_W, 2 * RWKV_W, 3 * RWKV_W, 3 * RWKV_W + DECAY_LORA, 3 * RWKV_W + DECAY_LORA + AAA_LORA)

kernel_name = 'hymba_rwkv7_shortconv_convffn_memxattn_step'


def rmsnorm(x, g):
    xf = x.astype(jnp.float32)
    y = xf * lax.rsqrt(jnp.mean(xf * xf, axis=-1, keepdims=True) + EPS)
    return (y * g.astype(jnp.float32)).astype(x.dtype)


def causal_dwconv(u, prev, w):
    K = w.shape[0]
    T = u.shape[1]
    ext = jnp.concatenate([prev.astype(u.dtype), u], axis=1)
    out = w[0] * ext[:, 0:T]
    for j in range(1, K):
        out = out + w[j] * ext[:, j:j + T]
    return out, ext[:, -(K - 1):]


def wkv_scan(S0, r, decay, k, v, a, b):
    def step(S, inp):
        r_t, d_t, k_t, v_t, a_t, b_t = inp
        Sa = jnp.einsum('bhvk,bhk->bhv', S, a_t)
        S = S * d_t[:, :, None, :] + Sa[..., :, None] * b_t[..., None, :] + v_t[..., :, None] * k_t[..., None, :]
        return S, jnp.einsum('bhvk,bhk->bhv', S, r_t)
    xs = tuple(jnp.swapaxes(t, 0, 1) for t in (r, decay, k, v, a, b))
    S, ys = lax.scan(step, S0, xs)
    return S, jnp.swapaxes(ys, 0, 1)


def rwkv7_group(p_cur, p_prev, S0, v_first, l, P):
    B, T, _ = p_cur.shape
    f32 = jnp.float32
    p_shift = jnp.concatenate([p_prev.astype(p_cur.dtype), p_cur[:, :-1]], axis=1)
    z = p_cur + (p_shift - p_cur) * P['mu_shift'][l]
    r, k, v, wl, al, gl = jnp.split(z, RWKV_SPLITS, axis=-1)
    w = -jax.nn.softplus(-(P['w0'][l] + jnp.tanh(wl) @ P['w2'][l]).astype(f32)) - 0.5
    decay = jnp.exp(-jnp.exp(w))
    a = jax.nn.sigmoid((P['a0'][l] + al @ P['a2'][l]).astype(f32))
    g = jax.nn.sigmoid(gl) @ P['g2'][l]
    if v_first is None:
        v_first = v
    else:
        vmix = jax.nn.sigmoid(P['v0'][l - 1] + (v @ P['v1'][l - 1]) @ P['v2'][l - 1])
        v = v + (v_first - v) * vmix
    hs = lambda t: t.reshape(B, T, N_RWKV_HEADS, HEAD_SIZE).astype(f32)
    ph = lambda t: t.reshape(N_RWKV_HEADS, HEAD_SIZE).astype(f32)
    r_h, k_h, v_h, a_h, d_h = hs(r), hs(k), hs(v), hs(a), hs(decay)
    kk = k_h * ph(P['k_k'][l])
    kk = kk / jnp.maximum(jnp.sqrt(jnp.sum(kk * kk, axis=-1, keepdims=True)), 1e-12)
    k_h = k_h * (1.0 + (a_h - 1.0) * ph(P['k_a'][l]))
    S, y = wkv_scan(S0.astype(f32), r_h, d_h, k_h, v_h, -kk, kk * a_h)
    mean = jnp.mean(y, axis=-1, keepdims=True)
    var = jnp.mean(jnp.square(y - mean), axis=-1, keepdims=True)
    y = (y - mean) * lax.rsqrt(var + GN_EPS) * ph(P['ln_x_w'][l]) + ph(P['ln_x_b'][l])
    y = y + jnp.sum(r_h * k_h * ph(P['r_k'][l]), axis=-1, keepdims=True) * v_h
    out = y.reshape(B, T, RWKV_W).astype(p_cur.dtype) * g
    return out, S, v_first


def layer(x, l, mem_k, mem_v, shift_prev, wkv_prev, conv_prev, ffn_prev, v_first, P):
    B, T, _ = x.shape
    xn = rmsnorm(x, P['norm_mix'][l])
    w_in = P['w_in'][l]
    proj = xn @ w_in
    p_rwkv, p_conv = proj[..., :RWKV_COLS], proj[..., RWKV_COLS:]
    p_prev = (shift_prev.astype(xn.dtype) @ w_in[:, :RWKV_COLS])[:, None, :]
    y_a, wkv_new, v_first = rwkv7_group(p_rwkv, p_prev, wkv_prev, v_first, l, P)
    gate_b, gate_c, h_in = jnp.split(p_conv, 3, axis=-1)
    conv_out, conv_new = causal_dwconv(gate_c * h_in, conv_prev, P['conv_w'][l])
    y_b = gate_b * conv_out
    x = x + jnp.concatenate([y_a, y_b], axis=-1) @ P['w_out'][l]
    xq = rmsnorm(x, P['norm_x'][l])
    q = (xq @ P['wq'][l]).reshape(B, T, N_XHEADS, XHEAD_DIM)
    s = jnp.einsum('bthd,bmhd->bhtm', q, mem_k.astype(q.dtype)).astype(jnp.float32) * (XHEAD_DIM ** -0.5)
    p = jax.nn.softmax(s, axis=-1).astype(x.dtype)
    o = jnp.einsum('bhtm,bmhd->bthd', p, mem_v.astype(x.dtype)).reshape(B, T, D_MODEL)
    x = x + o @ P['wo'][l]
    xf = rmsnorm(x, P['norm_ffn'][l])
    up = xf @ P['w_up'][l]
    upc, ffn_new = causal_dwconv(up, ffn_prev, P['ffn_conv_w'][l])
    u, gt = jnp.split(upc, 2, axis=-1)
    x = x + (jax.nn.silu(gt) * u) @ P['w_down'][l]
    return x, xn[:, -1], wkv_new, conv_new, ffn_new, v_first


def trunk(x, mem_k, mem_v, shift0, wkv0, conv0, ffn0, P):
    v_first = None
    shs, wks, cvs, ffs = [], [], [], []
    for l in range(DEPTH):
        x, sh, S, cs, fs, v_first = layer(x, l, mem_k[l], mem_v[l], shift0[l], wkv0[l], conv0[l], ffn0[l], v_first, P)
        shs.append(sh)
        wks.append(S)
        cvs.append(cs)
        ffs.append(fs)
    y = rmsnorm(x, P['norm_final'])
    return y, jnp.stack(shs), jnp.stack(wks), jnp.stack(cvs), jnp.stack(ffs)


def setup_inputs(seed: int = 0) -> dict:
    key = jax.random.key(seed)
    ks = iter(jax.random.split(key, 48))
    nrm = lambda shape, scale: jax.random.normal(next(ks), shape, jnp.float32) * scale
    L = DEPTH
    D = D_MODEL
    H, N = N_RWKV_HEADS, HEAD_SIZE
    d = {}
    d['x_prompt'] = nrm((BATCH, SEQ, D), 1.0)
    d['x_sample'] = nrm((DEC_BATCH, DEC_SEQ, D), 1.0)
    d['mem_prompt'] = nrm((BATCH, N_MEM, D), 1.0)
    d['state_shift'] = nrm((L, DEC_BATCH, D), 1.0)
    d['state_wkv'] = nrm((L, DEC_BATCH, H, N, N), 0.3)
    d['state_conv'] = nrm((L, DEC_BATCH, CONV_K - 1, CONV_W), 1.0)
    d['state_ffn'] = nrm((L, DEC_BATCH, FFN_K - 1, 2 * FFN_W), 1.0)
    d['cache_mem_k'] = nrm((L, DEC_BATCH, N_MEM, N_XHEADS, XHEAD_DIM), 1.0)
    d['cache_mem_v'] = nrm((L, DEC_BATCH, N_MEM, N_XHEADS, XHEAD_DIM), 1.0)
    d['norm_mix'] = 1.0 + nrm((L, D), 0.02)
    d['w_in'] = nrm((L, D, IN_COLS), D ** -0.5)
    d['mu_shift'] = jax.random.uniform(next(ks), (L, RWKV_COLS), jnp.float32)
    d['w0'] = jax.random.uniform(next(ks), (L, RWKV_W), jnp.float32, -2.0, 1.0)
    d['w2'] = nrm((L, DECAY_LORA, RWKV_W), 0.1)
    d['a0'] = nrm((L, RWKV_W), 0.1)
    d['a2'] = nrm((L, AAA_LORA, RWKV_W), 0.1)
    d['g2'] = nrm((L, GATE_LORA, RWKV_W), GATE_LORA ** -0.5)
    d['v0'] = nrm((L - 1, RWKV_W), 0.1)
    d['v1'] = nrm((L - 1, RWKV_W, MV_LORA), RWKV_W ** -0.5)
    d['v2'] = nrm((L - 1, MV_LORA, RWKV_W), 0.1)
    d['k_k'] = 0.85 + nrm((L, RWKV_W), 0.02)
    d['k_a'] = 1.0 + nrm((L, RWKV_W), 0.02)
    d['r_k'] = nrm((L, RWKV_W), 0.1)
    d['ln_x_w'] = 1.0 + nrm((L, RWKV_W), 0.02)
    d['ln_x_b'] = nrm((L, RWKV_W), 0.02)
    d['conv_w'] = nrm((L, CONV_K, CONV_W), CONV_K ** -0.5)
    d['w_out'] = nrm((L, MIX_W, D), MIX_W ** -0.5)
    d['norm_x'] = 1.0 + nrm((L, D), 0.02)
    d['norm_mem'] = 1.0 + nrm((L, D), 0.02)
    d['wq'] = nrm((L, D, D), D ** -0.5)
    d['wk'] = nrm((L, D, D), D ** -0.5)
    d['wv'] = nrm((L, D, D), D ** -0.5)
    d['wo'] = nrm((L, D, D), D ** -0.5)
    d['norm_ffn'] = 1.0 + nrm((L, D), 0.02)
    d['w_up'] = nrm((L, D, 2 * FFN_W), D ** -0.5)
    d['ffn_conv_w'] = nrm((L, FFN_K, 2 * FFN_W), FFN_K ** -0.5)
    d['w_down'] = nrm((L, FFN_W, D), FFN_W ** -0.5)
    d['norm_final'] = 1.0 + nrm((D,), 0.02)
    return d


def reference(x_prompt, x_sample, mem_prompt, state_shift, state_wkv, state_conv, state_ffn,
              cache_mem_k, cache_mem_v, norm_mix, w_in, mu_shift, w0, w2, a0, a2, g2, v0, v1, v2,
              k_k, k_a, r_k, ln_x_w, ln_x_b, conv_w, w_out, norm_x, norm_mem, wq, wk, wv, wo,
              norm_ffn, w_up, ffn_conv_w, w_down, norm_final):
    P = dict(norm_mix=norm_mix, w_in=w_in, mu_shift=mu_shift, w0=w0, w2=w2, a0=a0, a2=a2, g2=g2,
             v0=v0, v1=v1, v2=v2, k_k=k_k, k_a=k_a, r_k=r_k, ln_x_w=ln_x_w, ln_x_b=ln_x_b,
             conv_w=conv_w, w_out=w_out, norm_x=norm_x, wq=wq, wo=wo, norm_ffn=norm_ffn,
             w_up=w_up, ffn_conv_w=ffn_conv_w, w_down=w_down, norm_final=norm_final)
    Bp, Mp = mem_prompt.shape[0], mem_prompt.shape[1]
    mks, mvs = [], []
    for l in range(DEPTH):
        mn = rmsnorm(mem_prompt, norm_mem[l])
        mks.append((mn @ wk[l]).reshape(Bp, Mp, N_XHEADS, XHEAD_DIM))
        mvs.append((mn @ wv[l]).reshape(Bp, Mp, N_XHEADS, XHEAD_DIM))
    mem_k_p = jnp.stack(mks)
    mem_v_p = jnp.stack(mvs)
    dt = x_prompt.dtype
    shift0 = jnp.zeros((DEPTH, Bp, D_MODEL), dt)
    wkv0 = jnp.zeros((DEPTH, Bp, N_RWKV_HEADS, HEAD_SIZE, HEAD_SIZE), jnp.float32)
    conv0 = jnp.zeros((DEPTH, Bp, CONV_K - 1, CONV_W), dt)
    ffn0 = jnp.zeros((DEPTH, Bp, FFN_K - 1, 2 * FFN_W), dt)
    y_prompt, shift_p, wkv_p, conv_p, ffn_p = trunk(x_prompt, mem_k_p, mem_v_p, shift0, wkv0, conv0, ffn0, P)
    y_sample, shift_s, wkv_s, conv_s, ffn_s = trunk(x_sample, cache_mem_k, cache_mem_v, state_shift, state_wkv, state_conv, state_ffn, P)
    return (y_prompt, y_sample, shift_p, wkv_p, conv_p, ffn_p, mem_k_p, mem_v_p, shift_s, wkv_s, conv_s, ffn_s)
```

```cpp
#include <hip/hip_runtime.h>
#include <hip/hip_cooperative_groups.h>
#include <cstdio>
#include <cstdint>
namespace cg = cooperative_groups;

#ifndef PH_MASK
#define PH_MASK 0xFFFFF
#endif
#define PHON(k) (((PH_MASK) >> (k)) & 1)
#ifndef REP_MASK
#define REP_MASK 0
#endif
#ifndef MK_PER_PHASE
#define MK_PER_PHASE 0
#endif

#define LAS __attribute__((address_space(3)))
typedef unsigned short bf16_t;
typedef short bf16x8 __attribute__((ext_vector_type(8)));
typedef float f32x4 __attribute__((ext_vector_type(4)));
typedef unsigned u32x4 __attribute__((ext_vector_type(4)));
typedef unsigned u32x2 __attribute__((ext_vector_type(2)));
#define LDS_WAIT() asm volatile("s_waitcnt lgkmcnt(0)" ::: "memory")

constexpr int D = 1024, NB = 8, TT = 2048, MP = NB * TT, NS = 128, MTOK = MP + NS, MROWS = 16640;
constexpr int INC = 3328, LDP = 3584, FW = 2816, FW2 = 5632, NMEM = 256, MMEM = NB * NMEM;
constexpr float EPS = 1e-6f, GN_EPS = 64e-5f;
constexpr int NPHASE = 26;
constexpr int LDS_BYTES = 147456;

constexpr size_t O_YP = 0, O_YS = 16777216, O_SHP = 16908288, O_WKVP = 16924672, O_CONVP = 17448960, O_FFNP = 17465344,
                 O_MKP = 17645568, O_MVP = 21839872, O_SHS = 26034176, O_WKVS = 26296320, O_CONVS = 34684928, O_FFNS = 34947072;

constexpr size_t al256(size_t x) { return (x + 255) & ~(size_t)255; }
constexpr size_t OFF_SS = 0;
constexpr size_t OFF_SSM = al256(OFF_SS + (size_t)7 * MROWS * 4);
constexpr size_t OFF_WIN = al256(OFF_SSM + 2048 * 4);
constexpr size_t OFF_WOUT = OFF_WIN + (size_t)2 * LDP * D * 2;
constexpr size_t OFF_WQ = OFF_WOUT + (size_t)2 * D * D * 2;
constexpr size_t OFF_WK = OFF_WQ + (size_t)2 * D * D * 2;
constexpr size_t OFF_WV = OFF_WK + (size_t)2 * D * D * 2;
constexpr size_t OFF_WO = OFF_WV + (size_t)2 * D * D * 2;
constexpr size_t OFF_WUP = OFF_WO + (size_t)2 * D * D * 2;
constexpr size_t OFF_WDN = OFF_WUP + (size_t)2 * FW2 * D * 2;
constexpr size_t OFF_W2 = OFF_WDN + (size_t)2 * D * FW * 2;
constexpr size_t OFF_A2 = OFF_W2 + (size_t)2 * 512 * 64 * 2;
constexpr size_t OFF_G2 = OFF_A2 + (size_t)2 * 512 * 64 * 2;
constexpr size_t OFF_V1 = OFF_G2 + (size_t)2 * 512 * 128 * 2;
constexpr size_t OFF_V2 = OFF_V1 + (size_t)32 * 512 * 2;
constexpr size_t OFF_X = al256(OFF_V2 + (size_t)512 * 32 * 2);
constexpr size_t OFF_XB = OFF_X + (size_t)MROWS * D * 4;
constexpr size_t OFF_MNB = OFF_XB + (size_t)MROWS * D * 2;
constexpr size_t OFF_MK = OFF_MNB + (size_t)MMEM * D * 2;
constexpr size_t OFF_MVT = OFF_MK + (size_t)2 * MMEM * D * 2;
constexpr size_t OFF_PROJ = OFF_MVT + (size_t)2 * MMEM * D * 2;
constexpr size_t OFF_H = OFF_PROJ;
constexpr size_t SCN = (size_t)MTOK * 512 * 4;
constexpr size_t OFF_SA = OFF_PROJ + (size_t)MROWS * LDP * 2;
constexpr size_t OFF_SB = OFF_SA + SCN, OFF_SD = OFF_SB + SCN, OFF_SK = OFF_SD + SCN, OFF_SRD = OFF_SK + SCN, OFF_G = OFF_SRD + SCN;
constexpr size_t OFF_UP = OFF_SA;
constexpr size_t OFF_SV0 = OFF_G + SCN, OFF_SV1 = OFF_SV0 + SCN;
constexpr size_t OFF_SBR = OFF_SV1 + SCN;
constexpr size_t OFF_SKR = OFF_SBR + (size_t)MTOK * 8 * 4, OFF_RKR = OFF_SKR + (size_t)MTOK * 8 * 4;
constexpr size_t OFF_Y = al256(OFF_RKR + (size_t)MTOK * 8 * 4);
constexpr size_t OFF_YAB = OFF_Y + SCN;
constexpr size_t OFF_Q = OFF_YAB + (size_t)MROWS * D * 2;
constexpr size_t OFF_P = OFF_Q + (size_t)MROWS * D * 2;
constexpr size_t OFF_O = OFF_P + (size_t)MROWS * D * 2;
constexpr size_t OFF_BAR = OFF_O + (size_t)MROWS * D * 2;
constexpr size_t BAR_BYTES = 16384;
constexpr size_t WS_END = OFF_BAR + BAR_BYTES;
static_assert((size_t)MROWS * FW2 * 2 <= 6 * SCN, "UP overlay");
static_assert((size_t)MROWS * FW * 2 <= (size_t)MROWS * LDP * 2, "H overlay");
static_assert(WS_END < (size_t)1050000000, "workspace");

__device__ __forceinline__ unsigned f2bf(float f) { unsigned u = __builtin_bit_cast(unsigned, f); return (u + 0x7fffu + ((u >> 16) & 1u)) >> 16; }
__device__ __forceinline__ unsigned pk2(float lo, float hi) { return f2bf(lo) | (f2bf(hi) << 16); }
__device__ __forceinline__ unsigned cvt_pk_bf16(float lo, float hi) { unsigned r; asm volatile("v_cvt_pk_bf16_f32 %0, %1, %2" : "=v"(r) : "v"(lo), "v"(hi)); return r; }
__device__ __forceinline__ float bflo(unsigned w) { return __builtin_bit_cast(float, w << 16); }
__device__ __forceinline__ float bfhi(unsigned w) { return __builtin_bit_cast(float, w & 0xffff0000u); }
__device__ __forceinline__ float wave_sum(float v) {
#pragma unroll
    for (int o = 1; o < 64; o <<= 1) v += __shfl_xor(v, o);
    return v;
}
__device__ __forceinline__ float wave_max(float v) {
#pragma unroll
    for (int o = 1; o < 64; o <<= 1) v = fmaxf(v, __shfl_xor(v, o));
    return v;
}
__device__ __forceinline__ float sigmoidf_(float x) { return 1.f / (1.f + __expf(-x)); }
__device__ __forceinline__ void unpack8(u32x4 w, float* f) { f[0] = bflo(w.x); f[1] = bfhi(w.x); f[2] = bflo(w.y); f[3] = bfhi(w.y); f[4] = bflo(w.z); f[5] = bfhi(w.z); f[6] = bflo(w.w); f[7] = bfhi(w.w); }
template <int CTRL> __device__ __forceinline__ float dppf(float v) { return __builtin_bit_cast(float, __builtin_amdgcn_update_dpp(0, __builtin_bit_cast(int, v), CTRL, 0xF, 0xF, true)); }
__device__ __forceinline__ float red16(float v) { v += dppf<0xB1>(v); v += dppf<0x4E>(v); v += dppf<0x124>(v); v += dppf<0x128>(v); return v; }

namespace pg8 {
constexpr int BM = 256, BK = 64, HALF = 128, HTB = HALF * BK * 2, STAGE_BYTES = 8 * HTB, NXCD = 8, WGM = 8;
__host__ __device__ __forceinline__ int lds_byte(int r, int c) { const int st = (r >> 4) * 2 + (c >> 5), rr = r & 15, cc = c & 31, ob = rr * 64 + cc * 2; return st * 1024 + (ob ^ (((ob >> 9) & 1) << 5)); }
__host__ __device__ __forceinline__ void stage_rc(int b, int& R, int& C) { const int st = b / 1024, sb = b % 1024, swz = sb ^ (((sb >> 9) & 1) << 5); R = (st >> 1) * 16 + swz / 64; C = (st & 1) * 32 + (swz % 64) / 2; }
__host__ __device__ __forceinline__ int perm32(int rho) { const int n = rho >> 4, i = rho & 15; return 8 * (i >> 2) + 4 * n + (i & 3); }

struct Unit { int pm, pn; size_t offA, offB; };
struct Gemm { const bf16_t* A; const bf16_t* Bt; int lda, ldb, K; };

struct GenOrder {
    int mode, nM, nN, nwg, G, c; size_t sA, sB;
    __device__ void init(int mode_, int M, int N, int lda, int ldb, int G_, int c_) { mode = mode_; nM = M / BM; nN = N / BM; nwg = nM * nN; G = G_; c = c_; sA = (size_t)BM * lda * 2; sB = (size_t)BM * ldb * 2; }
    __device__ bool next(int i, Unit& u) const {
        const long L = (long)i * G + c; if (L >= nwg) return false;
        if (mode == 0) {
            int wgid = (int)L; { const int q = nwg / NXCD, r = nwg % NXCD, xcd = wgid % NXCD, off = wgid / NXCD; wgid = (xcd < r ? xcd * (q + 1) : r * (q + 1) + (xcd - r) * q) + off; }
            const int nig = WGM * nN, gid = wgid / nig, fm = gid * WGM, gsz = (nM - fm) < WGM ? (nM - fm) : WGM;
            u.pm = fm + ((wgid % nig) % gsz); u.pn = (wgid % nig) / gsz; u.offA = (size_t)u.pm * sA; u.offB = (size_t)u.pn * sB;
        } else {
            const int b = (int)L >> 5, qb = ((int)L >> 2) & 7, h = (int)L & 3;
            u.pm = b * 8 + qb; u.pn = h;
            u.offA = ((size_t)(b * 2048 + qb * 256) * 1024 + h * 256) * 2;
            u.offB = mode == 1 ? ((size_t)(b * 256) * 1024 + h * 256) * 2 : ((size_t)(b * 4 + h) * 256 * 256) * 2;
        }
        return true;
    }
};

template <class Epi, class Sched, bool ALIGN_EPI>
__device__ __forceinline__ void gemm_phase(LAS unsigned char* lds, const Gemm g, const Sched& S, const Epi& E) {
    int tid = threadIdx.x; asm volatile("" : "+v"(tid));
    const int wid = __builtin_amdgcn_readfirstlane(tid >> 6), lane = tid & 63, wr = wid >> 2, wc = wid & 3, fr = lane & 15, fq = lane >> 4;
    const int K = g.K, nt = K / BK;
    unsigned voffA[2], voffB[2];
#pragma unroll
    for (int i = 0; i < 2; ++i) { int R, C; stage_rc(tid * 16 + i * 8192, R, C); const int Rb = Epi::PERM ? ((R & ~31) + perm32(R & 31)) : R;
        voffA[i] = (unsigned)(R * g.lda + C) * 2u; voffB[i] = (unsigned)(Rb * g.ldb + C) * 2u; }
    const size_t kstep = (size_t)(BK * 2);
    const size_t hstepA = (size_t)HALF * g.lda * 2, hstepB = (size_t)HALF * g.ldb * 2;
    const unsigned ldsw = (unsigned)wid * 1024u;
    const int aoff = lds_byte(wr * 64 + fr, fq * 8), boff = lds_byte(wc * 32 + fr, fq * 8);
#define PG8_SA(b, h) (((b) * 2 + (h)) * HTB)
#define PG8_SB(b, h) ((4 + (b) * 2 + (h)) * HTB)
#define PG8_STAGE(bufoff, gbase, voff) do { _Pragma("unroll") for (int _i = 0; _i < 2; ++_i) \
        __builtin_amdgcn_global_load_lds((const unsigned*)((const char*)(gbase) + (voff)[_i]), (LAS unsigned*)(lds + (bufoff) + ldsw + _i * 8192), 16, 0, 0); } while (0)
#define PG8_LDA(dst, b, h) do { _Pragma("unroll") for (int m = 0; m < 4; ++m) _Pragma("unroll") for (int k = 0; k < 2; ++k) dst[m][k] = *(const LAS bf16x8*)(lds + PG8_SA(b, h) + aoff + m * 2048 + k * 1024); } while (0)
#define PG8_LDB(dst, b, h) do { _Pragma("unroll") for (int n = 0; n < 2; ++n) _Pragma("unroll") for (int k = 0; k < 2; ++k) dst[n][k] = *(const LAS bf16x8*)(lds + PG8_SB(b, h) + boff + n * 2048 + k * 1024); } while (0)
#define PG8_MMA(ai, bj, At, Bt) do { __builtin_amdgcn_s_setprio(1); _Pragma("unroll") for (int m = 0; m < 4; ++m) _Pragma("unroll") for (int n = 0; n < 2; ++n) _Pragma("unroll") for (int k = 0; k < 2; ++k) \
        acc[ai][bj][m][n] = __builtin_amdgcn_mfma_f32_16x16x32_bf16(Bt[n][k], At[m][k], acc[ai][bj][m][n], 0, 0, 0); __builtin_amdgcn_s_setprio(0); } while (0)
#define PG8_WAIT_V(n) asm volatile("s_waitcnt vmcnt(" #n ")" ::: "memory")
#define PG8_WAIT_L(n) asm volatile("s_waitcnt lgkmcnt(" #n ")" ::: "memory")
#define PG8_BAR __builtin_amdgcn_s_barrier()
#define PG8_SCHED __builtin_amdgcn_sched_barrier(0)
    Unit cur, nxt; int ui = 0;
    if (!S.next(0, cur)) return;
    f32x4 acc[2][2][4][2];
#pragma unroll
    for (int a = 0; a < 2; ++a)
#pragma unroll
        for (int b = 0; b < 2; ++b)
#pragma unroll
            for (int m = 0; m < 4; ++m)
#pragma unroll
                for (int n = 0; n < 2; ++n) acc[a][b][m][n] = (f32x4){0.f, 0.f, 0.f, 0.f};
    bf16x8 At[4][2], B0[2][2], B1[2][2];
    const char* cA = (const char*)g.A + cur.offA; const char* cB = (const char*)g.Bt + cur.offB;
    PG8_STAGE(PG8_SB(0, 0), cB, voffB); PG8_STAGE(PG8_SB(0, 1), cB + hstepB, voffB); PG8_STAGE(PG8_SA(0, 0), cA, voffA); PG8_STAGE(PG8_SA(0, 1), cA + hstepA, voffA);
    if (wr == 1) PG8_BAR;
    PG8_WAIT_V(2); PG8_BAR;
    PG8_STAGE(PG8_SB(1, 0), cB + kstep, voffB); PG8_STAGE(PG8_SA(1, 0), cA + kstep, voffA); PG8_STAGE(PG8_SB(1, 1), cB + hstepB + kstep, voffB);
    PG8_WAIT_V(6); PG8_BAR;
    for (;;) {
        const bool has_next = S.next(ui + 1, nxt);
        const char* nA = has_next ? (const char*)g.A + nxt.offA : cA; const char* nB = has_next ? (const char*)g.Bt + nxt.offB : cB;
        for (int t = 0; t < nt; t += 2) {
            const bool last = (t == nt - 2);
            const char* a1 = cA + (size_t)(t + 1) * kstep;
            const char* a2 = last ? nA : cA + (size_t)(t + 2) * kstep; const char* b2 = last ? nB : cB + (size_t)(t + 2) * kstep;
            const char* a3 = a2 + kstep; const char* b3 = b2 + kstep;
            PG8_LDB(B0, 0, 0); PG8_LDB(B1, 0, 1); PG8_SCHED; PG8_LDA(At, 0, 0); PG8_STAGE(PG8_SA(1, 1), a1 + hstepA, voffA);
            PG8_WAIT_V(8); PG8_WAIT_L(0); PG8_BAR; PG8_MMA(0, 0, At, B0); PG8_MMA(0, 1, At, B1); PG8_BAR; PG8_SCHED;
            PG8_LDA(At, 0, 1); PG8_STAGE(PG8_SB(0, 0), b2, voffB); PG8_STAGE(PG8_SB(0, 1), b2 + hstepB, voffB); PG8_STAGE(PG8_SA(0, 0), a2, voffA);
            PG8_WAIT_V(8); PG8_WAIT_L(0); PG8_BAR; PG8_MMA(1, 0, At, B0); PG8_MMA(1, 1, At, B1); PG8_BAR; PG8_SCHED;
            PG8_LDB(B0, 1, 0); PG8_LDB(B1, 1, 1); PG8_SCHED; PG8_LDA(At, 1, 0); PG8_STAGE(PG8_SA(0, 1), a2 + hstepA, voffA);
            PG8_WAIT_V(8); PG8_WAIT_L(0); PG8_BAR; PG8_MMA(0, 0, At, B0); PG8_MMA(0, 1, At, B1); PG8_BAR; PG8_SCHED;
            PG8_LDA(At, 1, 1); PG8_STAGE(PG8_SB(1, 0), b3, voffB); PG8_STAGE(PG8_SB(1, 1), b3 + hstepB, voffB); PG8_STAGE(PG8_SA(1, 0), a3, voffA);
            PG8_WAIT_V(8); PG8_WAIT_L(0); PG8_BAR; PG8_MMA(1, 0, At, B0); PG8_MMA(1, 1, At, B1); PG8_BAR; PG8_SCHED;
        }
        if constexpr (ALIGN_EPI) { if (wr == 0) PG8_BAR; }
        if constexpr (!Epi::AFTER_DRAIN) { E(acc, cur, wr, wc, fr, fq); }
        if (!has_next) break;
#pragma unroll
        for (int a = 0; a < 2; ++a)
#pragma unroll
            for (int b = 0; b < 2; ++b)
#pragma unroll
                for (int m = 0; m < 4; ++m)
#pragma unroll
                    for (int n = 0; n < 2; ++n) acc[a][b][m][n] = (f32x4){0.f, 0.f, 0.f, 0.f};
        cur = nxt; cA = nA; cB = nB; ++ui;
        if constexpr (ALIGN_EPI) { if (wr == 1) PG8_BAR; }
    }
    PG8_WAIT_V(0);
    if constexpr (!ALIGN_EPI) { if (wr == 0) PG8_BAR; }
    PG8_BAR;
    if constexpr (Epi::AFTER_DRAIN) { E.fused(acc, cur, wr, wc, fr, fq, lds, wid, lane); }
#undef PG8_SA
#undef PG8_SB
#undef PG8_STAGE
#undef PG8_LDA
#undef PG8_LDB
#undef PG8_MMA
#undef PG8_WAIT_V
#undef PG8_WAIT_L
#undef PG8_BAR
#undef PG8_SCHED
}

struct Epi {
    static constexpr bool PERM = true, AFTER_DRAIN = false;
    int mode;
    bf16_t* O; int ldc;
    const float* ss;
    float* X;
    float* ssn;
    float* F;
    int l; int dry;
    __device__ __forceinline__ void operator()(const f32x4 (&acc)[2][2][4][2], const Unit& u, int wr, int wc, int fr, int fq) const {
        const int row0 = u.pm * 256 + wr * 64 + fr, col0 = u.pn * 256 + wc * 32 + 8 * fq;
        if (dry) return;
        if (mode == 1) {
#pragma unroll
            for (int ai = 0; ai < 2; ++ai)
#pragma unroll
                for (int m = 0; m < 4; ++m) {
                    const int row = row0 + ai * 128 + m * 16; const bool valid = row < MTOK; float sq = 0.f;
#pragma unroll
                    for (int bj = 0; bj < 2; ++bj) {
                        const size_t idx = (size_t)row * 1024 + col0 + bj * 128;
                        if (valid) {
                            f32x4 x0 = *(const f32x4*)(X + idx) + acc[ai][bj][m][0], x1 = *(const f32x4*)(X + idx + 4) + acc[ai][bj][m][1];
                            *(f32x4*)(X + idx) = x0; *(f32x4*)(X + idx + 4) = x1;
                            sq += (x0[0] * x0[0] + x0[1] * x0[1]) + (x0[2] * x0[2] + x0[3] * x0[3]) + (x1[0] * x1[0] + x1[1] * x1[1]) + (x1[2] * x1[2] + x1[3] * x1[3]);
                            u32x4 w; w.x = cvt_pk_bf16(x0[0], x0[1]); w.y = cvt_pk_bf16(x0[2], x0[3]); w.z = cvt_pk_bf16(x1[0], x1[1]); w.w = cvt_pk_bf16(x1[2], x1[3]);
                            *(u32x4*)(O + idx) = w;
                        }
                    }
                    sq += __shfl_xor(sq, 16); sq += __shfl_xor(sq, 32);
                    if (valid && fq == 0) atomicAdd(ssn + row, sq);
                }
        } else {
#pragma unroll
            for (int ai = 0; ai < 2; ++ai)
#pragma unroll
                for (int m = 0; m < 4; ++m) {
                    const int row = row0 + ai * 128 + m * 16;
                    float rs = 1.f;
                    if (ss != nullptr && (mode == 2 || mode == 3 || row < MTOK)) rs = rsqrtf(ss[row] * (1.f / 1024.f) + EPS);
#pragma unroll
                    for (int bj = 0; bj < 2; ++bj) {
                        const int col = col0 + bj * 128;
                        const f32x4 v0 = acc[ai][bj][m][0] * rs, v1 = acc[ai][bj][m][1] * rs;
                        u32x4 w; w.x = cvt_pk_bf16(v0[0], v0[1]); w.y = cvt_pk_bf16(v0[2], v0[3]); w.z = cvt_pk_bf16(v1[0], v1[1]); w.w = cvt_pk_bf16(v1[2], v1[3]);
                        if (mode == 3) {
                            const int b = row >> 8, mem = row & 255;
                            bf16_t* o = O + ((size_t)(b * 1024 + col)) * 256 + mem;
                            o[0] = (bf16_t)(w.x & 0xffff); o[256] = (bf16_t)(w.x >> 16); o[512] = (bf16_t)(w.y & 0xffff); o[768] = (bf16_t)(w.y >> 16);
                            o[1024] = (bf16_t)(w.z & 0xffff); o[1280] = (bf16_t)(w.z >> 16); o[1536] = (bf16_t)(w.w & 0xffff); o[1792] = (bf16_t)(w.w >> 16);
                        } else {
                            *(u32x4*)(O + (size_t)row * ldc + col) = w;
                        }
                        if (mode == 2 || mode == 3) { float* f = F + (size_t)row * 1024 + col; *(f32x4*)f = v0; *(f32x4*)(f + 4) = v1; }
                        if (mode == 4) {
                            float* f = nullptr;
                            if (row < MP) { const int t = row & 2047; if (t >= 2046) f = F + O_FFNP + ((size_t)((l * 8 + (row >> 11)) * 2 + (t - 2046))) * FW2 + col; }
                            else if (row < MTOK) f = F + O_FFNS + ((size_t)((l * 128 + (row - MP)) * 2 + 1)) * FW2 + col;
                            if (f) { *(f32x4*)f = v0; *(f32x4*)(f + 4) = v1; }
                        }
                    }
                }
        }
    }
};

struct EpiSm {
    static constexpr bool PERM = true, AFTER_DRAIN = true;
    bf16_t* P;
    __device__ __forceinline__ void operator()(const f32x4 (&)[2][2][4][2], const Unit&, int, int, int, int) const {}
    __device__ __forceinline__ void fused(f32x4 (&acc)[2][2][4][2], const Unit& u, int wr, int wc, int fr, int fq, LAS unsigned char* lds, int wid, int lane) const {
        LAS float* red = (LAS float*)lds; LAS float* red2 = red + 1024;
        float mx[2][4];
#pragma unroll
        for (int ai = 0; ai < 2; ++ai)
#pragma unroll
            for (int m = 0; m < 4; ++m) {
                float v = -3.0e38f;
#pragma unroll
                for (int bj = 0; bj < 2; ++bj)
#pragma unroll
                    for (int n = 0; n < 2; ++n) { const f32x4 x = acc[ai][bj][m][n]; v = fmaxf(v, fmaxf(fmaxf(x[0], x[1]), fmaxf(x[2], x[3]))); }
                v = fmaxf(v, __shfl_xor(v, 16)); v = fmaxf(v, __shfl_xor(v, 32));
                if (fq == 0) red[(ai * 128 + wr * 64 + m * 16 + fr) * 4 + wc] = v;
            }
        __syncthreads();
#pragma unroll
        for (int ai = 0; ai < 2; ++ai)
#pragma unroll
            for (int m = 0; m < 4; ++m) {
                const f32x4 r = *(const LAS f32x4*)(red + (ai * 128 + wr * 64 + m * 16 + fr) * 4);
                const float M = fmaxf(fmaxf(r[0], r[1]), fmaxf(r[2], r[3])); mx[ai][m] = M;
                float s = 0.f;
#pragma unroll
                for (int bj = 0; bj < 2; ++bj)
#pragma unroll
                    for (int n = 0; n < 2; ++n) { f32x4 x = acc[ai][bj][m][n];
                        x[0] = __expf(x[0] - M); x[1] = __expf(x[1] - M); x[2] = __expf(x[2] - M); x[3] = __expf(x[3] - M); acc[ai][bj][m][n] = x; s += (x[0] + x[1]) + (x[2] + x[3]); }
                s += __shfl_xor(s, 16); s += __shfl_xor(s, 32);
                if (fq == 0) red2[(ai * 128 + wr * 64 + m * 16 + fr) * 4 + wc] = s;
            }
        __syncthreads();
#pragma unroll
        for (int ai = 0; ai < 2; ++ai)
#pragma unroll
            for (int m = 0; m < 4; ++m) {
                const int rl = ai * 128 + wr * 64 + m * 16 + fr;
                const f32x4 r = *(const LAS f32x4*)(red2 + rl * 4);
                const float inv = 1.f / ((r[0] + r[1]) + (r[2] + r[3]));
#pragma unroll
                for (int bj = 0; bj < 2; ++bj) {
                    const f32x4 v0 = acc[ai][bj][m][0] * inv, v1 = acc[ai][bj][m][1] * inv;
                    u32x4 w; w.x = cvt_pk_bf16(v0[0], v0[1]); w.y = cvt_pk_bf16(v0[2], v0[3]); w.z = cvt_pk_bf16(v1[0], v1[1]); w.w = cvt_pk_bf16(v1[2], v1[3]);
                    *(u32x4*)(P + (size_t)(u.pm * 256 + rl) * 1024 + u.pn * 256 + bj * 128 + wc * 32 + 8 * fq) = w;
                }
            }
        (void)mx; (void)wid; (void)lane;
    }
};
}

struct Args { const float* in[38]; float* out; unsigned char* ws; int ph_lo, ph_hi; };
enum { I_XP = 0, I_XS, I_MEM, I_SSHIFT, I_SWKV, I_SCONV, I_SFFN, I_CK, I_CV, I_NMIX, I_WIN, I_MU, I_W0, I_W2, I_A0, I_A2, I_G2, I_V0, I_V1, I_V2,
       I_KK, I_KA, I_RK, I_LNW, I_LNB, I_CONVW, I_WOUT, I_NX, I_NMEM, I_WQ, I_WK, I_WV, I_WO, I_NFFN, I_WUP, I_FCW, I_WDN, I_NFIN };

__device__ __forceinline__ void tr_item(const float* W, int K, int N, bf16_t* WT, const float* gain, float scale, LAS float* scr, int item, int lane) {
    const int nblk = N / 32, kb = item / nblk, nb = item % nblk, k0 = 64 * kb, n0 = 32 * nb;
#pragma unroll
    for (int i = 0; i < 8; ++i) { const int kk = 8 * i + (lane >> 3); const float gk = gain ? gain[k0 + kk] * scale : scale;
        const f32x4 v = *(const f32x4*)(W + (size_t)(k0 + kk) * N + n0 + (lane & 7) * 4) * gk;
        LAS float* d = scr + kk * 33 + (lane & 7) * 4; d[0] = v[0]; d[1] = v[1]; d[2] = v[2]; d[3] = v[3]; }
    LDS_WAIT();
    const int c = lane & 7;
#pragma unroll
    for (int j = 0; j < 4; ++j) { const int n = (lane >> 3) + 8 * j; const LAS float* s = scr + (8 * c) * 33 + n;
        u32x4 o; o.x = pk2(s[0 * 33], s[1 * 33]); o.y = pk2(s[2 * 33], s[3 * 33]); o.z = pk2(s[4 * 33], s[5 * 33]); o.w = pk2(s[6 * 33], s[7 * 33]);
        *(u32x4*)(WT + (size_t)(n0 + n) * K + k0 + 8 * c) = o; }
    LDS_WAIT();
}

constexpr int TR_NL = 8512;
__device__ __forceinline__ void tr_dispatch(const Args& a, unsigned char* ws, int l, int r, LAS float* scr, int lane) {
    constexpr int I_IN_ = 16 * 104, I_SQ_ = 16 * 32, I_UP_ = 16 * 176, I_DN_ = 44 * 32, I_L64 = 16;
    if (r < I_IN_) { tr_item(a.in[I_WIN] + (size_t)l * D * INC, D, INC, (bf16_t*)(ws + OFF_WIN) + (size_t)l * LDP * D, a.in[I_NMIX] + l * D, 1.f, scr, r, lane); return; } r -= I_IN_;
    if (r < I_SQ_) { tr_item(a.in[I_WOUT] + (size_t)l * D * D, D, D, (bf16_t*)(ws + OFF_WOUT) + (size_t)l * D * D, nullptr, 1.f, scr, r, lane); return; } r -= I_SQ_;
    if (r < I_SQ_) { tr_item(a.in[I_WQ] + (size_t)l * D * D, D, D, (bf16_t*)(ws + OFF_WQ) + (size_t)l * D * D, a.in[I_NX] + l * D, 0.0625f, scr, r, lane); return; } r -= I_SQ_;
    if (r < I_SQ_) { tr_item(a.in[I_WK] + (size_t)l * D * D, D, D, (bf16_t*)(ws + OFF_WK) + (size_t)l * D * D, a.in[I_NMEM] + l * D, 1.f, scr, r, lane); return; } r -= I_SQ_;
    if (r < I_SQ_) { tr_item(a.in[I_WV] + (size_t)l * D * D, D, D, (bf16_t*)(ws + OFF_WV) + (size_t)l * D * D, a.in[I_NMEM] + l * D, 1.f, scr, r, lane); return; } r -= I_SQ_;
    if (r < I_SQ_) { tr_item(a.in[I_WO] + (size_t)l * D * D, D, D, (bf16_t*)(ws + OFF_WO) + (size_t)l * D * D, nullptr, 1.f, scr, r, lane); return; } r -= I_SQ_;
    if (r < I_UP_) { tr_item(a.in[I_WUP] + (size_t)l * D * FW2, D, FW2, (bf16_t*)(ws + OFF_WUP) + (size_t)l * FW2 * D, a.in[I_NFFN] + l * D, 1.f, scr, r, lane); return; } r -= I_UP_;
    if (r < I_DN_) { tr_item(a.in[I_WDN] + (size_t)l * FW * D, FW, D, (bf16_t*)(ws + OFF_WDN) + (size_t)l * D * FW, nullptr, 1.f, scr, r, lane); return; } r -= I_DN_;
    if (r < I_L64) { tr_item(a.in[I_W2] + (size_t)l * 64 * 512, 64, 512, (bf16_t*)(ws + OFF_W2) + (size_t)l * 512 * 64, nullptr, 1.f, scr, r, lane); return; } r -= I_L64;
    if (r < I_L64) { tr_item(a.in[I_A2] + (size_t)l * 64 * 512, 64, 512, (bf16_t*)(ws + OFF_A2) + (size_t)l * 512 * 64, nullptr, 1.f, scr, r, lane); return; } r -= I_L64;
    tr_item(a.in[I_G2] + (size_t)l * 128 * 512, 128, 512, (bf16_t*)(ws + OFF_G2) + (size_t)l * 512 * 128, nullptr, 1.f, scr, r, lane);
}
constexpr int TR_DEFERRED = TR_NL + 5760;
__device__ __forceinline__ void tr_deferred(const Args& a, unsigned char* ws, int d, LAS float* scr, int lane) {
    if (d < TR_NL) { tr_dispatch(a, ws, 1, d, scr, lane); return; }
    const int e = d - TR_NL;
    const int r = e < 1024 ? 1664 + e : (e < 1536 ? 3712 + (e - 1024) : 4224 + (e - 1536));
    tr_dispatch(a, ws, 0, r, scr, lane);
}

__device__ __forceinline__ void p0_prologue(LAS unsigned char* lds, const Args& a, int tid, int lane, int wave, int gw, int NGW) {
    unsigned char* ws = a.ws;
    LAS float* scr = (LAS float*)(lds + wave * 16384);
    for (int it = gw; it < 1664 + 1024 + 64; it += NGW) {
        const int r = it < 1664 ? it : (it < 2688 ? 2688 + (it - 1664) : 8448 + (it - 2688));
        tr_dispatch(a, ws, 0, r, scr, lane);
    }
    float* X = (float*)(ws + OFF_X); bf16_t* XB = (bf16_t*)(ws + OFF_XB); float* SS = (float*)(ws + OFF_SS);
    bf16_t* MNB = (bf16_t*)(ws + OFF_MNB); float* SSM = (float*)(ws + OFF_SSM);
    for (int m = gw; m < MROWS + MMEM; m += NGW) {
        const float* src; bf16_t* dstb; float* dstx = nullptr; float* dss = nullptr; bool shiftrow = false;
        if (m < MP) { src = a.in[I_XP] + (size_t)m * D; dstb = XB + (size_t)m * D; dstx = X + (size_t)m * D; dss = SS + m; }
        else if (m < MTOK) { src = a.in[I_XS] + (size_t)(m - MP) * D; dstb = XB + (size_t)m * D; dstx = X + (size_t)m * D; dss = SS + m; }
        else if (m < MROWS) { src = a.in[I_SSHIFT] + (size_t)(m - MTOK) * D; dstb = XB + (size_t)m * D; shiftrow = true; }
        else { src = a.in[I_MEM] + (size_t)(m - MROWS) * D; dstb = MNB + (size_t)(m - MROWS) * D; dss = SSM + (m - MROWS); }
        float s = 0.f;
#pragma unroll
        for (int j = 0; j < 4; ++j) {
            f32x4 v = *(const f32x4*)(src + 4 * lane + 256 * j);
            if (shiftrow) { const f32x4 gn = *(const f32x4*)(a.in[I_NMIX] + 4 * lane + 256 * j); v[0] /= gn[0]; v[1] /= gn[1]; v[2] /= gn[2]; v[3] /= gn[3]; }
            s += (v[0] * v[0] + v[1] * v[1]) + (v[2] * v[2] + v[3] * v[3]);
            if (dstx) *(f32x4*)(dstx + 4 * lane + 256 * j) = v;
            u32x2 w; w.x = pk2(v[0], v[1]); w.y = pk2(v[2], v[3]);
            *(u32x2*)(dstb + 4 * lane + 256 * j) = w;
        }
        s = wave_sum(s);
        if (dss && lane == 0) *dss = s;
    }
    if (blockIdx.x * 8 < D) {
        __syncthreads();
        LAS float* M = (LAS float*)lds;
        const float* muv = a.in[I_MU] + 1792 + 1024; const float* v1 = a.in[I_V1];
#pragma unroll 8
        for (int i = tid; i < 512 * 64; i += 512) { const int c = i >> 6, o = i & 63; const float mv = muv[c]; M[i] = ((o >> 5) ? mv : 1.f - mv) * v1[c * 32 + (o & 31)]; }
        __syncthreads();
        for (int k = gw; k < D; k += NGW) {
            const float* wrow = a.in[I_WIN] + (size_t)1 * D * INC + (size_t)k * INC + 1024;
            float acc = 0.f;
#pragma unroll 4
            for (int c = 0; c < 512; c += 4) {
                const f32x4 w4 = *(const f32x4*)(wrow + c);
                acc += w4[0] * M[c * 64 + lane] + w4[1] * M[(c + 1) * 64 + lane] + w4[2] * M[(c + 2) * 64 + lane] + w4[3] * M[(c + 3) * 64 + lane];
            }
            ((bf16_t*)(ws + OFF_WIN))[(size_t)1 * LDP * D + (size_t)(INC + lane) * D + k] = (bf16_t)f2bf(acc * a.in[I_NMIX][D + k]);
        }
    }
    const int gt = blockIdx.x * 512 + tid, NGT = gridDim.x * 512;
    for (int i = gt; i < 6 * MROWS; i += NGT) SS[MROWS + i] = 0.f;
    bf16_t* V2T = (bf16_t*)(ws + OFF_V2);
    for (int i = gt; i < 512 * 32; i += NGT) { const int n = i >> 5, k = i & 31; V2T[i] = (bf16_t)f2bf(a.in[I_V2][k * 512 + n]); }
}

__device__ __forceinline__ const bf16_t* prev_row(const bf16_t* PROJ, int m) {
    if (m < MP) { if ((m & 2047) == 0) return nullptr; return PROJ + (size_t)(m - 1) * LDP; }
    return PROJ + (size_t)(m + NS) * LDP;
}
__device__ __forceinline__ void mix4(const bf16_t* cur, const bf16_t* prv, const float* mu, int col, float* z) {
    const u32x2 c = *(const u32x2*)(cur + col); const f32x4 m4 = *(const f32x4*)(mu + col);
    float cf[4] = {bflo(c.x), bfhi(c.x), bflo(c.y), bfhi(c.y)}; float pf[4] = {0.f, 0.f, 0.f, 0.f};
    if (prv) { const u32x2 p = *(const u32x2*)(prv + col); pf[0] = bflo(p.x); pf[1] = bfhi(p.x); pf[2] = bflo(p.y); pf[3] = bfhi(p.y); }
#pragma unroll
    for (int j = 0; j < 4; ++j) z[j] = cf[j] + (pf[j] - cf[j]) * m4[j];
}
__device__ __forceinline__ void mix8(const bf16_t* cur, const bf16_t* prv, const float* mu, int col, float* z) {
    const u32x4 c = *(const u32x4*)(cur + col); float cf[8], pf[8]; unpack8(c, cf);
#pragma unroll
    for (int j = 0; j < 8; ++j) pf[j] = 0.f;
    if (prv) { const u32x4 p = *(const u32x4*)(prv + col); unpack8(p, pf); }
    const f32x4 m0 = *(const f32x4*)(mu + col), m1 = *(const f32x4*)(mu + col + 4);
#pragma unroll
    for (int j = 0; j < 4; ++j) { z[j] = cf[j] + (pf[j] - cf[j]) * m0[j]; z[4 + j] = cf[4 + j] + (pf[4 + j] - cf[4 + j]) * m1[j]; }
}

__device__ __forceinline__ float fsig(float x) { return __builtin_amdgcn_rcpf(1.f + __expf(-x)); }
__device__ __forceinline__ void mixw(u32x2 c, u32x2 p, const LAS float* mu, float* z) {
    const f32x4 m4 = *(const LAS f32x4*)mu;
    const float cf[4] = {bflo(c.x), bfhi(c.x), bflo(c.y), bfhi(c.y)}, pf[4] = {bflo(p.x), bfhi(p.x), bflo(p.y), bfhi(p.y)};
#pragma unroll
    for (int j = 0; j < 4; ++j) z[j] = cf[j] + (pf[j] - cf[j]) * m4[j];
}
__device__ __forceinline__ void prep_phase(LAS unsigned char* lds, const Args& a, int l, int tid, int lane, int wave, int gw) {
    unsigned char* ws = a.ws;
    const bf16_t* PROJ = (const bf16_t*)(ws + OFF_PROJ);
    const float* mu = a.in[I_MU] + l * 1792;
    if (gw < NB + NS) {
        const int row = gw < NB ? gw * 2048 + 2047 : MP + (gw - NB);
        float* dst = gw < NB ? a.out + O_SHP + (size_t)(l * NB + gw) * D : a.out + O_SHS + (size_t)(l * NS + (gw - NB)) * D;
        const float* X = (const float*)(ws + OFF_X) + (size_t)row * D;
        const float rs = rsqrtf(((const float*)(ws + OFF_SS))[3 * l * MROWS + row] * (1.f / 1024.f) + EPS);
#pragma unroll
        for (int j = 0; j < 4; ++j) { const f32x4 v = *(const f32x4*)(X + 4 * lane + 256 * j), gn = *(const f32x4*)(a.in[I_NMIX] + l * D + 4 * lane + 256 * j);
            *(f32x4*)(dst + 4 * lane + 256 * j) = v * rs * gn; }
    }
    LAS bf16_t* WL2 = (LAS bf16_t*)lds;
    LAS bf16_t* WLA = (LAS bf16_t*)(lds + 18432);
    LAS bf16_t* WLG = (LAS bf16_t*)(lds + 36864);
    LAS bf16_t* WLV = (LAS bf16_t*)(lds + 71680);
    LAS float* PAR = (LAS float*)(lds + 81920);
    LAS bf16_t* LA = (LAS bf16_t*)(lds + 88064);
    LAS bf16_t* LW = (LAS bf16_t*)(lds + 121856);
    const int hp = blockIdx.x & 3;
    {
        const bf16_t* W2T = (const bf16_t*)(ws + OFF_W2) + (size_t)l * 512 * 64 + (size_t)hp * 128 * 64;
        const bf16_t* A2T = (const bf16_t*)(ws + OFF_A2) + (size_t)l * 512 * 64 + (size_t)hp * 128 * 64;
        const bf16_t* G2T = (const bf16_t*)(ws + OFF_G2) + (size_t)l * 512 * 128 + (size_t)hp * 128 * 128;
        const bf16_t* V2T = (const bf16_t*)(ws + OFF_V2) + (size_t)hp * 128 * 32;
#pragma unroll
        for (int q = 0; q < 2; ++q) { const int i = tid + 512 * q, n = i >> 3, c = (i & 7) * 8;
            *(LAS u32x4*)(WL2 + n * 72 + c) = *(const u32x4*)(W2T + n * 64 + c); *(LAS u32x4*)(WLA + n * 72 + c) = *(const u32x4*)(A2T + n * 64 + c); }
#pragma unroll
        for (int q = 0; q < 4; ++q) { const int i = tid + 512 * q, n = i >> 4, c = (i & 15) * 8; *(LAS u32x4*)(WLG + n * 136 + c) = *(const u32x4*)(G2T + n * 128 + c); }
        { const int n = tid >> 2, c = (tid & 3) * 8; *(LAS u32x4*)(WLV + n * 40 + c) = *(const u32x4*)(V2T + n * 32 + c); }
        if (tid < 128) {
            const int ch = hp * 128 + tid;
            PAR[tid] = a.in[I_W0][l * 512 + ch]; PAR[128 + tid] = a.in[I_A0][l * 512 + ch]; PAR[256 + tid] = a.in[I_KK][l * 512 + ch]; PAR[384 + tid] = a.in[I_KA][l * 512 + ch];
            PAR[512 + tid] = a.in[I_RK][l * 512 + ch]; PAR[640 + tid] = l == 1 ? a.in[I_V0][ch] : 0.f; PAR[768 + tid] = mu[ch]; PAR[896 + tid] = mu[512 + ch]; PAR[1024 + tid] = mu[1024 + ch];
        }
    }
    float* SA = (float*)(ws + OFF_SA); float* SB = (float*)(ws + OFF_SB); float* SD = (float*)(ws + OFF_SD); float* SK = (float*)(ws + OFF_SK);
    float* SRD = (float*)(ws + OFF_SRD); float* GG = (float*)(ws + OFF_G); float* SV = (float*)(ws + (l == 0 ? OFF_SV0 : OFF_SV1));
    const float* SV0 = (const float*)(ws + OFF_SV0);
    float* SBR = (float*)(ws + OFF_SBR); float* SKR = (float*)(ws + OFF_SKR); float* RKR = (float*)(ws + OFF_RKR);
    const int mt = wave & 3, hh = wave >> 2, h = hp * 2 + hh, fr = lane & 15, fq = lane >> 4;
    constexpr int NTILE = MTOK / 64;
    for (int tile = blockIdx.x >> 2; tile < NTILE; tile += gridDim.x >> 2) {
        const int m0 = tile * 64;
        {
            u32x4 cu[4], pv[4];
#pragma unroll
            for (int q = 0; q < 4; ++q) {
                const int row = (tid >> 5) + 16 * q, ch = tid & 31, m = m0 + row;
                const bf16_t* prv = prev_row(PROJ, m);
                cu[q] = *(const u32x4*)(PROJ + (size_t)m * LDP + 1536 + ch * 8);
                pv[q] = prv ? *(const u32x4*)(prv + 1536 + ch * 8) : (u32x4){0u, 0u, 0u, 0u};
            }
            u32x2 vc = (u32x2){0u, 0u}, vp = vc;
            if (l == 1) {
                const int m = m0 + (tid >> 3), j4 = (tid & 7) * 4; const bf16_t* prv = prev_row(PROJ, m);
                vc = *(const u32x2*)(PROJ + (size_t)m * LDP + INC + j4); if (prv) vp = *(const u32x2*)(prv + INC + 32 + j4);
            }
            const int ch = tid & 31;
            const f32x4 m0v = *(const f32x4*)(mu + 1536 + ch * 8), m1v = *(const f32x4*)(mu + 1536 + ch * 8 + 4);
#pragma unroll
            for (int q = 0; q < 4; ++q) {
                const int row = (tid >> 5) + 16 * q;
                float cf[8], pf[8], z[8]; unpack8(cu[q], cf); unpack8(pv[q], pf);
#pragma unroll
                for (int j = 0; j < 4; ++j) { z[j] = cf[j] + (pf[j] - cf[j]) * m0v[j]; z[4 + j] = cf[4 + j] + (pf[4 + j] - cf[4 + j]) * m1v[j]; }
                if (ch < 8) {
#pragma unroll
                    for (int j = 0; j < 8; ++j) z[j] = 2.f * fsig(2.f * z[j]) - 1.f;
                } else if (ch >= 16) {
#pragma unroll
                    for (int j = 0; j < 8; ++j) z[j] = fsig(z[j]);
                }
                u32x4 w; w.x = pk2(z[0], z[1]); w.y = pk2(z[2], z[3]); w.z = pk2(z[4], z[5]); w.w = pk2(z[6], z[7]);
                *(LAS u32x4*)(LA + row * 264 + ch * 8) = w;
            }
            if (l == 1) {
                u32x2 w; w.x = pk2(bflo(vc.x) + bflo(vp.x), bfhi(vc.x) + bfhi(vp.x)); w.y = pk2(bflo(vc.y) + bflo(vp.y), bfhi(vc.y) + bfhi(vp.y));
                *(LAS u32x2*)(LW + (tid >> 3) * 40 + (tid & 7) * 4) = w;
            }
        }
        __syncthreads();
        const int m = m0 + mt * 16 + fr;
        const bf16_t* cur = PROJ + (size_t)m * LDP; const bf16_t* prv = prev_row(PROJ, m);
        u32x2 cR[4], cK[4], cV[4], pR[4], pK[4], pV[4]; f32x4 vf[4];
#pragma unroll
        for (int nt = 0; nt < 4; ++nt) {
            const int ch = h * 64 + nt * 16 + fq * 4;
            cR[nt] = *(const u32x2*)(cur + ch); cK[nt] = *(const u32x2*)(cur + 512 + ch); cV[nt] = *(const u32x2*)(cur + 1024 + ch);
            pR[nt] = (u32x2){0u, 0u}; pK[nt] = pR[nt]; pV[nt] = pR[nt];
            if (prv) { pR[nt] = *(const u32x2*)(prv + ch); pK[nt] = *(const u32x2*)(prv + 512 + ch); pV[nt] = *(const u32x2*)(prv + 1024 + ch); }
            vf[nt] = (f32x4){0.f, 0.f, 0.f, 0.f};
            if (l == 1) vf[nt] = *(const f32x4*)(SV0 + (size_t)m * 512 + ch);
        }
        float ssq = 0.f;
#pragma unroll
        for (int nt = 0; nt < 4; ++nt) {
            const int cl = hh * 64 + nt * 16 + fq * 4; float kz[4]; mixw(cK[nt], pK[nt], PAR + 896 + cl, kz);
            const f32x4 kk4 = *(const LAS f32x4*)(PAR + 256 + cl);
#pragma unroll
            for (int j = 0; j < 4; ++j) { const float kk = kz[j] * kk4[j]; ssq += kk * kk; }
        }
        ssq += __shfl_xor(ssq, 16); ssq += __shfl_xor(ssq, 32);
        const float inv = 1.f / fmaxf(sqrtf(ssq), 1e-12f);
        float br = 0.f, kr = 0.f, rkr = 0.f;
#pragma unroll
        for (int nt = 0; nt < 4; ++nt) {
            const int cl = hh * 64 + nt * 16 + fq * 4, ch = h * 64 + nt * 16 + fq * 4, nl = hh * 64 + nt * 16 + fr;
            f32x4 dl = (f32x4){0.f, 0.f, 0.f, 0.f}, al = dl, gl = dl, vm = dl;
            bf16x8 af[8];
#pragma unroll
            for (int ks = 0; ks < 8; ++ks) af[ks] = *(const LAS bf16x8*)(LA + (mt * 16 + fr) * 264 + ks * 32 + fq * 8);
            const bf16x8 avv = *(const LAS bf16x8*)(LW + (mt * 16 + fr) * 40 + fq * 8);
#pragma unroll
            for (int ks = 0; ks < 2; ++ks) {
                dl = __builtin_amdgcn_mfma_f32_16x16x32_bf16(*(const LAS bf16x8*)(WL2 + nl * 72 + ks * 32 + fq * 8), af[ks], dl, 0, 0, 0);
                al = __builtin_amdgcn_mfma_f32_16x16x32_bf16(*(const LAS bf16x8*)(WLA + nl * 72 + ks * 32 + fq * 8), af[2 + ks], al, 0, 0, 0);
            }
#pragma unroll
            for (int ks = 0; ks < 4; ++ks) gl = __builtin_amdgcn_mfma_f32_16x16x32_bf16(*(const LAS bf16x8*)(WLG + nl * 136 + ks * 32 + fq * 8), af[4 + ks], gl, 0, 0, 0);
            if (l == 1) vm = __builtin_amdgcn_mfma_f32_16x16x32_bf16(*(const LAS bf16x8*)(WLV + nl * 40 + fq * 8), avv, vm, 0, 0, 0);
            float rz[4], kz[4], vz[4];
            mixw(cR[nt], pR[nt], PAR + 768 + cl, rz); mixw(cK[nt], pK[nt], PAR + 896 + cl, kz); mixw(cV[nt], pV[nt], PAR + 1024 + cl, vz);
            const f32x4 w0 = *(const LAS f32x4*)(PAR + cl), a0 = *(const LAS f32x4*)(PAR + 128 + cl), kk4 = *(const LAS f32x4*)(PAR + 256 + cl);
            const f32x4 ka4 = *(const LAS f32x4*)(PAR + 384 + cl), rk4 = *(const LAS f32x4*)(PAR + 512 + cl), v04 = *(const LAS f32x4*)(PAR + 640 + cl);
            f32x4 oa, ob, od, ok, ord_, ov;
#pragma unroll
            for (int j = 0; j < 4; ++j) {
                const float dcy = __expf(-0.60653065971f * fsig(w0[j] + dl[j]));
                const float av_ = fsig(a0[j] + al[j]);
                float vj = vz[j];
                if (l == 1) { const float vmix = fsig(v04[j] + vm[j]); vj = vj + (vf[nt][j] - vj) * vmix; }
                const float kk = kz[j] * kk4[j] * inv, k2 = kz[j] * (1.f + (av_ - 1.f) * ka4[j]);
                oa[j] = -kk; ob[j] = kk * av_; od[j] = dcy; ok[j] = k2; ord_[j] = rz[j] * dcy; ov[j] = vj;
                br += ob[j] * rz[j]; kr += k2 * rz[j]; rkr += rz[j] * k2 * rk4[j];
            }
            const size_t o = (size_t)m * 512 + ch;
            *(f32x4*)(SA + o) = oa; *(f32x4*)(SB + o) = ob; *(f32x4*)(SD + o) = od; *(f32x4*)(SK + o) = ok; *(f32x4*)(SRD + o) = ord_; *(f32x4*)(SV + o) = ov; *(f32x4*)(GG + o) = gl;
            __builtin_amdgcn_sched_barrier(0);
        }
        br += __shfl_xor(br, 16); br += __shfl_xor(br, 32); kr += __shfl_xor(kr, 16); kr += __shfl_xor(kr, 32); rkr += __shfl_xor(rkr, 16); rkr += __shfl_xor(rkr, 32);
        if (fq == 0) { SBR[m * 8 + h] = br; SKR[m * 8 + h] = kr; RKR[m * 8 + h] = rkr; }
        __syncthreads();
    }
}

__device__ __forceinline__ void convB_token(const Args& a, int l, int m, int lane) {
    unsigned char* ws = a.ws;
    const bf16_t* __restrict__ PROJ = (const bf16_t*)(ws + OFF_PROJ);
    bf16_t* __restrict__ YAB = (bf16_t*)(ws + OFF_YAB);
    const int cb = lane * 8;
        const bf16_t* pr = PROJ + (size_t)m * LDP;
        float gb[8], gc[8], hi[8], u0[8], u1[8], u2[8];
        unpack8(*(const u32x4*)(pr + 1792 + cb), gb); unpack8(*(const u32x4*)(pr + 2304 + cb), gc); unpack8(*(const u32x4*)(pr + 2816 + cb), hi);
#pragma unroll
        for (int j = 0; j < 8; ++j) { u0[j] = gc[j] * hi[j]; u1[j] = 0.f; u2[j] = 0.f; }
        if (m < MP) {
            const int t = m & 2047;
            if (t >= 1) { unpack8(*(const u32x4*)(pr - LDP + 2304 + cb), gc); unpack8(*(const u32x4*)(pr - LDP + 2816 + cb), hi);
#pragma unroll
                for (int j = 0; j < 8; ++j) u1[j] = gc[j] * hi[j]; }
            if (t >= 2) { unpack8(*(const u32x4*)(pr - 2 * LDP + 2304 + cb), gc); unpack8(*(const u32x4*)(pr - 2 * LDP + 2816 + cb), hi);
#pragma unroll
                for (int j = 0; j < 8; ++j) u2[j] = gc[j] * hi[j]; }
            if (t >= 2046) { float* dst = a.out + O_CONVP + (size_t)((l * NB + (m >> 11)) * 2 + (t - 2046)) * 512 + cb;
                *(f32x4*)dst = (f32x4){u0[0], u0[1], u0[2], u0[3]}; *(f32x4*)(dst + 4) = (f32x4){u0[4], u0[5], u0[6], u0[7]}; }
        } else {
            const int i = m - MP; const float* sc = a.in[I_SCONV] + (size_t)(l * NS + i) * 2 * 512 + cb;
            const f32x4 a0 = *(const f32x4*)sc, a1 = *(const f32x4*)(sc + 4), b0 = *(const f32x4*)(sc + 512), b1 = *(const f32x4*)(sc + 516);
#pragma unroll
            for (int j = 0; j < 4; ++j) { u2[j] = a0[j]; u2[4 + j] = a1[j]; u1[j] = b0[j]; u1[4 + j] = b1[j]; }
            float* dst = a.out + O_CONVS + (size_t)(l * NS + i) * 2 * 512 + cb;
            *(f32x4*)dst = b0; *(f32x4*)(dst + 4) = b1;
            *(f32x4*)(dst + 512) = (f32x4){u0[0], u0[1], u0[2], u0[3]}; *(f32x4*)(dst + 516) = (f32x4){u0[4], u0[5], u0[6], u0[7]};
        }
        const float* cw = a.in[I_CONVW] + (size_t)l * 3 * 512 + cb;
        float ob[8];
#pragma unroll
        for (int j = 0; j < 8; ++j) ob[j] = gb[j] * (cw[j] * u2[j] + cw[512 + j] * u1[j] + cw[1024 + j] * u0[j]);
        u32x4 w2; w2.x = pk2(ob[0], ob[1]); w2.y = pk2(ob[2], ob[3]); w2.z = pk2(ob[4], ob[5]); w2.w = pk2(ob[6], ob[7]);
        *(u32x4*)(YAB + (size_t)m * 1024 + 512 + cb) = w2;
}

typedef float f32x2 __attribute__((ext_vector_type(2)));
__device__ __forceinline__ float scan_step(float (&s)[4], const f32x4 av, const f32x4 bv, const f32x4 dv, const f32x4 kv, const f32x4 rd, float vi, float br, float kr) {
    f32x2 s01 = (f32x2){s[0], s[1]}, s23 = (f32x2){s[2], s[3]};
    f32x2 t = s01 * (f32x2){av[0], av[1]}; t = __builtin_elementwise_fma(s23, (f32x2){av[2], av[3]}, t);
    f32x2 u = s01 * (f32x2){rd[0], rd[1]}; u = __builtin_elementwise_fma(s23, (f32x2){rd[2], rd[3]}, u);
    float pa = t.x + t.y, py = u.x + u.y;
    pa = red16(pa); py = red16(py);
    const f32x2 pav = (f32x2){pa, pa}, viv = (f32x2){vi, vi};
    f32x2 w01 = (f32x2){kv[0], kv[1]} * viv; w01 = __builtin_elementwise_fma((f32x2){bv[0], bv[1]}, pav, w01);
    f32x2 w23 = (f32x2){kv[2], kv[3]} * viv; w23 = __builtin_elementwise_fma((f32x2){bv[2], bv[3]}, pav, w23);
    s01 = __builtin_elementwise_fma(s01, (f32x2){dv[0], dv[1]}, w01);
    s23 = __builtin_elementwise_fma(s23, (f32x2){dv[2], dv[3]}, w23);
    s[0] = s01.x; s[1] = s01.y; s[2] = s23.x; s[3] = s23.y;
    return py + pa * br + vi * kr;
}

__device__ __forceinline__ void scan_phase(LAS unsigned char* lds, const Args& a, int l, int tid, int lane, int wave) {
    unsigned char* ws = a.ws;
    const float* SA = (const float*)(ws + OFF_SA); const float* SB = (const float*)(ws + OFF_SB); const float* SD = (const float*)(ws + OFF_SD); const float* SK = (const float*)(ws + OFF_SK);
    const float* SRD = (const float*)(ws + OFF_SRD); const float* SV = (const float*)(ws + (l == 0 ? OFF_SV0 : OFF_SV1));
    const float* SBR = (const float*)(ws + OFF_SBR); const float* SKR = (const float*)(ws + OFF_SKR);
    float* Y = (float*)(ws + OFF_Y);
    constexpr int TC = 32, CB = 5 * TC * 64 + TC * 16 + 2 * TC;
    LAS float* L = (LAS float*)lds;
    const int j4 = lane >> 4, c = lane & 15;
    for (int ci = blockIdx.x; ci < 256; ci += gridDim.x) {
        const int hc = ci >> 2, rg = ci & 3, b = hc >> 3, h = hc & 7;
        const int st = tid >> 4, c16 = tid & 15;
        const int rl = (wave & 3) * 4 + j4;
        float s[4] = {0.f, 0.f, 0.f, 0.f};
        f32x4 pa, pb, pd, pk, pr; float pv, ps = 0.f;
        {
            const size_t m = (size_t)b * 2048 + st; const size_t o = m * 512 + h * 64 + c16 * 4;
            pa = *(const f32x4*)(SA + o); pb = *(const f32x4*)(SB + o); pd = *(const f32x4*)(SD + o); pk = *(const f32x4*)(SK + o); pr = *(const f32x4*)(SRD + o);
            pv = SV[m * 512 + h * 64 + rg * 16 + c16];
            if (tid < 32) ps = SBR[((size_t)b * 2048 + tid) * 8 + h]; else if (tid < 64) ps = SKR[((size_t)b * 2048 + tid - 32) * 8 + h];
        }
        {
            LAS float* B0 = L;
            *(LAS f32x4*)(B0 + st * 64 + c16 * 4) = pa; *(LAS f32x4*)(B0 + 2048 + st * 64 + c16 * 4) = pb; *(LAS f32x4*)(B0 + 4096 + st * 64 + c16 * 4) = pd;
            *(LAS f32x4*)(B0 + 6144 + st * 64 + c16 * 4) = pk; *(LAS f32x4*)(B0 + 8192 + st * 64 + c16 * 4) = pr; B0[10240 + st * 16 + c16] = pv;
            if (tid < 64) B0[10752 + tid] = ps;
        }
        __syncthreads();
        for (int n = 0; n < TT / TC; ++n) {
            LAS float* Bc = L + (n & 1) * CB; LAS float* Bn = L + ((n + 1) & 1) * CB; LAS float* yb = L + 2 * CB + (n & 1) * 512;
            const bool more = n + 1 < TT / TC;
            if (more) {
                const size_t m = (size_t)b * 2048 + (n + 1) * TC + st; const size_t o = m * 512 + h * 64 + c16 * 4;
                pa = *(const f32x4*)(SA + o); pb = *(const f32x4*)(SB + o); pd = *(const f32x4*)(SD + o); pk = *(const f32x4*)(SK + o); pr = *(const f32x4*)(SRD + o);
                pv = SV[m * 512 + h * 64 + rg * 16 + c16];
                if (tid < 32) ps = SBR[((size_t)b * 2048 + (n + 1) * TC + tid) * 8 + h]; else if (tid < 64) ps = SKR[((size_t)b * 2048 + (n + 1) * TC + tid - 32) * 8 + h];
            }
            if (wave < 4) {
                LAS float* ybase = (c == 0) ? (yb + rl) : (L + 2 * CB + 1024 + lane);
                const LAS float* p0 = Bc + c * 4;
                f32x4 av = *(const LAS f32x4*)p0, bv = *(const LAS f32x4*)(p0 + 2048), dv = *(const LAS f32x4*)(p0 + 4096), kv = *(const LAS f32x4*)(p0 + 6144), rd = *(const LAS f32x4*)(p0 + 8192);
                float vi = Bc[10240 + rl], br = Bc[10752], kr = Bc[10784];
#pragma unroll 8
                for (int t = 0; t < TC; ++t) {
                    const int tn = (t + 1 < TC) ? t + 1 : t;
                    const LAS float* p = Bc + tn * 64 + c * 4;
                    const f32x4 av2 = *(const LAS f32x4*)p, bv2 = *(const LAS f32x4*)(p + 2048), dv2 = *(const LAS f32x4*)(p + 4096), kv2 = *(const LAS f32x4*)(p + 6144), rd2 = *(const LAS f32x4*)(p + 8192);
                    const float vi2 = Bc[10240 + tn * 16 + rl], br2 = Bc[10752 + tn], kr2 = Bc[10784 + tn];
                    const float y = scan_step(s, av, bv, dv, kv, rd, vi, br, kr);
                    ybase[t * 16] = y;
                    av = av2; bv = bv2; dv = dv2; kv = kv2; rd = rd2; vi = vi2; br = br2; kr = kr2;
                }
            }
            else {
                const int hw4 = wave - 4;
                if (l == 0 && n < 14) {
                    const int d = (blockIdx.x * 4 + hw4) + 1024 * n;
                    if (d < TR_DEFERRED) tr_deferred(a, ws, d, (LAS float*)(lds + 94208 + hw4 * 8448), lane);
                } else if (n >= 24 && n < 41) {
                    const int tt = (n - 24) * 4 + hw4;
                    int mB = -1;
                    if (tt < 64) mB = blockIdx.x * 64 + tt; else if (tt == 64 && blockIdx.x < NS) mB = MP + blockIdx.x;
                    if (mB >= 0) convB_token(a, l, mB, lane);
                } else if (n >= 20 && n < 24) {
                    const int q = blockIdx.x + gridDim.x * (n - 20);
                    if (q < NS * 8) {
                        const int i = q >> 3, hs = q & 7; const size_t ms = MP + i;
                        const size_t o = ms * 512 + hs * 64 + c * 4;
                        const f32x4 av = *(const f32x4*)(SA + o), bv = *(const f32x4*)(SB + o), dv = *(const f32x4*)(SD + o), kv = *(const f32x4*)(SK + o), rd = *(const f32x4*)(SRD + o);
                        const float br = SBR[ms * 8 + hs], kr = SKR[ms * 8 + hs];
                        f32x4 s4[4]; float vi[4];
#pragma unroll
                        for (int p4 = 0; p4 < 4; ++p4) {
                            const int row = p4 * 16 + hw4 * 4 + j4;
                            s4[p4] = *(const f32x4*)(a.in[I_SWKV] + ((size_t)((l * NS + i) * 8 + hs)) * 4096 + row * 64 + c * 4);
                            vi[p4] = SV[ms * 512 + hs * 64 + row];
                        }
#pragma unroll
                        for (int p4 = 0; p4 < 4; ++p4) {
                            const int row = p4 * 16 + hw4 * 4 + j4;
                            float ss_[4] = {s4[p4][0], s4[p4][1], s4[p4][2], s4[p4][3]};
                            const float y = scan_step(ss_, av, bv, dv, kv, rd, vi[p4], br, kr);
                            *(f32x4*)(a.out + O_WKVS + ((size_t)((l * NS + i) * 8 + hs)) * 4096 + row * 64 + c * 4) = (f32x4){ss_[0], ss_[1], ss_[2], ss_[3]};
                            if (c == 0) Y[ms * 512 + hs * 64 + row] = y;
                        }
                    }
                }
            }
            if (more) {
                *(LAS f32x4*)(Bn + st * 64 + c16 * 4) = pa; *(LAS f32x4*)(Bn + 2048 + st * 64 + c16 * 4) = pb; *(LAS f32x4*)(Bn + 4096 + st * 64 + c16 * 4) = pd;
                *(LAS f32x4*)(Bn + 6144 + st * 64 + c16 * 4) = pk; *(LAS f32x4*)(Bn + 8192 + st * 64 + c16 * 4) = pr; Bn[10240 + st * 16 + c16] = pv;
                if (tid < 64) Bn[10752 + tid] = ps;
            }
            __syncthreads();
            Y[((size_t)b * 2048 + n * TC + st) * 512 + h * 64 + rg * 16 + c16] = yb[st * 16 + c16];
        }
        if (wave < 4) {
            float* o = a.out + O_WKVP + ((size_t)((l * 8 + b) * 8 + h)) * 4096 + (rg * 16 + rl) * 64 + c * 4;
            *(f32x4*)o = (f32x4){s[0], s[1], s[2], s[3]};
        }
        __syncthreads();
    }
}

__device__ __forceinline__ void post_phase(const Args& a, int l, int lane, int gw, int NGW) {
    unsigned char* ws = a.ws;
    const bf16_t* __restrict__ PROJ = (const bf16_t*)(ws + OFF_PROJ);
    const float* __restrict__ Y = (const float*)(ws + OFF_Y); const float* __restrict__ SV = (const float*)(ws + (l == 0 ? OFF_SV0 : OFF_SV1)); const float* __restrict__ GG = (const float*)(ws + OFF_G);
    const float* __restrict__ RKR = (const float*)(ws + OFF_RKR);
    bf16_t* __restrict__ YAB = (bf16_t*)(ws + OFF_YAB);
    const int cb = lane * 8, h = lane >> 3;
#pragma unroll 4
    for (int m = gw; m < MTOK; m += NGW) {
        const size_t o = (size_t)m * 512 + cb;
        const f32x4 y0 = *(const f32x4*)(Y + o), y1 = *(const f32x4*)(Y + o + 4);
        float s = (y0[0] + y0[1]) + (y0[2] + y0[3]) + (y1[0] + y1[1]) + (y1[2] + y1[3]);
        s += __shfl_xor(s, 1); s += __shfl_xor(s, 2); s += __shfl_xor(s, 4);
        const float mean = s * (1.f / 64.f);
        const f32x4 d0 = y0 - mean, d1 = y1 - mean;
        float q = (d0[0] * d0[0] + d0[1] * d0[1]) + (d0[2] * d0[2] + d0[3] * d0[3]) + (d1[0] * d1[0] + d1[1] * d1[1]) + (d1[2] * d1[2] + d1[3] * d1[3]);
        q += __shfl_xor(q, 1); q += __shfl_xor(q, 2); q += __shfl_xor(q, 4);
        const float rstd = rsqrtf(q * (1.f / 64.f) + GN_EPS);
        const float rkr = RKR[m * 8 + h];
        const f32x4 v0 = *(const f32x4*)(SV + o), v1 = *(const f32x4*)(SV + o + 4), g0 = *(const f32x4*)(GG + o), g1 = *(const f32x4*)(GG + o + 4);
        const f32x4 lw0 = *(const f32x4*)(a.in[I_LNW] + l * 512 + cb), lw1 = *(const f32x4*)(a.in[I_LNW] + l * 512 + cb + 4);
        const f32x4 lb0 = *(const f32x4*)(a.in[I_LNB] + l * 512 + cb), lb1 = *(const f32x4*)(a.in[I_LNB] + l * 512 + cb + 4);
        const f32x4 r0 = (d0 * rstd * lw0 + lb0 + v0 * rkr) * g0, r1 = (d1 * rstd * lw1 + lb1 + v1 * rkr) * g1;
        u32x4 w; w.x = pk2(r0[0], r0[1]); w.y = pk2(r0[2], r0[3]); w.z = pk2(r1[0], r1[1]); w.w = pk2(r1[2], r1[3]);
        *(u32x4*)(YAB + (size_t)m * 1024 + cb) = w;
    }
    if (l + 1 < 2 && gw < NS) {
        bf16_t* XB = (bf16_t*)(ws + OFF_XB) + (size_t)(MTOK + gw) * D;
        const float* src = a.in[I_SSHIFT] + (size_t)((l + 1) * NS + gw) * D; const float* gn = a.in[I_NMIX] + (l + 1) * D;
#pragma unroll
        for (int j = 0; j < 4; ++j) { const f32x4 v = *(const f32x4*)(src + 4 * lane + 256 * j), g4 = *(const f32x4*)(gn + 4 * lane + 256 * j);
            u32x2 w; w.x = pk2(v[0] / g4[0], v[1] / g4[1]); w.y = pk2(v[2] / g4[2], v[3] / g4[3]); *(u32x2*)(XB + 4 * lane + 256 * j) = w; }
    }
}

__device__ __forceinline__ void lds_barrier() { asm volatile("s_waitcnt lgkmcnt(0)" ::: "memory"); __builtin_amdgcn_s_barrier(); asm volatile("" ::: "memory"); }
__device__ __forceinline__ void sample_attn(LAS unsigned char* lds, const Args& a, int l, int tid, int lane, int wave) {
    unsigned char* ws = a.ws;
    const bf16_t* Q = (const bf16_t*)(ws + OFF_Q); bf16_t* O = (bf16_t*)(ws + OFF_O);
    LAS float* sc = (LAS float*)lds;
    LAS float* part = sc + 256;
    int q = blockIdx.x;
    if (q >= NS * 4) return;
    f32x4 kx[8], kn[8], vx[8], vn[8];
    u32x2 qw;
    {
        const int i = q >> 2, h = q & 3;
        qw = *(const u32x2*)(Q + (size_t)(MP + i) * 1024 + h * 256 + lane * 4);
        const float* Kb = a.in[I_CK] + ((size_t)((l * NS + i) * 256) * 4 + h) * 256 + lane * 4;
#pragma unroll
        for (int e = 0; e < 8; ++e) kx[e] = __builtin_nontemporal_load((const f32x4*)(Kb + (size_t)(wave * 32 + e) * 1024));
    }
    for (; q < NS * 4; q += gridDim.x) {
        const int i = q >> 2, h = q & 3;
        const float q0 = bflo(qw.x), q1 = bfhi(qw.x), q2 = bflo(qw.y), q3 = bfhi(qw.y);
        const float* Kb = a.in[I_CK] + ((size_t)((l * NS + i) * 256) * 4 + h) * 256 + lane * 4;
        const float* Vb = a.in[I_CV] + ((size_t)((l * NS + i) * 256) * 4 + h) * 256 + lane * 4;
#pragma unroll
        for (int g8 = 0; g8 < 4; ++g8) {
            if (g8 < 3) {
#pragma unroll
                for (int e = 0; e < 8; ++e) kn[e] = __builtin_nontemporal_load((const f32x4*)(Kb + (size_t)(wave * 32 + (g8 + 1) * 8 + e) * 1024));
            } else {
#pragma unroll
                for (int e = 0; e < 8; ++e) vx[e] = __builtin_nontemporal_load((const f32x4*)(Vb + (size_t)(wave * 32 + e) * 1024));
            }
#pragma unroll
            for (int e = 0; e < 8; ++e) { float p = kx[e][0] * q0 + kx[e][1] * q1 + kx[e][2] * q2 + kx[e][3] * q3; p = wave_sum(p); if (lane == 0) sc[wave * 32 + g8 * 8 + e] = p; }
#pragma unroll
            for (int e = 0; e < 8; ++e) kx[e] = kn[e];
        }
        lds_barrier();
        if (wave == 0) {
            const f32x4 s4 = *(const LAS f32x4*)(sc + lane * 4);
            const float mx = wave_max(fmaxf(fmaxf(s4[0], s4[1]), fmaxf(s4[2], s4[3])));
            f32x4 e4; e4[0] = __expf(s4[0] - mx); e4[1] = __expf(s4[1] - mx); e4[2] = __expf(s4[2] - mx); e4[3] = __expf(s4[3] - mx);
            const float inv = 1.f / wave_sum((e4[0] + e4[1]) + (e4[2] + e4[3]));
            *(LAS f32x4*)(sc + lane * 4) = e4 * inv;
        }
        lds_barrier();
        f32x4 acc = (f32x4){0.f, 0.f, 0.f, 0.f};
        const int qn = q + gridDim.x;
#pragma unroll
        for (int g8 = 0; g8 < 4; ++g8) {
            if (g8 < 3) {
#pragma unroll
                for (int e = 0; e < 8; ++e) vn[e] = __builtin_nontemporal_load((const f32x4*)(Vb + (size_t)(wave * 32 + (g8 + 1) * 8 + e) * 1024));
            } else if (qn < NS * 4) {
                const int in_ = qn >> 2, hn = qn & 3;
                qw = *(const u32x2*)(Q + (size_t)(MP + in_) * 1024 + hn * 256 + lane * 4);
                const float* Kn = a.in[I_CK] + ((size_t)((l * NS + in_) * 256) * 4 + hn) * 256 + lane * 4;
#pragma unroll
                for (int e = 0; e < 8; ++e) kx[e] = __builtin_nontemporal_load((const f32x4*)(Kn + (size_t)(wave * 32 + e) * 1024));
            }
#pragma unroll
            for (int e = 0; e < 8; ++e) acc += vx[e] * sc[wave * 32 + g8 * 8 + e];
            if (g8 < 3) {
#pragma unroll
                for (int e = 0; e < 8; ++e) vx[e] = vn[e];
            }
        }
        *(LAS f32x4*)(part + wave * 256 + lane * 4) = acc;
        lds_barrier();
        if (tid < 256) {
            float s = 0.f;
#pragma unroll
            for (int w = 0; w < 8; ++w) s += part[w * 256 + tid];
            O[(size_t)(MP + i) * 1024 + h * 256 + tid] = (bf16_t)f2bf(s);
        }
        lds_barrier();
    }
}

__device__ __forceinline__ void ffnconv_phase(const Args& a, int l, int tid) {
    unsigned char* ws = a.ws;
    const bf16_t* __restrict__ UP = (const bf16_t*)(ws + OFF_UP); bf16_t* __restrict__ H = (bf16_t*)(ws + OFF_H);
    const float* __restrict__ cw = a.in[I_FCW] + (size_t)l * 3 * FW2;
    constexpr int CH = FW / 8;
    for (int rb = blockIdx.x; rb < MP / 64; rb += gridDim.x) {
        if (tid < CH) {
            const int c = tid * 8, r0 = rb * 64, t0 = r0 & 2047;
            float wu[3][8], wg[3][8];
#pragma unroll
            for (int k = 0; k < 3; ++k) {
                const f32x4 a0 = *(const f32x4*)(cw + k * FW2 + c), a1 = *(const f32x4*)(cw + k * FW2 + c + 4), b0 = *(const f32x4*)(cw + k * FW2 + FW + c), b1 = *(const f32x4*)(cw + k * FW2 + FW + c + 4);
#pragma unroll
                for (int j = 0; j < 4; ++j) { wu[k][j] = a0[j]; wu[k][4 + j] = a1[j]; wg[k][j] = b0[j]; wg[k][4 + j] = b1[j]; }
            }
            float u2[8], u1[8], g2[8], g1[8];
#pragma unroll
            for (int j = 0; j < 8; ++j) { u2[j] = 0.f; u1[j] = 0.f; g2[j] = 0.f; g1[j] = 0.f; }
            if (t0 >= 2) {
                const bf16_t* p = UP + (size_t)(r0 - 2) * FW2 + c;
                unpack8(*(const u32x4*)p, u2); unpack8(*(const u32x4*)(p + FW), g2); unpack8(*(const u32x4*)(p + FW2), u1); unpack8(*(const u32x4*)(p + FW2 + FW), g1);
            }
            const bf16_t* p = UP + (size_t)r0 * FW2 + c; bf16_t* hp = H + (size_t)r0 * FW + c;
#pragma unroll 1
            for (int r = 0; r < 64; r += 4) {
                u32x4 lu[4], lg[4];
#pragma unroll
                for (int e = 0; e < 4; ++e) { lu[e] = *(const u32x4*)(p + (size_t)(r + e) * FW2); lg[e] = *(const u32x4*)(p + (size_t)(r + e) * FW2 + FW); }
#pragma unroll
                for (int e = 0; e < 4; ++e) {
                    float u0[8], g0[8], hh[8]; unpack8(lu[e], u0); unpack8(lg[e], g0);
#pragma unroll
                    for (int j = 0; j < 8; ++j) {
                        const float uu = wu[0][j] * u2[j] + wu[1][j] * u1[j] + wu[2][j] * u0[j], gg = wg[0][j] * g2[j] + wg[1][j] * g1[j] + wg[2][j] * g0[j];
                        hh[j] = gg * __builtin_amdgcn_rcpf(1.f + __expf(-gg)) * uu;
                        u2[j] = u1[j]; u1[j] = u0[j]; g2[j] = g1[j]; g1[j] = g0[j];
                    }
                    u32x4 w; w.x = cvt_pk_bf16(hh[0], hh[1]); w.y = cvt_pk_bf16(hh[2], hh[3]); w.z = cvt_pk_bf16(hh[4], hh[5]); w.w = cvt_pk_bf16(hh[6], hh[7]);
                    *(u32x4*)(hp + (size_t)(r + e) * FW) = w;
                }
            }
        }
    }
    for (int it = blockIdx.x * 512 + tid; it < NS * CH; it += gridDim.x * 512) {
        const int i = it / CH, c = (it % CH) * 8, m = MP + i;
        const bf16_t* r0 = UP + (size_t)m * FW2;
        float u[8], g[8], t0[8], t1[8];
        unpack8(*(const u32x4*)(r0 + c), t0); unpack8(*(const u32x4*)(r0 + FW + c), t1);
        const float* sf = a.in[I_SFFN] + (size_t)(l * NS + i) * 2 * FW2;
        float* dst = a.out + O_FFNS + (size_t)(l * NS + i) * 2 * FW2;
        float hh[8];
#pragma unroll
        for (int q = 0; q < 2; ++q) {
            const int cc = c + 4 * q;
            const f32x4 p0u = *(const f32x4*)(sf + cc), p0g = *(const f32x4*)(sf + FW + cc), p1u = *(const f32x4*)(sf + FW2 + cc), p1g = *(const f32x4*)(sf + FW2 + FW + cc);
            const f32x4 w0u = *(const f32x4*)(cw + cc), w1u = *(const f32x4*)(cw + FW2 + cc), w2u = *(const f32x4*)(cw + 2 * FW2 + cc);
            const f32x4 w0g = *(const f32x4*)(cw + FW + cc), w1g = *(const f32x4*)(cw + FW2 + FW + cc), w2g = *(const f32x4*)(cw + 2 * FW2 + FW + cc);
            *(f32x4*)(dst + cc) = p1u; *(f32x4*)(dst + FW + cc) = p1g;
#pragma unroll
            for (int j = 0; j < 4; ++j) {
                u[4 * q + j] = w2u[j] * t0[4 * q + j] + w0u[j] * p0u[j] + w1u[j] * p1u[j]; g[4 * q + j] = w2g[j] * t1[4 * q + j] + w0g[j] * p0g[j] + w1g[j] * p1g[j];
                hh[4 * q + j] = g[4 * q + j] * sigmoidf_(g[4 * q + j]) * u[4 * q + j];
            }
        }
        u32x4 w; w.x = pk2(hh[0], hh[1]); w.y = pk2(hh[2], hh[3]); w.z = pk2(hh[4], hh[5]); w.w = pk2(hh[6], hh[7]);
        *(u32x4*)(H + (size_t)m * FW + c) = w;
    }
}

__device__ __forceinline__ void final_phase(const Args& a, int lane, int gw, int NGW) {
    unsigned char* ws = a.ws;
    const float* __restrict__ X = (const float*)(ws + OFF_X); const float* __restrict__ SS = (const float*)(ws + OFF_SS) + (size_t)6 * MROWS;
    float* __restrict__ outp = a.out;
#pragma unroll 4
    for (int m = gw; m < MTOK; m += NGW) {
        const float rs = rsqrtf(SS[m] * (1.f / 1024.f) + EPS);
        float* __restrict__ dst = m < MP ? outp + O_YP + (size_t)m * D : outp + O_YS + (size_t)(m - MP) * D;
#pragma unroll
        for (int j = 0; j < 4; ++j) { const f32x4 v = *(const f32x4*)(X + (size_t)m * D + 4 * lane + 256 * j), gn = *(const f32x4*)(a.in[I_NFIN] + 4 * lane + 256 * j);
            *(f32x4*)(dst + 4 * lane + 256 * j) = v * rs * gn; }
    }
}

__device__ __forceinline__ void skinny_gemm(LAS unsigned char* lds, const bf16_t* __restrict__ A, int lda, const bf16_t* __restrict__ Wt, int K, int mode, float* X, bf16_t* O, float* ssn, const float* ss, int lane, int wave) {
    LAS f32x4* part = (LAS f32x4*)lds;
    for (int item = blockIdx.x; item < 256; item += gridDim.x) {
        const int n0 = (item & 63) * 16, r0 = MP + (item >> 6) * 32, fr = lane & 15, fq = lane >> 4;
        const bf16_t* ap = A + (size_t)(r0 + fr) * lda + fq * 8;
        const bf16_t* bp = Wt + (size_t)(n0 + fr) * K + fq * 8;
        f32x4 acc0 = (f32x4){0.f, 0.f, 0.f, 0.f}, acc1 = acc0;
#pragma unroll 4
        for (int ks = wave; ks < K / 32; ks += 8) {
            const bf16x8 bf = *(const bf16x8*)(bp + ks * 32), a0 = *(const bf16x8*)(ap + ks * 32), a1 = *(const bf16x8*)(ap + (size_t)16 * lda + ks * 32);
            acc0 = __builtin_amdgcn_mfma_f32_16x16x32_bf16(bf, a0, acc0, 0, 0, 0);
            acc1 = __builtin_amdgcn_mfma_f32_16x16x32_bf16(bf, a1, acc1, 0, 0, 0);
        }
        part[(wave * 2 + 0) * 64 + lane] = acc0; part[(wave * 2 + 1) * 64 + lane] = acc1;
        __syncthreads();
        if (wave < 2) {
            f32x4 acc = part[wave * 64 + lane];
#pragma unroll
            for (int w = 1; w < 8; ++w) acc += part[(w * 2 + wave) * 64 + lane];
            const int row = r0 + wave * 16 + fr, col = n0 + fq * 4;
            const size_t idx = (size_t)row * 1024 + col;
            if (mode == 1) {
                const f32x4 x = *(const f32x4*)(X + idx) + acc;
                *(f32x4*)(X + idx) = x;
                u32x2 w; w.x = cvt_pk_bf16(x[0], x[1]); w.y = cvt_pk_bf16(x[2], x[3]); *(u32x2*)(O + idx) = w;
                float sq = (x[0] * x[0] + x[1] * x[1]) + (x[2] * x[2] + x[3] * x[3]);
                sq += __shfl_xor(sq, 16); sq += __shfl_xor(sq, 32);
                if (fq == 0) atomicAdd(ssn + row, sq);
            } else {
                const float rs = rsqrtf(ss[row] * (1.f / 1024.f) + EPS);
                u32x2 w; w.x = cvt_pk_bf16(acc[0] * rs, acc[1] * rs); w.y = cvt_pk_bf16(acc[2] * rs, acc[3] * rs); *(u32x2*)(O + idx) = w;
            }
        }
        __syncthreads();
    }
}

#define XB_TMO      128
#define XB_XCNT(j)  (256  + 64 * (j))
#define XB_XSUB(j)  (1280 + 64 * (j))
#define XB_XGEN(j)  (2304 + 64 * (j))
#define XB_TOP      3328
#define XB_TOPGEN   3392
#define XCD_BAR_WORDS 3456
#define XB_SPIN_CAP (1u << 22)
__device__ __forceinline__ unsigned xb_ld(unsigned* p)              { return __hip_atomic_load(p, __ATOMIC_RELAXED, __HIP_MEMORY_SCOPE_AGENT); }
__device__ __forceinline__ unsigned xb_add(unsigned* p, unsigned v) { return __hip_atomic_fetch_add(p, v, __ATOMIC_RELAXED, __HIP_MEMORY_SCOPE_AGENT); }
__device__ __forceinline__ unsigned xb_xcc_id() { return (unsigned)__builtin_amdgcn_s_getreg((3 << 11) | 20) & 0xFu; }
#define XB_SPIN(cond, bar) do { unsigned _sp = 0; while (cond) { __builtin_amdgcn_s_sleep(1); \
    if ((++_sp & 255u) == 0u) { if (xb_ld(&(bar)[XB_TMO])) break; if (_sp > XB_SPIN_CAP) { atomicAdd(&(bar)[XB_TMO], 1u); break; } } } } while (0)
struct XcdBarrier { unsigned* bar; unsigned x; volatile LAS unsigned* st; };
__device__ __forceinline__ XcdBarrier xcd_barrier_post(unsigned* bar, volatile LAS unsigned* st) {
    XcdBarrier b; b.bar = bar; b.x = xb_xcc_id(); b.st = st;
    if (threadIdx.x == 0) (void)xb_add(&bar[XB_XCNT(b.x)], 1u);
    return b;
}
__device__ __forceinline__ void xcd_barrier_complete(unsigned* bar, unsigned x, unsigned& nloc, unsigned& nx) {
    const unsigned G = gridDim.x * gridDim.y * gridDim.z;
    unsigned sum, cnt, mine, sp = 0u;
    for (;;) {
        sum = 0u; cnt = 0u; mine = 0u;
#pragma unroll
        for (unsigned j = 0; j < 16; ++j) { const unsigned c = xb_ld(&bar[XB_XCNT(j)]); sum += c; cnt += (c > 0u) ? 1u : 0u; mine = (j == x) ? c : mine; }
        if (sum == G) break;
        __builtin_amdgcn_s_sleep(1);
        if ((++sp & 255u) == 0u) { if (xb_ld(&bar[XB_TMO])) break; if (sp > XB_SPIN_CAP) { atomicAdd(&bar[XB_TMO], 1u); break; } }
    }
    nloc = mine > 0u ? mine : 1u; nx = cnt > 0u ? cnt : 1u;
}
__device__ __forceinline__ void xcd_barrier(const XcdBarrier& b) {
    asm volatile("s_waitcnt vmcnt(0)" ::: "memory");
    __syncthreads();
    if (threadIdx.x == 0) {
        unsigned* bar = b.bar;
        __builtin_amdgcn_s_waitcnt(0);
        unsigned nloc = b.st[0], nx = b.st[1];
        if (nloc == 0u) { xcd_barrier_complete(bar, b.x, nloc, nx); b.st[0] = nloc; b.st[1] = nx; }
        const unsigned old = xb_add(&bar[XB_XSUB(b.x)], 1u);
        const unsigned gen = old / nloc;
        if (old + 1u == (gen + 1u) * nloc) {
            __builtin_amdgcn_fence(__ATOMIC_RELEASE, "agent");
            asm volatile("s_waitcnt vmcnt(0)" ::: "memory");
            const unsigned og = xb_add(&bar[XB_TOP], 1u);
            const unsigned tg = og / nx;
            if (og + 1u == (tg + 1u) * nx) xb_add(&bar[XB_TOPGEN], 1u);
            else XB_SPIN(xb_ld(&bar[XB_TOPGEN]) == tg, bar);
            __builtin_amdgcn_fence(__ATOMIC_ACQUIRE, "agent");
            xb_add(&bar[XB_XGEN(b.x)], 1u);
            asm volatile("s_waitcnt vmcnt(0)" ::: "memory");
        } else {
            XB_SPIN(xb_ld(&bar[XB_XGEN(b.x)]) == gen, bar);
            __builtin_amdgcn_fence(__ATOMIC_ACQUIRE, "agent");
            asm volatile("s_waitcnt vmcnt(0)" ::: "memory");
        }
    }
    __syncthreads();
}

__global__ void __launch_bounds__(512, 2) mega(Args a) {
    extern __shared__ __attribute__((aligned(16))) unsigned char lds_raw[];
    LAS unsigned char* lds = (LAS unsigned char*)lds_raw;
    cg::grid_group grid = cg::this_grid();
    volatile LAS unsigned* bst = (volatile LAS unsigned*)(lds + 131072 + 64);
    if (threadIdx.x == 0) { bst[0] = 0u; bst[1] = 0u; }
    __syncthreads();
    const XcdBarrier xbar = xcd_barrier_post((unsigned*)(a.ws + OFF_BAR), bst);
    for (int ph2 = 2 * a.ph_lo; ph2 < 2 * a.ph_hi; ++ph2) {
        const int ph = ph2 >> 1;
        if (ph2 & 1) { const int spx = (ph == 0) ? 12 : (ph == NPHASE - 1) ? 13 : (ph - 1) % 12; if (!((REP_MASK >> spx) & 1)) continue; }
        int tid = threadIdx.x; asm volatile("" : "+v"(tid));
        const int lane = tid & 63, wave = __builtin_amdgcn_readfirstlane(tid >> 6);
        const int G = gridDim.x, gw = blockIdx.x * 8 + wave, NGW = G * 8;
        unsigned char* ws = a.ws; asm volatile("" : "+s"(ws));
        float* SS = (float*)(ws + OFF_SS);
        bf16_t* XB = (bf16_t*)(ws + OFF_XB); float* X = (float*)(ws + OFF_X);
        if (ph == 0) {
            if (PHON(12)) p0_prologue(lds, a, tid, lane, wave, gw, NGW);
        } else if (ph == NPHASE - 1) {
            if (PHON(13)) final_phase(a, lane, gw, NGW);
        } else {
            const int l = (ph - 1) / 12, sp = (ph - 1) % 12;
            const bool is_gemm = (sp == 0 || sp == 4 || sp == 5 || sp == 7 || sp == 8 || sp == 9 || sp == 11);
            if (is_gemm && PHON(0)) {
                const int njobs = (l == 0 && (sp == 0 || sp == 9)) ? 3 : 1;
                for (int jb = 0; jb < njobs; ++jb) {
                    pg8::Gemm g; pg8::GenOrder S; pg8::Epi E;
                    E.mode = 0; E.O = nullptr; E.ldc = D; E.ss = nullptr; E.X = nullptr; E.ssn = nullptr; E.F = nullptr; E.l = l; E.dry = (ph2 & 1);
                    if (sp == 0 && jb == 0) {
                        g = pg8::Gemm{XB, (const bf16_t*)(ws + OFF_WIN) + (size_t)l * LDP * D, D, D, D};
                        S.init(0, MROWS, LDP, D, D, G, (int)blockIdx.x);
                        E.O = (bf16_t*)(ws + OFF_PROJ); E.ldc = LDP; E.ss = SS + (size_t)3 * l * MROWS;
                    } else if (jb > 0) {
                        const int kv = (sp == 0 ? 0 : 2) + jb - 1, ll = kv >> 1, isv = kv & 1;
                        g = pg8::Gemm{(const bf16_t*)(ws + OFF_MNB), (const bf16_t*)(ws + (isv ? OFF_WV : OFF_WK)) + (size_t)ll * D * D, D, D, D};
                        S.init(0, MMEM, D, D, D, G, (int)((blockIdx.x + G - 160 - 32 * (jb - 1)) % G));
                        E.mode = isv ? 3 : 2; E.O = (bf16_t*)(ws + (isv ? OFF_MVT : OFF_MK)) + (size_t)ll * MMEM * D; E.ss = (const float*)(ws + OFF_SSM);
                        E.F = a.out + (isv ? O_MVP : O_MKP) + (size_t)ll * MMEM * D; E.l = ll;
                    } else if (sp == 4 || sp == 8 || sp == 11) {
                        const bf16_t* A = (const bf16_t*)(ws + (sp == 4 ? OFF_YAB : sp == 8 ? OFF_O : OFF_H));
                        const bf16_t* B = sp == 4 ? (const bf16_t*)(ws + OFF_WOUT) + (size_t)l * D * D : sp == 8 ? (const bf16_t*)(ws + OFF_WO) + (size_t)l * D * D : (const bf16_t*)(ws + OFF_WDN) + (size_t)l * D * FW;
                        const int K = sp == 11 ? FW : D;
                        const int nrm = 3 * l + (sp == 4 ? 1 : sp == 8 ? 2 : 3);
                        g = pg8::Gemm{A, B, K, K, K};
                        S.init(0, MP, D, K, K, G, (int)blockIdx.x);
                        E.mode = 1; E.O = XB; E.X = X; E.ssn = SS + (size_t)nrm * MROWS;
                    } else if (sp == 5) {
                        g = pg8::Gemm{XB, (const bf16_t*)(ws + OFF_WQ) + (size_t)l * D * D, D, D, D};
                        S.init(0, MP, D, D, D, G, (int)blockIdx.x);
                        E.O = (bf16_t*)(ws + OFF_Q); E.ss = SS + (size_t)(3 * l + 1) * MROWS;
                    } else if (sp == 7) {
                        g = pg8::Gemm{(const bf16_t*)(ws + OFF_P), (const bf16_t*)(ws + OFF_MVT) + (size_t)l * MMEM * D, D, 256, 256};
                        S.init(2, MP, D, D, 256, G, (int)blockIdx.x);
                        E.O = (bf16_t*)(ws + OFF_O);
                    } else {
                        g = pg8::Gemm{XB, (const bf16_t*)(ws + OFF_WUP) + (size_t)l * FW2 * D, D, D, D};
                        S.init(0, MROWS, FW2, D, D, G, (int)blockIdx.x);
                        E.mode = 4; E.O = (bf16_t*)(ws + OFF_UP); E.ldc = FW2; E.ss = SS + (size_t)(3 * l + 2) * MROWS; E.F = a.out;
                    }
                    pg8::gemm_phase<pg8::Epi, pg8::GenOrder, true>(lds, g, S, E);
                    if (jb == 0 && !(ph2 & 1) && (sp == 4 || sp == 5 || sp == 8 || sp == 11))
                        skinny_gemm(lds, g.A, g.lda, g.Bt, g.K, E.mode, X, E.O, E.ssn, E.ss, lane, wave);
                }
            } else if (sp == 1 && PHON(1)) {
                prep_phase(lds, a, l, tid, lane, wave, gw);
            } else if (sp == 2 && PHON(2)) {
                scan_phase(lds, a, l, tid, lane, wave);
            } else if (sp == 3 && PHON(3)) {
                post_phase(a, l, lane, gw, NGW);
            } else if (sp == 6 && PHON(6)) {
                {
                    pg8::Gemm g{(const bf16_t*)(ws + OFF_Q), (const bf16_t*)(ws + OFF_MK) + (size_t)l * MMEM * D, D, D, 256};
                    pg8::GenOrder S; S.init(1, MP, D, D, D, G, (int)blockIdx.x);
                    pg8::EpiSm E{(bf16_t*)(ws + OFF_P)};
                    pg8::gemm_phase<pg8::EpiSm, pg8::GenOrder, false>(lds, g, S, E);
                }
                __syncthreads();
                sample_attn(lds, a, l, tid, lane, wave);
            } else if (sp == 10 && PHON(10)) {
                ffnconv_phase(a, l, tid);
            }
        }
        if (ph2 + 1 < 2 * a.ph_hi) { if (a.ph_lo < 0) grid.sync(); else xcd_barrier(xbar); }
        if (((REP_MASK >> 14) & 1) && ph2 == 0) { for (int q = 0; q < 40; ++q) xcd_barrier(xbar); }
    }
}

extern "C" void kernel_launch(void* const* d_in, const int* in_sizes, int n_in, void* d_out, int out_size, void* d_ws, size_t ws_size, hipStream_t stream) {
    static int grid = 0;
    if (grid == 0) {
        if (n_in != 38 || ws_size < WS_END) { fprintf(stderr, "kernel_launch: expected 38 inputs and >= %zu bytes of workspace (got %d, %zu)\n", (size_t)WS_END, n_in, ws_size); grid = -1; return; }
        int dev = 0, cus = 0, per_cu = 0;
        hipGetDevice(&dev);
        hipDeviceGetAttribute(&cus, hipDeviceAttributeMultiprocessorCount, dev);
        if (hipFuncSetAttribute((const void*)mega, hipFuncAttributeMaxDynamicSharedMemorySize, LDS_BYTES) != hipSuccess) { fprintf(stderr, "kernel_launch: hipFuncSetAttribute failed\n"); grid = -1; return; }
        hipOccupancyMaxActiveBlocksPerMultiprocessor(&per_cu, (const void*)mega, 512, LDS_BYTES);
        if (per_cu < 1) { fprintf(stderr, "kernel_launch: occupancy query says %d blocks per CU\n", per_cu); per_cu = 1; }
        (void)hipGetLastError();
        grid = cus;
        if (grid != 256) fprintf(stderr, "kernel_launch: built for 256 CUs, got %d\n", grid);
    }
    if (grid < 0) return;
    if (hipMemsetAsync((char*)d_ws + OFF_BAR, 0, BAR_BYTES, stream) != hipSuccess) { fprintf(stderr, "kernel_launch: hipMemsetAsync failed\n"); return; }
    Args a{};
    for (int i = 0; i < 38; ++i) a.in[i] = (const float*)d_in[i];
    a.out = (float*)d_out; a.ws = (unsigned char*)d_ws;
#if MK_PER_PHASE
    for (int ph = 0; ph < NPHASE; ++ph) {
        a.ph_lo = ph; a.ph_hi = ph + 1;
        void* args[] = {&a};
        hipError_t e = hipLaunchCooperativeKernel((const void*)mega, dim3(grid), dim3(512), args, LDS_BYTES, stream);
        if (e != hipSuccess) { fprintf(stderr, "cooperative launch failed: %s\n", hipGetErrorString(e)); break; }
    }
#else
    a.ph_lo = 0; a.ph_hi = NPHASE;
    void* args[] = {&a};
    hipError_t e = hipLaunchCooperativeKernel((const void*)mega, dim3(grid), dim3(512), args, LDS_BYTES, stream);
    if (e != hipSuccess) fprintf(stderr, "cooperative launch failed: %s (grid %d)\n", hipGetErrorString(e), grid);
#endif
    (void)in_sizes; (void)out_size;
}
```

```cpp
#include <hip/hip_runtime.h>
#include <hip/hip_cooperative_groups.h>
#include <cstdio>
#include <cstdint>
namespace cg = cooperative_groups;

#ifndef PH_MASK
#define PH_MASK 0xFFFFF
#endif
#define PHON(k) (((PH_MASK) >> (k)) & 1)
#ifndef REP_MASK
#define REP_MASK 0
#endif
#ifndef MK_PER_PHASE
#define MK_PER_PHASE 0
#endif

#define LAS __attribute__((address_space(3)))
typedef unsigned short bf16_t;
typedef short bf16x8 __attribute__((ext_vector_type(8)));
typedef float f32x4 __attribute__((ext_vector_type(4)));
typedef unsigned u32x4 __attribute__((ext_vector_type(4)));
typedef unsigned u32x2 __attribute__((ext_vector_type(2)));
#define LDS_WAIT() asm volatile("s_waitcnt lgkmcnt(0)" ::: "memory")

constexpr int D = 1024, NB = 8, TT = 2048, MP = NB * TT, NS = 128, MTOK = MP + NS, MROWS = 16640;
constexpr int INC = 3328, LDP = 3584, FW = 2816, FW2 = 5632, NMEM = 256, MMEM = NB * NMEM;
constexpr float EPS = 1e-6f, GN_EPS = 64e-5f;
constexpr int NPHASE = 26;
constexpr int LDS_BYTES = 147456;

constexpr size_t O_YP = 0, O_YS = 16777216, O_SHP = 16908288, O_WKVP = 16924672, O_CONVP = 17448960, O_FFNP = 17465344,
                 O_MKP = 17645568, O_MVP = 21839872, O_SHS = 26034176, O_WKVS = 26296320, O_CONVS = 34684928, O_FFNS = 34947072;

constexpr size_t al256(size_t x) { return (x + 255) & ~(size_t)255; }
constexpr size_t OFF_SS = 0;
constexpr size_t OFF_SSM = al256(OFF_SS + (size_t)7 * MROWS * 4);
constexpr size_t OFF_WIN = al256(OFF_SSM + 2048 * 4);
constexpr size_t OFF_WOUT = OFF_WIN + (size_t)2 * LDP * D * 2;
constexpr size_t OFF_WQ = OFF_WOUT + (size_t)2 * D * D * 2;
constexpr size_t OFF_WK = OFF_WQ + (size_t)2 * D * D * 2;
constexpr size_t OFF_WV = OFF_WK + (size_t)2 * D * D * 2;
constexpr size_t OFF_WO = OFF_WV + (size_t)2 * D * D * 2;
constexpr size_t OFF_WUP = OFF_WO + (size_t)2 * D * D * 2;
constexpr size_t OFF_WDN = OFF_WUP + (size_t)2 * FW2 * D * 2;
constexpr size_t OFF_W2 = OFF_WDN + (size_t)2 * D * FW * 2;
constexpr size_t OFF_A2 = OFF_W2 + (size_t)2 * 512 * 64 * 2;
constexpr size_t OFF_G2 = OFF_A2 + (size_t)2 * 512 * 64 * 2;
constexpr size_t OFF_V1 = OFF_G2 + (size_t)2 * 512 * 128 * 2;
constexpr size_t OFF_V2 = OFF_V1 + (size_t)32 * 512 * 2;
constexpr size_t OFF_X = al256(OFF_V2 + (size_t)512 * 32 * 2);
constexpr size_t OFF_XB = OFF_X + (size_t)MROWS * D * 4;
constexpr size_t OFF_MNB = OFF_XB + (size_t)MROWS * D * 2;
constexpr size_t OFF_MK = OFF_MNB + (size_t)MMEM * D * 2;
constexpr size_t OFF_MVT = OFF_MK + (size_t)2 * MMEM * D * 2;
constexpr size_t OFF_PROJ = OFF_MVT + (size_t)2 * MMEM * D * 2;
constexpr size_t OFF_H = OFF_PROJ;
constexpr size_t SCN = (size_t)MTOK * 512 * 4;
constexpr size_t OFF_SA = OFF_PROJ + (size_t)MROWS * LDP * 2;
constexpr size_t OFF_SB = OFF_SA + SCN, OFF_SD = OFF_SB + SCN, OFF_SK = OFF_SD + SCN, OFF_SRD = OFF_SK + SCN, OFF_G = OFF_SRD + SCN;
constexpr size_t OFF_UP = OFF_SA;
constexpr size_t OFF_SV0 = OFF_G + SCN, OFF_SV1 = OFF_SV0 + SCN;
constexpr size_t OFF_SBR = OFF_SV1 + SCN;
constexpr size_t OFF_SKR = OFF_SBR + (size_t)MTOK * 8 * 4, OFF_RKR = OFF_SKR + (size_t)MTOK * 8 * 4;
constexpr size_t OFF_Y = al256(OFF_RKR + (size_t)MTOK * 8 * 4);
constexpr size_t OFF_YAB = OFF_Y + SCN;
constexpr size_t OFF_Q = OFF_YAB + (size_t)MROWS * D * 2;
constexpr size_t OFF_P = OFF_Q + (size_t)MROWS * D * 2;
constexpr size_t OFF_O = OFF_P + (size_t)MROWS * D * 2;
constexpr size_t OFF_BAR = OFF_O + (size_t)MROWS * D * 2;
constexpr size_t BAR_BYTES = 16384;
constexpr size_t WS_END = OFF_BAR + BAR_BYTES;
static_assert((size_t)MROWS * FW2 * 2 <= 6 * SCN, "UP overlay");
static_assert((size_t)MROWS * FW * 2 <= (size_t)MROWS * LDP * 2, "H overlay");
static_assert(WS_END < (size_t)1050000000, "workspace");

__device__ __forceinline__ unsigned f2bf(float f) { unsigned u = __builtin_bit_cast(unsigned, f); return (u + 0x7fffu + ((u >> 16) & 1u)) >> 16; }
__device__ __forceinline__ unsigned pk2(float lo, float hi) { return f2bf(lo) | (f2bf(hi) << 16); }
__device__ __forceinline__ unsigned cvt_pk_bf16(float lo, float hi) { unsigned r; asm volatile("v_cvt_pk_bf16_f32 %0, %1, %2" : "=v"(r) : "v"(lo), "v"(hi)); return r; }
__device__ __forceinline__ float bflo(unsigned w) { return __builtin_bit_cast(float, w << 16); }
__device__ __forceinline__ float bfhi(unsigned w) { return __builtin_bit_cast(float, w & 0xffff0000u); }
__device__ __forceinline__ float wave_sum(float v) {
#pragma unroll
    for (int o = 1; o < 64; o <<= 1) v += __shfl_xor(v, o);
    return v;
}
__device__ __forceinline__ float wave_max(float v) {
#pragma unroll
    for (int o = 1; o < 64; o <<= 1) v = fmaxf(v, __shfl_xor(v, o));
    return v;
}
__device__ __forceinline__ float sigmoidf_(float x) { return 1.f / (1.f + __expf(-x)); }
__device__ __forceinline__ void unpack8(u32x4 w, float* f) { f[0] = bflo(w.x); f[1] = bfhi(w.x); f[2] = bflo(w.y); f[3] = bfhi(w.y); f[4] = bflo(w.z); f[5] = bfhi(w.z); f[6] = bflo(w.w); f[7] = bfhi(w.w); }
template <int CTRL> __device__ __forceinline__ float dppf(float v) { return __builtin_bit_cast(float, __builtin_amdgcn_update_dpp(0, __builtin_bit_cast(int, v), CTRL, 0xF, 0xF, true)); }
__device__ __forceinline__ float red16(float v) { v += dppf<0xB1>(v); v += dppf<0x4E>(v); v += dppf<0x124>(v); v += dppf<0x128>(v); return v; }

namespace pg8 {
constexpr int BM = 256, BK = 64, HALF = 128, HTB = HALF * BK * 2, STAGE_BYTES = 8 * HTB, NXCD = 8, WGM = 8;
__host__ __device__ __forceinline__ int lds_byte(int r, int c) { const int st = (r >> 4) * 2 + (c >> 5), rr = r & 15, cc = c & 31, ob = rr * 64 + cc * 2; return st * 1024 + (ob ^ (((ob >> 9) & 1) << 5)); }
__host__ __device__ __forceinline__ void stage_rc(int b, int& R, int& C) { const int st = b / 1024, sb = b % 1024, swz = sb ^ (((sb >> 9) & 1) << 5); R = (st >> 1) * 16 + swz / 64; C = (st & 1) * 32 + (swz % 64) / 2; }
__host__ __device__ __forceinline__ int perm32(int rho) { const int n = rho >> 4, i = rho & 15; return 8 * (i >> 2) + 4 * n + (i & 3); }

struct Unit { int pm, pn; size_t offA, offB; };
struct Gemm { const bf16_t* A; const bf16_t* Bt; int lda, ldb, K; };

struct GenOrder {
    int mode, nM, nN, nwg, G, c; size_t sA, sB;
    __device__ void init(int mode_, int M, int N, int lda, int ldb, int G_, int c_) { mode = mode_; nM = M / BM; nN = N / BM; nwg = nM * nN; G = G_; c = c_; sA = (size_t)BM * lda * 2; sB = (size_t)BM * ldb * 2; }
    __device__ bool next(int i, Unit& u) const {
        const long L = (long)i * G + c; if (L >= nwg) return false;
        if (mode == 0) {
            int wgid = (int)L; { const int q = nwg / NXCD, r = nwg % NXCD, xcd = wgid % NXCD, off = wgid / NXCD; wgid = (xcd < r ? xcd * (q + 1) : r * (q + 1) + (xcd - r) * q) + off; }
            const int nig = WGM * nN, gid = wgid / nig, fm = gid * WGM, gsz = (nM - fm) < WGM ? (nM - fm) : WGM;
            u.pm = fm + ((wgid % nig) % gsz); u.pn = (wgid % nig) / gsz; u.offA = (size_t)u.pm * sA; u.offB = (size_t)u.pn * sB;
        } else {
            const int b = (int)L >> 5, qb = ((int)L >> 2) & 7, h = (int)L & 3;
            u.pm = b * 8 + qb; u.pn = h;
            u.offA = ((size_t)(b * 2048 + qb * 256) * 1024 + h * 256) * 2;
            u.offB = mode == 1 ? ((size_t)(b * 256) * 1024 + h * 256) * 2 : ((size_t)(b * 4 + h) * 256 * 256) * 2;
        }
        return true;
    }
};

template <class Epi, class Sched, bool ALIGN_EPI>
__device__ __forceinline__ void gemm_phase(LAS unsigned char* lds, const Gemm g, const Sched& S, const Epi& E) {
    int tid = threadIdx.x; asm volatile("" : "+v"(tid));
    const int wid = __builtin_amdgcn_readfirstlane(tid >> 6), lane = tid & 63, wr = wid >> 2, wc = wid & 3, fr = lane & 15, fq = lane >> 4;
    const int K = g.K, nt = K / BK;
    unsigned voffA[2], voffB[2];
#pragma unroll
    for (int i = 0; i < 2; ++i) { int R, C; stage_rc(tid * 16 + i * 8192, R, C); const int Rb = Epi::PERM ? ((R & ~31) + perm32(R & 31)) : R;
        voffA[i] = (unsigned)(R * g.lda + C) * 2u; voffB[i] = (unsigned)(Rb * g.ldb + C) * 2u; }
    const size_t kstep = (size_t)(BK * 2);
    const size_t hstepA = (size_t)HALF * g.lda * 2, hstepB = (size_t)HALF * g.ldb * 2;
    const unsigned ldsw = (unsigned)wid * 1024u;
    const int aoff = lds_byte(wr * 64 + fr, fq * 8), boff = lds_byte(wc * 32 + fr, fq * 8);
#define PG8_SA(b, h) (((b) * 2 + (h)) * HTB)
#define PG8_SB(b, h) ((4 + (b) * 2 + (h)) * HTB)
#define PG8_STAGE(bufoff, gbase, voff) do { _Pragma("unroll") for (int _i = 0; _i < 2; ++_i) \
        __builtin_amdgcn_global_load_lds((const unsigned*)((const char*)(gbase) + (voff)[_i]), (LAS unsigned*)(lds + (bufoff) + ldsw + _i * 8192), 16, 0, 0); } while (0)
#define PG8_LDA(dst, b, h) do { _Pragma("unroll") for (int m = 0; m < 4; ++m) _Pragma("unroll") for (int k = 0; k < 2; ++k) dst[m][k] = *(const LAS bf16x8*)(lds + PG8_SA(b, h) + aoff + m * 2048 + k * 1024); } while (0)
#define PG8_LDB(dst, b, h) do { _Pragma("unroll") for (int n = 0; n < 2; ++n) _Pragma("unroll") for (int k = 0; k < 2; ++k) dst[n][k] = *(const LAS bf16x8*)(lds + PG8_SB(b, h) + boff + n * 2048 + k * 1024); } while (0)
#define PG8_MMA(ai, bj, At, Bt) do { __builtin_amdgcn_s_setprio(1); _Pragma("unroll") for (int m = 0; m < 4; ++m) _Pragma("unroll") for (int n = 0; n < 2; ++n) _Pragma("unroll") for (int k = 0; k < 2; ++k) \
        acc[ai][bj][m][n] = __builtin_amdgcn_mfma_f32_16x16x32_bf16(Bt[n][k], At[m][k], acc[ai][bj][m][n], 0, 0, 0); __builtin_amdgcn_s_setprio(0); } while (0)
#define PG8_WAIT_V(n) asm volatile("s_waitcnt vmcnt(" #n ")" ::: "memory")
#define PG8_WAIT_L(n) asm volatile("s_waitcnt lgkmcnt(" #n ")" ::: "memory")
#define PG8_BAR __builtin_amdgcn_s_barrier()
#define PG8_SCHED __builtin_amdgcn_sched_barrier(0)
    Unit cur, nxt; int ui = 0;
    if (!S.next(0, cur)) return;
    f32x4 acc[2][2][4][2];
#pragma unroll
    for (int a = 0; a < 2; ++a)
#pragma unroll
        for (int b = 0; b < 2; ++b)
#pragma unroll
            for (int m = 0; m < 4; ++m)
#pragma unroll
                for (int n = 0; n < 2; ++n) acc[a][b][m][n] = (f32x4){0.f, 0.f, 0.f, 0.f};
    bf16x8 At[4][2], B0[2][2], B1[2][2];
    const char* cA = (const char*)g.A + cur.offA; const char* cB = (const char*)g.Bt + cur.offB;
    PG8_STAGE(PG8_SB(0, 0), cB, voffB); PG8_STAGE(PG8_SB(0, 1), cB + hstepB, voffB); PG8_STAGE(PG8_SA(0, 0), cA, voffA); PG8_STAGE(PG8_SA(0, 1), cA + hstepA, voffA);
    if (wr == 1) PG8_BAR;
    PG8_WAIT_V(2); PG8_BAR;
    PG8_STAGE(PG8_SB(1, 0), cB + kstep, voffB); PG8_STAGE(PG8_SA(1, 0), cA + kstep, voffA); PG8_STAGE(PG8_SB(1, 1), cB + hstepB + kstep, voffB);
    PG8_WAIT_V(6); PG8_BAR;
    for (;;) {
        const bool has_next = S.next(ui + 1, nxt);
        const char* nA = has_next ? (const char*)g.A + nxt.offA : cA; const char* nB = has_next ? (const char*)g.Bt + nxt.offB : cB;
        for (int t = 0; t < nt; t += 2) {
            const bool last = (t == nt - 2);
            const char* a1 = cA + (size_t)(t + 1) * kstep;
            const char* a2 = last ? nA : cA + (size_t)(t + 2) * kstep; const char* b2 = last ? nB : cB + (size_t)(t + 2) * kstep;
            const char* a3 = a2 + kstep; const char* b3 = b2 + kstep;
            PG8_LDB(B0, 0, 0); PG8_LDB(B1, 0, 1); PG8_SCHED; PG8_LDA(At, 0, 0); PG8_STAGE(PG8_SA(1, 1), a1 + hstepA, voffA);
            PG8_WAIT_V(8); PG8_WAIT_L(0); PG8_BAR; PG8_MMA(0, 0, At, B0); PG8_MMA(0, 1, At, B1); PG8_BAR; PG8_SCHED;
            PG8_LDA(At, 0, 1); PG8_STAGE(PG8_SB(0, 0), b2, voffB); PG8_STAGE(PG8_SB(0, 1), b2 + hstepB, voffB); PG8_STAGE(PG8_SA(0, 0), a2, voffA);
            PG8_WAIT_V(8); PG8_WAIT_L(0); PG8_BAR; PG8_MMA(1, 0, At, B0); PG8_MMA(1, 1, At, B1); PG8_BAR; PG8_SCHED;
            PG8_LDB(B0, 1, 0); PG8_LDB(B1, 1, 1); PG8_SCHED; PG8_LDA(At, 1, 0); PG8_STAGE(PG8_SA(0, 1), a2 + hstepA, voffA);
            PG8_WAIT_V(8); PG8_WAIT_L(0); PG8_BAR; PG8_MMA(0, 0, At, B0); PG8_MMA(0, 1, At, B1); PG8_BAR; PG8_SCHED;
            PG8_LDA(At, 1, 1); PG8_STAGE(PG8_SB(1, 0), b3, voffB); PG8_STAGE(PG8_SB(1, 1), b3 + hstepB, voffB); PG8_STAGE(PG8_SA(1, 0), a3, voffA);
            PG8_WAIT_V(8); PG8_WAIT_L(0); PG8_BAR; PG8_MMA(1, 0, At, B0); PG8_MMA(1, 1, At, B1); PG8_BAR; PG8_SCHED;
        }
        if constexpr (ALIGN_EPI) { if (wr == 0) PG8_BAR; }
        if constexpr (!Epi::AFTER_DRAIN) { E(acc, cur, wr, wc, fr, fq); }
        if (!has_next) break;
#pragma unroll
        for (int a = 0; a < 2; ++a)
#pragma unroll
            for (int b = 0; b < 2; ++b)
#pragma unroll
                for (int m = 0; m < 4; ++m)
#pragma unroll
                    for (int n = 0; n < 2; ++n) acc[a][b][m][n] = (f32x4){0.f, 0.f, 0.f, 0.f};
        cur = nxt; cA = nA; cB = nB; ++ui;
        if constexpr (ALIGN_EPI) { if (wr == 1) PG8_BAR; }
    }
    PG8_WAIT_V(0);
    if constexpr (!ALIGN_EPI) { if (wr == 0) PG8_BAR; }
    PG8_BAR;
    if constexpr (Epi::AFTER_DRAIN) { E.fused(acc, cur, wr, wc, fr, fq, lds, wid, lane); }
#undef PG8_SA
#undef PG8_SB
#undef PG8_STAGE
#undef PG8_LDA
#undef PG8_LDB
#undef PG8_MMA
#undef PG8_WAIT_V
#undef PG8_WAIT_L
#undef PG8_BAR
#undef PG8_SCHED
}

struct Epi {
    static constexpr bool PERM = true, AFTER_DRAIN = false;
    int mode;
    bf16_t* O; int ldc;
    const float* ss;
    float* X;
    float* ssn;
    float* F;
    int l; int dry;
    __device__ __forceinline__ void operator()(const f32x4 (&acc)[2][2][4][2], const Unit& u, int wr, int wc, int fr, int fq) const {
        const int row0 = u.pm * 256 + wr * 64 + fr, col0 = u.pn * 256 + wc * 32 + 8 * fq;
        if (dry) return;
        if (mode == 1) {
#pragma unroll
            for (int ai = 0; ai < 2; ++ai)
#pragma unroll
                for (int m = 0; m < 4; ++m) {
                    const int row = row0 + ai * 128 + m * 16; const bool valid = row < MTOK; float sq = 0.f;
#pragma unroll
                    for (int bj = 0; bj < 2; ++bj) {
                        const size_t idx = (size_t)row * 1024 + col0 + bj * 128;
                        if (valid) {
                            f32x4 x0 = *(const f32x4*)(X + idx) + acc[ai][bj][m][0], x1 = *(const f32x4*)(X + idx + 4) + acc[ai][bj][m][1];
                            *(f32x4*)(X + idx) = x0; *(f32x4*)(X + idx + 4) = x1;
                            sq += (x0[0] * x0[0] + x0[1] * x0[1]) + (x0[2] * x0[2] + x0[3] * x0[3]) + (x1[0] * x1[0] + x1[1] * x1[1]) + (x1[2] * x1[2] + x1[3] * x1[3]);
                            u32x4 w; w.x = cvt_pk_bf16(x0[0], x0[1]); w.y = cvt_pk_bf16(x0[2], x0[3]); w.z = cvt_pk_bf16(x1[0], x1[1]); w.w = cvt_pk_bf16(x1[2], x1[3]);
                            *(u32x4*)(O + idx) = w;
                        }
                    }
                    sq += __shfl_xor(sq, 16); sq += __shfl_xor(sq, 32);
                    if (valid && fq == 0) atomicAdd(ssn + row, sq);
                }
        } else {
#pragma unroll
            for (int ai = 0; ai < 2; ++ai)
#pragma unroll
                for (int m = 0; m < 4; ++m) {
                    const int row = row0 + ai * 128 + m * 16;
                    float rs = 1.f;
                    if (ss != nullptr && (mode == 2 || mode == 3 || row < MTOK)) rs = rsqrtf(ss[row] * (1.f / 1024.f) + EPS);
#pragma unroll
                    for (int bj = 0; bj < 2; ++bj) {
                        const int col = col0 + bj * 128;
                        const f32x4 v0 = acc[ai][bj][m][0] * rs, v1 = acc[ai][bj][m][1] * rs;
                        u32x4 w; w.x = cvt_pk_bf16(v0[0], v0[1]); w.y = cvt_pk_bf16(v0[2], v0[3]); w.z = cvt_pk_bf16(v1[0], v1[1]); w.w = cvt_pk_bf16(v1[2], v1[3]);
                        if (mode == 3) {
                            const int b = row >> 8, mem = row & 255;
                            bf16_t* o = O + ((size_t)(b * 1024 + col)) * 256 + mem;
                            o[0] = (bf16_t)(w.x & 0xffff); o[256] = (bf16_t)(w.x >> 16); o[512] = (bf16_t)(w.y & 0xffff); o[768] = (bf16_t)(w.y >> 16);
                            o[1024] = (bf16_t)(w.z & 0xffff); o[1280] = (bf16_t)(w.z >> 16); o[1536] = (bf16_t)(w.w & 0xffff); o[1792] = (bf16_t)(w.w >> 16);
                        } else {
                            *(u32x4*)(O + (size_t)row * ldc + col) = w;
                        }
                        if (mode == 2 || mode == 3) { float* f = F + (size_t)row * 1024 + col; *(f32x4*)f = v0; *(f32x4*)(f + 4) = v1; }
                        if (mode == 4) {
                            float* f = nullptr;
                            if (row < MP) { const int t = row & 2047; if (t >= 2046) f = F + O_FFNP + ((size_t)((l * 8 + (row >> 11)) * 2 + (t - 2046))) * FW2 + col; }
                            else if (row < MTOK) f = F + O_FFNS + ((size_t)((l * 128 + (row - MP)) * 2 + 1)) * FW2 + col;
                            if (f) { *(f32x4*)f = v0; *(f32x4*)(f + 4) = v1; }
                        }
                    }
                }
        }
    }
};

struct EpiSm {
    static constexpr bool PERM = true, AFTER_DRAIN = true;
    bf16_t* P;
    __device__ __forceinline__ void operator()(const f32x4 (&)[2][2][4][2], const Unit&, int, int, int, int) const {}
    __device__ __forceinline__ void fused(f32x4 (&acc)[2][2][4][2], const Unit& u, int wr, int wc, int fr, int fq, LAS unsigned char* lds, int wid, int lane) const {
        LAS float* red = (LAS float*)lds; LAS float* red2 = red + 1024;
        float mx[2][4];
#pragma unroll
        for (int ai = 0; ai < 2; ++ai)
#pragma unroll
            for (int m = 0; m < 4; ++m) {
                float v = -3.0e38f;
#pragma unroll
                for (int bj = 0; bj < 2; ++bj)
#pragma unroll
                    for (int n = 0; n < 2; ++n) { const f32x4 x = acc[ai][bj][m][n]; v = fmaxf(v, fmaxf(fmaxf(x[0], x[1]), fmaxf(x[2], x[3]))); }
                v = fmaxf(v, __shfl_xor(v, 16)); v = fmaxf(v, __shfl_xor(v, 32));
                if (fq == 0) red[(ai * 128 + wr * 64 + m * 16 + fr) * 4 + wc] = v;
            }
        __syncthreads();
#pragma unroll
        for (int ai = 0; ai < 2; ++ai)
#pragma unroll
            for (int m = 0; m < 4; ++m) {
                const f32x4 r = *(const LAS f32x4*)(red + (ai * 128 + wr * 64 + m * 16 + fr) * 4);
                const float M = fmaxf(fmaxf(r[0], r[1]), fmaxf(r[2], r[3])); mx[ai][m] = M;
                float s = 0.f;
#pragma unroll
                for (int bj = 0; bj < 2; ++bj)
#pragma unroll
                    for (int n = 0; n < 2; ++n) { f32x4 x = acc[ai][bj][m][n];
                        x[0] = __expf(x[0] - M); x[1] = __expf(x[1] - M); x[2] = __expf(x[2] - M); x[3] = __expf(x[3] - M); acc[ai][bj][m][n] = x; s += (x[0] + x[1]) + (x[2] + x[3]); }
                s += __shfl_xor(s, 16); s += __shfl_xor(s, 32);
                if (fq == 0) red2[(ai * 128 + wr * 64 + m * 16 + fr) * 4 + wc] = s;
            }
        __syncthreads();
#pragma unroll
        for (int ai = 0; ai < 2; ++ai)
#pragma unroll
            for (int m = 0; m < 4; ++m) {
                const int rl = ai * 128 + wr * 64 + m * 16 + fr;
                const f32x4 r = *(const LAS f32x4*)(red2 + rl * 4);
                const float inv = 1.f / ((r[0] + r[1]) + (r[2] + r[3]));
#pragma unroll
                for (int bj = 0; bj < 2; ++bj) {
                    const f32x4 v0 = acc[ai][bj][m][0] * inv, v1 = acc[ai][bj][m][1] * inv;
                    u32x4 w; w.x = cvt_pk_bf16(v0[0], v0[1]); w.y = cvt_pk_bf16(v0[2], v0[3]); w.z = cvt_pk_bf16(v1[0], v1[1]); w.w = cvt_pk_bf16(v1[2], v1[3]);
                    *(u32x4*)(P + (size_t)(u.pm * 256 + rl) * 1024 + u.pn * 256 + bj * 128 + wc * 32 + 8 * fq) = w;
                }
            }
        (void)mx; (void)wid; (void)lane;
    }
};
}

struct Args { const float* in[38]; float* out; unsigned char* ws; int ph_lo, ph_hi; };
enum { I_XP = 0, I_XS, I_MEM, I_SSHIFT, I_SWKV, I_SCONV, I_SFFN, I_CK, I_CV, I_NMIX, I_WIN, I_MU, I_W0, I_W2, I_A0, I_A2, I_G2, I_V0, I_V1, I_V2,
       I_KK, I_KA, I_RK, I_LNW, I_LNB, I_CONVW, I_WOUT, I_NX, I_NMEM, I_WQ, I_WK, I_WV, I_WO, I_NFFN, I_WUP, I_FCW, I_WDN, I_NFIN };

__device__ __forceinline__ void tr_item(const float* W, int K, int N, bf16_t* WT, const float* gain, float scale, LAS float* scr, int item, int lane) {
    const int nblk = N / 32, kb = item / nblk, nb = item % nblk, k0 = 64 * kb, n0 = 32 * nb;
#pragma unroll
    for (int i = 0; i < 8; ++i) { const int kk = 8 * i + (lane >> 3); const float gk = gain ? gain[k0 + kk] * scale : scale;
        const f32x4 v = *(const f32x4*)(W + (size_t)(k0 + kk) * N + n0 + (lane & 7) * 4) * gk;
        LAS float* d = scr + kk * 33 + (lane & 7) * 4; d[0] = v[0]; d[1] = v[1]; d[2] = v[2]; d[3] = v[3]; }
    LDS_WAIT();
    const int c = lane & 7;
#pragma unroll
    for (int j = 0; j < 4; ++j) { const int n = (lane >> 3) + 8 * j; const LAS float* s = scr + (8 * c) * 33 + n;
        u32x4 o; o.x = pk2(s[0 * 33], s[1 * 33]); o.y = pk2(s[2 * 33], s[3 * 33]); o.z = pk2(s[4 * 33], s[5 * 33]); o.w = pk2(s[6 * 33], s[7 * 33]);
        *(u32x4*)(WT + (size_t)(n0 + n) * K + k0 + 8 * c) = o; }
    LDS_WAIT();
}

constexpr int TR_NL = 8512;
__device__ __forceinline__ void tr_dispatch(const Args& a, unsigned char* ws, int l, int r, LAS float* scr, int lane) {
    constexpr int I_IN_ = 16 * 104, I_SQ_ = 16 * 32, I_UP_ = 16 * 176, I_DN_ = 44 * 32, I_L64 = 16;
    if (r < I_IN_) { tr_item(a.in[I_WIN] + (size_t)l * D * INC, D, INC, (bf16_t*)(ws + OFF_WIN) + (size_t)l * LDP * D, a.in[I_NMIX] + l * D, 1.f, scr, r, lane); return; } r -= I_IN_;
    if (r < I_SQ_) { tr_item(a.in[I_WOUT] + (size_t)l * D * D, D, D, (bf16_t*)(ws + OFF_WOUT) + (size_t)l * D * D, nullptr, 1.f, scr, r, lane); return; } r -= I_SQ_;
    if (r < I_SQ_) { tr_item(a.in[I_WQ] + (size_t)l * D * D, D, D, (bf16_t*)(ws + OFF_WQ) + (size_t)l * D * D, a.in[I_NX] + l * D, 0.0625f, scr, r, lane); return; } r -= I_SQ_;
    if (r < I_SQ_) { tr_item(a.in[I_WK] + (size_t)l * D * D, D, D, (bf16_t*)(ws + OFF_WK) + (size_t)l * D * D, a.in[I_NMEM] + l * D, 1.f, scr, r, lane); return; } r -= I_SQ_;
    if (r < I_SQ_) { tr_item(a.in[I_WV] + (size_t)l * D * D, D, D, (bf16_t*)(ws + OFF_WV) + (size_t)l * D * D, a.in[I_NMEM] + l * D, 1.f, scr, r, lane); return; } r -= I_SQ_;
    if (r < I_SQ_) { tr_item(a.in[I_WO] + (size_t)l * D * D, D, D, (bf16_t*)(ws + OFF_WO) + (size_t)l * D * D, nullptr, 1.f, scr, r, lane); return; } r -= I_SQ_;
    if (r < I_UP_) { tr_item(a.in[I_WUP] + (size_t)l * D * FW2, D, FW2, (bf16_t*)(ws + OFF_WUP) + (size_t)l * FW2 * D, a.in[I_NFFN] + l * D, 1.f, scr, r, lane); return; } r -= I_UP_;
    if (r < I_DN_) { tr_item(a.in[I_WDN] + (size_t)l * FW * D, FW, D, (bf16_t*)(ws + OFF_WDN) + (size_t)l * D * FW, nullptr, 1.f, scr, r, lane); return; } r -= I_DN_;
    if (r < I_L64) { tr_item(a.in[I_W2] + (size_t)l * 64 * 512, 64, 512, (bf16_t*)(ws + OFF_W2) + (size_t)l * 512 * 64, nullptr, 1.f, scr, r, lane); return; } r -= I_L64;
    if (r < I_L64) { tr_item(a.in[I_A2] + (size_t)l * 64 * 512, 64, 512, (bf16_t*)(ws + OFF_A2) + (size_t)l * 512 * 64, nullptr, 1.f, scr, r, lane); return; } r -= I_L64;
    tr_item(a.in[I_G2] + (size_t)l * 128 * 512, 128, 512, (bf16_t*)(ws + OFF_G2) + (size_t)l * 512 * 128, nullptr, 1.f, scr, r, lane);
}
constexpr int TR_DEFERRED = TR_NL + 5760;
__device__ __forceinline__ void tr_deferred(const Args& a, unsigned char* ws, int d, LAS float* scr, int lane) {
    if (d < TR_NL) { tr_dispatch(a, ws, 1, d, scr, lane); return; }
    const int e = d - TR_NL;
    const int r = e < 1024 ? 1664 + e : (e < 1536 ? 3712 + (e - 1024) : 4224 + (e - 1536));
    tr_dispatch(a, ws, 0, r, scr, lane);
}

__device__ __forceinline__ void p0_prologue(LAS unsigned char* lds, const Args& a, int tid, int lane, int wave, int gw, int NGW) {
    unsigned char* ws = a.ws;
    LAS float* scr = (LAS float*)(lds + wave * 16384);
    for (int it = gw; it < 1664 + 1024 + 64; it += NGW) {
        const int r = it < 1664 ? it : (it < 2688 ? 2688 + (it - 1664) : 8448 + (it - 2688));
        tr_dispatch(a, ws, 0, r, scr, lane);
    }
    float* X = (float*)(ws + OFF_X); bf16_t* XB = (bf16_t*)(ws + OFF_XB); float* SS = (float*)(ws + OFF_SS);
    bf16_t* MNB = (bf16_t*)(ws + OFF_MNB); float* SSM = (float*)(ws + OFF_SSM);
    for (int m = gw; m < MROWS + MMEM; m += NGW) {
        const float* src; bf16_t* dstb; float* dstx = nullptr; float* dss = nullptr; bool shiftrow = false;
        if (m < MP) { src = a.in[I_XP] + (size_t)m * D; dstb = XB + (size_t)m * D; dstx = X + (size_t)m * D; dss = SS + m; }
        else if (m < MTOK) { src = a.in[I_XS] + (size_t)(m - MP) * D; dstb = XB + (size_t)m * D; dstx = X + (size_t)m * D; dss = SS + m; }
        else if (m < MROWS) { src = a.in[I_SSHIFT] + (size_t)(m - MTOK) * D; dstb = XB + (size_t)m * D; shiftrow = true; }
        else { src = a.in[I_MEM] + (size_t)(m - MROWS) * D; dstb = MNB + (size_t)(m - MROWS) * D; dss = SSM + (m - MROWS); }
        float s = 0.f;
#pragma unroll
        for (int j = 0; j < 4; ++j) {
            f32x4 v = *(const f32x4*)(src + 4 * lane + 256 * j);
            if (shiftrow) { const f32x4 gn = *(const f32x4*)(a.in[I_NMIX] + 4 * lane + 256 * j); v[0] /= gn[0]; v[1] /= gn[1]; v[2] /= gn[2]; v[3] /= gn[3]; }
            s += (v[0] * v[0] + v[1] * v[1]) + (v[2] * v[2] + v[3] * v[3]);
            if (dstx) *(f32x4*)(dstx + 4 * lane + 256 * j) = v;
            u32x2 w; w.x = pk2(v[0], v[1]); w.y = pk2(v[2], v[3]);
            *(u32x2*)(dstb + 4 * lane + 256 * j) = w;
        }
        s = wave_sum(s);
        if (dss && lane == 0) *dss = s;
    }
    if (blockIdx.x * 8 < D) {
        __syncthreads();
        LAS float* M = (LAS float*)lds;
        const float* muv = a.in[I_MU] + 1792 + 1024; const float* v1 = a.in[I_V1];
#pragma unroll 8
        for (int i = tid; i < 512 * 64; i += 512) { const int c = i >> 6, o = i & 63; const float mv = muv[c]; M[i] = ((o >> 5) ? mv : 1.f - mv) * v1[c * 32 + (o & 31)]; }
        __syncthreads();
        for (int k = gw; k < D; k += NGW) {
            const float* wrow = a.in[I_WIN] + (size_t)1 * D * INC + (size_t)k * INC + 1024;
            float acc = 0.f;
#pragma unroll 4
            for (int c = 0; c < 512; c += 4) {
                const f32x4 w4 = *(const f32x4*)(wrow + c);
                acc += w4[0] * M[c * 64 + lane] + w4[1] * M[(c + 1) * 64 + lane] + w4[2] * M[(c + 2) * 64 + lane] + w4[3] * M[(c + 3) * 64 + lane];
            }
            ((bf16_t*)(ws + OFF_WIN))[(size_t)1 * LDP * D + (size_t)(INC + lane) * D + k] = (bf16_t)f2bf(acc * a.in[I_NMIX][D + k]);
        }
    }
    const int gt = blockIdx.x * 512 + tid, NGT = gridDim.x * 512;
    for (int i = gt; i < 6 * MROWS; i += NGT) SS[MROWS + i] = 0.f;
    bf16_t* V2T = (bf16_t*)(ws + OFF_V2);
    for (int i = gt; i < 512 * 32; i += NGT) { const int n = i >> 5, k = i & 31; V2T[i] = (bf16_t)f2bf(a.in[I_V2][k * 512 + n]); }
}

__device__ __forceinline__ const bf16_t* prev_row(const bf16_t* PROJ, int m) {
    if (m < MP) { if ((m & 2047) == 0) return nullptr; return PROJ + (size_t)(m - 1) * LDP; }
    return PROJ + (size_t)(m + NS) * LDP;
}
__device__ __forceinline__ void mix4(const bf16_t* cur, const bf16_t* prv, const float* mu, int col, float* z) {
    const u32x2 c = *(const u32x2*)(cur + col); const f32x4 m4 = *(const f32x4*)(mu + col);
    float cf[4] = {bflo(c.x), bfhi(c.x), bflo(c.y), bfhi(c.y)}; float pf[4] = {0.f, 0.f, 0.f, 0.f};
    if (prv) { const u32x2 p = *(const u32x2*)(prv + col); pf[0] = bflo(p.x); pf[1] = bfhi(p.x); pf[2] = bflo(p.y); pf[3] = bfhi(p.y); }
#pragma unroll
    for (int j = 0; j < 4; ++j) z[j] = cf[j] + (pf[j] - cf[j]) * m4[j];
}
__device__ __forceinline__ void mix8(const bf16_t* cur, const bf16_t* prv, const float* mu, int col, float* z) {
    const u32x4 c = *(const u32x4*)(cur + col); float cf[8], pf[8]; unpack8(c, cf);
#pragma unroll
    for (int j = 0; j < 8; ++j) pf[j] = 0.f;
    if (prv) { const u32x4 p = *(const u32x4*)(prv + col); unpack8(p, pf); }
    const f32x4 m0 = *(const f32x4*)(mu + col), m1 = *(const f32x4*)(mu + col + 4);
#pragma unroll
    for (int j = 0; j < 4; ++j) { z[j] = cf[j] + (pf[j] - cf[j]) * m0[j]; z[4 + j] = cf[4 + j] + (pf[4 + j] - cf[4 + j]) * m1[j]; }
}

__device__ __forceinline__ float fsig(float x) { return __builtin_amdgcn_rcpf(1.f + __expf(-x)); }
__device__ __forceinline__ void mixw(u32x2 c, u32x2 p, const LAS float* mu, float* z) {
    const f32x4 m4 = *(const LAS f32x4*)mu;
    const float cf[4] = {bflo(c.x), bfhi(c.x), bflo(c.y), bfhi(c.y)}, pf[4] = {bflo(p.x), bfhi(p.x), bflo(p.y), bfhi(p.y)};
#pragma unroll
    for (int j = 0; j < 4; ++j) z[j] = cf[j] + (pf[j] - cf[j]) * m4[j];
}
__device__ __forceinline__ void prep_phase(LAS unsigned char* lds, const Args& a, int l, int tid, int lane, int wave, int gw) {
    unsigned char* ws = a.ws;
    const bf16_t* PROJ = (const bf16_t*)(ws + OFF_PROJ);
    const float* mu = a.in[I_MU] + l * 1792;
    if (gw < NB + NS) {
        const int row = gw < NB ? gw * 2048 + 2047 : MP + (gw - NB);
        float* dst = gw < NB ? a.out + O_SHP + (size_t)(l * NB + gw) * D : a.out + O_SHS + (size_t)(l * NS + (gw - NB)) * D;
        const float* X = (const float*)(ws + OFF_X) + (size_t)row * D;
        const float rs = rsqrtf(((const float*)(ws + OFF_SS))[3 * l * MROWS + row] * (1.f / 1024.f) + EPS);
#pragma unroll
        for (int j = 0; j < 4; ++j) { const f32x4 v = *(const f32x4*)(X + 4 * lane + 256 * j), gn = *(const f32x4*)(a.in[I_NMIX] + l * D + 4 * lane + 256 * j);
            *(f32x4*)(dst + 4 * lane + 256 * j) = v * rs * gn; }
    }
    LAS bf16_t* WL2 = (LAS bf16_t*)lds;
    LAS bf16_t* WLA = (LAS bf16_t*)(lds + 18432);
    LAS bf16_t* WLG = (LAS bf16_t*)(lds + 36864);
    LAS bf16_t* WLV = (LAS bf16_t*)(lds + 71680);
    LAS float* PAR = (LAS float*)(lds + 81920);
    LAS bf16_t* LA = (LAS bf16_t*)(lds + 88064);
    LAS bf16_t* LW = (LAS bf16_t*)(lds + 121856);
    const int hp = blockIdx.x & 3;
    {
        const bf16_t* W2T = (const bf16_t*)(ws + OFF_W2) + (size_t)l * 512 * 64 + (size_t)hp * 128 * 64;
        const bf16_t* A2T = (const bf16_t*)(ws + OFF_A2) + (size_t)l * 512 * 64 + (size_t)hp * 128 * 64;
        const bf16_t* G2T = (const bf16_t*)(ws + OFF_G2) + (size_t)l * 512 * 128 + (size_t)hp * 128 * 128;
        const bf16_t* V2T = (const bf16_t*)(ws + OFF_V2) + (size_t)hp * 128 * 32;
#pragma unroll
        for (int q = 0; q < 2; ++q) { const int i = tid + 512 * q, n = i >> 3, c = (i & 7) * 8;
            *(LAS u32x4*)(WL2 + n * 72 + c) = *(const u32x4*)(W2T + n * 64 + c); *(LAS u32x4*)(WLA + n * 72 + c) = *(const u32x4*)(A2T + n * 64 + c); }
#pragma unroll
        for (int q = 0; q < 4; ++q) { const int i = tid + 512 * q, n = i >> 4, c = (i & 15) * 8; *(LAS u32x4*)(WLG + n * 136 + c) = *(const u32x4*)(G2T + n * 128 + c); }
        { const int n = tid >> 2, c = (tid & 3) * 8; *(LAS u32x4*)(WLV + n * 40 + c) = *(const u32x4*)(V2T + n * 32 + c); }
        if (tid < 128) {
            const int ch = hp * 128 + tid;
            PAR[tid] = a.in[I_W0][l * 512 + ch]; PAR[128 + tid] = a.in[I_A0][l * 512 + ch]; PAR[256 + tid] = a.in[I_KK][l * 512 + ch]; PAR[384 + tid] = a.in[I_KA][l * 512 + ch];
            PAR[512 + tid] = a.in[I_RK][l * 512 + ch]; PAR[640 + tid] = l == 1 ? a.in[I_V0][ch] : 0.f; PAR[768 + tid] = mu[ch]; PAR[896 + tid] = mu[512 + ch]; PAR[1024 + tid] = mu[1024 + ch];
        }
    }
    float* SA = (float*)(ws + OFF_SA); float* SB = (float*)(ws + OFF_SB); float* SD = (float*)(ws + OFF_SD); float* SK = (float*)(ws + OFF_SK);
    float* SRD = (float*)(ws + OFF_SRD); float* GG = (float*)(ws + OFF_G); float* SV = (float*)(ws + (l == 0 ? OFF_SV0 : OFF_SV1));
    const float* SV0 = (const float*)(ws + OFF_SV0);
    float* SBR = (float*)(ws + OFF_SBR); float* SKR = (float*)(ws + OFF_SKR); float* RKR = (float*)(ws + OFF_RKR);
    const int mt = wave & 3, hh = wave >> 2, h = hp * 2 + hh, fr = lane & 15, fq = lane >> 4;
    constexpr int NTILE = MTOK / 64;
    for (int tile = blockIdx.x >> 2; tile < NTILE; tile += gridDim.x >> 2) {
        const int m0 = tile * 64;
        {
            u32x4 cu[4], pv[4];
#pragma unroll
            for (int q = 0; q < 4; ++q) {
                const int row = (tid >> 5) + 16 * q, ch = tid & 31, m = m0 + row;
                const bf16_t* prv = prev_row(PROJ, m);
                cu[q] = *(const u32x4*)(PROJ + (size_t)m * LDP + 1536 + ch * 8);
                pv[q] = prv ? *(const u32x4*)(prv + 1536 + ch * 8) : (u32x4){0u, 0u, 0u, 0u};
            }
            u32x2 vc = (u32x2){0u, 0u}, vp = vc;
            if (l == 1) {
                const int m = m0 + (tid >> 3), j4 = (tid & 7) * 4; const bf16_t* prv = prev_row(PROJ, m);
                vc = *(const u32x2*)(PROJ + (size_t)m * LDP + INC + j4); if (prv) vp = *(const u32x2*)(prv + INC + 32 + j4);
            }
            const int ch = tid & 31;
            const f32x4 m0v = *(const f32x4*)(mu + 1536 + ch * 8), m1v = *(const f32x4*)(mu + 1536 + ch * 8 + 4);
#pragma unroll
            for (int q = 0; q < 4; ++q) {
                const int row = (tid >> 5) + 16 * q;
                float cf[8], pf[8], z[8]; unpack8(cu[q], cf); unpack8(pv[q], pf);
#pragma unroll
                for (int j = 0; j < 4; ++j) { z[j] = cf[j] + (pf[j] - cf[j]) * m0v[j]; z[4 + j] = cf[4 + j] + (pf[4 + j] - cf[4 + j]) * m1v[j]; }
                if (ch < 8) {
#pragma unroll
                    for (int j = 0; j < 8; ++j) z[j] = 2.f * fsig(2.f * z[j]) - 1.f;
                } else if (ch >= 16) {
#pragma unroll
                    for (int j = 0; j < 8; ++j) z[j] = fsig(z[j]);
                }
                u32x4 w; w.x = pk2(z[0], z[1]); w.y = pk2(z[2], z[3]); w.z = pk2(z[4], z[5]); w.w = pk2(z[6], z[7]);
                *(LAS u32x4*)(LA + row * 264 + ch * 8) = w;
            }
            if (l == 1) {
                u32x2 w; w.x = pk2(bflo(vc.x) + bflo(vp.x), bfhi(vc.x) + bfhi(vp.x)); w.y = pk2(bflo(vc.y) + bflo(vp.y), bfhi(vc.y) + bfhi(vp.y));
                *(LAS u32x2*)(LW + (tid >> 3) * 40 + (tid & 7) * 4) = w;
            }
        }
        __syncthreads();
        const int m = m0 + mt * 16 + fr;
        const bf16_t* cur = PROJ + (size_t)m * LDP; const bf16_t* prv = prev_row(PROJ, m);
        u32x2 cR[4], cK[4], cV[4], pR[4], pK[4], pV[4]; f32x4 vf[4];
#pragma unroll
        for (int nt = 0; nt < 4; ++nt) {
            const int ch = h * 64 + nt * 16 + fq * 4;
            cR[nt] = *(const u32x2*)(cur + ch); cK[nt] = *(const u32x2*)(cur + 512 + ch); cV[nt] = *(const u32x2*)(cur + 1024 + ch);
            pR[nt] = (u32x2){0u, 0u}; pK[nt] = pR[nt]; pV[nt] = pR[nt];
            if (prv) { pR[nt] = *(const u32x2*)(prv + ch); pK[nt] = *(const u32x2*)(prv + 512 + ch); pV[nt] = *(const u32x2*)(prv + 1024 + ch); }
            vf[nt] = (f32x4){0.f, 0.f, 0.f, 0.f};
            if (l == 1) vf[nt] = *(const f32x4*)(SV0 + (size_t)m * 512 + ch);
        }
        float ssq = 0.f;
#pragma unroll
        for (int nt = 0; nt < 4; ++nt) {
            const int cl = hh * 64 + nt * 16 + fq * 4; float kz[4]; mixw(cK[nt], pK[nt], PAR + 896 + cl, kz);
            const f32x4 kk4 = *(const LAS f32x4*)(PAR + 256 + cl);
#pragma unroll
            for (int j = 0; j < 4; ++j) { const float kk = kz[j] * kk4[j]; ssq += kk * kk; }
        }
        ssq += __shfl_xor(ssq, 16); ssq += __shfl_xor(ssq, 32);
        const float inv = 1.f / fmaxf(sqrtf(ssq), 1e-12f);
        float br = 0.f, kr = 0.f, rkr = 0.f;
#pragma unroll
        for (int nt = 0; nt < 4; ++nt) {
            const int cl = hh * 64 + nt * 16 + fq * 4, ch = h * 64 + nt * 16 + fq * 4, nl = hh * 64 + nt * 16 + fr;
            f32x4 dl = (f32x4){0.f, 0.f, 0.f, 0.f}, al = dl, gl = dl, vm = dl;
            bf16x8 af[8];
#pragma unroll
            for (int ks = 0; ks < 8; ++ks) af[ks] = *(const LAS bf16x8*)(LA + (mt * 16 + fr) * 264 + ks * 32 + fq * 8);
            const bf16x8 avv = *(const LAS bf16x8*)(LW + (mt * 16 + fr) * 40 + fq * 8);
#pragma unroll
            for (int ks = 0; ks < 2; ++ks) {
                dl = __builtin_amdgcn_mfma_f32_16x16x32_bf16(*(const LAS bf16x8*)(WL2 + nl * 72 + ks * 32 + fq * 8), af[ks], dl, 0, 0, 0);
                al = __builtin_amdgcn_mfma_f32_16x16x32_bf16(*(const LAS bf16x8*)(WLA + nl * 72 + ks * 32 + fq * 8), af[2 + ks], al, 0, 0, 0);
            }
#pragma unroll
            for (int ks = 0; ks < 4; ++ks) gl = __builtin_amdgcn_mfma_f32_16x16x32_bf16(*(const LAS bf16x8*)(WLG + nl * 136 + ks * 32 + fq * 8), af[4 + ks], gl, 0, 0, 0);
            if (l == 1) vm = __builtin_amdgcn_mfma_f32_16x16x32_bf16(*(const LAS bf16x8*)(WLV + nl * 40 + fq * 8), avv, vm, 0, 0, 0);
            float rz[4], kz[4], vz[4];
            mixw(cR[nt], pR[nt], PAR + 768 + cl, rz); mixw(cK[nt], pK[nt], PAR + 896 + cl, kz); mixw(cV[nt], pV[nt], PAR + 1024 + cl, vz);
            const f32x4 w0 = *(const LAS f32x4*)(PAR + cl), a0 = *(const LAS f32x4*)(PAR + 128 + cl), kk4 = *(const LAS f32x4*)(PAR + 256 + cl);
            const f32x4 ka4 = *(const LAS f32x4*)(PAR + 384 + cl), rk4 = *(const LAS f32x4*)(PAR + 512 + cl), v04 = *(const LAS f32x4*)(PAR + 640 + cl);
            f32x4 oa, ob, od, ok, ord_, ov;
#pragma unroll
            for (int j = 0; j < 4; ++j) {
                const float dcy = __expf(-0.60653065971f * fsig(w0[j] + dl[j]));
                const float av_ = fsig(a0[j] + al[j]);
                float vj = vz[j];
                if (l == 1) { const float vmix = fsig(v04[j] + vm[j]); vj = vj + (vf[nt][j] - vj) * vmix; }
                const float kk = kz[j] * kk4[j] * inv, k2 = kz[j] * (1.f + (av_ - 1.f) * ka4[j]);
                oa[j] = -kk; ob[j] = kk * av_; od[j] = dcy; ok[j] = k2; ord_[j] = rz[j] * dcy; ov[j] = vj;
                br += ob[j] * rz[j]; kr += k2 * rz[j]; rkr += rz[j] * k2 * rk4[j];
            }
            const size_t o = (size_t)m * 512 + ch;
            *(f32x4*)(SA + o) = oa; *(f32x4*)(SB + o) = ob; *(f32x4*)(SD + o) = od; *(f32x4*)(SK + o) = ok; *(f32x4*)(SRD + o) = ord_; *(f32x4*)(SV + o) = ov; { u32x2 gw2; gw2.x = cvt_pk_bf16(gl[0], gl[1]); gw2.y = cvt_pk_bf16(gl[2], gl[3]); *(u32x2*)((bf16_t*)GG + o) = gw2; }
            __builtin_amdgcn_sched_barrier(0);
        }
        br += __shfl_xor(br, 16); br += __shfl_xor(br, 32); kr += __shfl_xor(kr, 16); kr += __shfl_xor(kr, 32); rkr += __shfl_xor(rkr, 16); rkr += __shfl_xor(rkr, 32);
        if (fq == 0) { SBR[m * 8 + h] = br; SKR[m * 8 + h] = kr; RKR[m * 8 + h] = rkr; }
        __syncthreads();
    }
}

__device__ __forceinline__ void convB_token(const Args& a, int l, int m, int lane) {
    unsigned char* ws = a.ws;
    const bf16_t* __restrict__ PROJ = (const bf16_t*)(ws + OFF_PROJ);
    bf16_t* __restrict__ YAB = (bf16_t*)(ws + OFF_YAB);
    const int cb = lane * 8;
        const bf16_t* pr = PROJ + (size_t)m * LDP;
        float gb[8], gc[8], hi[8], u0[8], u1[8], u2[8];
        unpack8(*(const u32x4*)(pr + 1792 + cb), gb); unpack8(*(const u32x4*)(pr + 2304 + cb), gc); unpack8(*(const u32x4*)(pr + 2816 + cb), hi);
#pragma unroll
        for (int j = 0; j < 8; ++j) { u0[j] = gc[j] * hi[j]; u1[j] = 0.f; u2[j] = 0.f; }
        if (m < MP) {
            const int t = m & 2047;
            if (t >= 1) { unpack8(*(const u32x4*)(pr - LDP + 2304 + cb), gc); unpack8(*(const u32x4*)(pr - LDP + 2816 + cb), hi);
#pragma unroll
                for (int j = 0; j < 8; ++j) u1[j] = gc[j] * hi[j]; }
            if (t >= 2) { unpack8(*(const u32x4*)(pr - 2 * LDP + 2304 + cb), gc); unpack8(*(const u32x4*)(pr - 2 * LDP + 2816 + cb), hi);
#pragma unroll
                for (int j = 0; j < 8; ++j) u2[j] = gc[j] * hi[j]; }
            if (t >= 2046) { float* dst = a.out + O_CONVP + (size_t)((l * NB + (m >> 11)) * 2 + (t - 2046)) * 512 + cb;
                *(f32x4*)dst = (f32x4){u0[0], u0[1], u0[2], u0[3]}; *(f32x4*)(dst + 4) = (f32x4){u0[4], u0[5], u0[6], u0[7]}; }
        } else {
            const int i = m - MP; const float* sc = a.in[I_SCONV] + (size_t)(l * NS + i) * 2 * 512 + cb;
            const f32x4 a0 = *(const f32x4*)sc, a1 = *(const f32x4*)(sc + 4), b0 = *(const f32x4*)(sc + 512), b1 = *(const f32x4*)(sc + 516);
#pragma unroll
            for (int j = 0; j < 4; ++j) { u2[j] = a0[j]; u2[4 + j] = a1[j]; u1[j] = b0[j]; u1[4 + j] = b1[j]; }
            float* dst = a.out + O_CONVS + (size_t)(l * NS + i) * 2 * 512 + cb;
            *(f32x4*)dst = b0; *(f32x4*)(dst + 4) = b1;
            *(f32x4*)(dst + 512) = (f32x4){u0[0], u0[1], u0[2], u0[3]}; *(f32x4*)(dst + 516) = (f32x4){u0[4], u0[5], u0[6], u0[7]};
        }
        const float* cw = a.in[I_CONVW] + (size_t)l * 3 * 512 + cb;
        float ob[8];
#pragma unroll
        for (int j = 0; j < 8; ++j) ob[j] = gb[j] * (cw[j] * u2[j] + cw[512 + j] * u1[j] + cw[1024 + j] * u0[j]);
        u32x4 w2; w2.x = pk2(ob[0], ob[1]); w2.y = pk2(ob[2], ob[3]); w2.z = pk2(ob[4], ob[5]); w2.w = pk2(ob[6], ob[7]);
        *(u32x4*)(YAB + (size_t)m * 1024 + 512 + cb) = w2;
}

typedef float f32x2 __attribute__((ext_vector_type(2)));
__device__ __forceinline__ float scan_step(float (&s)[4], const f32x4 av, const f32x4 bv, const f32x4 dv, const f32x4 kv, const f32x4 rd, float vi, float br, float kr) {
    f32x2 s01 = (f32x2){s[0], s[1]}, s23 = (f32x2){s[2], s[3]};
    f32x2 t = s01 * (f32x2){av[0], av[1]}; t = __builtin_elementwise_fma(s23, (f32x2){av[2], av[3]}, t);
    f32x2 u = s01 * (f32x2){rd[0], rd[1]}; u = __builtin_elementwise_fma(s23, (f32x2){rd[2], rd[3]}, u);
    float pa = t.x + t.y, py = u.x + u.y;
    pa = red16(pa); py = red16(py);
    const f32x2 pav = (f32x2){pa, pa}, viv = (f32x2){vi, vi};
    f32x2 w01 = (f32x2){kv[0], kv[1]} * viv; w01 = __builtin_elementwise_fma((f32x2){bv[0], bv[1]}, pav, w01);
    f32x2 w23 = (f32x2){kv[2], kv[3]} * viv; w23 = __builtin_elementwise_fma((f32x2){bv[2], bv[3]}, pav, w23);
    s01 = __builtin_elementwise_fma(s01, (f32x2){dv[0], dv[1]}, w01);
    s23 = __builtin_elementwise_fma(s23, (f32x2){dv[2], dv[3]}, w23);
    s[0] = s01.x; s[1] = s01.y; s[2] = s23.x; s[3] = s23.y;
    return py + pa * br + vi * kr;
}

__device__ __forceinline__ void scan_phase(LAS unsigned char* lds, const Args& a, int l, int tid, int lane, int wave) {
    unsigned char* ws = a.ws;
    const float* SA = (const float*)(ws + OFF_SA); const float* SB = (const float*)(ws + OFF_SB); const float* SD = (const float*)(ws + OFF_SD); const float* SK = (const float*)(ws + OFF_SK);
    const float* SRD = (const float*)(ws + OFF_SRD); const float* SV = (const float*)(ws + (l == 0 ? OFF_SV0 : OFF_SV1));
    const float* SBR = (const float*)(ws + OFF_SBR); const float* SKR = (const float*)(ws + OFF_SKR);
    float* Y = (float*)(ws + OFF_Y);
    constexpr int TC = 32, CB = 5 * TC * 64 + TC * 16 + 2 * TC;
    LAS float* L = (LAS float*)lds;
    const int j4 = lane >> 4, c = lane & 15;
    for (int ci = blockIdx.x; ci < 256; ci += gridDim.x) {
        const int hc = ci >> 2, rg = ci & 3, b = hc >> 3, h = hc & 7;
        const int st = tid >> 4, c16 = tid & 15;
        const int rl = (wave & 3) * 4 + j4;
        float s[4] = {0.f, 0.f, 0.f, 0.f};
        f32x4 pa, pb, pd, pk, pr; float pv, ps = 0.f;
        {
            const size_t m = (size_t)b * 2048 + st; const size_t o = m * 512 + h * 64 + c16 * 4;
            pa = *(const f32x4*)(SA + o); pb = *(const f32x4*)(SB + o); pd = *(const f32x4*)(SD + o); pk = *(const f32x4*)(SK + o); pr = *(const f32x4*)(SRD + o);
            pv = SV[m * 512 + h * 64 + rg * 16 + c16];
            if (tid < 32) ps = SBR[((size_t)b * 2048 + tid) * 8 + h]; else if (tid < 64) ps = SKR[((size_t)b * 2048 + tid - 32) * 8 + h];
        }
        {
            LAS float* B0 = L;
            *(LAS f32x4*)(B0 + st * 64 + c16 * 4) = pa; *(LAS f32x4*)(B0 + 2048 + st * 64 + c16 * 4) = pb; *(LAS f32x4*)(B0 + 4096 + st * 64 + c16 * 4) = pd;
            *(LAS f32x4*)(B0 + 6144 + st * 64 + c16 * 4) = pk; *(LAS f32x4*)(B0 + 8192 + st * 64 + c16 * 4) = pr; B0[10240 + st * 16 + c16] = pv;
            if (tid < 64) B0[10752 + tid] = ps;
        }
        __syncthreads();
        for (int n = 0; n < TT / TC; ++n) {
            LAS float* Bc = L + (n & 1) * CB; LAS float* Bn = L + ((n + 1) & 1) * CB; LAS float* yb = L + 2 * CB + (n & 1) * 512;
            const bool more = n + 1 < TT / TC;
            if (more) {
                const size_t m = (size_t)b * 2048 + (n + 1) * TC + st; const size_t o = m * 512 + h * 64 + c16 * 4;
                pa = *(const f32x4*)(SA + o); pb = *(const f32x4*)(SB + o); pd = *(const f32x4*)(SD + o); pk = *(const f32x4*)(SK + o); pr = *(const f32x4*)(SRD + o);
                pv = SV[m * 512 + h * 64 + rg * 16 + c16];
                if (tid < 32) ps = SBR[((size_t)b * 2048 + (n + 1) * TC + tid) * 8 + h]; else if (tid < 64) ps = SKR[((size_t)b * 2048 + (n + 1) * TC + tid - 32) * 8 + h];
            }
            if (wave < 4) {
                LAS float* ybase = (c == 0) ? (yb + rl) : (L + 2 * CB + 1024 + lane);
                const LAS float* p0 = Bc + c * 4;
                f32x4 av = *(const LAS f32x4*)p0, bv = *(const LAS f32x4*)(p0 + 2048), dv = *(const LAS f32x4*)(p0 + 4096), kv = *(const LAS f32x4*)(p0 + 6144), rd = *(const LAS f32x4*)(p0 + 8192);
                float vi = Bc[10240 + rl], br = Bc[10752], kr = Bc[10784];
#pragma unroll 8
                for (int t = 0; t < TC; ++t) {
                    const int tn = (t + 1 < TC) ? t + 1 : t;
                    const LAS float* p = Bc + tn * 64 + c * 4;
                    const f32x4 av2 = *(const LAS f32x4*)p, bv2 = *(const LAS f32x4*)(p + 2048), dv2 = *(const LAS f32x4*)(p + 4096), kv2 = *(const LAS f32x4*)(p + 6144), rd2 = *(const LAS f32x4*)(p + 8192);
                    const float vi2 = Bc[10240 + tn * 16 + rl], br2 = Bc[10752 + tn], kr2 = Bc[10784 + tn];
                    const float y = scan_step(s, av, bv, dv, kv, rd, vi, br, kr);
                    ybase[t * 16] = y;
                    av = av2; bv = bv2; dv = dv2; kv = kv2; rd = rd2; vi = vi2; br = br2; kr = kr2;
                }
            }
            else {
                const int hw4 = wave - 4;
                if (l == 0 && n < 14) {
                    const int d = (blockIdx.x * 4 + hw4) + 1024 * n;
                    if (d < TR_DEFERRED) tr_deferred(a, ws, d, (LAS float*)(lds + 94208 + hw4 * 8448), lane);
                } else if (n >= 24 && n < 41) {
                    const int tt = (n - 24) * 4 + hw4;
                    int mB = -1;
                    if (tt < 64) mB = blockIdx.x * 64 + tt; else if (tt == 64 && blockIdx.x < NS) mB = MP + blockIdx.x;
                    if (mB >= 0) convB_token(a, l, mB, lane);
                } else if (n >= 20 && n < 24) {
                    const int q = blockIdx.x + gridDim.x * (n - 20);
                    if (q < NS * 8) {
                        const int i = q >> 3, hs = q & 7; const size_t ms = MP + i;
                        const size_t o = ms * 512 + hs * 64 + c * 4;
                        const f32x4 av = *(const f32x4*)(SA + o), bv = *(const f32x4*)(SB + o), dv = *(const f32x4*)(SD + o), kv = *(const f32x4*)(SK + o), rd = *(const f32x4*)(SRD + o);
                        const float br = SBR[ms * 8 + hs], kr = SKR[ms * 8 + hs];
                        f32x4 s4[4]; float vi[4];
#pragma unroll
                        for (int p4 = 0; p4 < 4; ++p4) {
                            const int row = p4 * 16 + hw4 * 4 + j4;
                            s4[p4] = *(const f32x4*)(a.in[I_SWKV] + ((size_t)((l * NS + i) * 8 + hs)) * 4096 + row * 64 + c * 4);
                            vi[p4] = SV[ms * 512 + hs * 64 + row];
                        }
#pragma unroll
                        for (int p4 = 0; p4 < 4; ++p4) {
                            const int row = p4 * 16 + hw4 * 4 + j4;
                            float ss_[4] = {s4[p4][0], s4[p4][1], s4[p4][2], s4[p4][3]};
                            const float y = scan_step(ss_, av, bv, dv, kv, rd, vi[p4], br, kr);
                            *(f32x4*)(a.out + O_WKVS + ((size_t)((l * NS + i) * 8 + hs)) * 4096 + row * 64 + c * 4) = (f32x4){ss_[0], ss_[1], ss_[2], ss_[3]};
                            if (c == 0) Y[ms * 512 + hs * 64 + row] = y;
                        }
                    }
                }
            }
            if (more) {
                *(LAS f32x4*)(Bn + st * 64 + c16 * 4) = pa; *(LAS f32x4*)(Bn + 2048 + st * 64 + c16 * 4) = pb; *(LAS f32x4*)(Bn + 4096 + st * 64 + c16 * 4) = pd;
                *(LAS f32x4*)(Bn + 6144 + st * 64 + c16 * 4) = pk; *(LAS f32x4*)(Bn + 8192 + st * 64 + c16 * 4) = pr; Bn[10240 + st * 16 + c16] = pv;
                if (tid < 64) Bn[10752 + tid] = ps;
            }
            __syncthreads();
            Y[((size_t)b * 2048 + n * TC + st) * 512 + h * 64 + rg * 16 + c16] = yb[st * 16 + c16];
        }
        if (wave < 4) {
            float* o = a.out + O_WKVP + ((size_t)((l * 8 + b) * 8 + h)) * 4096 + (rg * 16 + rl) * 64 + c * 4;
            *(f32x4*)o = (f32x4){s[0], s[1], s[2], s[3]};
        }
        __syncthreads();
    }
}

__device__ __forceinline__ void post_phase(const Args& a, int l, int lane, int gw, int NGW) {
    unsigned char* ws = a.ws;
    const bf16_t* __restrict__ PROJ = (const bf16_t*)(ws + OFF_PROJ);
    const float* __restrict__ Y = (const float*)(ws + OFF_Y); const float* __restrict__ SV = (const float*)(ws + (l == 0 ? OFF_SV0 : OFF_SV1)); const float* __restrict__ GG = (const float*)(ws + OFF_G);
    const float* __restrict__ RKR = (const float*)(ws + OFF_RKR);
    bf16_t* __restrict__ YAB = (bf16_t*)(ws + OFF_YAB);
    const int cb = lane * 8, h = lane >> 3;
#pragma unroll 4
    for (int m = gw; m < MTOK; m += NGW) {
        const size_t o = (size_t)m * 512 + cb;
        const f32x4 y0 = *(const f32x4*)(Y + o), y1 = *(const f32x4*)(Y + o + 4);
        float s = (y0[0] + y0[1]) + (y0[2] + y0[3]) + (y1[0] + y1[1]) + (y1[2] + y1[3]);
        s += __shfl_xor(s, 1); s += __shfl_xor(s, 2); s += __shfl_xor(s, 4);
        const float mean = s * (1.f / 64.f);
        const f32x4 d0 = y0 - mean, d1 = y1 - mean;
        float q = (d0[0] * d0[0] + d0[1] * d0[1]) + (d0[2] * d0[2] + d0[3] * d0[3]) + (d1[0] * d1[0] + d1[1] * d1[1]) + (d1[2] * d1[2] + d1[3] * d1[3]);
        q += __shfl_xor(q, 1); q += __shfl_xor(q, 2); q += __shfl_xor(q, 4);
        const float rstd = rsqrtf(q * (1.f / 64.f) + GN_EPS);
        const float rkr = RKR[m * 8 + h];
        const f32x4 v0 = *(const f32x4*)(SV + o), v1 = *(const f32x4*)(SV + o + 4); f32x4 g0, g1; { const u32x4 gq = *(const u32x4*)((const bf16_t*)GG + o); g0 = (f32x4){bflo(gq.x), bfhi(gq.x), bflo(gq.y), bfhi(gq.y)}; g1 = (f32x4){bflo(gq.z), bfhi(gq.z), bflo(gq.w), bfhi(gq.w)}; }
        const f32x4 lw0 = *(const f32x4*)(a.in[I_LNW] + l * 512 + cb), lw1 = *(const f32x4*)(a.in[I_LNW] + l * 512 + cb + 4);
        const f32x4 lb0 = *(const f32x4*)(a.in[I_LNB] + l * 512 + cb), lb1 = *(const f32x4*)(a.in[I_LNB] + l * 512 + cb + 4);
        const f32x4 r0 = (d0 * rstd * lw0 + lb0 + v0 * rkr) * g0, r1 = (d1 * rstd * lw1 + lb1 + v1 * rkr) * g1;
        u32x4 w; w.x = pk2(r0[0], r0[1]); w.y = pk2(r0[2], r0[3]); w.z = pk2(r1[0], r1[1]); w.w = pk2(r1[2], r1[3]);
        *(u32x4*)(YAB + (size_t)m * 1024 + cb) = w;
    }
    if (l + 1 < 2 && gw < NS) {
        bf16_t* XB = (bf16_t*)(ws + OFF_XB) + (size_t)(MTOK + gw) * D;
        const float* src = a.in[I_SSHIFT] + (size_t)((l + 1) * NS + gw) * D; const float* gn = a.in[I_NMIX] + (l + 1) * D;
#pragma unroll
        for (int j = 0; j < 4; ++j) { const f32x4 v = *(const f32x4*)(src + 4 * lane + 256 * j), g4 = *(const f32x4*)(gn + 4 * lane + 256 * j);
            u32x2 w; w.x = pk2(v[0] / g4[0], v[1] / g4[1]); w.y = pk2(v[2] / g4[2], v[3] / g4[3]); *(u32x2*)(XB + 4 * lane + 256 * j) = w; }
    }
}

__device__ __forceinline__ void sample_attn(LAS unsigned char* lds, const Args& a, int l, int tid, int lane, int wave) {
    unsigned char* ws = a.ws;
    const bf16_t* Q = (const bf16_t*)(ws + OFF_Q); bf16_t* O = (bf16_t*)(ws + OFF_O);
    LAS float* sc = (LAS float*)lds;
    LAS float* part = sc + 256;
    for (int q = blockIdx.x; q < NS * 4; q += gridDim.x) {
        const int i = q >> 2, h = q & 3;
        const u32x2 qw = *(const u32x2*)(Q + (size_t)(MP + i) * 1024 + h * 256 + lane * 4);
        const float q0 = bflo(qw.x), q1 = bfhi(qw.x), q2 = bflo(qw.y), q3 = bfhi(qw.y);
        const float* Kb = a.in[I_CK] + ((size_t)((l * NS + i) * 256) * 4 + h) * 256 + lane * 4;
        const float* Vb = a.in[I_CV] + ((size_t)((l * NS + i) * 256) * 4 + h) * 256 + lane * 4;
        {
            f32x4 kx[8], kn[8];
#pragma unroll
            for (int e = 0; e < 8; ++e) kx[e] = __builtin_nontemporal_load((const f32x4*)(Kb + (size_t)(wave * 32 + e) * 1024));
#pragma unroll
            for (int g8 = 0; g8 < 4; ++g8) {
                if (g8 < 3) {
#pragma unroll
                    for (int e = 0; e < 8; ++e) kn[e] = __builtin_nontemporal_load((const f32x4*)(Kb + (size_t)(wave * 32 + (g8 + 1) * 8 + e) * 1024));
                }
#pragma unroll
                for (int e = 0; e < 8; ++e) { float p = kx[e][0] * q0 + kx[e][1] * q1 + kx[e][2] * q2 + kx[e][3] * q3; p = wave_sum(p); if (lane == 0) sc[wave * 32 + g8 * 8 + e] = p; }
#pragma unroll
                for (int e = 0; e < 8; ++e) kx[e] = kn[e];
            }
        }
        __syncthreads();
        if (wave == 0) {
            const f32x4 s4 = *(const LAS f32x4*)(sc + lane * 4);
            const float mx = wave_max(fmaxf(fmaxf(s4[0], s4[1]), fmaxf(s4[2], s4[3])));
            f32x4 e4; e4[0] = __expf(s4[0] - mx); e4[1] = __expf(s4[1] - mx); e4[2] = __expf(s4[2] - mx); e4[3] = __expf(s4[3] - mx);
            const float inv = 1.f / wave_sum((e4[0] + e4[1]) + (e4[2] + e4[3]));
            *(LAS f32x4*)(sc + lane * 4) = e4 * inv;
        }
        __syncthreads();
        f32x4 acc = (f32x4){0.f, 0.f, 0.f, 0.f};
        {
            f32x4 vx[8], vn[8];
#pragma unroll
            for (int e = 0; e < 8; ++e) vx[e] = __builtin_nontemporal_load((const f32x4*)(Vb + (size_t)(wave * 32 + e) * 1024));
#pragma unroll
            for (int g8 = 0; g8 < 4; ++g8) {
                if (g8 < 3) {
#pragma unroll
                    for (int e = 0; e < 8; ++e) vn[e] = __builtin_nontemporal_load((const f32x4*)(Vb + (size_t)(wave * 32 + (g8 + 1) * 8 + e) * 1024));
                }
#pragma unroll
                for (int e = 0; e < 8; ++e) acc += vx[e] * sc[wave * 32 + g8 * 8 + e];
#pragma unroll
                for (int e = 0; e < 8; ++e) vx[e] = vn[e];
            }
        }
        *(LAS f32x4*)(part + wave * 256 + lane * 4) = acc;
        __syncthreads();
        if (tid < 256) {
            float s = 0.f;
#pragma unroll
            for (int w = 0; w < 8; ++w) s += part[w * 256 + tid];
            O[(size_t)(MP + i) * 1024 + h * 256 + tid] = (bf16_t)f2bf(s);
        }
        __syncthreads();
    }
}

__device__ __forceinline__ void ffnconv_phase(const Args& a, int l, int tid) {
    unsigned char* ws = a.ws;
    const bf16_t* __restrict__ UP = (const bf16_t*)(ws + OFF_UP); bf16_t* __restrict__ H = (bf16_t*)(ws + OFF_H);
    const float* __restrict__ cw = a.in[I_FCW] + (size_t)l * 3 * FW2;
    constexpr int CH = FW / 8;
    for (int rb = blockIdx.x; rb < MP / 64; rb += gridDim.x) {
        if (tid < CH) {
            const int c = tid * 8, r0 = rb * 64, t0 = r0 & 2047;
            float wu[3][8], wg[3][8];
#pragma unroll
            for (int k = 0; k < 3; ++k) {
                const f32x4 a0 = *(const f32x4*)(cw + k * FW2 + c), a1 = *(const f32x4*)(cw + k * FW2 + c + 4), b0 = *(const f32x4*)(cw + k * FW2 + FW + c), b1 = *(const f32x4*)(cw + k * FW2 + FW + c + 4);
#pragma unroll
                for (int j = 0; j < 4; ++j) { wu[k][j] = a0[j]; wu[k][4 + j] = a1[j]; wg[k][j] = b0[j]; wg[k][4 + j] = b1[j]; }
            }
            float u2[8], u1[8], g2[8], g1[8];
#pragma unroll
            for (int j = 0; j < 8; ++j) { u2[j] = 0.f; u1[j] = 0.f; g2[j] = 0.f; g1[j] = 0.f; }
            if (t0 >= 2) {
                const bf16_t* p = UP + (size_t)(r0 - 2) * FW2 + c;
                unpack8(*(const u32x4*)p, u2); unpack8(*(const u32x4*)(p + FW), g2); unpack8(*(const u32x4*)(p + FW2), u1); unpack8(*(const u32x4*)(p + FW2 + FW), g1);
            }
            const bf16_t* p = UP + (size_t)r0 * FW2 + c; bf16_t* hp = H + (size_t)r0 * FW + c;
#pragma unroll 1
            for (int r = 0; r < 64; r += 4) {
                u32x4 lu[4], lg[4];
#pragma unroll
                for (int e = 0; e < 4; ++e) { lu[e] = *(const u32x4*)(p + (size_t)(r + e) * FW2); lg[e] = *(const u32x4*)(p + (size_t)(r + e) * FW2 + FW); }
#pragma unroll
                for (int e = 0; e < 4; ++e) {
                    float u0[8], g0[8], hh[8]; unpack8(lu[e], u0); unpack8(lg[e], g0);
#pragma unroll
                    for (int j = 0; j < 8; ++j) {
                        const float uu = wu[0][j] * u2[j] + wu[1][j] * u1[j] + wu[2][j] * u0[j], gg = wg[0][j] * g2[j] + wg[1][j] * g1[j] + wg[2][j] * g0[j];
                        hh[j] = gg * __builtin_amdgcn_rcpf(1.f + __expf(-gg)) * uu;
                        u2[j] = u1[j]; u1[j] = u0[j]; g2[j] = g1[j]; g1[j] = g0[j];
                    }
                    u32x4 w; w.x = cvt_pk_bf16(hh[0], hh[1]); w.y = cvt_pk_bf16(hh[2], hh[3]); w.z = cvt_pk_bf16(hh[4], hh[5]); w.w = cvt_pk_bf16(hh[6], hh[7]);
                    *(u32x4*)(hp + (size_t)(r + e) * FW) = w;
                }
            }
        }
    }
    for (int it = blockIdx.x * 512 + tid; it < NS * CH; it += gridDim.x * 512) {
        const int i = it / CH, c = (it % CH) * 8, m = MP + i;
        const bf16_t* r0 = UP + (size_t)m * FW2;
        float u[8], g[8], t0[8], t1[8];
        unpack8(*(const u32x4*)(r0 + c), t0); unpack8(*(const u32x4*)(r0 + FW + c), t1);
        const float* sf = a.in[I_SFFN] + (size_t)(l * NS + i) * 2 * FW2;
        float* dst = a.out + O_FFNS + (size_t)(l * NS + i) * 2 * FW2;
        float hh[8];
#pragma unroll
        for (int q = 0; q < 2; ++q) {
            const int cc = c + 4 * q;
            const f32x4 p0u = *(const f32x4*)(sf + cc), p0g = *(const f32x4*)(sf + FW + cc), p1u = *(const f32x4*)(sf + FW2 + cc), p1g = *(const f32x4*)(sf + FW2 + FW + cc);
            const f32x4 w0u = *(const f32x4*)(cw + cc), w1u = *(const f32x4*)(cw + FW2 + cc), w2u = *(const f32x4*)(cw + 2 * FW2 + cc);
            const f32x4 w0g = *(const f32x4*)(cw + FW + cc), w1g = *(const f32x4*)(cw + FW2 + FW + cc), w2g = *(const f32x4*)(cw + 2 * FW2 + FW + cc);
            *(f32x4*)(dst + cc) = p1u; *(f32x4*)(dst + FW + cc) = p1g;
#pragma unroll
            for (int j = 0; j < 4; ++j) {
                u[4 * q + j] = w2u[j] * t0[4 * q + j] + w0u[j] * p0u[j] + w1u[j] * p1u[j]; g[4 * q + j] = w2g[j] * t1[4 * q + j] + w0g[j] * p0g[j] + w1g[j] * p1g[j];
                hh[4 * q + j] = g[4 * q + j] * sigmoidf_(g[4 * q + j]) * u[4 * q + j];
            }
        }
        u32x4 w; w.x = pk2(hh[0], hh[1]); w.y = pk2(hh[2], hh[3]); w.z = pk2(hh[4], hh[5]); w.w = pk2(hh[6], hh[7]);
        *(u32x4*)(H + (size_t)m * FW + c) = w;
    }
}

__device__ __forceinline__ void final_phase(const Args& a, int lane, int gw, int NGW) {
    unsigned char* ws = a.ws;
    const float* __restrict__ X = (const float*)(ws + OFF_X); const float* __restrict__ SS = (const float*)(ws + OFF_SS) + (size_t)6 * MROWS;
    float* __restrict__ outp = a.out;
#pragma unroll 4
    for (int m = gw; m < MTOK; m += NGW) {
        const float rs = rsqrtf(SS[m] * (1.f / 1024.f) + EPS);
        float* __restrict__ dst = m < MP ? outp + O_YP + (size_t)m * D : outp + O_YS + (size_t)(m - MP) * D;
#pragma unroll
        for (int j = 0; j < 4; ++j) { const f32x4 v = *(const f32x4*)(X + (size_t)m * D + 4 * lane + 256 * j), gn = *(const f32x4*)(a.in[I_NFIN] + 4 * lane + 256 * j);
            *(f32x4*)(dst + 4 * lane + 256 * j) = v * rs * gn; }
    }
}

__device__ __forceinline__ void skinny_gemm(LAS unsigned char* lds, const bf16_t* __restrict__ A, int lda, const bf16_t* __restrict__ Wt, int K, int mode, float* X, bf16_t* O, float* ssn, const float* ss, int lane, int wave) {
    LAS f32x4* part = (LAS f32x4*)lds;
    for (int item = blockIdx.x; item < 256; item += gridDim.x) {
        const int n0 = (item & 63) * 16, r0 = MP + (item >> 6) * 32, fr = lane & 15, fq = lane >> 4;
        const bf16_t* ap = A + (size_t)(r0 + fr) * lda + fq * 8;
        const bf16_t* bp = Wt + (size_t)(n0 + fr) * K + fq * 8;
        f32x4 acc0 = (f32x4){0.f, 0.f, 0.f, 0.f}, acc1 = acc0;
#pragma unroll 4
        for (int ks = wave; ks < K / 32; ks += 8) {
            const bf16x8 bf = *(const bf16x8*)(bp + ks * 32), a0 = *(const bf16x8*)(ap + ks * 32), a1 = *(const bf16x8*)(ap + (size_t)16 * lda + ks * 32);
            acc0 = __builtin_amdgcn_mfma_f32_16x16x32_bf16(bf, a0, acc0, 0, 0, 0);
            acc1 = __builtin_amdgcn_mfma_f32_16x16x32_bf16(bf, a1, acc1, 0, 0, 0);
        }
        part[(wave * 2 + 0) * 64 + lane] = acc0; part[(wave * 2 + 1) * 64 + lane] = acc1;
        __syncthreads();
        if (wave < 2) {
            f32x4 acc = part[wave * 64 + lane];
#pragma unroll
            for (int w = 1; w < 8; ++w) acc += part[(w * 2 + wave) * 64 + lane];
            const int row = r0 + wave * 16 + fr, col = n0 + fq * 4;
            const size_t idx = (size_t)row * 1024 + col;
            if (mode == 1) {
                const f32x4 x = *(const f32x4*)(X + idx) + acc;
                *(f32x4*)(X + idx) = x;
                u32x2 w; w.x = cvt_pk_bf16(x[0], x[1]); w.y = cvt_pk_bf16(x[2], x[3]); *(u32x2*)(O + idx) = w;
                float sq = (x[0] * x[0] + x[1] * x[1]) + (x[2] * x[2] + x[3] * x[3]);
                sq += __shfl_xor(sq, 16); sq += __shfl_xor(sq, 32);
                if (fq == 0) atomicAdd(ssn + row, sq);
            } else {
                const float rs = rsqrtf(ss[row] * (1.f / 1024.f) + EPS);
                u32x2 w; w.x = cvt_pk_bf16(acc[0] * rs, acc[1] * rs); w.y = cvt_pk_bf16(acc[2] * rs, acc[3] * rs); *(u32x2*)(O + idx) = w;
            }
        }
        __syncthreads();
    }
}

#define XB_TMO      128
#define XB_XCNT(j)  (256  + 64 * (j))
#define XB_XSUB(j)  (1280 + 64 * (j))
#define XB_XGEN(j)  (2304 + 64 * (j))
#define XB_TOP      3328
#define XB_TOPGEN   3392
#define XCD_BAR_WORDS 3456
#define XB_SPIN_CAP (1u << 22)
__device__ __forceinline__ unsigned xb_ld(unsigned* p)              { return __hip_atomic_load(p, __ATOMIC_RELAXED, __HIP_MEMORY_SCOPE_AGENT); }
__device__ __forceinline__ unsigned xb_add(unsigned* p, unsigned v) { return __hip_atomic_fetch_add(p, v, __ATOMIC_RELAXED, __HIP_MEMORY_SCOPE_AGENT); }
__device__ __forceinline__ unsigned xb_xcc_id() { return (unsigned)__builtin_amdgcn_s_getreg((3 << 11) | 20) & 0xFu; }
#define XB_SPIN(cond, bar) do { unsigned _sp = 0; while (cond) { __builtin_amdgcn_s_sleep(1); \
    if ((++_sp & 255u) == 0u) { if (xb_ld(&(bar)[XB_TMO])) break; if (_sp > XB_SPIN_CAP) { atomicAdd(&(bar)[XB_TMO], 1u); break; } } } } while (0)
struct XcdBarrier { unsigned* bar; unsigned x; volatile LAS unsigned* st; };
__device__ __forceinline__ XcdBarrier xcd_barrier_post(unsigned* bar, volatile LAS unsigned* st) {
    XcdBarrier b; b.bar = bar; b.x = xb_xcc_id(); b.st = st;
    if (threadIdx.x == 0) (void)xb_add(&bar[XB_XCNT(b.x)], 1u);
    return b;
}
__device__ __forceinline__ void xcd_barrier_complete(unsigned* bar, unsigned x, unsigned& nloc, unsigned& nx) {
    const unsigned G = gridDim.x * gridDim.y * gridDim.z;
    unsigned sum, cnt, mine, sp = 0u;
    for (;;) {
        sum = 0u; cnt = 0u; mine = 0u;
#pragma unroll
        for (unsigned j = 0; j < 16; ++j) { const unsigned c = xb_ld(&bar[XB_XCNT(j)]); sum += c; cnt += (c > 0u) ? 1u : 0u; mine = (j == x) ? c : mine; }
        if (sum == G) break;
        __builtin_amdgcn_s_sleep(1);
        if ((++sp & 255u) == 0u) { if (xb_ld(&bar[XB_TMO])) break; if (sp > XB_SPIN_CAP) { atomicAdd(&bar[XB_TMO], 1u); break; } }
    }
    nloc = mine > 0u ? mine : 1u; nx = cnt > 0u ? cnt : 1u;
}
__device__ __forceinline__ void xcd_barrier(const XcdBarrier& b) {
    asm volatile("s_waitcnt vmcnt(0)" ::: "memory");
    __syncthreads();
    if (threadIdx.x == 0) {
        unsigned* bar = b.bar;
        __builtin_amdgcn_s_waitcnt(0);
        unsigned nloc = b.st[0], nx = b.st[1];
        if (nloc == 0u) { xcd_barrier_complete(bar, b.x, nloc, nx); b.st[0] = nloc; b.st[1] = nx; }
        const unsigned old = xb_add(&bar[XB_XSUB(b.x)], 1u);
        const unsigned gen = old / nloc;
        if (old + 1u == (gen + 1u) * nloc) {
            __builtin_amdgcn_fence(__ATOMIC_RELEASE, "agent");
            asm volatile("s_waitcnt vmcnt(0)" ::: "memory");
            const unsigned og = xb_add(&bar[XB_TOP], 1u);
            const unsigned tg = og / nx;
            if (og + 1u == (tg + 1u) * nx) xb_add(&bar[XB_TOPGEN], 1u);
            else XB_SPIN(xb_ld(&bar[XB_TOPGEN]) == tg, bar);
            __builtin_amdgcn_fence(__ATOMIC_ACQUIRE, "agent");
            xb_add(&bar[XB_XGEN(b.x)], 1u);
            asm volatile("s_waitcnt vmcnt(0)" ::: "memory");
        } else {
            XB_SPIN(xb_ld(&bar[XB_XGEN(b.x)]) == gen, bar);
            __builtin_amdgcn_fence(__ATOMIC_ACQUIRE, "agent");
            asm volatile("s_waitcnt vmcnt(0)" ::: "memory");
        }
    }
    __syncthreads();
}

__global__ void __launch_bounds__(512, 2) mega(Args a) {
    extern __shared__ __attribute__((aligned(16))) unsigned char lds_raw[];
    LAS unsigned char* lds = (LAS unsigned char*)lds_raw;
    cg::grid_group grid = cg::this_grid();
    volatile LAS unsigned* bst = (volatile LAS unsigned*)(lds + 131072 + 64);
    if (threadIdx.x == 0) { bst[0] = 0u; bst[1] = 0u; }
    __syncthreads();
    const XcdBarrier xbar = xcd_barrier_post((unsigned*)(a.ws + OFF_BAR), bst);
    for (int ph2 = 2 * a.ph_lo; ph2 < 2 * a.ph_hi; ++ph2) {
        const int ph = ph2 >> 1;
        if (ph2 & 1) { const int spx = (ph == 0) ? 12 : (ph == NPHASE - 1) ? 13 : (ph - 1) % 12; if (!((REP_MASK >> spx) & 1)) continue; }
        int tid = threadIdx.x; asm volatile("" : "+v"(tid));
        const int lane = tid & 63, wave = __builtin_amdgcn_readfirstlane(tid >> 6);
        const int G = gridDim.x, gw = blockIdx.x * 8 + wave, NGW = G * 8;
        unsigned char* ws = a.ws; asm volatile("" : "+s"(ws));
        float* SS = (float*)(ws + OFF_SS);
        bf16_t* XB = (bf16_t*)(ws + OFF_XB); float* X = (float*)(ws + OFF_X);
        if (ph == 0) {
            if (PHON(12)) p0_prologue(lds, a, tid, lane, wave, gw, NGW);
        } else if (ph == NPHASE - 1) {
            if (PHON(13)) final_phase(a, lane, gw, NGW);
        } else {
            const int l = (ph - 1) / 12, sp = (ph - 1) % 12;
            const bool is_gemm = (sp == 0 || sp == 4 || sp == 5 || sp == 7 || sp == 8 || sp == 9 || sp == 11);
            if (is_gemm && PHON(0)) {
                const int njobs = (l == 0 && (sp == 0 || sp == 9)) ? 3 : 1;
                for (int jb = 0; jb < njobs; ++jb) {
                    pg8::Gemm g; pg8::GenOrder S; pg8::Epi E;
                    E.mode = 0; E.O = nullptr; E.ldc = D; E.ss = nullptr; E.X = nullptr; E.ssn = nullptr; E.F = nullptr; E.l = l; E.dry = (ph2 & 1);
                    if (sp == 0 && jb == 0) {
                        g = pg8::Gemm{XB, (const bf16_t*)(ws + OFF_WIN) + (size_t)l * LDP * D, D, D, D};
                        S.init(0, MROWS, LDP, D, D, G, (int)blockIdx.x);
                        E.O = (bf16_t*)(ws + OFF_PROJ); E.ldc = LDP; E.ss = SS + (size_t)3 * l * MROWS;
                    } else if (jb > 0) {
                        const int kv = (sp == 0 ? 0 : 2) + jb - 1, ll = kv >> 1, isv = kv & 1;
                        g = pg8::Gemm{(const bf16_t*)(ws + OFF_MNB), (const bf16_t*)(ws + (isv ? OFF_WV : OFF_WK)) + (size_t)ll * D * D, D, D, D};
                        S.init(0, MMEM, D, D, D, G, (int)((blockIdx.x + G - 160 - 32 * (jb - 1)) % G));
                        E.mode = isv ? 3 : 2; E.O = (bf16_t*)(ws + (isv ? OFF_MVT : OFF_MK)) + (size_t)ll * MMEM * D; E.ss = (const float*)(ws + OFF_SSM);
                        E.F = a.out + (isv ? O_MVP : O_MKP) + (size_t)ll * MMEM * D; E.l = ll;
                    } else if (sp == 4 || sp == 8 || sp == 11) {
                        const bf16_t* A = (const bf16_t*)(ws + (sp == 4 ? OFF_YAB : sp == 8 ? OFF_O : OFF_H));
                        const bf16_t* B = sp == 4 ? (const bf16_t*)(ws + OFF_WOUT) + (size_t)l * D * D : sp == 8 ? (const bf16_t*)(ws + OFF_WO) + (size_t)l * D * D : (const bf16_t*)(ws + OFF_WDN) + (size_t)l * D * FW;
                        const int K = sp == 11 ? FW : D;
                        const int nrm = 3 * l + (sp == 4 ? 1 : sp == 8 ? 2 : 3);
                        g = pg8::Gemm{A, B, K, K, K};
                        S.init(0, MP, D, K, K, G, (int)blockIdx.x);
                        E.mode = 1; E.O = XB; E.X = X; E.ssn = SS + (size_t)nrm * MROWS;
                    } else if (sp == 5) {
                        g = pg8::Gemm{XB, (const bf16_t*)(ws + OFF_WQ) + (size_t)l * D * D, D, D, D};
                        S.init(0, MP, D, D, D, G, (int)blockIdx.x);
                        E.O = (bf16_t*)(ws + OFF_Q); E.ss = SS + (size_t)(3 * l + 1) * MROWS;
                    } else if (sp == 7) {
                        g = pg8::Gemm{(const bf16_t*)(ws + OFF_P), (const bf16_t*)(ws + OFF_MVT) + (size_t)l * MMEM * D, D, 256, 256};
                        S.init(2, MP, D, D, 256, G, (int)blockIdx.x);
                        E.O = (bf16_t*)(ws + OFF_O);
                    } else {
                        g = pg8::Gemm{XB, (const bf16_t*)(ws + OFF_WUP) + (size_t)l * FW2 * D, D, D, D};
                        S.init(0, MROWS, FW2, D, D, G, (int)blockIdx.x);
                        E.mode = 4; E.O = (bf16_t*)(ws + OFF_UP); E.ldc = FW2; E.ss = SS + (size_t)(3 * l + 2) * MROWS; E.F = a.out;
                    }
                    pg8::gemm_phase<pg8::Epi, pg8::GenOrder, true>(lds, g, S, E);
                    if (jb == 0 && !(ph2 & 1) && (sp == 4 || sp == 5 || sp == 8 || sp == 11))
                        skinny_gemm(lds, g.A, g.lda, g.Bt, g.K, E.mode, X, E.O, E.ssn, E.ss, lane, wave);
                }
            } else if (sp == 1 && PHON(1)) {
                prep_phase(lds, a, l, tid, lane, wave, gw);
            } else if (sp == 2 && PHON(2)) {
                scan_phase(lds, a, l, tid, lane, wave);
            } else if (sp == 3 && PHON(3)) {
                post_phase(a, l, lane, gw, NGW);
            } else if (sp == 6 && PHON(6)) {
                {
                    pg8::Gemm g{(const bf16_t*)(ws + OFF_Q), (const bf16_t*)(ws + OFF_MK) + (size_t)l * MMEM * D, D, D, 256};
                    pg8::GenOrder S; S.init(1, MP, D, D, D, G, (int)blockIdx.x);
                    pg8::EpiSm E{(bf16_t*)(ws + OFF_P)};
                    pg8::gemm_phase<pg8::EpiSm, pg8::GenOrder, false>(lds, g, S, E);
                }
                __syncthreads();
                sample_attn(lds, a, l, tid, lane, wave);
            } else if (sp == 10 && PHON(10)) {
                ffnconv_phase(a, l, tid);
            }
        }
        if (ph2 + 1 < 2 * a.ph_hi) { if (a.ph_lo < 0) grid.sync(); else xcd_barrier(xbar); }
        if (((REP_MASK >> 14) & 1) && ph2 == 0) { for (int q = 0; q < 40; ++q) xcd_barrier(xbar); }
    }
}

extern "C" void kernel_launch(void* const* d_in, const int* in_sizes, int n_in, void* d_out, int out_size, void* d_ws, size_t ws_size, hipStream_t stream) {
    static int grid = 0;
    if (grid == 0) {
        if (n_in != 38 || ws_size < WS_END) { fprintf(stderr, "kernel_launch: expected 38 inputs and >= %zu bytes of workspace (got %d, %zu)\n", (size_t)WS_END, n_in, ws_size); grid = -1; return; }
        int dev = 0, cus = 0, per_cu = 0;
        hipGetDevice(&dev);
        hipDeviceGetAttribute(&cus, hipDeviceAttributeMultiprocessorCount, dev);
        if (hipFuncSetAttribute((const void*)mega, hipFuncAttributeMaxDynamicSharedMemorySize, LDS_BYTES) != hipSuccess) { fprintf(stderr, "kernel_launch: hipFuncSetAttribute failed\n"); grid = -1; return; }
        hipOccupancyMaxActiveBlocksPerMultiprocessor(&per_cu, (const void*)mega, 512, LDS_BYTES);
        if (per_cu < 1) { fprintf(stderr, "kernel_launch: occupancy query says %d blocks per CU\n", per_cu); per_cu = 1; }
        (void)hipGetLastError();
        grid = cus;
        if (grid != 256) fprintf(stderr, "kernel_launch: built for 256 CUs, got %d\n", grid);
    }
    if (grid < 0) return;
    if (hipMemsetAsync((char*)d_ws + OFF_BAR, 0, BAR_BYTES, stream) != hipSuccess) { fprintf(stderr, "kernel_launch: hipMemsetAsync failed\n"); return; }
    Args a{};
    for (int i = 0; i < 38; ++i) a.in[i] = (const float*)d_in[i];
    a.out = (float*)d_out; a.ws = (unsigned char*)d_ws;
#if MK_PER_PHASE
    for (int ph = 0; ph < NPHASE; ++ph) {
        a.ph_lo = ph; a.ph_hi = ph + 1;
        void* args[] = {&a};
        hipError_t e = hipLaunchCooperativeKernel((const void*)mega, dim3(grid), dim3(512), args, LDS_BYTES, stream);
        if (e != hipSuccess) { fprintf(stderr, "cooperative launch failed: %s\n", hipGetErrorString(e)); break; }
    }
#else
    a.ph_lo = 0; a.ph_hi = NPHASE;
    void* args[] = {&a};
    hipError_t e = hipLaunchCooperativeKernel((const void*)mega, dim3(grid), dim3(512), args, LDS_BYTES, stream);
    if (e != hipSuccess) fprintf(stderr, "cooperative launch failed: %s (grid %d)\n", hipGetErrorString(e), grid);
#endif
    (void)in_sizes; (void)out_size;
}
```

```cpp
#include <hip/hip_runtime.h>
#include <hip/hip_cooperative_groups.h>
#include <cstdio>
#include <cstdint>
namespace cg = cooperative_groups;

#ifndef PH_MASK
#define PH_MASK 0xFFFFF
#endif
#define PHON(k) (((PH_MASK) >> (k)) & 1)
#ifndef REP_MASK
#define REP_MASK 0
#endif
#ifndef MK_PER_PHASE
#define MK_PER_PHASE 0
#endif

#define LAS __attribute__((address_space(3)))
typedef unsigned short bf16_t;
typedef short bf16x8 __attribute__((ext_vector_type(8)));
typedef float f32x4 __attribute__((ext_vector_type(4)));
typedef unsigned u32x4 __attribute__((ext_vector_type(4)));
typedef unsigned u32x2 __attribute__((ext_vector_type(2)));
#define LDS_WAIT() asm volatile("s_waitcnt lgkmcnt(0)" ::: "memory")

constexpr int D = 1024, NB = 8, TT = 2048, MP = NB * TT, NS = 128, MTOK = MP + NS, MROWS = 16640;
constexpr int INC = 3328, LDP = 3584, FW = 2816, FW2 = 5632, NMEM = 256, MMEM = NB * NMEM;
constexpr float EPS = 1e-6f, GN_EPS = 64e-5f;
constexpr int NPHASE = 26;
constexpr int LDS_BYTES = 147456;

constexpr size_t O_YP = 0, O_YS = 16777216, O_SHP = 16908288, O_WKVP = 16924672, O_CONVP = 17448960, O_FFNP = 17465344,
                 O_MKP = 17645568, O_MVP = 21839872, O_SHS = 26034176, O_WKVS = 26296320, O_CONVS = 34684928, O_FFNS = 34947072;

constexpr size_t al256(size_t x) { return (x + 255) & ~(size_t)255; }
constexpr size_t OFF_SS = 0;
constexpr size_t OFF_SSM = al256(OFF_SS + (size_t)7 * MROWS * 4);
constexpr size_t OFF_WIN = al256(OFF_SSM + 2048 * 4);
constexpr size_t OFF_WOUT = OFF_WIN + (size_t)2 * LDP * D * 2;
constexpr size_t OFF_WQ = OFF_WOUT + (size_t)2 * D * D * 2;
constexpr size_t OFF_WK = OFF_WQ + (size_t)2 * D * D * 2;
constexpr size_t OFF_WV = OFF_WK + (size_t)2 * D * D * 2;
constexpr size_t OFF_WO = OFF_WV + (size_t)2 * D * D * 2;
constexpr size_t OFF_WUP = OFF_WO + (size_t)2 * D * D * 2;
constexpr size_t OFF_WDN = OFF_WUP + (size_t)2 * FW2 * D * 2;
constexpr size_t OFF_W2 = OFF_WDN + (size_t)2 * D * FW * 2;
constexpr size_t OFF_A2 = OFF_W2 + (size_t)2 * 512 * 64 * 2;
constexpr size_t OFF_G2 = OFF_A2 + (size_t)2 * 512 * 64 * 2;
constexpr size_t OFF_V1 = OFF_G2 + (size_t)2 * 512 * 128 * 2;
constexpr size_t OFF_V2 = OFF_V1 + (size_t)32 * 512 * 2;
constexpr size_t OFF_X = al256(OFF_V2 + (size_t)512 * 32 * 2);
constexpr size_t OFF_XB = OFF_X + (size_t)MROWS * D * 4;
constexpr size_t OFF_MNB = OFF_XB + (size_t)MROWS * D * 2;
constexpr size_t OFF_MK = OFF_MNB + (size_t)MMEM * D * 2;
constexpr size_t OFF_MVT = OFF_MK + (size_t)2 * MMEM * D * 2;
constexpr size_t OFF_PROJ = OFF_MVT + (size_t)2 * MMEM * D * 2;
constexpr size_t OFF_H = OFF_PROJ;
constexpr size_t SCN = (size_t)MTOK * 512 * 4;
constexpr size_t OFF_SA = OFF_PROJ + (size_t)MROWS * LDP * 2;
constexpr size_t OFF_SB = OFF_SA + SCN, OFF_SD = OFF_SB + SCN, OFF_SK = OFF_SD + SCN, OFF_SRD = OFF_SK + SCN, OFF_G = OFF_SRD + SCN;
constexpr size_t OFF_UP = OFF_SA;
constexpr size_t OFF_SV0 = OFF_G + SCN, OFF_SV1 = OFF_SV0 + SCN;
constexpr size_t OFF_SBR = OFF_SV1 + SCN;
constexpr size_t OFF_SKR = OFF_SBR + (size_t)MTOK * 8 * 4, OFF_RKR = OFF_SKR + (size_t)MTOK * 8 * 4;
constexpr size_t OFF_Y = al256(OFF_RKR + (size_t)MTOK * 8 * 4);
constexpr size_t OFF_YAB = OFF_Y + SCN;
constexpr size_t OFF_Q = OFF_YAB + (size_t)MROWS * D * 2;
constexpr size_t OFF_P = OFF_Q + (size_t)MROWS * D * 2;
constexpr size_t OFF_O = OFF_P + (size_t)MROWS * D * 2;
constexpr size_t OFF_BAR = OFF_O + (size_t)MROWS * D * 2;
constexpr size_t BAR_BYTES = 16384;
constexpr size_t WS_END = OFF_BAR + BAR_BYTES;
static_assert((size_t)MROWS * FW2 * 2 <= 6 * SCN, "UP overlay");
static_assert((size_t)MROWS * FW * 2 <= (size_t)MROWS * LDP * 2, "H overlay");
static_assert(WS_END < (size_t)1050000000, "workspace");

__device__ __forceinline__ unsigned f2bf(float f) { unsigned u = __builtin_bit_cast(unsigned, f); return (u + 0x7fffu + ((u >> 16) & 1u)) >> 16; }
__device__ __forceinline__ unsigned pk2(float lo, float hi) { return f2bf(lo) | (f2bf(hi) << 16); }
__device__ __forceinline__ unsigned cvt_pk_bf16(float lo, float hi) { unsigned r; asm volatile("v_cvt_pk_bf16_f32 %0, %1, %2" : "=v"(r) : "v"(lo), "v"(hi)); return r; }
__device__ __forceinline__ float bflo(unsigned w) { return __builtin_bit_cast(float, w << 16); }
__device__ __forceinline__ float bfhi(unsigned w) { return __builtin_bit_cast(float, w & 0xffff0000u); }
__device__ __forceinline__ float wave_sum(float v) {
#pragma unroll
    for (int o = 1; o < 64; o <<= 1) v += __shfl_xor(v, o);
    return v;
}
__device__ __forceinline__ float wave_max(float v) {
#pragma unroll
    for (int o = 1; o < 64; o <<= 1) v = fmaxf(v, __shfl_xor(v, o));
    return v;
}
__device__ __forceinline__ float sigmoidf_(float x) { return 1.f / (1.f + __expf(-x)); }
__device__ __forceinline__ void unpack8(u32x4 w, float* f) { f[0] = bflo(w.x); f[1] = bfhi(w.x); f[2] = bflo(w.y); f[3] = bfhi(w.y); f[4] = bflo(w.z); f[5] = bfhi(w.z); f[6] = bflo(w.w); f[7] = bfhi(w.w); }
template <int CTRL> __device__ __forceinline__ float dppf(float v) { return __builtin_bit_cast(float, __builtin_amdgcn_update_dpp(0, __builtin_bit_cast(int, v), CTRL, 0xF, 0xF, true)); }
__device__ __forceinline__ float red16(float v) { v += dppf<0xB1>(v); v += dppf<0x4E>(v); v += dppf<0x124>(v); v += dppf<0x128>(v); return v; }

namespace pg8 {
constexpr int BM = 256, BK = 64, HALF = 128, HTB = HALF * BK * 2, STAGE_BYTES = 8 * HTB, NXCD = 8, WGM = 8;
__host__ __device__ __forceinline__ int lds_byte(int r, int c) { const int st = (r >> 4) * 2 + (c >> 5), rr = r & 15, cc = c & 31, ob = rr * 64 + cc * 2; return st * 1024 + (ob ^ (((ob >> 9) & 1) << 5)); }
__host__ __device__ __forceinline__ void stage_rc(int b, int& R, int& C) { const int st = b / 1024, sb = b % 1024, swz = sb ^ (((sb >> 9) & 1) << 5); R = (st >> 1) * 16 + swz / 64; C = (st & 1) * 32 + (swz % 64) / 2; }
__host__ __device__ __forceinline__ int perm32(int rho) { const int n = rho >> 4, i = rho & 15; return 8 * (i >> 2) + 4 * n + (i & 3); }

struct Unit { int pm, pn; size_t offA, offB; };
struct Gemm { const bf16_t* A; const bf16_t* Bt; int lda, ldb, K; };

struct GenOrder {
    int mode, nM, nN, nwg, G, c; size_t sA, sB;
    __device__ void init(int mode_, int M, int N, int lda, int ldb, int G_, int c_) { mode = mode_; nM = M / BM; nN = N / BM; nwg = nM * nN; G = G_; c = c_; sA = (size_t)BM * lda * 2; sB = (size_t)BM * ldb * 2; }
    __device__ bool next(int i, Unit& u) const {
        const long L = (long)i * G + c; if (L >= nwg) return false;
        if (mode == 0) {
            int wgid = (int)L; { const int q = nwg / NXCD, r = nwg % NXCD, xcd = wgid % NXCD, off = wgid / NXCD; wgid = (xcd < r ? xcd * (q + 1) : r * (q + 1) + (xcd - r) * q) + off; }
            const int nig = WGM * nN, gid = wgid / nig, fm = gid * WGM, gsz = (nM - fm) < WGM ? (nM - fm) : WGM;
            u.pm = fm + ((wgid % nig) % gsz); u.pn = (wgid % nig) / gsz; u.offA = (size_t)u.pm * sA; u.offB = (size_t)u.pn * sB;
        } else {
            const int b = (int)L >> 5, qb = ((int)L >> 2) & 7, h = (int)L & 3;
            u.pm = b * 8 + qb; u.pn = h;
            u.offA = ((size_t)(b * 2048 + qb * 256) * 1024 + h * 256) * 2;
            u.offB = mode == 1 ? ((size_t)(b * 256) * 1024 + h * 256) * 2 : ((size_t)(b * 4 + h) * 256 * 256) * 2;
        }
        return true;
    }
};

template <class Epi, class Sched, bool ALIGN_EPI>
__device__ __forceinline__ void gemm_phase(LAS unsigned char* lds, const Gemm g, const Sched& S, const Epi& E) {
    int tid = threadIdx.x; asm volatile("" : "+v"(tid));
    const int wid = __builtin_amdgcn_readfirstlane(tid >> 6), lane = tid & 63, wr = wid >> 2, wc = wid & 3, fr = lane & 15, fq = lane >> 4;
    const int K = g.K, nt = K / BK;
    unsigned voffA[2], voffB[2];
#pragma unroll
    for (int i = 0; i < 2; ++i) { int R, C; stage_rc(tid * 16 + i * 8192, R, C); const int Rb = Epi::PERM ? ((R & ~31) + perm32(R & 31)) : R;
        voffA[i] = (unsigned)(R * g.lda + C) * 2u; voffB[i] = (unsigned)(Rb * g.ldb + C) * 2u; }
    const size_t kstep = (size_t)(BK * 2);
    const size_t hstepA = (size_t)HALF * g.lda * 2, hstepB = (size_t)HALF * g.ldb * 2;
    const unsigned ldsw = (unsigned)wid * 1024u;
    const int aoff = lds_byte(wr * 64 + fr, fq * 8), boff = lds_byte(wc * 32 + fr, fq * 8);
#define PG8_SA(b, h) (((b) * 2 + (h)) * HTB)
#define PG8_SB(b, h) ((4 + (b) * 2 + (h)) * HTB)
#define PG8_STAGE(bufoff, gbase, voff) do { _Pragma("unroll") for (int _i = 0; _i < 2; ++_i) \
        __builtin_amdgcn_global_load_lds((const unsigned*)((const char*)(gbase) + (voff)[_i]), (LAS unsigned*)(lds + (bufoff) + ldsw + _i * 8192), 16, 0, 0); } while (0)
#define PG8_LDA(dst, b, h) do { _Pragma("unroll") for (int m = 0; m < 4; ++m) _Pragma("unroll") for (int k = 0; k < 2; ++k) dst[m][k] = *(const LAS bf16x8*)(lds + PG8_SA(b, h) + aoff + m * 2048 + k * 1024); } while (0)
#define PG8_LDB(dst, b, h) do { _Pragma("unroll") for (int n = 0; n < 2; ++n) _Pragma("unroll") for (int k = 0; k < 2; ++k) dst[n][k] = *(const LAS bf16x8*)(lds + PG8_SB(b, h) + boff + n * 2048 + k * 1024); } while (0)
#define PG8_MMA(ai, bj, At, Bt) do { __builtin_amdgcn_s_setprio(1); _Pragma("unroll") for (int m = 0; m < 4; ++m) _Pragma("unroll") for (int n = 0; n < 2; ++n) _Pragma("unroll") for (int k = 0; k < 2; ++k) \
        acc[ai][bj][m][n] = __builtin_amdgcn_mfma_f32_16x16x32_bf16(Bt[n][k], At[m][k], acc[ai][bj][m][n], 0, 0, 0); __builtin_amdgcn_s_setprio(0); } while (0)
#define PG8_WAIT_V(n) asm volatile("s_waitcnt vmcnt(" #n ")" ::: "memory")
#define PG8_WAIT_L(n) asm volatile("s_waitcnt lgkmcnt(" #n ")" ::: "memory")
#define PG8_BAR __builtin_amdgcn_s_barrier()
#define PG8_SCHED __builtin_amdgcn_sched_barrier(0)
    Unit cur, nxt; int ui = 0;
    if (!S.next(0, cur)) return;
    f32x4 acc[2][2][4][2];
#pragma unroll
    for (int a = 0; a < 2; ++a)
#pragma unroll
        for (int b = 0; b < 2; ++b)
#pragma unroll
            for (int m = 0; m < 4; ++m)
#pragma unroll
                for (int n = 0; n < 2; ++n) acc[a][b][m][n] = (f32x4){0.f, 0.f, 0.f, 0.f};
    bf16x8 At[4][2], B0[2][2], B1[2][2];
    const char* cA = (const char*)g.A + cur.offA; const char* cB = (const char*)g.Bt + cur.offB;
    PG8_STAGE(PG8_SB(0, 0), cB, voffB); PG8_STAGE(PG8_SB(0, 1), cB + hstepB, voffB); PG8_STAGE(PG8_SA(0, 0), cA, voffA); PG8_STAGE(PG8_SA(0, 1), cA + hstepA, voffA);
    if (wr == 1) PG8_BAR;
    PG8_WAIT_V(2); PG8_BAR;
    PG8_STAGE(PG8_SB(1, 0), cB + kstep, voffB); PG8_STAGE(PG8_SA(1, 0), cA + kstep, voffA); PG8_STAGE(PG8_SB(1, 1), cB + hstepB + kstep, voffB);
    PG8_WAIT_V(6); PG8_BAR;
    for (;;) {
        const bool has_next = S.next(ui + 1, nxt);
        const char* nA = has_next ? (const char*)g.A + nxt.offA : cA; const char* nB = has_next ? (const char*)g.Bt + nxt.offB : cB;
        for (int t = 0; t < nt; t += 2) {
            const bool last = (t == nt - 2);
            const char* a1 = cA + (size_t)(t + 1) * kstep;
            const char* a2 = last ? nA : cA + (size_t)(t + 2) * kstep; const char* b2 = last ? nB : cB + (size_t)(t + 2) * kstep;
            const char* a3 = a2 + kstep; const char* b3 = b2 + kstep;
            PG8_LDB(B0, 0, 0); PG8_LDB(B1, 0, 1); PG8_SCHED; PG8_LDA(At, 0, 0); PG8_STAGE(PG8_SA(1, 1), a1 + hstepA, voffA);
            PG8_WAIT_V(8); PG8_WAIT_L(0); PG8_BAR; PG8_MMA(0, 0, At, B0); PG8_MMA(0, 1, At, B1); PG8_BAR; PG8_SCHED;
            PG8_LDA(At, 0, 1); PG8_STAGE(PG8_SB(0, 0), b2, voffB); PG8_STAGE(PG8_SB(0, 1), b2 + hstepB, voffB); PG8_STAGE(PG8_SA(0, 0), a2, voffA);
            PG8_WAIT_V(8); PG8_WAIT_L(0); PG8_BAR; PG8_MMA(1, 0, At, B0); PG8_MMA(1, 1, At, B1); PG8_BAR; PG8_SCHED;
            PG8_LDB(B0, 1, 0); PG8_LDB(B1, 1, 1); PG8_SCHED; PG8_LDA(At, 1, 0); PG8_STAGE(PG8_SA(0, 1), a2 + hstepA, voffA);
            PG8_WAIT_V(8); PG8_WAIT_L(0); PG8_BAR; PG8_MMA(0, 0, At, B0); PG8_MMA(0, 1, At, B1); PG8_BAR; PG8_SCHED;
            PG8_LDA(At, 1, 1); PG8_STAGE(PG8_SB(1, 0), b3, voffB); PG8_STAGE(PG8_SB(1, 1), b3 + hstepB, voffB); PG8_STAGE(PG8_SA(1, 0), a3, voffA);
            PG8_WAIT_V(8); PG8_WAIT_L(0); PG8_BAR; PG8_MMA(1, 0, At, B0); PG8_MMA(1, 1, At, B1); PG8_BAR; PG8_SCHED;
        }
        if constexpr (ALIGN_EPI) { if (wr == 0) PG8_BAR; }
        if constexpr (!Epi::AFTER_DRAIN) { E(acc, cur, wr, wc, fr, fq); }
        if (!has_next) break;
#pragma unroll
        for (int a = 0; a < 2; ++a)
#pragma unroll
            for (int b = 0; b < 2; ++b)
#pragma unroll
                for (int m = 0; m < 4; ++m)
#pragma unroll
                    for (int n = 0; n < 2; ++n) acc[a][b][m][n] = (f32x4){0.f, 0.f, 0.f, 0.f};
        cur = nxt; cA = nA; cB = nB; ++ui;
        if constexpr (ALIGN_EPI) { if (wr == 1) PG8_BAR; }
    }
    PG8_WAIT_V(0);
    if constexpr (!ALIGN_EPI) { if (wr == 0) PG8_BAR; }
    PG8_BAR;
    if constexpr (Epi::AFTER_DRAIN) { E.fused(acc, cur, wr, wc, fr, fq, lds, wid, lane); }
#undef PG8_SA
#undef PG8_SB
#undef PG8_STAGE
#undef PG8_LDA
#undef PG8_LDB
#undef PG8_MMA
#undef PG8_WAIT_V
#undef PG8_WAIT_L
#undef PG8_BAR
#undef PG8_SCHED
}

struct Epi {
    static constexpr bool PERM = true, AFTER_DRAIN = false;
    int mode;
    bf16_t* O; int ldc;
    const float* ss;
    float* X;
    float* ssn;
    float* F;
    int l; int dry;
    __device__ __forceinline__ void operator()(const f32x4 (&acc)[2][2][4][2], const Unit& u, int wr, int wc, int fr, int fq) const {
        const int row0 = u.pm * 256 + wr * 64 + fr, col0 = u.pn * 256 + wc * 32 + 8 * fq;
        if (dry) return;
        if (mode == 1) {
#pragma unroll
            for (int ai = 0; ai < 2; ++ai)
#pragma unroll
                for (int m = 0; m < 4; ++m) {
                    const int row = row0 + ai * 128 + m * 16; const bool valid = row < MTOK; float sq = 0.f;
#pragma unroll
                    for (int bj = 0; bj < 2; ++bj) {
                        const size_t idx = (size_t)row * 1024 + col0 + bj * 128;
                        if (valid) {
                            float xf[8]; unpack8(*(const u32x4*)(O + idx), xf);
                            const f32x4 x0 = (f32x4){xf[0], xf[1], xf[2], xf[3]} + acc[ai][bj][m][0], x1 = (f32x4){xf[4], xf[5], xf[6], xf[7]} + acc[ai][bj][m][1];
                            sq += (x0[0] * x0[0] + x0[1] * x0[1]) + (x0[2] * x0[2] + x0[3] * x0[3]) + (x1[0] * x1[0] + x1[1] * x1[1]) + (x1[2] * x1[2] + x1[3] * x1[3]);
                            u32x4 w; w.x = cvt_pk_bf16(x0[0], x0[1]); w.y = cvt_pk_bf16(x0[2], x0[3]); w.z = cvt_pk_bf16(x1[0], x1[1]); w.w = cvt_pk_bf16(x1[2], x1[3]);
                            *(u32x4*)(O + idx) = w;
                        }
                    }
                    sq += __shfl_xor(sq, 16); sq += __shfl_xor(sq, 32);
                    if (valid && fq == 0) atomicAdd(ssn + row, sq);
                }
        } else {
#pragma unroll
            for (int ai = 0; ai < 2; ++ai)
#pragma unroll
                for (int m = 0; m < 4; ++m) {
                    const int row = row0 + ai * 128 + m * 16;
                    float rs = 1.f;
                    if (ss != nullptr && (mode == 2 || mode == 3 || row < MTOK)) rs = rsqrtf(ss[row] * (1.f / 1024.f) + EPS);
#pragma unroll
                    for (int bj = 0; bj < 2; ++bj) {
                        const int col = col0 + bj * 128;
                        const f32x4 v0 = acc[ai][bj][m][0] * rs, v1 = acc[ai][bj][m][1] * rs;
                        u32x4 w; w.x = cvt_pk_bf16(v0[0], v0[1]); w.y = cvt_pk_bf16(v0[2], v0[3]); w.z = cvt_pk_bf16(v1[0], v1[1]); w.w = cvt_pk_bf16(v1[2], v1[3]);
                        if (mode == 3) {
                            const int b = row >> 8, mem = row & 255;
                            bf16_t* o = O + ((size_t)(b * 1024 + col)) * 256 + mem;
                            o[0] = (bf16_t)(w.x & 0xffff); o[256] = (bf16_t)(w.x >> 16); o[512] = (bf16_t)(w.y & 0xffff); o[768] = (bf16_t)(w.y >> 16);
                            o[1024] = (bf16_t)(w.z & 0xffff); o[1280] = (bf16_t)(w.z >> 16); o[1536] = (bf16_t)(w.w & 0xffff); o[1792] = (bf16_t)(w.w >> 16);
                        } else {
                            *(u32x4*)(O + (size_t)row * ldc + col) = w;
                        }
                        if (mode == 2 || mode == 3) { float* f = F + (size_t)row * 1024 + col; *(f32x4*)f = v0; *(f32x4*)(f + 4) = v1; }
                        if (mode == 4) {
                            float* f = nullptr;
                            if (row < MP) { const int t = row & 2047; if (t >= 2046) f = F + O_FFNP + ((size_t)((l * 8 + (row >> 11)) * 2 + (t - 2046))) * FW2 + col; }
                            else if (row < MTOK) f = F + O_FFNS + ((size_t)((l * 128 + (row - MP)) * 2 + 1)) * FW2 + col;
                            if (f) { *(f32x4*)f = v0; *(f32x4*)(f + 4) = v1; }
                        }
                    }
                }
        }
    }
};

struct EpiSm {
    static constexpr bool PERM = true, AFTER_DRAIN = true;
    bf16_t* P;
    __device__ __forceinline__ void operator()(const f32x4 (&)[2][2][4][2], const Unit&, int, int, int, int) const {}
    __device__ __forceinline__ void fused(f32x4 (&acc)[2][2][4][2], const Unit& u, int wr, int wc, int fr, int fq, LAS unsigned char* lds, int wid, int lane) const {
        LAS float* red = (LAS float*)lds; LAS float* red2 = red + 1024;
        float mx[2][4];
#pragma unroll
        for (int ai = 0; ai < 2; ++ai)
#pragma unroll
            for (int m = 0; m < 4; ++m) {
                float v = -3.0e38f;
#pragma unroll
                for (int bj = 0; bj < 2; ++bj)
#pragma unroll
                    for (int n = 0; n < 2; ++n) { const f32x4 x = acc[ai][bj][m][n]; v = fmaxf(v, fmaxf(fmaxf(x[0], x[1]), fmaxf(x[2], x[3]))); }
                v = fmaxf(v, __shfl_xor(v, 16)); v = fmaxf(v, __shfl_xor(v, 32));
                if (fq == 0) red[(ai * 128 + wr * 64 + m * 16 + fr) * 4 + wc] = v;
            }
        __syncthreads();
#pragma unroll
        for (int ai = 0; ai < 2; ++ai)
#pragma unroll
            for (int m = 0; m < 4; ++m) {
                const f32x4 r = *(const LAS f32x4*)(red + (ai * 128 + wr * 64 + m * 16 + fr) * 4);
                const float M = fmaxf(fmaxf(r[0], r[1]), fmaxf(r[2], r[3])); mx[ai][m] = M;
                float s = 0.f;
#pragma unroll
                for (int bj = 0; bj < 2; ++bj)
#pragma unroll
                    for (int n = 0; n < 2; ++n) { f32x4 x = acc[ai][bj][m][n];
                        x[0] = __expf(x[0] - M); x[1] = __expf(x[1] - M); x[2] = __expf(x[2] - M); x[3] = __expf(x[3] - M); acc[ai][bj][m][n] = x; s += (x[0] + x[1]) + (x[2] + x[3]); }
                s += __shfl_xor(s, 16); s += __shfl_xor(s, 32);
                if (fq == 0) red2[(ai * 128 + wr * 64 + m * 16 + fr) * 4 + wc] = s;
            }
        __syncthreads();
#pragma unroll
        for (int ai = 0; ai < 2; ++ai)
#pragma unroll
            for (int m = 0; m < 4; ++m) {
                const int rl = ai * 128 + wr * 64 + m * 16 + fr;
                const f32x4 r = *(const LAS f32x4*)(red2 + rl * 4);
                const float inv = 1.f / ((r[0] + r[1]) + (r[2] + r[3]));
#pragma unroll
                for (int bj = 0; bj < 2; ++bj) {
                    const f32x4 v0 = acc[ai][bj][m][0] * inv, v1 = acc[ai][bj][m][1] * inv;
                    u32x4 w; w.x = cvt_pk_bf16(v0[0], v0[1]); w.y = cvt_pk_bf16(v0[2], v0[3]); w.z = cvt_pk_bf16(v1[0], v1[1]); w.w = cvt_pk_bf16(v1[2], v1[3]);
                    *(u32x4*)(P + (size_t)(u.pm * 256 + rl) * 1024 + u.pn * 256 + bj * 128 + wc * 32 + 8 * fq) = w;
                }
            }
        (void)mx; (void)wid; (void)lane;
    }
};
}

struct Args { const float* in[38]; float* out; unsigned char* ws; int ph_lo, ph_hi; };
enum { I_XP = 0, I_XS, I_MEM, I_SSHIFT, I_SWKV, I_SCONV, I_SFFN, I_CK, I_CV, I_NMIX, I_WIN, I_MU, I_W0, I_W2, I_A0, I_A2, I_G2, I_V0, I_V1, I_V2,
       I_KK, I_KA, I_RK, I_LNW, I_LNB, I_CONVW, I_WOUT, I_NX, I_NMEM, I_WQ, I_WK, I_WV, I_WO, I_NFFN, I_WUP, I_FCW, I_WDN, I_NFIN };

__device__ __forceinline__ void tr_item(const float* W, int K, int N, bf16_t* WT, const float* gain, float scale, LAS float* scr, int item, int lane) {
    const int nblk = N / 32, kb = item / nblk, nb = item % nblk, k0 = 64 * kb, n0 = 32 * nb;
#pragma unroll
    for (int i = 0; i < 8; ++i) { const int kk = 8 * i + (lane >> 3); const float gk = gain ? gain[k0 + kk] * scale : scale;
        const f32x4 v = *(const f32x4*)(W + (size_t)(k0 + kk) * N + n0 + (lane & 7) * 4) * gk;
        LAS float* d = scr + kk * 33 + (lane & 7) * 4; d[0] = v[0]; d[1] = v[1]; d[2] = v[2]; d[3] = v[3]; }
    LDS_WAIT();
    const int c = lane & 7;
#pragma unroll
    for (int j = 0; j < 4; ++j) { const int n = (lane >> 3) + 8 * j; const LAS float* s = scr + (8 * c) * 33 + n;
        u32x4 o; o.x = pk2(s[0 * 33], s[1 * 33]); o.y = pk2(s[2 * 33], s[3 * 33]); o.z = pk2(s[4 * 33], s[5 * 33]); o.w = pk2(s[6 * 33], s[7 * 33]);
        *(u32x4*)(WT + (size_t)(n0 + n) * K + k0 + 8 * c) = o; }
    LDS_WAIT();
}

constexpr int TR_NL = 8512;
__device__ __forceinline__ void tr_dispatch(const Args& a, unsigned char* ws, int l, int r, LAS float* scr, int lane) {
    constexpr int I_IN_ = 16 * 104, I_SQ_ = 16 * 32, I_UP_ = 16 * 176, I_DN_ = 44 * 32, I_L64 = 16;
    if (r < I_IN_) { tr_item(a.in[I_WIN] + (size_t)l * D * INC, D, INC, (bf16_t*)(ws + OFF_WIN) + (size_t)l * LDP * D, a.in[I_NMIX] + l * D, 1.f, scr, r, lane); return; } r -= I_IN_;
    if (r < I_SQ_) { tr_item(a.in[I_WOUT] + (size_t)l * D * D, D, D, (bf16_t*)(ws + OFF_WOUT) + (size_t)l * D * D, nullptr, 1.f, scr, r, lane); return; } r -= I_SQ_;
    if (r < I_SQ_) { tr_item(a.in[I_WQ] + (size_t)l * D * D, D, D, (bf16_t*)(ws + OFF_WQ) + (size_t)l * D * D, a.in[I_NX] + l * D, 0.0625f, scr, r, lane); return; } r -= I_SQ_;
    if (r < I_SQ_) { tr_item(a.in[I_WK] + (size_t)l * D * D, D, D, (bf16_t*)(ws + OFF_WK) + (size_t)l * D * D, a.in[I_NMEM] + l * D, 1.f, scr, r, lane); return; } r -= I_SQ_;
    if (r < I_SQ_) { tr_item(a.in[I_WV] + (size_t)l * D * D, D, D, (bf16_t*)(ws + OFF_WV) + (size_t)l * D * D, a.in[I_NMEM] + l * D, 1.f, scr, r, lane); return; } r -= I_SQ_;
    if (r < I_SQ_) { tr_item(a.in[I_WO] + (size_t)l * D * D, D, D, (bf16_t*)(ws + OFF_WO) + (size_t)l * D * D, nullptr, 1.f, scr, r, lane); return; } r -= I_SQ_;
    if (r < I_UP_) { tr_item(a.in[I_WUP] + (size_t)l * D * FW2, D, FW2, (bf16_t*)(ws + OFF_WUP) + (size_t)l * FW2 * D, a.in[I_NFFN] + l * D, 1.f, scr, r, lane); return; } r -= I_UP_;
    if (r < I_DN_) { tr_item(a.in[I_WDN] + (size_t)l * FW * D, FW, D, (bf16_t*)(ws + OFF_WDN) + (size_t)l * D * FW, nullptr, 1.f, scr, r, lane); return; } r -= I_DN_;
    if (r < I_L64) { tr_item(a.in[I_W2] + (size_t)l * 64 * 512, 64, 512, (bf16_t*)(ws + OFF_W2) + (size_t)l * 512 * 64, nullptr, 1.f, scr, r, lane); return; } r -= I_L64;
    if (r < I_L64) { tr_item(a.in[I_A2] + (size_t)l * 64 * 512, 64, 512, (bf16_t*)(ws + OFF_A2) + (size_t)l * 512 * 64, nullptr, 1.f, scr, r, lane); return; } r -= I_L64;
    tr_item(a.in[I_G2] + (size_t)l * 128 * 512, 128, 512, (bf16_t*)(ws + OFF_G2) + (size_t)l * 512 * 128, nullptr, 1.f, scr, r, lane);
}
constexpr int TR_DEFERRED = TR_NL + 5760;
__device__ __forceinline__ void tr_deferred(const Args& a, unsigned char* ws, int d, LAS float* scr, int lane) {
    if (d < TR_NL) { tr_dispatch(a, ws, 1, d, scr, lane); return; }
    const int e = d - TR_NL;
    const int r = e < 1024 ? 1664 + e : (e < 1536 ? 3712 + (e - 1024) : 4224 + (e - 1536));
    tr_dispatch(a, ws, 0, r, scr, lane);
}

__device__ __forceinline__ void p0_prologue(LAS unsigned char* lds, const Args& a, int tid, int lane, int wave, int gw, int NGW) {
    unsigned char* ws = a.ws;
    LAS float* scr = (LAS float*)(lds + wave * 16384);
    for (int it = gw; it < 1664 + 1024 + 64; it += NGW) {
        const int r = it < 1664 ? it : (it < 2688 ? 2688 + (it - 1664) : 8448 + (it - 2688));
        tr_dispatch(a, ws, 0, r, scr, lane);
    }
    float* X = (float*)(ws + OFF_X); bf16_t* XB = (bf16_t*)(ws + OFF_XB); float* SS = (float*)(ws + OFF_SS);
    bf16_t* MNB = (bf16_t*)(ws + OFF_MNB); float* SSM = (float*)(ws + OFF_SSM);
    for (int m = gw; m < MROWS + MMEM; m += NGW) {
        const float* src; bf16_t* dstb; float* dstx = nullptr; float* dss = nullptr; bool shiftrow = false;
        if (m < MP) { src = a.in[I_XP] + (size_t)m * D; dstb = XB + (size_t)m * D; dstx = X + (size_t)m * D; dss = SS + m; }
        else if (m < MTOK) { src = a.in[I_XS] + (size_t)(m - MP) * D; dstb = XB + (size_t)m * D; dstx = X + (size_t)m * D; dss = SS + m; }
        else if (m < MROWS) { src = a.in[I_SSHIFT] + (size_t)(m - MTOK) * D; dstb = XB + (size_t)m * D; shiftrow = true; }
        else { src = a.in[I_MEM] + (size_t)(m - MROWS) * D; dstb = MNB + (size_t)(m - MROWS) * D; dss = SSM + (m - MROWS); }
        float s = 0.f;
#pragma unroll
        for (int j = 0; j < 4; ++j) {
            f32x4 v = *(const f32x4*)(src + 4 * lane + 256 * j);
            if (shiftrow) { const f32x4 gn = *(const f32x4*)(a.in[I_NMIX] + 4 * lane + 256 * j); v[0] /= gn[0]; v[1] /= gn[1]; v[2] /= gn[2]; v[3] /= gn[3]; }
            s += (v[0] * v[0] + v[1] * v[1]) + (v[2] * v[2] + v[3] * v[3]);
            u32x2 w; w.x = pk2(v[0], v[1]); w.y = pk2(v[2], v[3]);
            *(u32x2*)(dstb + 4 * lane + 256 * j) = w;
        }
        s = wave_sum(s);
        if (dss && lane == 0) *dss = s;
    }
    if (blockIdx.x * 8 < D) {
        __syncthreads();
        LAS float* M = (LAS float*)lds;
        const float* muv = a.in[I_MU] + 1792 + 1024; const float* v1 = a.in[I_V1];
#pragma unroll 8
        for (int i = tid; i < 512 * 64; i += 512) { const int c = i >> 6, o = i & 63; const float mv = muv[c]; M[i] = ((o >> 5) ? mv : 1.f - mv) * v1[c * 32 + (o & 31)]; }
        __syncthreads();
        for (int k = gw; k < D; k += NGW) {
            const float* wrow = a.in[I_WIN] + (size_t)1 * D * INC + (size_t)k * INC + 1024;
            float acc = 0.f;
#pragma unroll 4
            for (int c = 0; c < 512; c += 4) {
                const f32x4 w4 = *(const f32x4*)(wrow + c);
                acc += w4[0] * M[c * 64 + lane] + w4[1] * M[(c + 1) * 64 + lane] + w4[2] * M[(c + 2) * 64 + lane] + w4[3] * M[(c + 3) * 64 + lane];
            }
            ((bf16_t*)(ws + OFF_WIN))[(size_t)1 * LDP * D + (size_t)(INC + lane) * D + k] = (bf16_t)f2bf(acc * a.in[I_NMIX][D + k]);
        }
    }
    const int gt = blockIdx.x * 512 + tid, NGT = gridDim.x * 512;
    for (int i = gt; i < 6 * MROWS; i += NGT) SS[MROWS + i] = 0.f;
    bf16_t* V2T = (bf16_t*)(ws + OFF_V2);
    for (int i = gt; i < 512 * 32; i += NGT) { const int n = i >> 5, k = i & 31; V2T[i] = (bf16_t)f2bf(a.in[I_V2][k * 512 + n]); }
}

__device__ __forceinline__ const bf16_t* prev_row(const bf16_t* PROJ, int m) {
    if (m < MP) { if ((m & 2047) == 0) return nullptr; return PROJ + (size_t)(m - 1) * LDP; }
    return PROJ + (size_t)(m + NS) * LDP;
}
__device__ __forceinline__ void mix4(const bf16_t* cur, const bf16_t* prv, const float* mu, int col, float* z) {
    const u32x2 c = *(const u32x2*)(cur + col); const f32x4 m4 = *(const f32x4*)(mu + col);
    float cf[4] = {bflo(c.x), bfhi(c.x), bflo(c.y), bfhi(c.y)}; float pf[4] = {0.f, 0.f, 0.f, 0.f};
    if (prv) { const u32x2 p = *(const u32x2*)(prv + col); pf[0] = bflo(p.x); pf[1] = bfhi(p.x); pf[2] = bflo(p.y); pf[3] = bfhi(p.y); }
#pragma unroll
    for (int j = 0; j < 4; ++j) z[j] = cf[j] + (pf[j] - cf[j]) * m4[j];
}
__device__ __forceinline__ void mix8(const bf16_t* cur, const bf16_t* prv, const float* mu, int col, float* z) {
    const u32x4 c = *(const u32x4*)(cur + col); float cf[8], pf[8]; unpack8(c, cf);
#pragma unroll
    for (int j = 0; j < 8; ++j) pf[j] = 0.f;
    if (prv) { const u32x4 p = *(const u32x4*)(prv + col); unpack8(p, pf); }
    const f32x4 m0 = *(const f32x4*)(mu + col), m1 = *(const f32x4*)(mu + col + 4);
#pragma unroll
    for (int j = 0; j < 4; ++j) { z[j] = cf[j] + (pf[j] - cf[j]) * m0[j]; z[4 + j] = cf[4 + j] + (pf[4 + j] - cf[4 + j]) * m1[j]; }
}

__device__ __forceinline__ float fsig(float x) { return __builtin_amdgcn_rcpf(1.f + __expf(-x)); }
__device__ __forceinline__ void mixw(u32x2 c, u32x2 p, const LAS float* mu, float* z) {
    const f32x4 m4 = *(const LAS f32x4*)mu;
    const float cf[4] = {bflo(c.x), bfhi(c.x), bflo(c.y), bfhi(c.y)}, pf[4] = {bflo(p.x), bfhi(p.x), bflo(p.y), bfhi(p.y)};
#pragma unroll
    for (int j = 0; j < 4; ++j) z[j] = cf[j] + (pf[j] - cf[j]) * m4[j];
}
__device__ __forceinline__ void prep_phase(LAS unsigned char* lds, const Args& a, int l, int tid, int lane, int wave, int gw) {
    unsigned char* ws = a.ws;
    const bf16_t* PROJ = (const bf16_t*)(ws + OFF_PROJ);
    const float* mu = a.in[I_MU] + l * 1792;
    if (gw < NB + NS) {
        const int row = gw < NB ? gw * 2048 + 2047 : MP + (gw - NB);
        float* dst = gw < NB ? a.out + O_SHP + (size_t)(l * NB + gw) * D : a.out + O_SHS + (size_t)(l * NS + (gw - NB)) * D;
        const bf16_t* Xr = (const bf16_t*)(ws + OFF_XB) + (size_t)row * D;
        const float rs = rsqrtf(((const float*)(ws + OFF_SS))[3 * l * MROWS + row] * (1.f / 1024.f) + EPS);
#pragma unroll
        for (int j = 0; j < 4; ++j) { const u32x2 xw = *(const u32x2*)(Xr + 4 * lane + 256 * j); const f32x4 v = (f32x4){bflo(xw.x), bfhi(xw.x), bflo(xw.y), bfhi(xw.y)}, gn = *(const f32x4*)(a.in[I_NMIX] + l * D + 4 * lane + 256 * j);
            *(f32x4*)(dst + 4 * lane + 256 * j) = v * rs * gn; }
    }
    LAS bf16_t* WL2 = (LAS bf16_t*)lds;
    LAS bf16_t* WLA = (LAS bf16_t*)(lds + 18432);
    LAS bf16_t* WLG = (LAS bf16_t*)(lds + 36864);
    LAS bf16_t* WLV = (LAS bf16_t*)(lds + 71680);
    LAS float* PAR = (LAS float*)(lds + 81920);
    LAS bf16_t* LA = (LAS bf16_t*)(lds + 88064);
    LAS bf16_t* LW = (LAS bf16_t*)(lds + 121856);
    const int hp = blockIdx.x & 3;
    {
        const bf16_t* W2T = (const bf16_t*)(ws + OFF_W2) + (size_t)l * 512 * 64 + (size_t)hp * 128 * 64;
        const bf16_t* A2T = (const bf16_t*)(ws + OFF_A2) + (size_t)l * 512 * 64 + (size_t)hp * 128 * 64;
        const bf16_t* G2T = (const bf16_t*)(ws + OFF_G2) + (size_t)l * 512 * 128 + (size_t)hp * 128 * 128;
        const bf16_t* V2T = (const bf16_t*)(ws + OFF_V2) + (size_t)hp * 128 * 32;
#pragma unroll
        for (int q = 0; q < 2; ++q) { const int i = tid + 512 * q, n = i >> 3, c = (i & 7) * 8;
            *(LAS u32x4*)(WL2 + n * 72 + c) = *(const u32x4*)(W2T + n * 64 + c); *(LAS u32x4*)(WLA + n * 72 + c) = *(const u32x4*)(A2T + n * 64 + c); }
#pragma unroll
        for (int q = 0; q < 4; ++q) { const int i = tid + 512 * q, n = i >> 4, c = (i & 15) * 8; *(LAS u32x4*)(WLG + n * 136 + c) = *(const u32x4*)(G2T + n * 128 + c); }
        { const int n = tid >> 2, c = (tid & 3) * 8; *(LAS u32x4*)(WLV + n * 40 + c) = *(const u32x4*)(V2T + n * 32 + c); }
        if (tid < 128) {
            const int ch = hp * 128 + tid;
            PAR[tid] = a.in[I_W0][l * 512 + ch]; PAR[128 + tid] = a.in[I_A0][l * 512 + ch]; PAR[256 + tid] = a.in[I_KK][l * 512 + ch]; PAR[384 + tid] = a.in[I_KA][l * 512 + ch];
            PAR[512 + tid] = a.in[I_RK][l * 512 + ch]; PAR[640 + tid] = l == 1 ? a.in[I_V0][ch] : 0.f; PAR[768 + tid] = mu[ch]; PAR[896 + tid] = mu[512 + ch]; PAR[1024 + tid] = mu[1024 + ch];
        }
    }
    float* SA = (float*)(ws + OFF_SA); float* SB = (float*)(ws + OFF_SB); float* SD = (float*)(ws + OFF_SD); float* SK = (float*)(ws + OFF_SK);
    float* SRD = (float*)(ws + OFF_SRD); float* GG = (float*)(ws + OFF_G); float* SV = (float*)(ws + (l == 0 ? OFF_SV0 : OFF_SV1));
    const float* SV0 = (const float*)(ws + OFF_SV0);
    float* SBR = (float*)(ws + OFF_SBR); float* SKR = (float*)(ws + OFF_SKR); float* RKR = (float*)(ws + OFF_RKR);
    const int mt = wave & 3, hh = wave >> 2, h = hp * 2 + hh, fr = lane & 15, fq = lane >> 4;
    constexpr int NTILE = MTOK / 64;
    for (int tile = blockIdx.x >> 2; tile < NTILE; tile += gridDim.x >> 2) {
        const int m0 = tile * 64;
        {
            u32x4 cu[4], pv[4];
#pragma unroll
            for (int q = 0; q < 4; ++q) {
                const int row = (tid >> 5) + 16 * q, ch = tid & 31, m = m0 + row;
                const bf16_t* prv = prev_row(PROJ, m);
                cu[q] = *(const u32x4*)(PROJ + (size_t)m * LDP + 1536 + ch * 8);
                pv[q] = prv ? *(const u32x4*)(prv + 1536 + ch * 8) : (u32x4){0u, 0u, 0u, 0u};
            }
            u32x2 vc = (u32x2){0u, 0u}, vp = vc;
            if (l == 1) {
                const int m = m0 + (tid >> 3), j4 = (tid & 7) * 4; const bf16_t* prv = prev_row(PROJ, m);
                vc = *(const u32x2*)(PROJ + (size_t)m * LDP + INC + j4); if (prv) vp = *(const u32x2*)(prv + INC + 32 + j4);
            }
            const int ch = tid & 31;
            const f32x4 m0v = *(const f32x4*)(mu + 1536 + ch * 8), m1v = *(const f32x4*)(mu + 1536 + ch * 8 + 4);
#pragma unroll
            for (int q = 0; q < 4; ++q) {
                const int row = (tid >> 5) + 16 * q;
                float cf[8], pf[8], z[8]; unpack8(cu[q], cf); unpack8(pv[q], pf);
#pragma unroll
                for (int j = 0; j < 4; ++j) { z[j] = cf[j] + (pf[j] - cf[j]) * m0v[j]; z[4 + j] = cf[4 + j] + (pf[4 + j] - cf[4 + j]) * m1v[j]; }
                if (ch < 8) {
#pragma unroll
                    for (int j = 0; j < 8; ++j) z[j] = 2.f * fsig(2.f * z[j]) - 1.f;
                } else if (ch >= 16) {
#pragma unroll
                    for (int j = 0; j < 8; ++j) z[j] = fsig(z[j]);
                }
                u32x4 w; w.x = pk2(z[0], z[1]); w.y = pk2(z[2], z[3]); w.z = pk2(z[4], z[5]); w.w = pk2(z[6], z[7]);
                *(LAS u32x4*)(LA + row * 264 + ch * 8) = w;
            }
            if (l == 1) {
                u32x2 w; w.x = pk2(bflo(vc.x) + bflo(vp.x), bfhi(vc.x) + bfhi(vp.x)); w.y = pk2(bflo(vc.y) + bflo(vp.y), bfhi(vc.y) + bfhi(vp.y));
                *(LAS u32x2*)(LW + (tid >> 3) * 40 + (tid & 7) * 4) = w;
            }
        }
        __syncthreads();
        const int m = m0 + mt * 16 + fr;
        const bf16_t* cur = PROJ + (size_t)m * LDP; const bf16_t* prv = prev_row(PROJ, m);
        u32x2 cR[4], cK[4], cV[4], pR[4], pK[4], pV[4]; f32x4 vf[4];
#pragma unroll
        for (int nt = 0; nt < 4; ++nt) {
            const int ch = h * 64 + nt * 16 + fq * 4;
            cR[nt] = *(const u32x2*)(cur + ch); cK[nt] = *(const u32x2*)(cur + 512 + ch); cV[nt] = *(const u32x2*)(cur + 1024 + ch);
            pR[nt] = (u32x2){0u, 0u}; pK[nt] = pR[nt]; pV[nt] = pR[nt];
            if (prv) { pR[nt] = *(const u32x2*)(prv + ch); pK[nt] = *(const u32x2*)(prv + 512 + ch); pV[nt] = *(const u32x2*)(prv + 1024 + ch); }
            vf[nt] = (f32x4){0.f, 0.f, 0.f, 0.f};
            if (l == 1) vf[nt] = *(const f32x4*)(SV0 + (size_t)m * 512 + ch);
        }
        float ssq = 0.f;
#pragma unroll
        for (int nt = 0; nt < 4; ++nt) {
            const int cl = hh * 64 + nt * 16 + fq * 4; float kz[4]; mixw(cK[nt], pK[nt], PAR + 896 + cl, kz);
            const f32x4 kk4 = *(const LAS f32x4*)(PAR + 256 + cl);
#pragma unroll
            for (int j = 0; j < 4; ++j) { const float kk = kz[j] * kk4[j]; ssq += kk * kk; }
        }
        ssq += __shfl_xor(ssq, 16); ssq += __shfl_xor(ssq, 32);
        const float inv = 1.f / fmaxf(sqrtf(ssq), 1e-12f);
        float br = 0.f, kr = 0.f, rkr = 0.f;
#pragma unroll
        for (int nt = 0; nt < 4; ++nt) {
            const int cl = hh * 64 + nt * 16 + fq * 4, ch = h * 64 + nt * 16 + fq * 4, nl = hh * 64 + nt * 16 + fr;
            f32x4 dl = (f32x4){0.f, 0.f, 0.f, 0.f}, al = dl, gl = dl, vm = dl;
            bf16x8 af[8];
#pragma unroll
            for (int ks = 0; ks < 8; ++ks) af[ks] = *(const LAS bf16x8*)(LA + (mt * 16 + fr) * 264 + ks * 32 + fq * 8);
            const bf16x8 avv = *(const LAS bf16x8*)(LW + (mt * 16 + fr) * 40 + fq * 8);
#pragma unroll
            for (int ks = 0; ks < 2; ++ks) {
                dl = __builtin_amdgcn_mfma_f32_16x16x32_bf16(*(const LAS bf16x8*)(WL2 + nl * 72 + ks * 32 + fq * 8), af[ks], dl, 0, 0, 0);
                al = __builtin_amdgcn_mfma_f32_16x16x32_bf16(*(const LAS bf16x8*)(WLA + nl * 72 + ks * 32 + fq * 8), af[2 + ks], al, 0, 0, 0);
            }
#pragma unroll
            for (int ks = 0; ks < 4; ++ks) gl = __builtin_amdgcn_mfma_f32_16x16x32_bf16(*(const LAS bf16x8*)(WLG + nl * 136 + ks * 32 + fq * 8), af[4 + ks], gl, 0, 0, 0);
            if (l == 1) vm = __builtin_amdgcn_mfma_f32_16x16x32_bf16(*(const LAS bf16x8*)(WLV + nl * 40 + fq * 8), avv, vm, 0, 0, 0);
            float rz[4], kz[4], vz[4];
            mixw(cR[nt], pR[nt], PAR + 768 + cl, rz); mixw(cK[nt], pK[nt], PAR + 896 + cl, kz); mixw(cV[nt], pV[nt], PAR + 1024 + cl, vz);
            const f32x4 w0 = *(const LAS f32x4*)(PAR + cl), a0 = *(const LAS f32x4*)(PAR + 128 + cl), kk4 = *(const LAS f32x4*)(PAR + 256 + cl);
            const f32x4 ka4 = *(const LAS f32x4*)(PAR + 384 + cl), rk4 = *(const LAS f32x4*)(PAR + 512 + cl), v04 = *(const LAS f32x4*)(PAR + 640 + cl);
            f32x4 oa, ob, od, ok, ord_, ov;
#pragma unroll
            for (int j = 0; j < 4; ++j) {
                const float dcy = __expf(-0.60653065971f * fsig(w0[j] + dl[j]));
                const float av_ = fsig(a0[j] + al[j]);
                float vj = vz[j];
                if (l == 1) { const float vmix = fsig(v04[j] + vm[j]); vj = vj + (vf[nt][j] - vj) * vmix; }
                const float kk = kz[j] * kk4[j] * inv, k2 = kz[j] * (1.f + (av_ - 1.f) * ka4[j]);
                oa[j] = -kk; ob[j] = kk * av_; od[j] = dcy; ok[j] = k2; ord_[j] = rz[j] * dcy; ov[j] = vj;
                br += ob[j] * rz[j]; kr += k2 * rz[j]; rkr += rz[j] * k2 * rk4[j];
            }
            const size_t o = (size_t)m * 512 + ch;
            *(f32x4*)(SA + o) = oa; *(f32x4*)(SB + o) = ob; *(f32x4*)(SD + o) = od; *(f32x4*)(SK + o) = ok; *(f32x4*)(SRD + o) = ord_; *(f32x4*)(SV + o) = ov; { u32x2 gw2; gw2.x = cvt_pk_bf16(gl[0], gl[1]); gw2.y = cvt_pk_bf16(gl[2], gl[3]); *(u32x2*)((bf16_t*)GG + o) = gw2; }
            __builtin_amdgcn_sched_barrier(0);
        }
        br += __shfl_xor(br, 16); br += __shfl_xor(br, 32); kr += __shfl_xor(kr, 16); kr += __shfl_xor(kr, 32); rkr += __shfl_xor(rkr, 16); rkr += __shfl_xor(rkr, 32);
        if (fq == 0) { SBR[m * 8 + h] = br; SKR[m * 8 + h] = kr; RKR[m * 8 + h] = rkr; }
        __syncthreads();
    }
}

__device__ __forceinline__ void convB_token(const Args& a, int l, int m, int lane) {
    unsigned char* ws = a.ws;
    const bf16_t* __restrict__ PROJ = (const bf16_t*)(ws + OFF_PROJ);
    bf16_t* __restrict__ YAB = (bf16_t*)(ws + OFF_YAB);
    const int cb = lane * 8;
        const bf16_t* pr = PROJ + (size_t)m * LDP;
        float gb[8], gc[8], hi[8], u0[8], u1[8], u2[8];
        unpack8(*(const u32x4*)(pr + 1792 + cb), gb); unpack8(*(const u32x4*)(pr + 2304 + cb), gc); unpack8(*(const u32x4*)(pr + 2816 + cb), hi);
#pragma unroll
        for (int j = 0; j < 8; ++j) { u0[j] = gc[j] * hi[j]; u1[j] = 0.f; u2[j] = 0.f; }
        if (m < MP) {
            const int t = m & 2047;
            if (t >= 1) { unpack8(*(const u32x4*)(pr - LDP + 2304 + cb), gc); unpack8(*(const u32x4*)(pr - LDP + 2816 + cb), hi);
#pragma unroll
                for (int j = 0; j < 8; ++j) u1[j] = gc[j] * hi[j]; }
            if (t >= 2) { unpack8(*(const u32x4*)(pr - 2 * LDP + 2304 + cb), gc); unpack8(*(const u32x4*)(pr - 2 * LDP + 2816 + cb), hi);
#pragma unroll
                for (int j = 0; j < 8; ++j) u2[j] = gc[j] * hi[j]; }
            if (t >= 2046) { float* dst = a.out + O_CONVP + (size_t)((l * NB + (m >> 11)) * 2 + (t - 2046)) * 512 + cb;
                *(f32x4*)dst = (f32x4){u0[0], u0[1], u0[2], u0[3]}; *(f32x4*)(dst + 4) = (f32x4){u0[4], u0[5], u0[6], u0[7]}; }
        } else {
            const int i = m - MP; const float* sc = a.in[I_SCONV] + (size_t)(l * NS + i) * 2 * 512 + cb;
            const f32x4 a0 = *(const f32x4*)sc, a1 = *(const f32x4*)(sc + 4), b0 = *(const f32x4*)(sc + 512), b1 = *(const f32x4*)(sc + 516);
#pragma unroll
            for (int j = 0; j < 4; ++j) { u2[j] = a0[j]; u2[4 + j] = a1[j]; u1[j] = b0[j]; u1[4 + j] = b1[j]; }
            float* dst = a.out + O_CONVS + (size_t)(l * NS + i) * 2 * 512 + cb;
            *(f32x4*)dst = b0; *(f32x4*)(dst + 4) = b1;
            *(f32x4*)(dst + 512) = (f32x4){u0[0], u0[1], u0[2], u0[3]}; *(f32x4*)(dst + 516) = (f32x4){u0[4], u0[5], u0[6], u0[7]};
        }
        const float* cw = a.in[I_CONVW] + (size_t)l * 3 * 512 + cb;
        float ob[8];
#pragma unroll
        for (int j = 0; j < 8; ++j) ob[j] = gb[j] * (cw[j] * u2[j] + cw[512 + j] * u1[j] + cw[1024 + j] * u0[j]);
        u32x4 w2; w2.x = pk2(ob[0], ob[1]); w2.y = pk2(ob[2], ob[3]); w2.z = pk2(ob[4], ob[5]); w2.w = pk2(ob[6], ob[7]);
        *(u32x4*)(YAB + (size_t)m * 1024 + 512 + cb) = w2;
}

typedef float f32x2 __attribute__((ext_vector_type(2)));
__device__ __forceinline__ float scan_step(float (&s)[4], const f32x4 av, const f32x4 bv, const f32x4 dv, const f32x4 kv, const f32x4 rd, float vi, float br, float kr) {
    f32x2 s01 = (f32x2){s[0], s[1]}, s23 = (f32x2){s[2], s[3]};
    f32x2 t = s01 * (f32x2){av[0], av[1]}; t = __builtin_elementwise_fma(s23, (f32x2){av[2], av[3]}, t);
    f32x2 u = s01 * (f32x2){rd[0], rd[1]}; u = __builtin_elementwise_fma(s23, (f32x2){rd[2], rd[3]}, u);
    float pa = t.x + t.y, py = u.x + u.y;
    pa = red16(pa); py = red16(py);
    const f32x2 pav = (f32x2){pa, pa}, viv = (f32x2){vi, vi};
    f32x2 w01 = (f32x2){kv[0], kv[1]} * viv; w01 = __builtin_elementwise_fma((f32x2){bv[0], bv[1]}, pav, w01);
    f32x2 w23 = (f32x2){kv[2], kv[3]} * viv; w23 = __builtin_elementwise_fma((f32x2){bv[2], bv[3]}, pav, w23);
    s01 = __builtin_elementwise_fma(s01, (f32x2){dv[0], dv[1]}, w01);
    s23 = __builtin_elementwise_fma(s23, (f32x2){dv[2], dv[3]}, w23);
    s[0] = s01.x; s[1] = s01.y; s[2] = s23.x; s[3] = s23.y;
    return py + pa * br + vi * kr;
}

__device__ __forceinline__ void scan_phase(LAS unsigned char* lds, const Args& a, int l, int tid, int lane, int wave) {
    unsigned char* ws = a.ws;
    const float* SA = (const float*)(ws + OFF_SA); const float* SB = (const float*)(ws + OFF_SB); const float* SD = (const float*)(ws + OFF_SD); const float* SK = (const float*)(ws + OFF_SK);
    const float* SRD = (const float*)(ws + OFF_SRD); const float* SV = (const float*)(ws + (l == 0 ? OFF_SV0 : OFF_SV1));
    const float* SBR = (const float*)(ws + OFF_SBR); const float* SKR = (const float*)(ws + OFF_SKR);
    float* Y = (float*)(ws + OFF_Y);
    constexpr int TC = 32, CB = 5 * TC * 64 + TC * 16 + 2 * TC;
    LAS float* L = (LAS float*)lds;
    const int j4 = lane >> 4, c = lane & 15;
    for (int ci = blockIdx.x; ci < 256; ci += gridDim.x) {
        const int hc = ci >> 2, rg = ci & 3, b = hc >> 3, h = hc & 7;
        const int st = tid >> 4, c16 = tid & 15;
        const int rl = (wave & 3) * 4 + j4;
        float s[4] = {0.f, 0.f, 0.f, 0.f};
        f32x4 pa, pb, pd, pk, pr; float pv, ps = 0.f;
        {
            const size_t m = (size_t)b * 2048 + st; const size_t o = m * 512 + h * 64 + c16 * 4;
            pa = *(const f32x4*)(SA + o); pb = *(const f32x4*)(SB + o); pd = *(const f32x4*)(SD + o); pk = *(const f32x4*)(SK + o); pr = *(const f32x4*)(SRD + o);
            pv = SV[m * 512 + h * 64 + rg * 16 + c16];
            if (tid < 32) ps = SBR[((size_t)b * 2048 + tid) * 8 + h]; else if (tid < 64) ps = SKR[((size_t)b * 2048 + tid - 32) * 8 + h];
        }
        {
            LAS float* B0 = L;
            *(LAS f32x4*)(B0 + st * 64 + c16 * 4) = pa; *(LAS f32x4*)(B0 + 2048 + st * 64 + c16 * 4) = pb; *(LAS f32x4*)(B0 + 4096 + st * 64 + c16 * 4) = pd;
            *(LAS f32x4*)(B0 + 6144 + st * 64 + c16 * 4) = pk; *(LAS f32x4*)(B0 + 8192 + st * 64 + c16 * 4) = pr; B0[10240 + st * 16 + c16] = pv;
            if (tid < 64) B0[10752 + tid] = ps;
        }
        __syncthreads();
        for (int n = 0; n < TT / TC; ++n) {
            LAS float* Bc = L + (n & 1) * CB; LAS float* Bn = L + ((n + 1) & 1) * CB; LAS float* yb = L + 2 * CB + (n & 1) * 512;
            const bool more = n + 1 < TT / TC;
            if (more) {
                const size_t m = (size_t)b * 2048 + (n + 1) * TC + st; const size_t o = m * 512 + h * 64 + c16 * 4;
                pa = *(const f32x4*)(SA + o); pb = *(const f32x4*)(SB + o); pd = *(const f32x4*)(SD + o); pk = *(const f32x4*)(SK + o); pr = *(const f32x4*)(SRD + o);
                pv = SV[m * 512 + h * 64 + rg * 16 + c16];
                if (tid < 32) ps = SBR[((size_t)b * 2048 + (n + 1) * TC + tid) * 8 + h]; else if (tid < 64) ps = SKR[((size_t)b * 2048 + (n + 1) * TC + tid - 32) * 8 + h];
            }
            if (wave < 4) {
                LAS float* ybase = (c == 0) ? (yb + rl) : (L + 2 * CB + 1024 + lane);
                const LAS float* p0 = Bc + c * 4;
                f32x4 av = *(const LAS f32x4*)p0, bv = *(const LAS f32x4*)(p0 + 2048), dv = *(const LAS f32x4*)(p0 + 4096), kv = *(const LAS f32x4*)(p0 + 6144), rd = *(const LAS f32x4*)(p0 + 8192);
                float vi = Bc[10240 + rl], br = Bc[10752], kr = Bc[10784];
#pragma unroll 8
                for (int t = 0; t < TC; ++t) {
                    const int tn = (t + 1 < TC) ? t + 1 : t;
                    const LAS float* p = Bc + tn * 64 + c * 4;
                    const f32x4 av2 = *(const LAS f32x4*)p, bv2 = *(const LAS f32x4*)(p + 2048), dv2 = *(const LAS f32x4*)(p + 4096), kv2 = *(const LAS f32x4*)(p + 6144), rd2 = *(const LAS f32x4*)(p + 8192);
                    const float vi2 = Bc[10240 + tn * 16 + rl], br2 = Bc[10752 + tn], kr2 = Bc[10784 + tn];
                    const float y = scan_step(s, av, bv, dv, kv, rd, vi, br, kr);
                    ybase[t * 16] = y;
                    av = av2; bv = bv2; dv = dv2; kv = kv2; rd = rd2; vi = vi2; br = br2; kr = kr2;
                }
            }
            else {
                const int hw4 = wave - 4;
                if (l == 0 && n < 14) {
                    const int d = (blockIdx.x * 4 + hw4) + 1024 * n;
                    if (d < TR_DEFERRED) tr_deferred(a, ws, d, (LAS float*)(lds + 94208 + hw4 * 8448), lane);
                } else if (n >= 24 && n < 41) {
                    const int tt = (n - 24) * 4 + hw4;
                    int mB = -1;
                    if (tt < 64) mB = blockIdx.x * 64 + tt; else if (tt == 64 && blockIdx.x < NS) mB = MP + blockIdx.x;
                    if (mB >= 0) convB_token(a, l, mB, lane);
                } else if (n >= 20 && n < 24) {
                    const int q = blockIdx.x + gridDim.x * (n - 20);
                    if (q < NS * 8) {
                        const int i = q >> 3, hs = q & 7; const size_t ms = MP + i;
                        const size_t o = ms * 512 + hs * 64 + c * 4;
                        const f32x4 av = *(const f32x4*)(SA + o), bv = *(const f32x4*)(SB + o), dv = *(const f32x4*)(SD + o), kv = *(const f32x4*)(SK + o), rd = *(const f32x4*)(SRD + o);
                        const float br = SBR[ms * 8 + hs], kr = SKR[ms * 8 + hs];
                        f32x4 s4[4]; float vi[4];
#pragma unroll
                        for (int p4 = 0; p4 < 4; ++p4) {
                            const int row = p4 * 16 + hw4 * 4 + j4;
                            s4[p4] = *(const f32x4*)(a.in[I_SWKV] + ((size_t)((l * NS + i) * 8 + hs)) * 4096 + row * 64 + c * 4);
                            vi[p4] = SV[ms * 512 + hs * 64 + row];
                        }
#pragma unroll
                        for (int p4 = 0; p4 < 4; ++p4) {
                            const int row = p4 * 16 + hw4 * 4 + j4;
                            float ss_[4] = {s4[p4][0], s4[p4][1], s4[p4][2], s4[p4][3]};
                            const float y = scan_step(ss_, av, bv, dv, kv, rd, vi[p4], br, kr);
                            *(f32x4*)(a.out + O_WKVS + ((size_t)((l * NS + i) * 8 + hs)) * 4096 + row * 64 + c * 4) = (f32x4){ss_[0], ss_[1], ss_[2], ss_[3]};
                            if (c == 0) Y[ms * 512 + hs * 64 + row] = y;
                        }
                    }
                }
            }
            if (more) {
                *(LAS f32x4*)(Bn + st * 64 + c16 * 4) = pa; *(LAS f32x4*)(Bn + 2048 + st * 64 + c16 * 4) = pb; *(LAS f32x4*)(Bn + 4096 + st * 64 + c16 * 4) = pd;
                *(LAS f32x4*)(Bn + 6144 + st * 64 + c16 * 4) = pk; *(LAS f32x4*)(Bn + 8192 + st * 64 + c16 * 4) = pr; Bn[10240 + st * 16 + c16] = pv;
                if (tid < 64) Bn[10752 + tid] = ps;
            }
            __syncthreads();
            Y[((size_t)b * 2048 + n * TC + st) * 512 + h * 64 + rg * 16 + c16] = yb[st * 16 + c16];
        }
        if (wave < 4) {
            float* o = a.out + O_WKVP + ((size_t)((l * 8 + b) * 8 + h)) * 4096 + (rg * 16 + rl) * 64 + c * 4;
            *(f32x4*)o = (f32x4){s[0], s[1], s[2], s[3]};
        }
        __syncthreads();
    }
}

__device__ __forceinline__ void post_phase(const Args& a, int l, int lane, int gw, int NGW) {
    unsigned char* ws = a.ws;
    const bf16_t* __restrict__ PROJ = (const bf16_t*)(ws + OFF_PROJ);
    const float* __restrict__ Y = (const float*)(ws + OFF_Y); const float* __restrict__ SV = (const float*)(ws + (l == 0 ? OFF_SV0 : OFF_SV1)); const float* __restrict__ GG = (const float*)(ws + OFF_G);
    const float* __restrict__ RKR = (const float*)(ws + OFF_RKR);
    bf16_t* __restrict__ YAB = (bf16_t*)(ws + OFF_YAB);
    const int cb = lane * 8, h = lane >> 3;
#pragma unroll 4
    for (int m = gw; m < MTOK; m += NGW) {
        const size_t o = (size_t)m * 512 + cb;
        const f32x4 y0 = *(const f32x4*)(Y + o), y1 = *(const f32x4*)(Y + o + 4);
        float s = (y0[0] + y0[1]) + (y0[2] + y0[3]) + (y1[0] + y1[1]) + (y1[2] + y1[3]);
        s += __shfl_xor(s, 1); s += __shfl_xor(s, 2); s += __shfl_xor(s, 4);
        const float mean = s * (1.f / 64.f);
        const f32x4 d0 = y0 - mean, d1 = y1 - mean;
        float q = (d0[0] * d0[0] + d0[1] * d0[1]) + (d0[2] * d0[2] + d0[3] * d0[3]) + (d1[0] * d1[0] + d1[1] * d1[1]) + (d1[2] * d1[2] + d1[3] * d1[3]);
        q += __shfl_xor(q, 1); q += __shfl_xor(q, 2); q += __shfl_xor(q, 4);
        const float rstd = rsqrtf(q * (1.f / 64.f) + GN_EPS);
        const float rkr = RKR[m * 8 + h];
        const f32x4 v0 = *(const f32x4*)(SV + o), v1 = *(const f32x4*)(SV + o + 4); f32x4 g0, g1; { const u32x4 gq = *(const u32x4*)((const bf16_t*)GG + o); g0 = (f32x4){bflo(gq.x), bfhi(gq.x), bflo(gq.y), bfhi(gq.y)}; g1 = (f32x4){bflo(gq.z), bfhi(gq.z), bflo(gq.w), bfhi(gq.w)}; }
        const f32x4 lw0 = *(const f32x4*)(a.in[I_LNW] + l * 512 + cb), lw1 = *(const f32x4*)(a.in[I_LNW] + l * 512 + cb + 4);
        const f32x4 lb0 = *(const f32x4*)(a.in[I_LNB] + l * 512 + cb), lb1 = *(const f32x4*)(a.in[I_LNB] + l * 512 + cb + 4);
        const f32x4 r0 = (d0 * rstd * lw0 + lb0 + v0 * rkr) * g0, r1 = (d1 * rstd * lw1 + lb1 + v1 * rkr) * g1;
        u32x4 w; w.x = pk2(r0[0], r0[1]); w.y = pk2(r0[2], r0[3]); w.z = pk2(r1[0], r1[1]); w.w = pk2(r1[2], r1[3]);
        *(u32x4*)(YAB + (size_t)m * 1024 + cb) = w;
    }
    if (l + 1 < 2 && gw < NS) {
        bf16_t* XB = (bf16_t*)(ws + OFF_XB) + (size_t)(MTOK + gw) * D;
        const float* src = a.in[I_SSHIFT] + (size_t)((l + 1) * NS + gw) * D; const float* gn = a.in[I_NMIX] + (l + 1) * D;
#pragma unroll
        for (int j = 0; j < 4; ++j) { const f32x4 v = *(const f32x4*)(src + 4 * lane + 256 * j), g4 = *(const f32x4*)(gn + 4 * lane + 256 * j);
            u32x2 w; w.x = pk2(v[0] / g4[0], v[1] / g4[1]); w.y = pk2(v[2] / g4[2], v[3] / g4[3]); *(u32x2*)(XB + 4 * lane + 256 * j) = w; }
    }
}

__device__ __forceinline__ void sample_attn(LAS unsigned char* lds, const Args& a, int l, int tid, int lane, int wave) {
    unsigned char* ws = a.ws;
    const bf16_t* Q = (const bf16_t*)(ws + OFF_Q); bf16_t* O = (bf16_t*)(ws + OFF_O);
    LAS float* sc = (LAS float*)lds;
    LAS float* part = sc + 256;
    for (int q = blockIdx.x; q < NS * 4; q += gridDim.x) {
        const int i = q >> 2, h = q & 3;
        const u32x2 qw = *(const u32x2*)(Q + (size_t)(MP + i) * 1024 + h * 256 + lane * 4);
        const float q0 = bflo(qw.x), q1 = bfhi(qw.x), q2 = bflo(qw.y), q3 = bfhi(qw.y);
        const float* Kb = a.in[I_CK] + ((size_t)((l * NS + i) * 256) * 4 + h) * 256 + lane * 4;
        const float* Vb = a.in[I_CV] + ((size_t)((l * NS + i) * 256) * 4 + h) * 256 + lane * 4;
        {
            f32x4 kx[8], kn[8];
#pragma unroll
            for (int e = 0; e < 8; ++e) kx[e] = __builtin_nontemporal_load((const f32x4*)(Kb + (size_t)(wave * 32 + e) * 1024));
#pragma unroll
            for (int g8 = 0; g8 < 4; ++g8) {
                if (g8 < 3) {
#pragma unroll
                    for (int e = 0; e < 8; ++e) kn[e] = __builtin_nontemporal_load((const f32x4*)(Kb + (size_t)(wave * 32 + (g8 + 1) * 8 + e) * 1024));
                }
#pragma unroll
                for (int e = 0; e < 8; ++e) { float p = kx[e][0] * q0 + kx[e][1] * q1 + kx[e][2] * q2 + kx[e][3] * q3; p = wave_sum(p); if (lane == 0) sc[wave * 32 + g8 * 8 + e] = p; }
#pragma unroll
                for (int e = 0; e < 8; ++e) kx[e] = kn[e];
            }
        }
        __syncthreads();
        if (wave == 0) {
            const f32x4 s4 = *(const LAS f32x4*)(sc + lane * 4);
            const float mx = wave_max(fmaxf(fmaxf(s4[0], s4[1]), fmaxf(s4[2], s4[3])));
            f32x4 e4; e4[0] = __expf(s4[0] - mx); e4[1] = __expf(s4[1] - mx); e4[2] = __expf(s4[2] - mx); e4[3] = __expf(s4[3] - mx);
            const float inv = 1.f / wave_sum((e4[0] + e4[1]) + (e4[2] + e4[3]));
            *(LAS f32x4*)(sc + lane * 4) = e4 * inv;
        }
        __syncthreads();
        f32x4 acc = (f32x4){0.f, 0.f, 0.f, 0.f};
        {
            f32x4 vx[8], vn[8];
#pragma unroll
            for (int e = 0; e < 8; ++e) vx[e] = __builtin_nontemporal_load((const f32x4*)(Vb + (size_t)(wave * 32 + e) * 1024));
#pragma unroll
            for (int g8 = 0; g8 < 4; ++g8) {
                if (g8 < 3) {
#pragma unroll
                    for (int e = 0; e < 8; ++e) vn[e] = __builtin_nontemporal_load((const f32x4*)(Vb + (size_t)(wave * 32 + (g8 + 1) * 8 + e) * 1024));
                }
#pragma unroll
                for (int e = 0; e < 8; ++e) acc += vx[e] * sc[wave * 32 + g8 * 8 + e];
#pragma unroll
                for (int e = 0; e < 8; ++e) vx[e] = vn[e];
            }
        }
        *(LAS f32x4*)(part + wave * 256 + lane * 4) = acc;
        __syncthreads();
        if (tid < 256) {
            float s = 0.f;
#pragma unroll
            for (int w = 0; w < 8; ++w) s += part[w * 256 + tid];
            O[(size_t)(MP + i) * 1024 + h * 256 + tid] = (bf16_t)f2bf(s);
        }
        __syncthreads();
    }
}

__device__ __forceinline__ void ffnconv_phase(const Args& a, int l, int tid) {
    unsigned char* ws = a.ws;
    const bf16_t* __restrict__ UP = (const bf16_t*)(ws + OFF_UP); bf16_t* __restrict__ H = (bf16_t*)(ws + OFF_H);
    const float* __restrict__ cw = a.in[I_FCW] + (size_t)l * 3 * FW2;
    constexpr int CH = FW / 8;
    for (int rb = blockIdx.x; rb < MP / 64; rb += gridDim.x) {
        if (tid < CH) {
            const int c = tid * 8, r0 = rb * 64, t0 = r0 & 2047;
            float wu[3][8], wg[3][8];
#pragma unroll
            for (int k = 0; k < 3; ++k) {
                const f32x4 a0 = *(const f32x4*)(cw + k * FW2 + c), a1 = *(const f32x4*)(cw + k * FW2 + c + 4), b0 = *(const f32x4*)(cw + k * FW2 + FW + c), b1 = *(const f32x4*)(cw + k * FW2 + FW + c + 4);
#pragma unroll
                for (int j = 0; j < 4; ++j) { wu[k][j] = a0[j]; wu[k][4 + j] = a1[j]; wg[k][j] = b0[j]; wg[k][4 + j] = b1[j]; }
            }
            float u2[8], u1[8], g2[8], g1[8];
#pragma unroll
            for (int j = 0; j < 8; ++j) { u2[j] = 0.f; u1[j] = 0.f; g2[j] = 0.f; g1[j] = 0.f; }
            if (t0 >= 2) {
                const bf16_t* p = UP + (size_t)(r0 - 2) * FW2 + c;
                unpack8(*(const u32x4*)p, u2); unpack8(*(const u32x4*)(p + FW), g2); unpack8(*(const u32x4*)(p + FW2), u1); unpack8(*(const u32x4*)(p + FW2 + FW), g1);
            }
            const bf16_t* p = UP + (size_t)r0 * FW2 + c; bf16_t* hp = H + (size_t)r0 * FW + c;
#pragma unroll 1
            for (int r = 0; r < 64; r += 4) {
                u32x4 lu[4], lg[4];
#pragma unroll
                for (int e = 0; e < 4; ++e) { lu[e] = *(const u32x4*)(p + (size_t)(r + e) * FW2); lg[e] = *(const u32x4*)(p + (size_t)(r + e) * FW2 + FW); }
#pragma unroll
                for (int e = 0; e < 4; ++e) {
                    float u0[8], g0[8], hh[8]; unpack8(lu[e], u0); unpack8(lg[e], g0);
#pragma unroll
                    for (int j = 0; j < 8; ++j) {
                        const float uu = wu[0][j] * u2[j] + wu[1][j] * u1[j] + wu[2][j] * u0[j], gg = wg[0][j] * g2[j] + wg[1][j] * g1[j] + wg[2][j] * g0[j];
                        hh[j] = gg * __builtin_amdgcn_rcpf(1.f + __expf(-gg)) * uu;
                        u2[j] = u1[j]; u1[j] = u0[j]; g2[j] = g1[j]; g1[j] = g0[j];
                    }
                    u32x4 w; w.x = cvt_pk_bf16(hh[0], hh[1]); w.y = cvt_pk_bf16(hh[2], hh[3]); w.z = cvt_pk_bf16(hh[4], hh[5]); w.w = cvt_pk_bf16(hh[6], hh[7]);
                    *(u32x4*)(hp + (size_t)(r + e) * FW) = w;
                }
            }
        }
    }
    for (int it = blockIdx.x * 512 + tid; it < NS * CH; it += gridDim.x * 512) {
        const int i = it / CH, c = (it % CH) * 8, m = MP + i;
        const bf16_t* r0 = UP + (size_t)m * FW2;
        float u[8], g[8], t0[8], t1[8];
        unpack8(*(const u32x4*)(r0 + c), t0); unpack8(*(const u32x4*)(r0 + FW + c), t1);
        const float* sf = a.in[I_SFFN] + (size_t)(l * NS + i) * 2 * FW2;
        float* dst = a.out + O_FFNS + (size_t)(l * NS + i) * 2 * FW2;
        float hh[8];
#pragma unroll
        for (int q = 0; q < 2; ++q) {
            const int cc = c + 4 * q;
            const f32x4 p0u = *(const f32x4*)(sf + cc), p0g = *(const f32x4*)(sf + FW + cc), p1u = *(const f32x4*)(sf + FW2 + cc), p1g = *(const f32x4*)(sf + FW2 + FW + cc);
            const f32x4 w0u = *(const f32x4*)(cw + cc), w1u = *(const f32x4*)(cw + FW2 + cc), w2u = *(const f32x4*)(cw + 2 * FW2 + cc);
            const f32x4 w0g = *(const f32x4*)(cw + FW + cc), w1g = *(const f32x4*)(cw + FW2 + FW + cc), w2g = *(const f32x4*)(cw + 2 * FW2 + FW + cc);
            *(f32x4*)(dst + cc) = p1u; *(f32x4*)(dst + FW + cc) = p1g;
#pragma unroll
            for (int j = 0; j < 4; ++j) {
                u[4 * q + j] = w2u[j] * t0[4 * q + j] + w0u[j] * p0u[j] + w1u[j] * p1u[j]; g[4 * q + j] = w2g[j] * t1[4 * q + j] + w0g[j] * p0g[j] + w1g[j] * p1g[j];
                hh[4 * q + j] = g[4 * q + j] * sigmoidf_(g[4 * q + j]) * u[4 * q + j];
            }
        }
        u32x4 w; w.x = pk2(hh[0], hh[1]); w.y = pk2(hh[2], hh[3]); w.z = pk2(hh[4], hh[5]); w.w = pk2(hh[6], hh[7]);
        *(u32x4*)(H + (size_t)m * FW + c) = w;
    }
}

__device__ __forceinline__ void final_phase(const Args& a, int lane, int gw, int NGW) {
    unsigned char* ws = a.ws;
    const bf16_t* __restrict__ X = (const bf16_t*)(ws + OFF_XB); const float* __restrict__ SS = (const float*)(ws + OFF_SS) + (size_t)6 * MROWS;
    float* __restrict__ outp = a.out;
#pragma unroll 4
    for (int m = gw; m < MTOK; m += NGW) {
        const float rs = rsqrtf(SS[m] * (1.f / 1024.f) + EPS);
        float* __restrict__ dst = m < MP ? outp + O_YP + (size_t)m * D : outp + O_YS + (size_t)(m - MP) * D;
#pragma unroll
        for (int j = 0; j < 4; ++j) { const u32x2 xw = *(const u32x2*)(X + (size_t)m * D + 4 * lane + 256 * j); const f32x4 v = (f32x4){bflo(xw.x), bfhi(xw.x), bflo(xw.y), bfhi(xw.y)}, gn = *(const f32x4*)(a.in[I_NFIN] + 4 * lane + 256 * j);
            *(f32x4*)(dst + 4 * lane + 256 * j) = v * rs * gn; }
    }
}

__device__ __forceinline__ void skinny_gemm(LAS unsigned char* lds, const bf16_t* __restrict__ A, int lda, const bf16_t* __restrict__ Wt, int K, int mode, float* X, bf16_t* O, float* ssn, const float* ss, int lane, int wave) {
    LAS f32x4* part = (LAS f32x4*)lds;
    for (int item = blockIdx.x; item < 256; item += gridDim.x) {
        const int n0 = (item & 63) * 16, r0 = MP + (item >> 6) * 32, fr = lane & 15, fq = lane >> 4;
        const bf16_t* ap = A + (size_t)(r0 + fr) * lda + fq * 8;
        const bf16_t* bp = Wt + (size_t)(n0 + fr) * K + fq * 8;
        f32x4 acc0 = (f32x4){0.f, 0.f, 0.f, 0.f}, acc1 = acc0;
#pragma unroll 4
        for (int ks = wave; ks < K / 32; ks += 8) {
            const bf16x8 bf = *(const bf16x8*)(bp + ks * 32), a0 = *(const bf16x8*)(ap + ks * 32), a1 = *(const bf16x8*)(ap + (size_t)16 * lda + ks * 32);
            acc0 = __builtin_amdgcn_mfma_f32_16x16x32_bf16(bf, a0, acc0, 0, 0, 0);
            acc1 = __builtin_amdgcn_mfma_f32_16x16x32_bf16(bf, a1, acc1, 0, 0, 0);
        }
        part[(wave * 2 + 0) * 64 + lane] = acc0; part[(wave * 2 + 1) * 64 + lane] = acc1;
        __syncthreads();
        if (wave < 2) {
            f32x4 acc = part[wave * 64 + lane];
#pragma unroll
            for (int w = 1; w < 8; ++w) acc += part[(w * 2 + wave) * 64 + lane];
            const int row = r0 + wave * 16 + fr, col = n0 + fq * 4;
            const size_t idx = (size_t)row * 1024 + col;
            if (mode == 1) {
                const u32x2 xi = *(const u32x2*)(O + idx);
                const f32x4 x = (f32x4){bflo(xi.x), bfhi(xi.x), bflo(xi.y), bfhi(xi.y)} + acc;
                u32x2 w; w.x = cvt_pk_bf16(x[0], x[1]); w.y = cvt_pk_bf16(x[2], x[3]); *(u32x2*)(O + idx) = w;
                float sq = (x[0] * x[0] + x[1] * x[1]) + (x[2] * x[2] + x[3] * x[3]);
                sq += __shfl_xor(sq, 16); sq += __shfl_xor(sq, 32);
                if (fq == 0) atomicAdd(ssn + row, sq);
            } else {
                const float rs = rsqrtf(ss[row] * (1.f / 1024.f) + EPS);
                u32x2 w; w.x = cvt_pk_bf16(acc[0] * rs, acc[1] * rs); w.y = cvt_pk_bf16(acc[2] * rs, acc[3] * rs); *(u32x2*)(O + idx) = w;
            }
        }
        __syncthreads();
    }
}

#define XB_TMO      128
#define XB_XCNT(j)  (256  + 64 * (j))
#define XB_XSUB(j)  (1280 + 64 * (j))
#define XB_XGEN(j)  (2304 + 64 * (j))
#define XB_TOP      3328
#define XB_TOPGEN   3392
#define XCD_BAR_WORDS 3456
#define XB_SPIN_CAP (1u << 22)
__device__ __forceinline__ unsigned xb_ld(unsigned* p)              { return __hip_atomic_load(p, __ATOMIC_RELAXED, __HIP_MEMORY_SCOPE_AGENT); }
__device__ __forceinline__ unsigned xb_add(unsigned* p, unsigned v) { return __hip_atomic_fetch_add(p, v, __ATOMIC_RELAXED, __HIP_MEMORY_SCOPE_AGENT); }
__device__ __forceinline__ unsigned xb_xcc_id() { return (unsigned)__builtin_amdgcn_s_getreg((3 << 11) | 20) & 0xFu; }
#define XB_SPIN(cond, bar) do { unsigned _sp = 0; while (cond) { __builtin_amdgcn_s_sleep(1); \
    if ((++_sp & 255u) == 0u) { if (xb_ld(&(bar)[XB_TMO])) break; if (_sp > XB_SPIN_CAP) { atomicAdd(&(bar)[XB_TMO], 1u); break; } } } } while (0)
struct XcdBarrier { unsigned* bar; unsigned x; volatile LAS unsigned* st; };
__device__ __forceinline__ XcdBarrier xcd_barrier_post(unsigned* bar, volatile LAS unsigned* st) {
    XcdBarrier b; b.bar = bar; b.x = xb_xcc_id(); b.st = st;
    if (threadIdx.x == 0) (void)xb_add(&bar[XB_XCNT(b.x)], 1u);
    return b;
}
__device__ __forceinline__ void xcd_barrier_complete(unsigned* bar, unsigned x, unsigned& nloc, unsigned& nx) {
    const unsigned G = gridDim.x * gridDim.y * gridDim.z;
    unsigned sum, cnt, mine, sp = 0u;
    for (;;) {
        sum = 0u; cnt = 0u; mine = 0u;
#pragma unroll
        for (unsigned j = 0; j < 16; ++j) { const unsigned c = xb_ld(&bar[XB_XCNT(j)]); sum += c; cnt += (c > 0u) ? 1u : 0u; mine = (j == x) ? c : mine; }
        if (sum == G) break;
        __builtin_amdgcn_s_sleep(1);
        if ((++sp & 255u) == 0u) { if (xb_ld(&bar[XB_TMO])) break; if (sp > XB_SPIN_CAP) { atomicAdd(&bar[XB_TMO], 1u); break; } }
    }
    nloc = mine > 0u ? mine : 1u; nx = cnt > 0u ? cnt : 1u;
}
__device__ __forceinline__ void xcd_barrier(const XcdBarrier& b) {
    asm volatile("s_waitcnt vmcnt(0)" ::: "memory");
    __syncthreads();
    if (threadIdx.x == 0) {
        unsigned* bar = b.bar;
        __builtin_amdgcn_s_waitcnt(0);
        unsigned nloc = b.st[0], nx = b.st[1];
        if (nloc == 0u) { xcd_barrier_complete(bar, b.x, nloc, nx); b.st[0] = nloc; b.st[1] = nx; }
        const unsigned old = xb_add(&bar[XB_XSUB(b.x)], 1u);
        const unsigned gen = old / nloc;
        if (old + 1u == (gen + 1u) * nloc) {
            __builtin_amdgcn_fence(__ATOMIC_RELEASE, "agent");
            asm volatile("s_waitcnt vmcnt(0)" ::: "memory");
            const unsigned og = xb_add(&bar[XB_TOP], 1u);
            const unsigned tg = og / nx;
            if (og + 1u == (tg + 1u) * nx) xb_add(&bar[XB_TOPGEN], 1u);
            else XB_SPIN(xb_ld(&bar[XB_TOPGEN]) == tg, bar);
            __builtin_amdgcn_fence(__ATOMIC_ACQUIRE, "agent");
            xb_add(&bar[XB_XGEN(b.x)], 1u);
            asm volatile("s_waitcnt vmcnt(0)" ::: "memory");
        } else {
            XB_SPIN(xb_ld(&bar[XB_XGEN(b.x)]) == gen, bar);
            __builtin_amdgcn_fence(__ATOMIC_ACQUIRE, "agent");
            asm volatile("s_waitcnt vmcnt(0)" ::: "memory");
        }
    }
    __syncthreads();
}

__global__ void __launch_bounds__(512, 2) mega(Args a) {
    extern __shared__ __attribute__((aligned(16))) unsigned char lds_raw[];
    LAS unsigned char* lds = (LAS unsigned char*)lds_raw;
    cg::grid_group grid = cg::this_grid();
    volatile LAS unsigned* bst = (volatile LAS unsigned*)(lds + 131072 + 64);
    if (threadIdx.x == 0) { bst[0] = 0u; bst[1] = 0u; }
    __syncthreads();
    const XcdBarrier xbar = xcd_barrier_post((unsigned*)(a.ws + OFF_BAR), bst);
    for (int ph2 = 2 * a.ph_lo; ph2 < 2 * a.ph_hi; ++ph2) {
        const int ph = ph2 >> 1;
        if (ph2 & 1) { const int spx = (ph == 0) ? 12 : (ph == NPHASE - 1) ? 13 : (ph - 1) % 12; if (!((REP_MASK >> spx) & 1)) continue; }
        int tid = threadIdx.x; asm volatile("" : "+v"(tid));
        const int lane = tid & 63, wave = __builtin_amdgcn_readfirstlane(tid >> 6);
        const int G = gridDim.x, gw = blockIdx.x * 8 + wave, NGW = G * 8;
        unsigned char* ws = a.ws; asm volatile("" : "+s"(ws));
        float* SS = (float*)(ws + OFF_SS);
        bf16_t* XB = (bf16_t*)(ws + OFF_XB); float* X = (float*)(ws + OFF_X);
        if (ph == 0) {
            if (PHON(12)) p0_prologue(lds, a, tid, lane, wave, gw, NGW);
        } else if (ph == NPHASE - 1) {
            if (PHON(13)) final_phase(a, lane, gw, NGW);
        } else {
            const int l = (ph - 1) / 12, sp = (ph - 1) % 12;
            const bool is_gemm = (sp == 0 || sp == 4 || sp == 5 || sp == 7 || sp == 8 || sp == 9 || sp == 11);
            if (is_gemm && PHON(0)) {
                const int njobs = (l == 0 && (sp == 0 || sp == 9)) ? 3 : 1;
                for (int jb = 0; jb < njobs; ++jb) {
                    pg8::Gemm g; pg8::GenOrder S; pg8::Epi E;
                    E.mode = 0; E.O = nullptr; E.ldc = D; E.ss = nullptr; E.X = nullptr; E.ssn = nullptr; E.F = nullptr; E.l = l; E.dry = (ph2 & 1);
                    if (sp == 0 && jb == 0) {
                        g = pg8::Gemm{XB, (const bf16_t*)(ws + OFF_WIN) + (size_t)l * LDP * D, D, D, D};
                        S.init(0, MROWS, LDP, D, D, G, (int)blockIdx.x);
                        E.O = (bf16_t*)(ws + OFF_PROJ); E.ldc = LDP; E.ss = SS + (size_t)3 * l * MROWS;
                    } else if (jb > 0) {
                        const int kv = (sp == 0 ? 0 : 2) + jb - 1, ll = kv >> 1, isv = kv & 1;
                        g = pg8::Gemm{(const bf16_t*)(ws + OFF_MNB), (const bf16_t*)(ws + (isv ? OFF_WV : OFF_WK)) + (size_t)ll * D * D, D, D, D};
                        S.init(0, MMEM, D, D, D, G, (int)((blockIdx.x + G - 160 - 32 * (jb - 1)) % G));
                        E.mode = isv ? 3 : 2; E.O = (bf16_t*)(ws + (isv ? OFF_MVT : OFF_MK)) + (size_t)ll * MMEM * D; E.ss = (const float*)(ws + OFF_SSM);
                        E.F = a.out + (isv ? O_MVP : O_MKP) + (size_t)ll * MMEM * D; E.l = ll;
                    } else if (sp == 4 || sp == 8 || sp == 11) {
                        const bf16_t* A = (const bf16_t*)(ws + (sp == 4 ? OFF_YAB : sp == 8 ? OFF_O : OFF_H));
                        const bf16_t* B = sp == 4 ? (const bf16_t*)(ws + OFF_WOUT) + (size_t)l * D * D : sp == 8 ? (const bf16_t*)(ws + OFF_WO) + (size_t)l * D * D : (const bf16_t*)(ws + OFF_WDN) + (size_t)l * D * FW;
                        const int K = sp == 11 ? FW : D;
                        const int nrm = 3 * l + (sp == 4 ? 1 : sp == 8 ? 2 : 3);
                        g = pg8::Gemm{A, B, K, K, K};
                        S.init(0, MP, D, K, K, G, (int)blockIdx.x);
                        E.mode = 1; E.O = XB; E.X = X; E.ssn = SS + (size_t)nrm * MROWS;
                    } else if (sp == 5) {
                        g = pg8::Gemm{XB, (const bf16_t*)(ws + OFF_WQ) + (size_t)l * D * D, D, D, D};
                        S.init(0, MP, D, D, D, G, (int)blockIdx.x);
                        E.O = (bf16_t*)(ws + OFF_Q); E.ss = SS + (size_t)(3 * l + 1) * MROWS;
                    } else if (sp == 7) {
                        g = pg8::Gemm{(const bf16_t*)(ws + OFF_P), (const bf16_t*)(ws + OFF_MVT) + (size_t)l * MMEM * D, D, 256, 256};
                        S.init(2, MP, D, D, 256, G, (int)blockIdx.x);
                        E.O = (bf16_t*)(ws + OFF_O);
                    } else {
                        g = pg8::Gemm{XB, (const bf16_t*)(ws + OFF_WUP) + (size_t)l * FW2 * D, D, D, D};
                        S.init(0, MROWS, FW2, D, D, G, (int)blockIdx.x);
                        E.mode = 4; E.O = (bf16_t*)(ws + OFF_UP); E.ldc = FW2; E.ss = SS + (size_t)(3 * l + 2) * MROWS; E.F = a.out;
                    }
                    pg8::gemm_phase<pg8::Epi, pg8::GenOrder, true>(lds, g, S, E);
                    if (jb == 0 && !(ph2 & 1) && (sp == 4 || sp == 5 || sp == 8 || sp == 11))
                        skinny_gemm(lds, g.A, g.lda, g.Bt, g.K, E.mode, X, E.O, E.ssn, E.ss, lane, wave);
                }
            } else if (sp == 1 && PHON(1)) {
                prep_phase(lds, a, l, tid, lane, wave, gw);
            } else if (sp == 2 && PHON(2)) {
                scan_phase(lds, a, l, tid, lane, wave);
            } else if (sp == 3 && PHON(3)) {
                post_phase(a, l, lane, gw, NGW);
            } else if (sp == 6 && PHON(6)) {
                {
                    pg8::Gemm g{(const bf16_t*)(ws + OFF_Q), (const bf16_t*)(ws + OFF_MK) + (size_t)l * MMEM * D, D, D, 256};
                    pg8::GenOrder S; S.init(1, MP, D, D, D, G, (int)blockIdx.x);
                    pg8::EpiSm E{(bf16_t*)(ws + OFF_P)};
                    pg8::gemm_phase<pg8::EpiSm, pg8::GenOrder, false>(lds, g, S, E);
                }
                __syncthreads();
                sample_attn(lds, a, l, tid, lane, wave);
            } else if (sp == 10 && PHON(10)) {
                ffnconv_phase(a, l, tid);
            }
        }
        if (ph2 + 1 < 2 * a.ph_hi) { if (a.ph_lo < 0) grid.sync(); else xcd_barrier(xbar); }
        if (((REP_MASK >> 14) & 1) && ph2 == 0) { for (int q = 0; q < 40; ++q) xcd_barrier(xbar); }
    }
}

extern "C" void kernel_launch(void* const* d_in, const int* in_sizes, int n_in, void* d_out, int out_size, void* d_ws, size_t ws_size, hipStream_t stream) {
    static int grid = 0;
    if (grid == 0) {
        if (n_in != 38 || ws_size < WS_END) { fprintf(stderr, "kernel_launch: expected 38 inputs and >= %zu bytes of workspace (got %d, %zu)\n", (size_t)WS_END, n_in, ws_size); grid = -1; return; }
        int dev = 0, cus = 0, per_cu = 0;
        hipGetDevice(&dev);
        hipDeviceGetAttribute(&cus, hipDeviceAttributeMultiprocessorCount, dev);
        if (hipFuncSetAttribute((const void*)mega, hipFuncAttributeMaxDynamicSharedMemorySize, LDS_BYTES) != hipSuccess) { fprintf(stderr, "kernel_launch: hipFuncSetAttribute failed\n"); grid = -1; return; }
        hipOccupancyMaxActiveBlocksPerMultiprocessor(&per_cu, (const void*)mega, 512, LDS_BYTES);
        if (per_cu < 1) { fprintf(stderr, "kernel_launch: occupancy query says %d blocks per CU\n", per_cu); per_cu = 1; }
        (void)hipGetLastError();
        grid = cus;
        if (grid != 256) fprintf(stderr, "kernel_launch: built for 256 CUs, got %d\n", grid);
    }
    if (grid < 0) return;
    if (hipMemsetAsync((char*)d_ws + OFF_BAR, 0, BAR_BYTES, stream) != hipSuccess) { fprintf(stderr, "kernel_launch: hipMemsetAsync failed\n"); return; }
    Args a{};
    for (int i = 0; i < 38; ++i) a.in[i] = (const float*)d_in[i];
    a.out = (float*)d_out; a.ws = (unsigned char*)d_ws;
#if MK_PER_PHASE
    for (int ph = 0; ph < NPHASE; ++ph) {
        a.ph_lo = ph; a.ph_hi = ph + 1;
        void* args[] = {&a};
        hipError_t e = hipLaunchCooperativeKernel((const void*)mega, dim3(grid), dim3(512), args, LDS_BYTES, stream);
        if (e != hipSuccess) { fprintf(stderr, "cooperative launch failed: %s\n", hipGetErrorString(e)); break; }
    }
#else
    a.ph_lo = 0; a.ph_hi = NPHASE;
    void* args[] = {&a};
    hipError_t e = hipLaunchCooperativeKernel((const void*)mega, dim3(grid), dim3(512), args, LDS_BYTES, stream);
    if (e != hipSuccess) fprintf(stderr, "cooperative launch failed: %s (grid %d)\n", hipGetErrorString(e), grid);
#endif
    (void)in_sizes; (void)out_size;
}
```

```cpp
#include <hip/hip_runtime.h>
#include <hip/hip_cooperative_groups.h>
#include <cstdio>
#include <cstdint>
namespace cg = cooperative_groups;

#ifndef PH_MASK
#define PH_MASK 0xFFFFF
#endif
#define PHON(k) (((PH_MASK) >> (k)) & 1)
#ifndef REP_MASK
#define REP_MASK 0
#endif
#ifndef MK_PER_PHASE
#define MK_PER_PHASE 0
#endif

#define LAS __attribute__((address_space(3)))
typedef unsigned short bf16_t;
typedef short bf16x8 __attribute__((ext_vector_type(8)));
typedef float f32x4 __attribute__((ext_vector_type(4)));
typedef unsigned u32x4 __attribute__((ext_vector_type(4)));
typedef unsigned u32x2 __attribute__((ext_vector_type(2)));
#define LDS_WAIT() asm volatile("s_waitcnt lgkmcnt(0)" ::: "memory")

constexpr int D = 1024, NB = 8, TT = 2048, MP = NB * TT, NS = 128, MTOK = MP + NS, MROWS = 16640;
constexpr int INC = 3328, LDP = 3584, FW = 2816, FW2 = 5632, NMEM = 256, MMEM = NB * NMEM;
constexpr float EPS = 1e-6f, GN_EPS = 64e-5f;
constexpr int NPHASE = 26;
constexpr int LDS_BYTES = 147456;

constexpr size_t O_YP = 0, O_YS = 16777216, O_SHP = 16908288, O_WKVP = 16924672, O_CONVP = 17448960, O_FFNP = 17465344,
                 O_MKP = 17645568, O_MVP = 21839872, O_SHS = 26034176, O_WKVS = 26296320, O_CONVS = 34684928, O_FFNS = 34947072;

constexpr size_t al256(size_t x) { return (x + 255) & ~(size_t)255; }
constexpr size_t OFF_SS = 0;
constexpr size_t OFF_SSM = al256(OFF_SS + (size_t)7 * MROWS * 4);
constexpr size_t OFF_WIN = al256(OFF_SSM + 2048 * 4);
constexpr size_t OFF_WOUT = OFF_WIN + (size_t)2 * LDP * D * 2;
constexpr size_t OFF_WQ = OFF_WOUT + (size_t)2 * D * D * 2;
constexpr size_t OFF_WK = OFF_WQ + (size_t)2 * D * D * 2;
constexpr size_t OFF_WV = OFF_WK + (size_t)2 * D * D * 2;
constexpr size_t OFF_WO = OFF_WV + (size_t)2 * D * D * 2;
constexpr size_t OFF_WUP = OFF_WO + (size_t)2 * D * D * 2;
constexpr size_t OFF_WDN = OFF_WUP + (size_t)2 * FW2 * D * 2;
constexpr size_t OFF_W2 = OFF_WDN + (size_t)2 * D * FW * 2;
constexpr size_t OFF_A2 = OFF_W2 + (size_t)2 * 512 * 64 * 2;
constexpr size_t OFF_G2 = OFF_A2 + (size_t)2 * 512 * 64 * 2;
constexpr size_t OFF_V1 = OFF_G2 + (size_t)2 * 512 * 128 * 2;
constexpr size_t OFF_V2 = OFF_V1 + (size_t)32 * 512 * 2;
constexpr size_t OFF_X = al256(OFF_V2 + (size_t)512 * 32 * 2);
constexpr size_t OFF_XB = OFF_X + (size_t)MROWS * D * 4;
constexpr size_t OFF_MNB = OFF_XB + (size_t)MROWS * D * 2;
constexpr size_t OFF_MK = OFF_MNB + (size_t)MMEM * D * 2;
constexpr size_t OFF_MVT = OFF_MK + (size_t)2 * MMEM * D * 2;
constexpr size_t OFF_PROJ = OFF_MVT + (size_t)2 * MMEM * D * 2;
constexpr size_t OFF_H = OFF_PROJ;
constexpr size_t SCN = (size_t)MTOK * 512 * 4;
constexpr size_t OFF_SA = OFF_PROJ + (size_t)MROWS * LDP * 2;
constexpr size_t OFF_SB = OFF_SA + SCN, OFF_SD = OFF_SB + SCN, OFF_SK = OFF_SD + SCN, OFF_SRD = OFF_SK + SCN, OFF_G = OFF_SRD + SCN;
constexpr size_t OFF_UP = OFF_SA;
constexpr size_t OFF_SV0 = OFF_G + SCN, OFF_SV1 = OFF_SV0 + SCN;
constexpr size_t OFF_SBR = OFF_SV1 + SCN;
constexpr size_t OFF_SKR = OFF_SBR + (size_t)MTOK * 8 * 4, OFF_RKR = OFF_SKR + (size_t)MTOK * 8 * 4;
constexpr size_t OFF_Y = al256(OFF_RKR + (size_t)MTOK * 8 * 4);
constexpr size_t OFF_YAB = OFF_Y + SCN;
constexpr size_t OFF_Q = OFF_YAB + (size_t)MROWS * D * 2;
constexpr size_t OFF_P = OFF_Q + (size_t)MROWS * D * 2;
constexpr size_t OFF_O = OFF_P + (size_t)MROWS * D * 2;
constexpr size_t OFF_BAR = OFF_O + (size_t)MROWS * D * 2;
constexpr size_t BAR_BYTES = 16384;
constexpr size_t WS_END = OFF_BAR + BAR_BYTES;
static_assert((size_t)MROWS * FW2 * 2 <= 6 * SCN, "UP overlay");
static_assert((size_t)MROWS * FW * 2 <= (size_t)MROWS * LDP * 2, "H overlay");
static_assert(WS_END < (size_t)1050000000, "workspace");

__device__ __forceinline__ unsigned f2bf(float f) { unsigned u = __builtin_bit_cast(unsigned, f); return (u + 0x7fffu + ((u >> 16) & 1u)) >> 16; }
__device__ __forceinline__ unsigned pk2(float lo, float hi) { return f2bf(lo) | (f2bf(hi) << 16); }
__device__ __forceinline__ unsigned cvt_pk_bf16(float lo, float hi) { unsigned r; asm volatile("v_cvt_pk_bf16_f32 %0, %1, %2" : "=v"(r) : "v"(lo), "v"(hi)); return r; }
__device__ __forceinline__ float bflo(unsigned w) { return __builtin_bit_cast(float, w << 16); }
__device__ __forceinline__ float bfhi(unsigned w) { return __builtin_bit_cast(float, w & 0xffff0000u); }
__device__ __forceinline__ float wave_sum(float v) {
#pragma unroll
    for (int o = 1; o < 64; o <<= 1) v += __shfl_xor(v, o);
    return v;
}
__device__ __forceinline__ float wave_max(float v) {
#pragma unroll
    for (int o = 1; o < 64; o <<= 1) v = fmaxf(v, __shfl_xor(v, o));
    return v;
}
__device__ __forceinline__ float sigmoidf_(float x) { return 1.f / (1.f + __expf(-x)); }
__device__ __forceinline__ void unpack8(u32x4 w, float* f) { f[0] = bflo(w.x); f[1] = bfhi(w.x); f[2] = bflo(w.y); f[3] = bfhi(w.y); f[4] = bflo(w.z); f[5] = bfhi(w.z); f[6] = bflo(w.w); f[7] = bfhi(w.w); }
__device__ __forceinline__ f32x4 ld_bf4(const bf16_t* p) { const u32x2 w = *(const u32x2*)p; return (f32x4){bflo(w.x), bfhi(w.x), bflo(w.y), bfhi(w.y)}; }
__device__ __forceinline__ void st_bf4(bf16_t* p, const f32x4 v) { u32x2 w; w.x = cvt_pk_bf16(v[0], v[1]); w.y = cvt_pk_bf16(v[2], v[3]); *(u32x2*)p = w; }
__device__ __forceinline__ float bf2f(bf16_t h) { return __builtin_bit_cast(float, (unsigned)h << 16); }
template <int CTRL> __device__ __forceinline__ float dppf(float v) { return __builtin_bit_cast(float, __builtin_amdgcn_update_dpp(0, __builtin_bit_cast(int, v), CTRL, 0xF, 0xF, true)); }
__device__ __forceinline__ float red16(float v) { v += dppf<0xB1>(v); v += dppf<0x4E>(v); v += dppf<0x124>(v); v += dppf<0x128>(v); return v; }

namespace pg8 {
constexpr int BM = 256, BK = 64, HALF = 128, HTB = HALF * BK * 2, STAGE_BYTES = 8 * HTB, NXCD = 8, WGM = 8;
__host__ __device__ __forceinline__ int lds_byte(int r, int c) { const int st = (r >> 4) * 2 + (c >> 5), rr = r & 15, cc = c & 31, ob = rr * 64 + cc * 2; return st * 1024 + (ob ^ (((ob >> 9) & 1) << 5)); }
__host__ __device__ __forceinline__ void stage_rc(int b, int& R, int& C) { const int st = b / 1024, sb = b % 1024, swz = sb ^ (((sb >> 9) & 1) << 5); R = (st >> 1) * 16 + swz / 64; C = (st & 1) * 32 + (swz % 64) / 2; }
__host__ __device__ __forceinline__ int perm32(int rho) { const int n = rho >> 4, i = rho & 15; return 8 * (i >> 2) + 4 * n + (i & 3); }

struct Unit { int pm, pn; size_t offA, offB; };
struct Gemm { const bf16_t* A; const bf16_t* Bt; int lda, ldb, K; };

struct GenOrder {
    int mode, nM, nN, nwg, G, c; size_t sA, sB;
    __device__ void init(int mode_, int M, int N, int lda, int ldb, int G_, int c_) { mode = mode_; nM = M / BM; nN = N / BM; nwg = nM * nN; G = G_; c = c_; sA = (size_t)BM * lda * 2; sB = (size_t)BM * ldb * 2; }
    __device__ bool next(int i, Unit& u) const {
        const long L = (long)i * G + c; if (L >= nwg) return false;
        if (mode == 0) {
            int wgid = (int)L; { const int q = nwg / NXCD, r = nwg % NXCD, xcd = wgid % NXCD, off = wgid / NXCD; wgid = (xcd < r ? xcd * (q + 1) : r * (q + 1) + (xcd - r) * q) + off; }
            const int nig = WGM * nN, gid = wgid / nig, fm = gid * WGM, gsz = (nM - fm) < WGM ? (nM - fm) : WGM;
            u.pm = fm + ((wgid % nig) % gsz); u.pn = (wgid % nig) / gsz; u.offA = (size_t)u.pm * sA; u.offB = (size_t)u.pn * sB;
        } else {
            const int b = (int)L >> 5, qb = ((int)L >> 2) & 7, h = (int)L & 3;
            u.pm = b * 8 + qb; u.pn = h;
            u.offA = ((size_t)(b * 2048 + qb * 256) * 1024 + h * 256) * 2;
            u.offB = mode == 1 ? ((size_t)(b * 256) * 1024 + h * 256) * 2 : ((size_t)(b * 4 + h) * 256 * 256) * 2;
        }
        return true;
    }
};

template <class Epi, class Sched, bool ALIGN_EPI>
__device__ __forceinline__ void gemm_phase(LAS unsigned char* lds, const Gemm g, const Sched& S, const Epi& E) {
    int tid = threadIdx.x; asm volatile("" : "+v"(tid));
    const int wid = __builtin_amdgcn_readfirstlane(tid >> 6), lane = tid & 63, wr = wid >> 2, wc = wid & 3, fr = lane & 15, fq = lane >> 4;
    const int K = g.K, nt = K / BK;
    unsigned voffA[2], voffB[2];
#pragma unroll
    for (int i = 0; i < 2; ++i) { int R, C; stage_rc(tid * 16 + i * 8192, R, C); const int Rb = Epi::PERM ? ((R & ~31) + perm32(R & 31)) : R;
        voffA[i] = (unsigned)(R * g.lda + C) * 2u; voffB[i] = (unsigned)(Rb * g.ldb + C) * 2u; }
    const size_t kstep = (size_t)(BK * 2);
    const size_t hstepA = (size_t)HALF * g.lda * 2, hstepB = (size_t)HALF * g.ldb * 2;
    const unsigned ldsw = (unsigned)wid * 1024u;
    const int aoff = lds_byte(wr * 64 + fr, fq * 8), boff = lds_byte(wc * 32 + fr, fq * 8);
#define PG8_SA(b, h) (((b) * 2 + (h)) * HTB)
#define PG8_SB(b, h) ((4 + (b) * 2 + (h)) * HTB)
#define PG8_STAGE(bufoff, gbase, voff) do { _Pragma("unroll") for (int _i = 0; _i < 2; ++_i) \
        __builtin_amdgcn_global_load_lds((const unsigned*)((const char*)(gbase) + (voff)[_i]), (LAS unsigned*)(lds + (bufoff) + ldsw + _i * 8192), 16, 0, 0); } while (0)
#define PG8_LDA(dst, b, h) do { _Pragma("unroll") for (int m = 0; m < 4; ++m) _Pragma("unroll") for (int k = 0; k < 2; ++k) dst[m][k] = *(const LAS bf16x8*)(lds + PG8_SA(b, h) + aoff + m * 2048 + k * 1024); } while (0)
#define PG8_LDB(dst, b, h) do { _Pragma("unroll") for (int n = 0; n < 2; ++n) _Pragma("unroll") for (int k = 0; k < 2; ++k) dst[n][k] = *(const LAS bf16x8*)(lds + PG8_SB(b, h) + boff + n * 2048 + k * 1024); } while (0)
#define PG8_MMA(ai, bj, At, Bt) do { __builtin_amdgcn_s_setprio(1); _Pragma("unroll") for (int m = 0; m < 4; ++m) _Pragma("unroll") for (int n = 0; n < 2; ++n) _Pragma("unroll") for (int k = 0; k < 2; ++k) \
        acc[ai][bj][m][n] = __builtin_amdgcn_mfma_f32_16x16x32_bf16(Bt[n][k], At[m][k], acc[ai][bj][m][n], 0, 0, 0); __builtin_amdgcn_s_setprio(0); } while (0)
#define PG8_WAIT_V(n) asm volatile("s_waitcnt vmcnt(" #n ")" ::: "memory")
#define PG8_WAIT_L(n) asm volatile("s_waitcnt lgkmcnt(" #n ")" ::: "memory")
#define PG8_BAR __builtin_amdgcn_s_barrier()
#define PG8_SCHED __builtin_amdgcn_sched_barrier(0)
    Unit cur, nxt; int ui = 0;
    if (!S.next(0, cur)) return;
    f32x4 acc[2][2][4][2];
#pragma unroll
    for (int a = 0; a < 2; ++a)
#pragma unroll
        for (int b = 0; b < 2; ++b)
#pragma unroll
            for (int m = 0; m < 4; ++m)
#pragma unroll
                for (int n = 0; n < 2; ++n) acc[a][b][m][n] = (f32x4){0.f, 0.f, 0.f, 0.f};
    bf16x8 At[4][2], B0[2][2], B1[2][2];
    const char* cA = (const char*)g.A + cur.offA; const char* cB = (const char*)g.Bt + cur.offB;
    PG8_STAGE(PG8_SB(0, 0), cB, voffB); PG8_STAGE(PG8_SB(0, 1), cB + hstepB, voffB); PG8_STAGE(PG8_SA(0, 0), cA, voffA); PG8_STAGE(PG8_SA(0, 1), cA + hstepA, voffA);
    if (wr == 1) PG8_BAR;
    PG8_WAIT_V(2); PG8_BAR;
    PG8_STAGE(PG8_SB(1, 0), cB + kstep, voffB); PG8_STAGE(PG8_SA(1, 0), cA + kstep, voffA); PG8_STAGE(PG8_SB(1, 1), cB + hstepB + kstep, voffB);
    PG8_WAIT_V(6); PG8_BAR;
    for (;;) {
        const bool has_next = S.next(ui + 1, nxt);
        const char* nA = has_next ? (const char*)g.A + nxt.offA : cA; const char* nB = has_next ? (const char*)g.Bt + nxt.offB : cB;
        for (int t = 0; t < nt; t += 2) {
            const bool last = (t == nt - 2);
            const char* a1 = cA + (size_t)(t + 1) * kstep;
            const char* a2 = last ? nA : cA + (size_t)(t + 2) * kstep; const char* b2 = last ? nB : cB + (size_t)(t + 2) * kstep;
            const char* a3 = a2 + kstep; const char* b3 = b2 + kstep;
            PG8_LDB(B0, 0, 0); PG8_LDB(B1, 0, 1); PG8_SCHED; PG8_LDA(At, 0, 0); PG8_STAGE(PG8_SA(1, 1), a1 + hstepA, voffA);
            PG8_WAIT_V(8); PG8_WAIT_L(0); PG8_BAR; PG8_MMA(0, 0, At, B0); PG8_MMA(0, 1, At, B1); PG8_BAR; PG8_SCHED;
            PG8_LDA(At, 0, 1); PG8_STAGE(PG8_SB(0, 0), b2, voffB); PG8_STAGE(PG8_SB(0, 1), b2 + hstepB, voffB); PG8_STAGE(PG8_SA(0, 0), a2, voffA);
            PG8_WAIT_V(8); PG8_WAIT_L(0); PG8_BAR; PG8_MMA(1, 0, At, B0); PG8_MMA(1, 1, At, B1); PG8_BAR; PG8_SCHED;
            PG8_LDB(B0, 1, 0); PG8_LDB(B1, 1, 1); PG8_SCHED; PG8_LDA(At, 1, 0); PG8_STAGE(PG8_SA(0, 1), a2 + hstepA, voffA);
            PG8_WAIT_V(8); PG8_WAIT_L(0); PG8_BAR; PG8_MMA(0, 0, At, B0); PG8_MMA(0, 1, At, B1); PG8_BAR; PG8_SCHED;
            PG8_LDA(At, 1, 1); PG8_STAGE(PG8_SB(1, 0), b3, voffB); PG8_STAGE(PG8_SB(1, 1), b3 + hstepB, voffB); PG8_STAGE(PG8_SA(1, 0), a3, voffA);
            PG8_WAIT_V(8); PG8_WAIT_L(0); PG8_BAR; PG8_MMA(1, 0, At, B0); PG8_MMA(1, 1, At, B1); PG8_BAR; PG8_SCHED;
        }
        if constexpr (ALIGN_EPI) { if (wr == 0) PG8_BAR; }
        if constexpr (!Epi::AFTER_DRAIN) { E(acc, cur, wr, wc, fr, fq); }
        if (!has_next) break;
#pragma unroll
        for (int a = 0; a < 2; ++a)
#pragma unroll
            for (int b = 0; b < 2; ++b)
#pragma unroll
                for (int m = 0; m < 4; ++m)
#pragma unroll
                    for (int n = 0; n < 2; ++n) acc[a][b][m][n] = (f32x4){0.f, 0.f, 0.f, 0.f};
        cur = nxt; cA = nA; cB = nB; ++ui;
        if constexpr (ALIGN_EPI) { if (wr == 1) PG8_BAR; }
    }
    PG8_WAIT_V(0);
    if constexpr (!ALIGN_EPI) { if (wr == 0) PG8_BAR; }
    PG8_BAR;
    if constexpr (Epi::AFTER_DRAIN) { E.fused(acc, cur, wr, wc, fr, fq, lds, wid, lane); }
#undef PG8_SA
#undef PG8_SB
#undef PG8_STAGE
#undef PG8_LDA
#undef PG8_LDB
#undef PG8_MMA
#undef PG8_WAIT_V
#undef PG8_WAIT_L
#undef PG8_BAR
#undef PG8_SCHED
}

struct Epi {
    static constexpr bool PERM = true, AFTER_DRAIN = false;
    int mode;
    bf16_t* O; int ldc;
    const float* ss;
    float* X;
    float* ssn;
    float* F;
    int l; int dry;
    __device__ __forceinline__ void operator()(const f32x4 (&acc)[2][2][4][2], const Unit& u, int wr, int wc, int fr, int fq) const {
        const int row0 = u.pm * 256 + wr * 64 + fr, col0 = u.pn * 256 + wc * 32 + 8 * fq;
        if (dry) return;
        if (mode == 1) {
#pragma unroll
            for (int ai = 0; ai < 2; ++ai)
#pragma unroll
                for (int m = 0; m < 4; ++m) {
                    const int row = row0 + ai * 128 + m * 16; const bool valid = row < MTOK; float sq = 0.f;
#pragma unroll
                    for (int bj = 0; bj < 2; ++bj) {
                        const size_t idx = (size_t)row * 1024 + col0 + bj * 128;
                        if (valid) {
                            float xf[8]; unpack8(*(const u32x4*)(O + idx), xf);
                            const f32x4 x0 = (f32x4){xf[0], xf[1], xf[2], xf[3]} + acc[ai][bj][m][0], x1 = (f32x4){xf[4], xf[5], xf[6], xf[7]} + acc[ai][bj][m][1];
                            sq += (x0[0] * x0[0] + x0[1] * x0[1]) + (x0[2] * x0[2] + x0[3] * x0[3]) + (x1[0] * x1[0] + x1[1] * x1[1]) + (x1[2] * x1[2] + x1[3] * x1[3]);
                            u32x4 w; w.x = cvt_pk_bf16(x0[0], x0[1]); w.y = cvt_pk_bf16(x0[2], x0[3]); w.z = cvt_pk_bf16(x1[0], x1[1]); w.w = cvt_pk_bf16(x1[2], x1[3]);
                            *(u32x4*)(O + idx) = w;
                        }
                    }
                    sq += __shfl_xor(sq, 16); sq += __shfl_xor(sq, 32);
                    if (valid && fq == 0) atomicAdd(ssn + row, sq);
                }
        } else {
#pragma unroll
            for (int ai = 0; ai < 2; ++ai)
#pragma unroll
                for (int m = 0; m < 4; ++m) {
                    const int row = row0 + ai * 128 + m * 16;
                    float rs = 1.f;
                    if (ss != nullptr && (mode == 2 || mode == 3 || row < MTOK)) rs = rsqrtf(ss[row] * (1.f / 1024.f) + EPS);
#pragma unroll
                    for (int bj = 0; bj < 2; ++bj) {
                        const int col = col0 + bj * 128;
                        const f32x4 v0 = acc[ai][bj][m][0] * rs, v1 = acc[ai][bj][m][1] * rs;
                        u32x4 w; w.x = cvt_pk_bf16(v0[0], v0[1]); w.y = cvt_pk_bf16(v0[2], v0[3]); w.z = cvt_pk_bf16(v1[0], v1[1]); w.w = cvt_pk_bf16(v1[2], v1[3]);
                        if (mode == 3) {
                            const int b = row >> 8, mem = row & 255;
                            bf16_t* o = O + ((size_t)(b * 1024 + col)) * 256 + mem;
                            o[0] = (bf16_t)(w.x & 0xffff); o[256] = (bf16_t)(w.x >> 16); o[512] = (bf16_t)(w.y & 0xffff); o[768] = (bf16_t)(w.y >> 16);
                            o[1024] = (bf16_t)(w.z & 0xffff); o[1280] = (bf16_t)(w.z >> 16); o[1536] = (bf16_t)(w.w & 0xffff); o[1792] = (bf16_t)(w.w >> 16);
                        } else {
                            *(u32x4*)(O + (size_t)row * ldc + col) = w;
                        }
                        if (mode == 2 || mode == 3) { float* f = F + (size_t)row * 1024 + col; *(f32x4*)f = v0; *(f32x4*)(f + 4) = v1; }
                        if (mode == 4) {
                            float* f = nullptr;
                            if (row < MP) { const int t = row & 2047; if (t >= 2046) f = F + O_FFNP + ((size_t)((l * 8 + (row >> 11)) * 2 + (t - 2046))) * FW2 + col; }
                            else if (row < MTOK) f = F + O_FFNS + ((size_t)((l * 128 + (row - MP)) * 2 + 1)) * FW2 + col;
                            if (f) { *(f32x4*)f = v0; *(f32x4*)(f + 4) = v1; }
                        }
                    }
                }
        }
    }
};

struct EpiSm {
    static constexpr bool PERM = true, AFTER_DRAIN = true;
    bf16_t* P;
    __device__ __forceinline__ void operator()(const f32x4 (&)[2][2][4][2], const Unit&, int, int, int, int) const {}
    __device__ __forceinline__ void fused(f32x4 (&acc)[2][2][4][2], const Unit& u, int wr, int wc, int fr, int fq, LAS unsigned char* lds, int wid, int lane) const {
        LAS float* red = (LAS float*)lds; LAS float* red2 = red + 1024;
        float mx[2][4];
#pragma unroll
        for (int ai = 0; ai < 2; ++ai)
#pragma unroll
            for (int m = 0; m < 4; ++m) {
                float v = -3.0e38f;
#pragma unroll
                for (int bj = 0; bj < 2; ++bj)
#pragma unroll
                    for (int n = 0; n < 2; ++n) { const f32x4 x = acc[ai][bj][m][n]; v = fmaxf(v, fmaxf(fmaxf(x[0], x[1]), fmaxf(x[2], x[3]))); }
                v = fmaxf(v, __shfl_xor(v, 16)); v = fmaxf(v, __shfl_xor(v, 32));
                if (fq == 0) red[(ai * 128 + wr * 64 + m * 16 + fr) * 4 + wc] = v;
            }
        __syncthreads();
#pragma unroll
        for (int ai = 0; ai < 2; ++ai)
#pragma unroll
            for (int m = 0; m < 4; ++m) {
                const f32x4 r = *(const LAS f32x4*)(red + (ai * 128 + wr * 64 + m * 16 + fr) * 4);
                const float M = fmaxf(fmaxf(r[0], r[1]), fmaxf(r[2], r[3])); mx[ai][m] = M;
                float s = 0.f;
#pragma unroll
                for (int bj = 0; bj < 2; ++bj)
#pragma unroll
                    for (int n = 0; n < 2; ++n) { f32x4 x = acc[ai][bj][m][n];
                        x[0] = __expf(x[0] - M); x[1] = __expf(x[1] - M); x[2] = __expf(x[2] - M); x[3] = __expf(x[3] - M); acc[ai][bj][m][n] = x; s += (x[0] + x[1]) + (x[2] + x[3]); }
                s += __shfl_xor(s, 16); s += __shfl_xor(s, 32);
                if (fq == 0) red2[(ai * 128 + wr * 64 + m * 16 + fr) * 4 + wc] = s;
            }
        __syncthreads();
#pragma unroll
        for (int ai = 0; ai < 2; ++ai)
#pragma unroll
            for (int m = 0; m < 4; ++m) {
                const int rl = ai * 128 + wr * 64 + m * 16 + fr;
                const f32x4 r = *(const LAS f32x4*)(red2 + rl * 4);
                const float inv = 1.f / ((r[0] + r[1]) + (r[2] + r[3]));
#pragma unroll
                for (int bj = 0; bj < 2; ++bj) {
                    const f32x4 v0 = acc[ai][bj][m][0] * inv, v1 = acc[ai][bj][m][1] * inv;
                    u32x4 w; w.x = cvt_pk_bf16(v0[0], v0[1]); w.y = cvt_pk_bf16(v0[2], v0[3]); w.z = cvt_pk_bf16(v1[0], v1[1]); w.w = cvt_pk_bf16(v1[2], v1[3]);
                    *(u32x4*)(P + (size_t)(u.pm * 256 + rl) * 1024 + u.pn * 256 + bj * 128 + wc * 32 + 8 * fq) = w;
                }
            }
        (void)mx; (void)wid; (void)lane;
    }
};
}

struct Args { const float* in[38]; float* out; unsigned char* ws; int ph_lo, ph_hi; };
enum { I_XP = 0, I_XS, I_MEM, I_SSHIFT, I_SWKV, I_SCONV, I_SFFN, I_CK, I_CV, I_NMIX, I_WIN, I_MU, I_W0, I_W2, I_A0, I_A2, I_G2, I_V0, I_V1, I_V2,
       I_KK, I_KA, I_RK, I_LNW, I_LNB, I_CONVW, I_WOUT, I_NX, I_NMEM, I_WQ, I_WK, I_WV, I_WO, I_NFFN, I_WUP, I_FCW, I_WDN, I_NFIN };

__device__ __forceinline__ void tr_item(const float* W, int K, int N, bf16_t* WT, const float* gain, float scale, LAS float* scr, int item, int lane) {
    const int nblk = N / 32, kb = item / nblk, nb = item % nblk, k0 = 64 * kb, n0 = 32 * nb;
#pragma unroll
    for (int i = 0; i < 8; ++i) { const int kk = 8 * i + (lane >> 3); const float gk = gain ? gain[k0 + kk] * scale : scale;
        const f32x4 v = *(const f32x4*)(W + (size_t)(k0 + kk) * N + n0 + (lane & 7) * 4) * gk;
        LAS float* d = scr + kk * 33 + (lane & 7) * 4; d[0] = v[0]; d[1] = v[1]; d[2] = v[2]; d[3] = v[3]; }
    LDS_WAIT();
    const int c = lane & 7;
#pragma unroll
    for (int j = 0; j < 4; ++j) { const int n = (lane >> 3) + 8 * j; const LAS float* s = scr + (8 * c) * 33 + n;
        u32x4 o; o.x = pk2(s[0 * 33], s[1 * 33]); o.y = pk2(s[2 * 33], s[3 * 33]); o.z = pk2(s[4 * 33], s[5 * 33]); o.w = pk2(s[6 * 33], s[7 * 33]);
        *(u32x4*)(WT + (size_t)(n0 + n) * K + k0 + 8 * c) = o; }
    LDS_WAIT();
}

constexpr int TR_NL = 8512;
__device__ __forceinline__ void tr_dispatch(const Args& a, unsigned char* ws, int l, int r, LAS float* scr, int lane) {
    constexpr int I_IN_ = 16 * 104, I_SQ_ = 16 * 32, I_UP_ = 16 * 176, I_DN_ = 44 * 32, I_L64 = 16;
    if (r < I_IN_) { tr_item(a.in[I_WIN] + (size_t)l * D * INC, D, INC, (bf16_t*)(ws + OFF_WIN) + (size_t)l * LDP * D, a.in[I_NMIX] + l * D, 1.f, scr, r, lane); return; } r -= I_IN_;
    if (r < I_SQ_) { tr_item(a.in[I_WOUT] + (size_t)l * D * D, D, D, (bf16_t*)(ws + OFF_WOUT) + (size_t)l * D * D, nullptr, 1.f, scr, r, lane); return; } r -= I_SQ_;
    if (r < I_SQ_) { tr_item(a.in[I_WQ] + (size_t)l * D * D, D, D, (bf16_t*)(ws + OFF_WQ) + (size_t)l * D * D, a.in[I_NX] + l * D, 0.0625f, scr, r, lane); return; } r -= I_SQ_;
    if (r < I_SQ_) { tr_item(a.in[I_WK] + (size_t)l * D * D, D, D, (bf16_t*)(ws + OFF_WK) + (size_t)l * D * D, a.in[I_NMEM] + l * D, 1.f, scr, r, lane); return; } r -= I_SQ_;
    if (r < I_SQ_) { tr_item(a.in[I_WV] + (size_t)l * D * D, D, D, (bf16_t*)(ws + OFF_WV) + (size_t)l * D * D, a.in[I_NMEM] + l * D, 1.f, scr, r, lane); return; } r -= I_SQ_;
    if (r < I_SQ_) { tr_item(a.in[I_WO] + (size_t)l * D * D, D, D, (bf16_t*)(ws + OFF_WO) + (size_t)l * D * D, nullptr, 1.f, scr, r, lane); return; } r -= I_SQ_;
    if (r < I_UP_) { tr_item(a.in[I_WUP] + (size_t)l * D * FW2, D, FW2, (bf16_t*)(ws + OFF_WUP) + (size_t)l * FW2 * D, a.in[I_NFFN] + l * D, 1.f, scr, r, lane); return; } r -= I_UP_;
    if (r < I_DN_) { tr_item(a.in[I_WDN] + (size_t)l * FW * D, FW, D, (bf16_t*)(ws + OFF_WDN) + (size_t)l * D * FW, nullptr, 1.f, scr, r, lane); return; } r -= I_DN_;
    if (r < I_L64) { tr_item(a.in[I_W2] + (size_t)l * 64 * 512, 64, 512, (bf16_t*)(ws + OFF_W2) + (size_t)l * 512 * 64, nullptr, 1.f, scr, r, lane); return; } r -= I_L64;
    if (r < I_L64) { tr_item(a.in[I_A2] + (size_t)l * 64 * 512, 64, 512, (bf16_t*)(ws + OFF_A2) + (size_t)l * 512 * 64, nullptr, 1.f, scr, r, lane); return; } r -= I_L64;
    tr_item(a.in[I_G2] + (size_t)l * 128 * 512, 128, 512, (bf16_t*)(ws + OFF_G2) + (size_t)l * 512 * 128, nullptr, 1.f, scr, r, lane);
}
constexpr int TR_DEFERRED = TR_NL + 5760;
__device__ __forceinline__ void tr_deferred(const Args& a, unsigned char* ws, int d, LAS float* scr, int lane) {
    if (d < TR_NL) { tr_dispatch(a, ws, 1, d, scr, lane); return; }
    const int e = d - TR_NL;
    const int r = e < 1024 ? 1664 + e : (e < 1536 ? 3712 + (e - 1024) : 4224 + (e - 1536));
    tr_dispatch(a, ws, 0, r, scr, lane);
}

__device__ __forceinline__ void p0_prologue(LAS unsigned char* lds, const Args& a, int tid, int lane, int wave, int gw, int NGW) {
    unsigned char* ws = a.ws;
    LAS float* scr = (LAS float*)(lds + wave * 16384);
    for (int it = gw; it < 1664 + 1024 + 64; it += NGW) {
        const int r = it < 1664 ? it : (it < 2688 ? 2688 + (it - 1664) : 8448 + (it - 2688));
        tr_dispatch(a, ws, 0, r, scr, lane);
    }
    float* X = (float*)(ws + OFF_X); bf16_t* XB = (bf16_t*)(ws + OFF_XB); float* SS = (float*)(ws + OFF_SS);
    bf16_t* MNB = (bf16_t*)(ws + OFF_MNB); float* SSM = (float*)(ws + OFF_SSM);
    for (int m = gw; m < MROWS + MMEM; m += NGW) {
        const float* src; bf16_t* dstb; float* dstx = nullptr; float* dss = nullptr; bool shiftrow = false;
        if (m < MP) { src = a.in[I_XP] + (size_t)m * D; dstb = XB + (size_t)m * D; dstx = X + (size_t)m * D; dss = SS + m; }
        else if (m < MTOK) { src = a.in[I_XS] + (size_t)(m - MP) * D; dstb = XB + (size_t)m * D; dstx = X + (size_t)m * D; dss = SS + m; }
        else if (m < MROWS) { src = a.in[I_SSHIFT] + (size_t)(m - MTOK) * D; dstb = XB + (size_t)m * D; shiftrow = true; }
        else { src = a.in[I_MEM] + (size_t)(m - MROWS) * D; dstb = MNB + (size_t)(m - MROWS) * D; dss = SSM + (m - MROWS); }
        float s = 0.f;
#pragma unroll
        for (int j = 0; j < 4; ++j) {
            f32x4 v = *(const f32x4*)(src + 4 * lane + 256 * j);
            if (shiftrow) { const f32x4 gn = *(const f32x4*)(a.in[I_NMIX] + 4 * lane + 256 * j); v[0] /= gn[0]; v[1] /= gn[1]; v[2] /= gn[2]; v[3] /= gn[3]; }
            s += (v[0] * v[0] + v[1] * v[1]) + (v[2] * v[2] + v[3] * v[3]);
            u32x2 w; w.x = pk2(v[0], v[1]); w.y = pk2(v[2], v[3]);
            *(u32x2*)(dstb + 4 * lane + 256 * j) = w;
        }
        s = wave_sum(s);
        if (dss && lane == 0) *dss = s;
    }
    if (blockIdx.x * 8 < D) {
        __syncthreads();
        LAS float* M = (LAS float*)lds;
        const float* muv = a.in[I_MU] + 1792 + 1024; const float* v1 = a.in[I_V1];
#pragma unroll 8
        for (int i = tid; i < 512 * 64; i += 512) { const int c = i >> 6, o = i & 63; const float mv = muv[c]; M[i] = ((o >> 5) ? mv : 1.f - mv) * v1[c * 32 + (o & 31)]; }
        __syncthreads();
        for (int k = gw; k < D; k += NGW) {
            const float* wrow = a.in[I_WIN] + (size_t)1 * D * INC + (size_t)k * INC + 1024;
            float acc = 0.f;
#pragma unroll 4
            for (int c = 0; c < 512; c += 4) {
                const f32x4 w4 = *(const f32x4*)(wrow + c);
                acc += w4[0] * M[c * 64 + lane] + w4[1] * M[(c + 1) * 64 + lane] + w4[2] * M[(c + 2) * 64 + lane] + w4[3] * M[(c + 3) * 64 + lane];
            }
            ((bf16_t*)(ws + OFF_WIN))[(size_t)1 * LDP * D + (size_t)(INC + lane) * D + k] = (bf16_t)f2bf(acc * a.in[I_NMIX][D + k]);
        }
    }
    const int gt = blockIdx.x * 512 + tid, NGT = gridDim.x * 512;
    for (int i = gt; i < 6 * MROWS; i += NGT) SS[MROWS + i] = 0.f;
    bf16_t* V2T = (bf16_t*)(ws + OFF_V2);
    for (int i = gt; i < 512 * 32; i += NGT) { const int n = i >> 5, k = i & 31; V2T[i] = (bf16_t)f2bf(a.in[I_V2][k * 512 + n]); }
}

__device__ __forceinline__ const bf16_t* prev_row(const bf16_t* PROJ, int m) {
    if (m < MP) { if ((m & 2047) == 0) return nullptr; return PROJ + (size_t)(m - 1) * LDP; }
    return PROJ + (size_t)(m + NS) * LDP;
}
__device__ __forceinline__ void mix4(const bf16_t* cur, const bf16_t* prv, const float* mu, int col, float* z) {
    const u32x2 c = *(const u32x2*)(cur + col); const f32x4 m4 = *(const f32x4*)(mu + col);
    float cf[4] = {bflo(c.x), bfhi(c.x), bflo(c.y), bfhi(c.y)}; float pf[4] = {0.f, 0.f, 0.f, 0.f};
    if (prv) { const u32x2 p = *(const u32x2*)(prv + col); pf[0] = bflo(p.x); pf[1] = bfhi(p.x); pf[2] = bflo(p.y); pf[3] = bfhi(p.y); }
#pragma unroll
    for (int j = 0; j < 4; ++j) z[j] = cf[j] + (pf[j] - cf[j]) * m4[j];
}
__device__ __forceinline__ void mix8(const bf16_t* cur, const bf16_t* prv, const float* mu, int col, float* z) {
    const u32x4 c = *(const u32x4*)(cur + col); float cf[8], pf[8]; unpack8(c, cf);
#pragma unroll
    for (int j = 0; j < 8; ++j) pf[j] = 0.f;
    if (prv) { const u32x4 p = *(const u32x4*)(prv + col); unpack8(p, pf); }
    const f32x4 m0 = *(const f32x4*)(mu + col), m1 = *(const f32x4*)(mu + col + 4);
#pragma unroll
    for (int j = 0; j < 4; ++j) { z[j] = cf[j] + (pf[j] - cf[j]) * m0[j]; z[4 + j] = cf[4 + j] + (pf[4 + j] - cf[4 + j]) * m1[j]; }
}

__device__ __forceinline__ float fsig(float x) { return __builtin_amdgcn_rcpf(1.f + __expf(-x)); }
__device__ __forceinline__ void mixw(u32x2 c, u32x2 p, const LAS float* mu, float* z) {
    const f32x4 m4 = *(const LAS f32x4*)mu;
    const float cf[4] = {bflo(c.x), bfhi(c.x), bflo(c.y), bfhi(c.y)}, pf[4] = {bflo(p.x), bfhi(p.x), bflo(p.y), bfhi(p.y)};
#pragma unroll
    for (int j = 0; j < 4; ++j) z[j] = cf[j] + (pf[j] - cf[j]) * m4[j];
}
__device__ __forceinline__ void prep_phase(LAS unsigned char* lds, const Args& a, int l, int tid, int lane, int wave, int gw) {
    unsigned char* ws = a.ws;
    const bf16_t* PROJ = (const bf16_t*)(ws + OFF_PROJ);
    const float* mu = a.in[I_MU] + l * 1792;
    if (gw < NB + NS) {
        const int row = gw < NB ? gw * 2048 + 2047 : MP + (gw - NB);
        float* dst = gw < NB ? a.out + O_SHP + (size_t)(l * NB + gw) * D : a.out + O_SHS + (size_t)(l * NS + (gw - NB)) * D;
        const bf16_t* Xr = (const bf16_t*)(ws + OFF_XB) + (size_t)row * D;
        const float rs = rsqrtf(((const float*)(ws + OFF_SS))[3 * l * MROWS + row] * (1.f / 1024.f) + EPS);
#pragma unroll
        for (int j = 0; j < 4; ++j) { const u32x2 xw = *(const u32x2*)(Xr + 4 * lane + 256 * j); const f32x4 v = (f32x4){bflo(xw.x), bfhi(xw.x), bflo(xw.y), bfhi(xw.y)}, gn = *(const f32x4*)(a.in[I_NMIX] + l * D + 4 * lane + 256 * j);
            *(f32x4*)(dst + 4 * lane + 256 * j) = v * rs * gn; }
    }
    LAS bf16_t* WL2 = (LAS bf16_t*)lds;
    LAS bf16_t* WLA = (LAS bf16_t*)(lds + 18432);
    LAS bf16_t* WLG = (LAS bf16_t*)(lds + 36864);
    LAS bf16_t* WLV = (LAS bf16_t*)(lds + 71680);
    LAS float* PAR = (LAS float*)(lds + 81920);
    LAS bf16_t* LA = (LAS bf16_t*)(lds + 88064);
    LAS bf16_t* LW = (LAS bf16_t*)(lds + 121856);
    const int hp = blockIdx.x & 3;
    {
        const bf16_t* W2T = (const bf16_t*)(ws + OFF_W2) + (size_t)l * 512 * 64 + (size_t)hp * 128 * 64;
        const bf16_t* A2T = (const bf16_t*)(ws + OFF_A2) + (size_t)l * 512 * 64 + (size_t)hp * 128 * 64;
        const bf16_t* G2T = (const bf16_t*)(ws + OFF_G2) + (size_t)l * 512 * 128 + (size_t)hp * 128 * 128;
        const bf16_t* V2T = (const bf16_t*)(ws + OFF_V2) + (size_t)hp * 128 * 32;
#pragma unroll
        for (int q = 0; q < 2; ++q) { const int i = tid + 512 * q, n = i >> 3, c = (i & 7) * 8;
            *(LAS u32x4*)(WL2 + n * 72 + c) = *(const u32x4*)(W2T + n * 64 + c); *(LAS u32x4*)(WLA + n * 72 + c) = *(const u32x4*)(A2T + n * 64 + c); }
#pragma unroll
        for (int q = 0; q < 4; ++q) { const int i = tid + 512 * q, n = i >> 4, c = (i & 15) * 8; *(LAS u32x4*)(WLG + n * 136 + c) = *(const u32x4*)(G2T + n * 128 + c); }
        { const int n = tid >> 2, c = (tid & 3) * 8; *(LAS u32x4*)(WLV + n * 40 + c) = *(const u32x4*)(V2T + n * 32 + c); }
        if (tid < 128) {
            const int ch = hp * 128 + tid;
            PAR[tid] = a.in[I_W0][l * 512 + ch]; PAR[128 + tid] = a.in[I_A0][l * 512 + ch]; PAR[256 + tid] = a.in[I_KK][l * 512 + ch]; PAR[384 + tid] = a.in[I_KA][l * 512 + ch];
            PAR[512 + tid] = a.in[I_RK][l * 512 + ch]; PAR[640 + tid] = l == 1 ? a.in[I_V0][ch] : 0.f; PAR[768 + tid] = mu[ch]; PAR[896 + tid] = mu[512 + ch]; PAR[1024 + tid] = mu[1024 + ch];
        }
    }
    float* SA = (float*)(ws + OFF_SA); float* SB = (float*)(ws + OFF_SB); float* SD = (float*)(ws + OFF_SD); float* SK = (float*)(ws + OFF_SK);
    float* SRD = (float*)(ws + OFF_SRD); float* GG = (float*)(ws + OFF_G); float* SV = (float*)(ws + (l == 0 ? OFF_SV0 : OFF_SV1));
    const float* SV0 = (const float*)(ws + OFF_SV0);
    float* SBR = (float*)(ws + OFF_SBR); float* SKR = (float*)(ws + OFF_SKR); float* RKR = (float*)(ws + OFF_RKR);
    const int mt = wave & 3, hh = wave >> 2, h = hp * 2 + hh, fr = lane & 15, fq = lane >> 4;
    constexpr int NTILE = MTOK / 64;
    for (int tile = blockIdx.x >> 2; tile < NTILE; tile += gridDim.x >> 2) {
        const int m0 = tile * 64;
        {
            u32x4 cu[4], pv[4];
#pragma unroll
            for (int q = 0; q < 4; ++q) {
                const int row = (tid >> 5) + 16 * q, ch = tid & 31, m = m0 + row;
                const bf16_t* prv = prev_row(PROJ, m);
                cu[q] = *(const u32x4*)(PROJ + (size_t)m * LDP + 1536 + ch * 8);
                pv[q] = prv ? *(const u32x4*)(prv + 1536 + ch * 8) : (u32x4){0u, 0u, 0u, 0u};
            }
            u32x2 vc = (u32x2){0u, 0u}, vp = vc;
            if (l == 1) {
                const int m = m0 + (tid >> 3), j4 = (tid & 7) * 4; const bf16_t* prv = prev_row(PROJ, m);
                vc = *(const u32x2*)(PROJ + (size_t)m * LDP + INC + j4); if (prv) vp = *(const u32x2*)(prv + INC + 32 + j4);
            }
            const int ch = tid & 31;
            const f32x4 m0v = *(const f32x4*)(mu + 1536 + ch * 8), m1v = *(const f32x4*)(mu + 1536 + ch * 8 + 4);
#pragma unroll
            for (int q = 0; q < 4; ++q) {
                const int row = (tid >> 5) + 16 * q;
                float cf[8], pf[8], z[8]; unpack8(cu[q], cf); unpack8(pv[q], pf);
#pragma unroll
                for (int j = 0; j < 4; ++j) { z[j] = cf[j] + (pf[j] - cf[j]) * m0v[j]; z[4 + j] = cf[4 + j] + (pf[4 + j] - cf[4 + j]) * m1v[j]; }
                if (ch < 8) {
#pragma unroll
                    for (int j = 0; j < 8; ++j) z[j] = 2.f * fsig(2.f * z[j]) - 1.f;
                } else if (ch >= 16) {
#pragma unroll
                    for (int j = 0; j < 8; ++j) z[j] = fsig(z[j]);
                }
                u32x4 w; w.x = pk2(z[0], z[1]); w.y = pk2(z[2], z[3]); w.z = pk2(z[4], z[5]); w.w = pk2(z[6], z[7]);
                *(LAS u32x4*)(LA + row * 264 + ch * 8) = w;
            }
            if (l == 1) {
                u32x2 w; w.x = pk2(bflo(vc.x) + bflo(vp.x), bfhi(vc.x) + bfhi(vp.x)); w.y = pk2(bflo(vc.y) + bflo(vp.y), bfhi(vc.y) + bfhi(vp.y));
                *(LAS u32x2*)(LW + (tid >> 3) * 40 + (tid & 7) * 4) = w;
            }
        }
        __syncthreads();
        const int m = m0 + mt * 16 + fr;
        const bf16_t* cur = PROJ + (size_t)m * LDP; const bf16_t* prv = prev_row(PROJ, m);
        u32x2 cR[4], cK[4], cV[4], pR[4], pK[4], pV[4]; f32x4 vf[4];
#pragma unroll
        for (int nt = 0; nt < 4; ++nt) {
            const int ch = h * 64 + nt * 16 + fq * 4;
            cR[nt] = *(const u32x2*)(cur + ch); cK[nt] = *(const u32x2*)(cur + 512 + ch); cV[nt] = *(const u32x2*)(cur + 1024 + ch);
            pR[nt] = (u32x2){0u, 0u}; pK[nt] = pR[nt]; pV[nt] = pR[nt];
            if (prv) { pR[nt] = *(const u32x2*)(prv + ch); pK[nt] = *(const u32x2*)(prv + 512 + ch); pV[nt] = *(const u32x2*)(prv + 1024 + ch); }
            vf[nt] = (f32x4){0.f, 0.f, 0.f, 0.f};
            if (l == 1) vf[nt] = ld_bf4((const bf16_t*)SV0 + (size_t)m * 512 + ch);
        }
        float ssq = 0.f;
#pragma unroll
        for (int nt = 0; nt < 4; ++nt) {
            const int cl = hh * 64 + nt * 16 + fq * 4; float kz[4]; mixw(cK[nt], pK[nt], PAR + 896 + cl, kz);
            const f32x4 kk4 = *(const LAS f32x4*)(PAR + 256 + cl);
#pragma unroll
            for (int j = 0; j < 4; ++j) { const float kk = kz[j] * kk4[j]; ssq += kk * kk; }
        }
        ssq += __shfl_xor(ssq, 16); ssq += __shfl_xor(ssq, 32);
        const float inv = 1.f / fmaxf(sqrtf(ssq), 1e-12f);
        float br = 0.f, kr = 0.f, rkr = 0.f;
#pragma unroll
        for (int nt = 0; nt < 4; ++nt) {
            const int cl = hh * 64 + nt * 16 + fq * 4, ch = h * 64 + nt * 16 + fq * 4, nl = hh * 64 + nt * 16 + fr;
            f32x4 dl = (f32x4){0.f, 0.f, 0.f, 0.f}, al = dl, gl = dl, vm = dl;
            bf16x8 af[8];
#pragma unroll
            for (int ks = 0; ks < 8; ++ks) af[ks] = *(const LAS bf16x8*)(LA + (mt * 16 + fr) * 264 + ks * 32 + fq * 8);
            const bf16x8 avv = *(const LAS bf16x8*)(LW + (mt * 16 + fr) * 40 + fq * 8);
#pragma unroll
            for (int ks = 0; ks < 2; ++ks) {
                dl = __builtin_amdgcn_mfma_f32_16x16x32_bf16(*(const LAS bf16x8*)(WL2 + nl * 72 + ks * 32 + fq * 8), af[ks], dl, 0, 0, 0);
                al = __builtin_amdgcn_mfma_f32_16x16x32_bf16(*(const LAS bf16x8*)(WLA + nl * 72 + ks * 32 + fq * 8), af[2 + ks], al, 0, 0, 0);
            }
#pragma unroll
            for (int ks = 0; ks < 4; ++ks) gl = __builtin_amdgcn_mfma_f32_16x16x32_bf16(*(const LAS bf16x8*)(WLG + nl * 136 + ks * 32 + fq * 8), af[4 + ks], gl, 0, 0, 0);
            if (l == 1) vm = __builtin_amdgcn_mfma_f32_16x16x32_bf16(*(const LAS bf16x8*)(WLV + nl * 40 + fq * 8), avv, vm, 0, 0, 0);
            float rz[4], kz[4], vz[4];
            mixw(cR[nt], pR[nt], PAR + 768 + cl, rz); mixw(cK[nt], pK[nt], PAR + 896 + cl, kz); mixw(cV[nt], pV[nt], PAR + 1024 + cl, vz);
            const f32x4 w0 = *(const LAS f32x4*)(PAR + cl), a0 = *(const LAS f32x4*)(PAR + 128 + cl), kk4 = *(const LAS f32x4*)(PAR + 256 + cl);
            const f32x4 ka4 = *(const LAS f32x4*)(PAR + 384 + cl), rk4 = *(const LAS f32x4*)(PAR + 512 + cl), v04 = *(const LAS f32x4*)(PAR + 640 + cl);
            f32x4 oa, ob, od, ok, ord_, ov;
#pragma unroll
            for (int j = 0; j < 4; ++j) {
                const float dcy = __expf(-0.60653065971f * fsig(w0[j] + dl[j]));
                const float av_ = fsig(a0[j] + al[j]);
                float vj = vz[j];
                if (l == 1) { const float vmix = fsig(v04[j] + vm[j]); vj = vj + (vf[nt][j] - vj) * vmix; }
                const float kk = kz[j] * kk4[j] * inv, k2 = kz[j] * (1.f + (av_ - 1.f) * ka4[j]);
                oa[j] = -kk; ob[j] = kk * av_; od[j] = dcy; ok[j] = k2; ord_[j] = rz[j] * dcy; ov[j] = vj;
                br += ob[j] * rz[j]; kr += k2 * rz[j]; rkr += rz[j] * k2 * rk4[j];
            }
            const size_t o = (size_t)m * 512 + ch;
            st_bf4((bf16_t*)SA + o, oa); st_bf4((bf16_t*)SB + o, ob); *(f32x4*)(SD + o) = od; st_bf4((bf16_t*)SK + o, ok); st_bf4((bf16_t*)SRD + o, ord_); st_bf4((bf16_t*)SV + o, ov); { u32x2 gw2; gw2.x = cvt_pk_bf16(gl[0], gl[1]); gw2.y = cvt_pk_bf16(gl[2], gl[3]); *(u32x2*)((bf16_t*)GG + o) = gw2; }
            __builtin_amdgcn_sched_barrier(0);
        }
        br += __shfl_xor(br, 16); br += __shfl_xor(br, 32); kr += __shfl_xor(kr, 16); kr += __shfl_xor(kr, 32); rkr += __shfl_xor(rkr, 16); rkr += __shfl_xor(rkr, 32);
        if (fq == 0) { SBR[m * 8 + h] = br; SKR[m * 8 + h] = kr; RKR[m * 8 + h] = rkr; }
        __syncthreads();
    }
}

__device__ __forceinline__ void convB_token(const Args& a, int l, int m, int lane) {
    unsigned char* ws = a.ws;
    const bf16_t* __restrict__ PROJ = (const bf16_t*)(ws + OFF_PROJ);
    bf16_t* __restrict__ YAB = (bf16_t*)(ws + OFF_YAB);
    const int cb = lane * 8;
        const bf16_t* pr = PROJ + (size_t)m * LDP;
        float gb[8], gc[8], hi[8], u0[8], u1[8], u2[8];
        unpack8(*(const u32x4*)(pr + 1792 + cb), gb); unpack8(*(const u32x4*)(pr + 2304 + cb), gc); unpack8(*(const u32x4*)(pr + 2816 + cb), hi);
#pragma unroll
        for (int j = 0; j < 8; ++j) { u0[j] = gc[j] * hi[j]; u1[j] = 0.f; u2[j] = 0.f; }
        if (m < MP) {
            const int t = m & 2047;
            if (t >= 1) { unpack8(*(const u32x4*)(pr - LDP + 2304 + cb), gc); unpack8(*(const u32x4*)(pr - LDP + 2816 + cb), hi);
#pragma unroll
                for (int j = 0; j < 8; ++j) u1[j] = gc[j] * hi[j]; }
            if (t >= 2) { unpack8(*(const u32x4*)(pr - 2 * LDP + 2304 + cb), gc); unpack8(*(const u32x4*)(pr - 2 * LDP + 2816 + cb), hi);
#pragma unroll
                for (int j = 0; j < 8; ++j) u2[j] = gc[j] * hi[j]; }
            if (t >= 2046) { float* dst = a.out + O_CONVP + (size_t)((l * NB + (m >> 11)) * 2 + (t - 2046)) * 512 + cb;
                *(f32x4*)dst = (f32x4){u0[0], u0[1], u0[2], u0[3]}; *(f32x4*)(dst + 4) = (f32x4){u0[4], u0[5], u0[6], u0[7]}; }
        } else {
            const int i = m - MP; const float* sc = a.in[I_SCONV] + (size_t)(l * NS + i) * 2 * 512 + cb;
            const f32x4 a0 = *(const f32x4*)sc, a1 = *(const f32x4*)(sc + 4), b0 = *(const f32x4*)(sc + 512), b1 = *(const f32x4*)(sc + 516);
#pragma unroll
            for (int j = 0; j < 4; ++j) { u2[j] = a0[j]; u2[4 + j] = a1[j]; u1[j] = b0[j]; u1[4 + j] = b1[j]; }
            float* dst = a.out + O_CONVS + (size_t)(l * NS + i) * 2 * 512 + cb;
            *(f32x4*)dst = b0; *(f32x4*)(dst + 4) = b1;
            *(f32x4*)(dst + 512) = (f32x4){u0[0], u0[1], u0[2], u0[3]}; *(f32x4*)(dst + 516) = (f32x4){u0[4], u0[5], u0[6], u0[7]};
        }
        const float* cw = a.in[I_CONVW] + (size_t)l * 3 * 512 + cb;
        float ob[8];
#pragma unroll
        for (int j = 0; j < 8; ++j) ob[j] = gb[j] * (cw[j] * u2[j] + cw[512 + j] * u1[j] + cw[1024 + j] * u0[j]);
        u32x4 w2; w2.x = pk2(ob[0], ob[1]); w2.y = pk2(ob[2], ob[3]); w2.z = pk2(ob[4], ob[5]); w2.w = pk2(ob[6], ob[7]);
        *(u32x4*)(YAB + (size_t)m * 1024 + 512 + cb) = w2;
}

typedef float f32x2 __attribute__((ext_vector_type(2)));
__device__ __forceinline__ float scan_step(float (&s)[4], const f32x4 av, const f32x4 bv, const f32x4 dv, const f32x4 kv, const f32x4 rd, float vi, float br, float kr) {
    f32x2 s01 = (f32x2){s[0], s[1]}, s23 = (f32x2){s[2], s[3]};
    f32x2 t = s01 * (f32x2){av[0], av[1]}; t = __builtin_elementwise_fma(s23, (f32x2){av[2], av[3]}, t);
    f32x2 u = s01 * (f32x2){rd[0], rd[1]}; u = __builtin_elementwise_fma(s23, (f32x2){rd[2], rd[3]}, u);
    float pa = t.x + t.y, py = u.x + u.y;
    pa = red16(pa); py = red16(py);
    const f32x2 pav = (f32x2){pa, pa}, viv = (f32x2){vi, vi};
    f32x2 w01 = (f32x2){kv[0], kv[1]} * viv; w01 = __builtin_elementwise_fma((f32x2){bv[0], bv[1]}, pav, w01);
    f32x2 w23 = (f32x2){kv[2], kv[3]} * viv; w23 = __builtin_elementwise_fma((f32x2){bv[2], bv[3]}, pav, w23);
    s01 = __builtin_elementwise_fma(s01, (f32x2){dv[0], dv[1]}, w01);
    s23 = __builtin_elementwise_fma(s23, (f32x2){dv[2], dv[3]}, w23);
    s[0] = s01.x; s[1] = s01.y; s[2] = s23.x; s[3] = s23.y;
    return py + pa * br + vi * kr;
}

__device__ __forceinline__ void scan_phase(LAS unsigned char* lds, const Args& a, int l, int tid, int lane, int wave) {
    unsigned char* ws = a.ws;
    const float* SA = (const float*)(ws + OFF_SA); const float* SB = (const float*)(ws + OFF_SB); const float* SD = (const float*)(ws + OFF_SD); const float* SK = (const float*)(ws + OFF_SK);
    const float* SRD = (const float*)(ws + OFF_SRD); const float* SV = (const float*)(ws + (l == 0 ? OFF_SV0 : OFF_SV1));
    const float* SBR = (const float*)(ws + OFF_SBR); const float* SKR = (const float*)(ws + OFF_SKR);
    float* Y = (float*)(ws + OFF_Y);
    constexpr int TC = 32, CB = 5 * TC * 64 + TC * 16 + 2 * TC;
    LAS float* L = (LAS float*)lds;
    const int j4 = lane >> 4, c = lane & 15;
    for (int ci = blockIdx.x; ci < 256; ci += gridDim.x) {
        const int hc = ci >> 2, rg = ci & 3, b = hc >> 3, h = hc & 7;
        const int st = tid >> 4, c16 = tid & 15;
        const int rl = (wave & 3) * 4 + j4;
        float s[4] = {0.f, 0.f, 0.f, 0.f};
        u32x2 pa, pb, pk, pr; f32x4 pd; bf16_t pv; float ps = 0.f;
        {
            const size_t m = (size_t)b * 2048 + st; const size_t o = m * 512 + h * 64 + c16 * 4;
            pa = *(const u32x2*)((const bf16_t*)SA + o); pb = *(const u32x2*)((const bf16_t*)SB + o); pd = *(const f32x4*)(SD + o); pk = *(const u32x2*)((const bf16_t*)SK + o); pr = *(const u32x2*)((const bf16_t*)SRD + o);
            pv = ((const bf16_t*)SV)[m * 512 + h * 64 + rg * 16 + c16];
            if (tid < 32) ps = SBR[((size_t)b * 2048 + tid) * 8 + h]; else if (tid < 64) ps = SKR[((size_t)b * 2048 + tid - 32) * 8 + h];
        }
        {
            LAS float* B0 = L;
            *(LAS f32x4*)(B0 + st * 64 + c16 * 4) = (f32x4){bflo(pa.x), bfhi(pa.x), bflo(pa.y), bfhi(pa.y)}; *(LAS f32x4*)(B0 + 2048 + st * 64 + c16 * 4) = (f32x4){bflo(pb.x), bfhi(pb.x), bflo(pb.y), bfhi(pb.y)}; *(LAS f32x4*)(B0 + 4096 + st * 64 + c16 * 4) = pd;
            *(LAS f32x4*)(B0 + 6144 + st * 64 + c16 * 4) = (f32x4){bflo(pk.x), bfhi(pk.x), bflo(pk.y), bfhi(pk.y)}; *(LAS f32x4*)(B0 + 8192 + st * 64 + c16 * 4) = (f32x4){bflo(pr.x), bfhi(pr.x), bflo(pr.y), bfhi(pr.y)}; B0[10240 + st * 16 + c16] = bf2f(pv);
            if (tid < 64) B0[10752 + tid] = ps;
        }
        __syncthreads();
        for (int n = 0; n < TT / TC; ++n) {
            LAS float* Bc = L + (n & 1) * CB; LAS float* Bn = L + ((n + 1) & 1) * CB; LAS float* yb = L + 2 * CB + (n & 1) * 512;
            const bool more = n + 1 < TT / TC;
            if (more) {
                const size_t m = (size_t)b * 2048 + (n + 1) * TC + st; const size_t o = m * 512 + h * 64 + c16 * 4;
                pa = *(const u32x2*)((const bf16_t*)SA + o); pb = *(const u32x2*)((const bf16_t*)SB + o); pd = *(const f32x4*)(SD + o); pk = *(const u32x2*)((const bf16_t*)SK + o); pr = *(const u32x2*)((const bf16_t*)SRD + o);
                pv = ((const bf16_t*)SV)[m * 512 + h * 64 + rg * 16 + c16];
                if (tid < 32) ps = SBR[((size_t)b * 2048 + (n + 1) * TC + tid) * 8 + h]; else if (tid < 64) ps = SKR[((size_t)b * 2048 + (n + 1) * TC + tid - 32) * 8 + h];
            }
            if (wave < 4) {
                LAS float* ybase = (c == 0) ? (yb + rl) : (L + 2 * CB + 1024 + lane);
                const LAS float* p0 = Bc + c * 4;
                f32x4 av = *(const LAS f32x4*)p0, bv = *(const LAS f32x4*)(p0 + 2048), dv = *(const LAS f32x4*)(p0 + 4096), kv = *(const LAS f32x4*)(p0 + 6144), rd = *(const LAS f32x4*)(p0 + 8192);
                float vi = Bc[10240 + rl], br = Bc[10752], kr = Bc[10784];
#pragma unroll 8
                for (int t = 0; t < TC; ++t) {
                    const int tn = (t + 1 < TC) ? t + 1 : t;
                    const LAS float* p = Bc + tn * 64 + c * 4;
                    const f32x4 av2 = *(const LAS f32x4*)p, bv2 = *(const LAS f32x4*)(p + 2048), dv2 = *(const LAS f32x4*)(p + 4096), kv2 = *(const LAS f32x4*)(p + 6144), rd2 = *(const LAS f32x4*)(p + 8192);
                    const float vi2 = Bc[10240 + tn * 16 + rl], br2 = Bc[10752 + tn], kr2 = Bc[10784 + tn];
                    const float y = scan_step(s, av, bv, dv, kv, rd, vi, br, kr);
                    ybase[t * 16] = y;
                    av = av2; bv = bv2; dv = dv2; kv = kv2; rd = rd2; vi = vi2; br = br2; kr = kr2;
                }
            }
            else {
                const int hw4 = wave - 4;
                if (l == 0 && n < 14) {
                    const int d = (blockIdx.x * 4 + hw4) + 1024 * n;
                    if (d < TR_DEFERRED) tr_deferred(a, ws, d, (LAS float*)(lds + 94208 + hw4 * 8448), lane);
                } else if (n >= 24 && n < 41) {
                    const int tt = (n - 24) * 4 + hw4;
                    int mB = -1;
                    if (tt < 64) mB = blockIdx.x * 64 + tt; else if (tt == 64 && blockIdx.x < NS) mB = MP + blockIdx.x;
                    if (mB >= 0) convB_token(a, l, mB, lane);
                } else if (n >= 20 && n < 24) {
                    const int q = blockIdx.x + gridDim.x * (n - 20);
                    if (q < NS * 8) {
                        const int i = q >> 3, hs = q & 7; const size_t ms = MP + i;
                        const size_t o = ms * 512 + hs * 64 + c * 4;
                        const f32x4 av = ld_bf4((const bf16_t*)SA + o), bv = ld_bf4((const bf16_t*)SB + o), dv = *(const f32x4*)(SD + o), kv = ld_bf4((const bf16_t*)SK + o), rd = ld_bf4((const bf16_t*)SRD + o);
                        const float br = SBR[ms * 8 + hs], kr = SKR[ms * 8 + hs];
#pragma unroll 1
                        for (int p4 = 0; p4 < 4; ++p4) {
                            const int row = p4 * 16 + hw4 * 4 + j4;
                            const size_t so = ((size_t)((l * NS + i) * 8 + hs)) * 4096 + row * 64 + c * 4;
                            const f32x4 s4 = *(const f32x4*)(a.in[I_SWKV] + so);
                            const float vi = bf2f(((const bf16_t*)SV)[ms * 512 + hs * 64 + row]);
                            float ss_[4] = {s4[0], s4[1], s4[2], s4[3]};
                            const float y = scan_step(ss_, av, bv, dv, kv, rd, vi, br, kr);
                            *(f32x4*)(a.out + O_WKVS + so) = (f32x4){ss_[0], ss_[1], ss_[2], ss_[3]};
                            if (c == 0) ((bf16_t*)Y)[ms * 512 + hs * 64 + row] = (bf16_t)f2bf(y);
                        }
                    }
                }
            }
            if (more) {
                *(LAS f32x4*)(Bn + st * 64 + c16 * 4) = (f32x4){bflo(pa.x), bfhi(pa.x), bflo(pa.y), bfhi(pa.y)}; *(LAS f32x4*)(Bn + 2048 + st * 64 + c16 * 4) = (f32x4){bflo(pb.x), bfhi(pb.x), bflo(pb.y), bfhi(pb.y)}; *(LAS f32x4*)(Bn + 4096 + st * 64 + c16 * 4) = pd;
                *(LAS f32x4*)(Bn + 6144 + st * 64 + c16 * 4) = (f32x4){bflo(pk.x), bfhi(pk.x), bflo(pk.y), bfhi(pk.y)}; *(LAS f32x4*)(Bn + 8192 + st * 64 + c16 * 4) = (f32x4){bflo(pr.x), bfhi(pr.x), bflo(pr.y), bfhi(pr.y)}; Bn[10240 + st * 16 + c16] = bf2f(pv);
                if (tid < 64) Bn[10752 + tid] = ps;
            }
            __syncthreads();
            ((bf16_t*)Y)[((size_t)b * 2048 + n * TC + st) * 512 + h * 64 + rg * 16 + c16] = (bf16_t)f2bf(yb[st * 16 + c16]);
        }
        if (wave < 4) {
            float* o = a.out + O_WKVP + ((size_t)((l * 8 + b) * 8 + h)) * 4096 + (rg * 16 + rl) * 64 + c * 4;
            *(f32x4*)o = (f32x4){s[0], s[1], s[2], s[3]};
        }
        __syncthreads();
    }
}

__device__ __forceinline__ void post_phase(const Args& a, int l, int lane, int gw, int NGW) {
    unsigned char* ws = a.ws;
    const bf16_t* __restrict__ PROJ = (const bf16_t*)(ws + OFF_PROJ);
    const float* __restrict__ Y = (const float*)(ws + OFF_Y); const float* __restrict__ SV = (const float*)(ws + (l == 0 ? OFF_SV0 : OFF_SV1)); const float* __restrict__ GG = (const float*)(ws + OFF_G);
    const float* __restrict__ RKR = (const float*)(ws + OFF_RKR);
    bf16_t* __restrict__ YAB = (bf16_t*)(ws + OFF_YAB);
    const int cb = lane * 8, h = lane >> 3;
#pragma unroll 4
    for (int m = gw; m < MTOK; m += NGW) {
        const size_t o = (size_t)m * 512 + cb;
        f32x4 y0, y1; { const u32x4 yq = *(const u32x4*)((const bf16_t*)Y + o); y0 = (f32x4){bflo(yq.x), bfhi(yq.x), bflo(yq.y), bfhi(yq.y)}; y1 = (f32x4){bflo(yq.z), bfhi(yq.z), bflo(yq.w), bfhi(yq.w)}; }
        float s = (y0[0] + y0[1]) + (y0[2] + y0[3]) + (y1[0] + y1[1]) + (y1[2] + y1[3]);
        s += __shfl_xor(s, 1); s += __shfl_xor(s, 2); s += __shfl_xor(s, 4);
        const float mean = s * (1.f / 64.f);
        const f32x4 d0 = y0 - mean, d1 = y1 - mean;
        float q = (d0[0] * d0[0] + d0[1] * d0[1]) + (d0[2] * d0[2] + d0[3] * d0[3]) + (d1[0] * d1[0] + d1[1] * d1[1]) + (d1[2] * d1[2] + d1[3] * d1[3]);
        q += __shfl_xor(q, 1); q += __shfl_xor(q, 2); q += __shfl_xor(q, 4);
        const float rstd = rsqrtf(q * (1.f / 64.f) + GN_EPS);
        const float rkr = RKR[m * 8 + h];
        f32x4 v0, v1; { const u32x4 vq = *(const u32x4*)((const bf16_t*)SV + o); v0 = (f32x4){bflo(vq.x), bfhi(vq.x), bflo(vq.y), bfhi(vq.y)}; v1 = (f32x4){bflo(vq.z), bfhi(vq.z), bflo(vq.w), bfhi(vq.w)}; } f32x4 g0, g1; { const u32x4 gq = *(const u32x4*)((const bf16_t*)GG + o); g0 = (f32x4){bflo(gq.x), bfhi(gq.x), bflo(gq.y), bfhi(gq.y)}; g1 = (f32x4){bflo(gq.z), bfhi(gq.z), bflo(gq.w), bfhi(gq.w)}; }
        const f32x4 lw0 = *(const f32x4*)(a.in[I_LNW] + l * 512 + cb), lw1 = *(const f32x4*)(a.in[I_LNW] + l * 512 + cb + 4);
        const f32x4 lb0 = *(const f32x4*)(a.in[I_LNB] + l * 512 + cb), lb1 = *(const f32x4*)(a.in[I_LNB] + l * 512 + cb + 4);
        const f32x4 r0 = (d0 * rstd * lw0 + lb0 + v0 * rkr) * g0, r1 = (d1 * rstd * lw1 + lb1 + v1 * rkr) * g1;
        u32x4 w; w.x = pk2(r0[0], r0[1]); w.y = pk2(r0[2], r0[3]); w.z = pk2(r1[0], r1[1]); w.w = pk2(r1[2], r1[3]);
        *(u32x4*)(YAB + (size_t)m * 1024 + cb) = w;
    }
    if (l + 1 < 2 && gw < NS) {
        bf16_t* XB = (bf16_t*)(ws + OFF_XB) + (size_t)(MTOK + gw) * D;
        const float* src = a.in[I_SSHIFT] + (size_t)((l + 1) * NS + gw) * D; const float* gn = a.in[I_NMIX] + (l + 1) * D;
#pragma unroll
        for (int j = 0; j < 4; ++j) { const f32x4 v = *(const f32x4*)(src + 4 * lane + 256 * j), g4 = *(const f32x4*)(gn + 4 * lane + 256 * j);
            u32x2 w; w.x = pk2(v[0] / g4[0], v[1] / g4[1]); w.y = pk2(v[2] / g4[2], v[3] / g4[3]); *(u32x2*)(XB + 4 * lane + 256 * j) = w; }
    }
}

__device__ __forceinline__ void sample_attn(LAS unsigned char* lds, const Args& a, int l, int tid, int lane, int wave) {
    unsigned char* ws = a.ws;
    const bf16_t* Q = (const bf16_t*)(ws + OFF_Q); bf16_t* O = (bf16_t*)(ws + OFF_O);
    LAS float* sc = (LAS float*)lds;
    LAS float* part = sc + 256;
    for (int q = blockIdx.x; q < NS * 4; q += gridDim.x) {
        const int i = q >> 2, h = q & 3;
        const u32x2 qw = *(const u32x2*)(Q + (size_t)(MP + i) * 1024 + h * 256 + lane * 4);
        const float q0 = bflo(qw.x), q1 = bfhi(qw.x), q2 = bflo(qw.y), q3 = bfhi(qw.y);
        const float* Kb = a.in[I_CK] + ((size_t)((l * NS + i) * 256) * 4 + h) * 256 + lane * 4;
        const float* Vb = a.in[I_CV] + ((size_t)((l * NS + i) * 256) * 4 + h) * 256 + lane * 4;
        {
            f32x4 kx[8], kn[8];
#pragma unroll
            for (int e = 0; e < 8; ++e) kx[e] = __builtin_nontemporal_load((const f32x4*)(Kb + (size_t)(wave * 32 + e) * 1024));
#pragma unroll
            for (int g8 = 0; g8 < 4; ++g8) {
                if (g8 < 3) {
#pragma unroll
                    for (int e = 0; e < 8; ++e) kn[e] = __builtin_nontemporal_load((const f32x4*)(Kb + (size_t)(wave * 32 + (g8 + 1) * 8 + e) * 1024));
                }
#pragma unroll
                for (int e = 0; e < 8; ++e) { float p = kx[e][0] * q0 + kx[e][1] * q1 + kx[e][2] * q2 + kx[e][3] * q3; p = wave_sum(p); if (lane == 0) sc[wave * 32 + g8 * 8 + e] = p; }
#pragma unroll
                for (int e = 0; e < 8; ++e) kx[e] = kn[e];
            }
        }
        __syncthreads();
        if (wave == 0) {
            const f32x4 s4 = *(const LAS f32x4*)(sc + lane * 4);
            const float mx = wave_max(fmaxf(fmaxf(s4[0], s4[1]), fmaxf(s4[2], s4[3])));
            f32x4 e4; e4[0] = __expf(s4[0] - mx); e4[1] = __expf(s4[1] - mx); e4[2] = __expf(s4[2] - mx); e4[3] = __expf(s4[3] - mx);
            const float inv = 1.f / wave_sum((e4[0] + e4[1]) + (e4[2] + e4[3]));
            *(LAS f32x4*)(sc + lane * 4) = e4 * inv;
        }
        __syncthreads();
        f32x4 acc = (f32x4){0.f, 0.f, 0.f, 0.f};
        {
            f32x4 vx[8], vn[8];
#pragma unroll
            for (int e = 0; e < 8; ++e) vx[e] = __builtin_nontemporal_load((const f32x4*)(Vb + (size_t)(wave * 32 + e) * 1024));
#pragma unroll
            for (int g8 = 0; g8 < 4; ++g8) {
                if (g8 < 3) {
#pragma unroll
                    for (int e = 0; e < 8; ++e) vn[e] = __builtin_nontemporal_load((const f32x4*)(Vb + (size_t)(wave * 32 + (g8 + 1) * 8 + e) * 1024));
                }
#pragma unroll
                for (int e = 0; e < 8; ++e) acc += vx[e] * sc[wave * 32 + g8 * 8 + e];
#pragma unroll
                for (int e = 0; e < 8; ++e) vx[e] = vn[e];
            }
        }
        *(LAS f32x4*)(part + wave * 256 + lane * 4) = acc;
        __syncthreads();
        if (tid < 256) {
            float s = 0.f;
#pragma unroll
            for (int w = 0; w < 8; ++w) s += part[w * 256 + tid];
            O[(size_t)(MP + i) * 1024 + h * 256 + tid] = (bf16_t)f2bf(s);
        }
        __syncthreads();
    }
}

__device__ __forceinline__ void ffnconv_phase(const Args& a, int l, int tid) {
    unsigned char* ws = a.ws;
    const bf16_t* __restrict__ UP = (const bf16_t*)(ws + OFF_UP); bf16_t* __restrict__ H = (bf16_t*)(ws + OFF_H);
    const float* __restrict__ cw = a.in[I_FCW] + (size_t)l * 3 * FW2;
    constexpr int CH = FW / 8;
    for (int rb = blockIdx.x; rb < MP / 64; rb += gridDim.x) {
        if (tid < CH) {
            const int c = tid * 8, r0 = rb * 64, t0 = r0 & 2047;
            float wu[3][8], wg[3][8];
#pragma unroll
            for (int k = 0; k < 3; ++k) {
                const f32x4 a0 = *(const f32x4*)(cw + k * FW2 + c), a1 = *(const f32x4*)(cw + k * FW2 + c + 4), b0 = *(const f32x4*)(cw + k * FW2 + FW + c), b1 = *(const f32x4*)(cw + k * FW2 + FW + c + 4);
#pragma unroll
                for (int j = 0; j < 4; ++j) { wu[k][j] = a0[j]; wu[k][4 + j] = a1[j]; wg[k][j] = b0[j]; wg[k][4 + j] = b1[j]; }
            }
            float u2[8], u1[8], g2[8], g1[8];
#pragma unroll
            for (int j = 0; j < 8; ++j) { u2[j] = 0.f; u1[j] = 0.f; g2[j] = 0.f; g1[j] = 0.f; }
            if (t0 >= 2) {
                const bf16_t* p = UP + (size_t)(r0 - 2) * FW2 + c;
                unpack8(*(const u32x4*)p, u2); unpack8(*(const u32x4*)(p + FW), g2); unpack8(*(const u32x4*)(p + FW2), u1); unpack8(*(const u32x4*)(p + FW2 + FW), g1);
            }
            const bf16_t* p = UP + (size_t)r0 * FW2 + c; bf16_t* hp = H + (size_t)r0 * FW + c;
#pragma unroll 1
            for (int r = 0; r < 64; r += 4) {
                u32x4 lu[4], lg[4];
#pragma unroll
                for (int e = 0; e < 4; ++e) { lu[e] = *(const u32x4*)(p + (size_t)(r + e) * FW2); lg[e] = *(const u32x4*)(p + (size_t)(r + e) * FW2 + FW); }
#pragma unroll
                for (int e = 0; e < 4; ++e) {
                    float u0[8], g0[8], hh[8]; unpack8(lu[e], u0); unpack8(lg[e], g0);
#pragma unroll
                    for (int j = 0; j < 8; ++j) {
                        const float uu = wu[0][j] * u2[j] + wu[1][j] * u1[j] + wu[2][j] * u0[j], gg = wg[0][j] * g2[j] + wg[1][j] * g1[j] + wg[2][j] * g0[j];
                        hh[j] = gg * __builtin_amdgcn_rcpf(1.f + __expf(-gg)) * uu;
                        u2[j] = u1[j]; u1[j] = u0[j]; g2[j] = g1[j]; g1[j] = g0[j];
                    }
                    u32x4 w; w.x = cvt_pk_bf16(hh[0], hh[1]); w.y = cvt_pk_bf16(hh[2], hh[3]); w.z = cvt_pk_bf16(hh[4], hh[5]); w.w = cvt_pk_bf16(hh[6], hh[7]);
                    *(u32x4*)(hp + (size_t)(r + e) * FW) = w;
                }
            }
        }
    }
    for (int it = blockIdx.x * 512 + tid; it < NS * CH; it += gridDim.x * 512) {
        const int i = it / CH, c = (it % CH) * 8, m = MP + i;
        const bf16_t* r0 = UP + (size_t)m * FW2;
        float u[8], g[8], t0[8], t1[8];
        unpack8(*(const u32x4*)(r0 + c), t0); unpack8(*(const u32x4*)(r0 + FW + c), t1);
        const float* sf = a.in[I_SFFN] + (size_t)(l * NS + i) * 2 * FW2;
        float* dst = a.out + O_FFNS + (size_t)(l * NS + i) * 2 * FW2;
        float hh[8];
#pragma unroll
        for (int q = 0; q < 2; ++q) {
            const int cc = c + 4 * q;
            const f32x4 p0u = *(const f32x4*)(sf + cc), p0g = *(const f32x4*)(sf + FW + cc), p1u = *(const f32x4*)(sf + FW2 + cc), p1g = *(const f32x4*)(sf + FW2 + FW + cc);
            const f32x4 w0u = *(const f32x4*)(cw + cc), w1u = *(const f32x4*)(cw + FW2 + cc), w2u = *(const f32x4*)(cw + 2 * FW2 + cc);
            const f32x4 w0g = *(const f32x4*)(cw + FW + cc), w1g = *(const f32x4*)(cw + FW2 + FW + cc), w2g = *(const f32x4*)(cw + 2 * FW2 + FW + cc);
            *(f32x4*)(dst + cc) = p1u; *(f32x4*)(dst + FW + cc) = p1g;
#pragma unroll
            for (int j = 0; j < 4; ++j) {
                u[4 * q + j] = w2u[j] * t0[4 * q + j] + w0u[j] * p0u[j] + w1u[j] * p1u[j]; g[4 * q + j] = w2g[j] * t1[4 * q + j] + w0g[j] * p0g[j] + w1g[j] * p1g[j];
                hh[4 * q + j] = g[4 * q + j] * sigmoidf_(g[4 * q + j]) * u[4 * q + j];
            }
        }
        u32x4 w; w.x = pk2(hh[0], hh[1]); w.y = pk2(hh[2], hh[3]); w.z = pk2(hh[4], hh[5]); w.w = pk2(hh[6], hh[7]);
        *(u32x4*)(H + (size_t)m * FW + c) = w;
    }
}

__device__ __forceinline__ void final_phase(const Args& a, int lane, int gw, int NGW) {
    unsigned char* ws = a.ws;
    const bf16_t* __restrict__ X = (const bf16_t*)(ws + OFF_XB); const float* __restrict__ SS = (const float*)(ws + OFF_SS) + (size_t)6 * MROWS;
    float* __restrict__ outp = a.out;
#pragma unroll 4
    for (int m = gw; m < MTOK; m += NGW) {
        const float rs = rsqrtf(SS[m] * (1.f / 1024.f) + EPS);
        float* __restrict__ dst = m < MP ? outp + O_YP + (size_t)m * D : outp + O_YS + (size_t)(m - MP) * D;
#pragma unroll
        for (int j = 0; j < 4; ++j) { const u32x2 xw = *(const u32x2*)(X + (size_t)m * D + 4 * lane + 256 * j); const f32x4 v = (f32x4){bflo(xw.x), bfhi(xw.x), bflo(xw.y), bfhi(xw.y)}, gn = *(const f32x4*)(a.in[I_NFIN] + 4 * lane + 256 * j);
            *(f32x4*)(dst + 4 * lane + 256 * j) = v * rs * gn; }
    }
}

__device__ __forceinline__ void skinny_gemm(LAS unsigned char* lds, const bf16_t* __restrict__ A, int lda, const bf16_t* __restrict__ Wt, int K, int mode, float* X, bf16_t* O, float* ssn, const float* ss, int lane, int wave) {
    LAS f32x4* part = (LAS f32x4*)lds;
    for (int item = blockIdx.x; item < 256; item += gridDim.x) {
        const int n0 = (item & 63) * 16, r0 = MP + (item >> 6) * 32, fr = lane & 15, fq = lane >> 4;
        const bf16_t* ap = A + (size_t)(r0 + fr) * lda + fq * 8;
        const bf16_t* bp = Wt + (size_t)(n0 + fr) * K + fq * 8;
        f32x4 acc0 = (f32x4){0.f, 0.f, 0.f, 0.f}, acc1 = acc0;
#pragma unroll 4
        for (int ks = wave; ks < K / 32; ks += 8) {
            const bf16x8 bf = *(const bf16x8*)(bp + ks * 32), a0 = *(const bf16x8*)(ap + ks * 32), a1 = *(const bf16x8*)(ap + (size_t)16 * lda + ks * 32);
            acc0 = __builtin_amdgcn_mfma_f32_16x16x32_bf16(bf, a0, acc0, 0, 0, 0);
            acc1 = __builtin_amdgcn_mfma_f32_16x16x32_bf16(bf, a1, acc1, 0, 0, 0);
        }
        part[(wave * 2 + 0) * 64 + lane] = acc0; part[(wave * 2 + 1) * 64 + lane] = acc1;
        __syncthreads();
        if (wave < 2) {
            f32x4 acc = part[wave * 64 + lane];
#pragma unroll
            for (int w = 1; w < 8; ++w) acc += part[(w * 2 + wave) * 64 + lane];
            const int row = r0 + wave * 16 + fr, col = n0 + fq * 4;
            const size_t idx = (size_t)row * 1024 + col;
            if (mode == 1) {
                const u32x2 xi = *(const u32x2*)(O + idx);
                const f32x4 x = (f32x4){bflo(xi.x), bfhi(xi.x), bflo(xi.y), bfhi(xi.y)} + acc;
                u32x2 w; w.x = cvt_pk_bf16(x[0], x[1]); w.y = cvt_pk_bf16(x[2], x[3]); *(u32x2*)(O + idx) = w;
                float sq = (x[0] * x[0] + x[1] * x[1]) + (x[2] * x[2] + x[3] * x[3]);
                sq += __shfl_xor(sq, 16); sq += __shfl_xor(sq, 32);
                if (fq == 0) atomicAdd(ssn + row, sq);
            } else {
                const float rs = rsqrtf(ss[row] * (1.f / 1024.f) + EPS);
                u32x2 w; w.x = cvt_pk_bf16(acc[0] * rs, acc[1] * rs); w.y = cvt_pk_bf16(acc[2] * rs, acc[3] * rs); *(u32x2*)(O + idx) = w;
            }
        }
        __syncthreads();
    }
}

#define XB_TMO      128
#define XB_XCNT(j)  (256  + 64 * (j))
#define XB_XSUB(j)  (1280 + 64 * (j))
#define XB_XGEN(j)  (2304 + 64 * (j))
#define XB_TOP      3328
#define XB_TOPGEN   3392
#define XCD_BAR_WORDS 3456
#define XB_SPIN_CAP (1u << 22)
__device__ __forceinline__ unsigned xb_ld(unsigned* p)              { return __hip_atomic_load(p, __ATOMIC_RELAXED, __HIP_MEMORY_SCOPE_AGENT); }
__device__ __forceinline__ unsigned xb_add(unsigned* p, unsigned v) { return __hip_atomic_fetch_add(p, v, __ATOMIC_RELAXED, __HIP_MEMORY_SCOPE_AGENT); }
__device__ __forceinline__ unsigned xb_xcc_id() { return (unsigned)__builtin_amdgcn_s_getreg((3 << 11) | 20) & 0xFu; }
#define XB_SPIN(cond, bar) do { unsigned _sp = 0; while (cond) { __builtin_amdgcn_s_sleep(1); \
    if ((++_sp & 255u) == 0u) { if (xb_ld(&(bar)[XB_TMO])) break; if (_sp > XB_SPIN_CAP) { atomicAdd(&(bar)[XB_TMO], 1u); break; } } } } while (0)
struct XcdBarrier { unsigned* bar; unsigned x; volatile LAS unsigned* st; };
__device__ __forceinline__ XcdBarrier xcd_barrier_post(unsigned* bar, volatile LAS unsigned* st) {
    XcdBarrier b; b.bar = bar; b.x = xb_xcc_id(); b.st = st;
    if (threadIdx.x == 0) (void)xb_add(&bar[XB_XCNT(b.x)], 1u);
    return b;
}
__device__ __forceinline__ void xcd_barrier_complete(unsigned* bar, unsigned x, unsigned& nloc, unsigned& nx) {
    const unsigned G = gridDim.x * gridDim.y * gridDim.z;
    unsigned sum, cnt, mine, sp = 0u;
    for (;;) {
        sum = 0u; cnt = 0u; mine = 0u;
#pragma unroll
        for (unsigned j = 0; j < 16; ++j) { const unsigned c = xb_ld(&bar[XB_XCNT(j)]); sum += c; cnt += (c > 0u) ? 1u : 0u; mine = (j == x) ? c : mine; }
        if (sum == G) break;
        __builtin_amdgcn_s_sleep(1);
        if ((++sp & 255u) == 0u) { if (xb_ld(&bar[XB_TMO])) break; if (sp > XB_SPIN_CAP) { atomicAdd(&bar[XB_TMO], 1u); break; } }
    }
    nloc = mine > 0u ? mine : 1u; nx = cnt > 0u ? cnt : 1u;
}
__device__ __forceinline__ void xcd_barrier(const XcdBarrier& b) {
    asm volatile("s_waitcnt vmcnt(0)" ::: "memory");
    __syncthreads();
    if (threadIdx.x == 0) {
        unsigned* bar = b.bar;
        __builtin_amdgcn_s_waitcnt(0);
        unsigned nloc = b.st[0], nx = b.st[1];
        if (nloc == 0u) { xcd_barrier_complete(bar, b.x, nloc, nx); b.st[0] = nloc; b.st[1] = nx; }
        const unsigned old = xb_add(&bar[XB_XSUB(b.x)], 1u);
        const unsigned gen = old / nloc;
        if (old + 1u == (gen + 1u) * nloc) {
            __builtin_amdgcn_fence(__ATOMIC_RELEASE, "agent");
            asm volatile("s_waitcnt vmcnt(0)" ::: "memory");
            const unsigned og = xb_add(&bar[XB_TOP], 1u);
            const unsigned tg = og / nx;
            if (og + 1u == (tg + 1u) * nx) xb_add(&bar[XB_TOPGEN], 1u);
            else XB_SPIN(xb_ld(&bar[XB_TOPGEN]) == tg, bar);
            __builtin_amdgcn_fence(__ATOMIC_ACQUIRE, "agent");
            xb_add(&bar[XB_XGEN(b.x)], 1u);
            asm volatile("s_waitcnt vmcnt(0)" ::: "memory");
        } else {
            XB_SPIN(xb_ld(&bar[XB_XGEN(b.x)]) == gen, bar);
            __builtin_amdgcn_fence(__ATOMIC_ACQUIRE, "agent");
            asm volatile("s_waitcnt vmcnt(0)" ::: "memory");
        }
    }
    __syncthreads();
}

__global__ void __launch_bounds__(512, 2) mega(Args a) {
    extern __shared__ __attribute__((aligned(16))) unsigned char lds_raw[];
    LAS unsigned char* lds = (LAS unsigned char*)lds_raw;
    cg::grid_group grid = cg::this_grid();
    volatile LAS unsigned* bst = (volatile LAS unsigned*)(lds + 131072 + 64);
    if (threadIdx.x == 0) { bst[0] = 0u; bst[1] = 0u; }
    __syncthreads();
    const XcdBarrier xbar = xcd_barrier_post((unsigned*)(a.ws + OFF_BAR), bst);
    for (int ph2 = 2 * a.ph_lo; ph2 < 2 * a.ph_hi; ++ph2) {
        const int ph = ph2 >> 1;
        if (ph2 & 1) { const int spx = (ph == 0) ? 12 : (ph == NPHASE - 1) ? 13 : (ph - 1) % 12; if (!((REP_MASK >> spx) & 1)) continue; }
        int tid = threadIdx.x; asm volatile("" : "+v"(tid));
        const int lane = tid & 63, wave = __builtin_amdgcn_readfirstlane(tid >> 6);
        const int G = gridDim.x, gw = blockIdx.x * 8 + wave, NGW = G * 8;
        unsigned char* ws = a.ws; asm volatile("" : "+s"(ws));
        float* SS = (float*)(ws + OFF_SS);
        bf16_t* XB = (bf16_t*)(ws + OFF_XB); float* X = (float*)(ws + OFF_X);
        if (ph == 0) {
            if (PHON(12)) p0_prologue(lds, a, tid, lane, wave, gw, NGW);
        } else if (ph == NPHASE - 1) {
            if (PHON(13)) final_phase(a, lane, gw, NGW);
        } else {
            const int l = (ph - 1) / 12, sp = (ph - 1) % 12;
            const bool is_gemm = (sp == 0 || sp == 4 || sp == 5 || sp == 7 || sp == 8 || sp == 9 || sp == 11);
            if (is_gemm && PHON(0)) {
                const int njobs = (l == 0 && (sp == 0 || sp == 9)) ? 3 : 1;
                for (int jb = 0; jb < njobs; ++jb) {
                    pg8::Gemm g; pg8::GenOrder S; pg8::Epi E;
                    E.mode = 0; E.O = nullptr; E.ldc = D; E.ss = nullptr; E.X = nullptr; E.ssn = nullptr; E.F = nullptr; E.l = l; E.dry = (ph2 & 1);
                    if (sp == 0 && jb == 0) {
                        g = pg8::Gemm{XB, (const bf16_t*)(ws + OFF_WIN) + (size_t)l * LDP * D, D, D, D};
                        S.init(0, MROWS, LDP, D, D, G, (int)blockIdx.x);
                        E.O = (bf16_t*)(ws + OFF_PROJ); E.ldc = LDP; E.ss = SS + (size_t)3 * l * MROWS;
                    } else if (jb > 0) {
                        const int kv = (sp == 0 ? 0 : 2) + jb - 1, ll = kv >> 1, isv = kv & 1;
                        g = pg8::Gemm{(const bf16_t*)(ws + OFF_MNB), (const bf16_t*)(ws + (isv ? OFF_WV : OFF_WK)) + (size_t)ll * D * D, D, D, D};
                        S.init(0, MMEM, D, D, D, G, (int)((blockIdx.x + G - 160 - 32 * (jb - 1)) % G));
                        E.mode = isv ? 3 : 2; E.O = (bf16_t*)(ws + (isv ? OFF_MVT : OFF_MK)) + (size_t)ll * MMEM * D; E.ss = (const float*)(ws + OFF_SSM);
                        E.F = a.out + (isv ? O_MVP : O_MKP) + (size_t)ll * MMEM * D; E.l = ll;
                    } else if (sp == 4 || sp == 8 || sp == 11) {
                        const bf16_t* A = (const bf16_t*)(ws + (sp == 4 ? OFF_YAB : sp == 8 ? OFF_O : OFF_H));
                        const bf16_t* B = sp == 4 ? (const bf16_t*)(ws + OFF_WOUT) + (size_t)l * D * D : sp == 8 ? (const bf16_t*)(ws + OFF_WO) + (size_t)l * D * D : (const bf16_t*)(ws + OFF_WDN) + (size_t)l * D * FW;
                        const int K = sp == 11 ? FW : D;
                        const int nrm = 3 * l + (sp == 4 ? 1 : sp == 8 ? 2 : 3);
                        g = pg8::Gemm{A, B, K, K, K};
                        S.init(0, MP, D, K, K, G, (int)blockIdx.x);
                        E.mode = 1; E.O = XB; E.X = X; E.ssn = SS + (size_t)nrm * MROWS;
                    } else if (sp == 5) {
                        g = pg8::Gemm{XB, (const bf16_t*)(ws + OFF_WQ) + (size_t)l * D * D, D, D, D};
                        S.init(0, MP, D, D, D, G, (int)blockIdx.x);
                        E.O = (bf16_t*)(ws + OFF_Q); E.ss = SS + (size_t)(3 * l + 1) * MROWS;
                    } else if (sp == 7) {
                        g = pg8::Gemm{(const bf16_t*)(ws + OFF_P), (const bf16_t*)(ws + OFF_MVT) + (size_t)l * MMEM * D, D, 256, 256};
                        S.init(2, MP, D, D, 256, G, (int)blockIdx.x);
                        E.O = (bf16_t*)(ws + OFF_O);
                    } else {
                        g = pg8::Gemm{XB, (const bf16_t*)(ws + OFF_WUP) + (size_t)l * FW2 * D, D, D, D};
                        S.init(0, MROWS, FW2, D, D, G, (int)blockIdx.x);
                        E.mode = 4; E.O = (bf16_t*)(ws + OFF_UP); E.ldc = FW2; E.ss = SS + (size_t)(3 * l + 2) * MROWS; E.F = a.out;
                    }
                    pg8::gemm_phase<pg8::Epi, pg8::GenOrder, true>(lds, g, S, E);
                    if (jb == 0 && !(ph2 & 1) && (sp == 4 || sp == 5 || sp == 8 || sp == 11))
                        skinny_gemm(lds, g.A, g.lda, g.Bt, g.K, E.mode, X, E.O, E.ssn, E.ss, lane, wave);
                }
            } else if (sp == 1 && PHON(1)) {
                prep_phase(lds, a, l, tid, lane, wave, gw);
            } else if (sp == 2 && PHON(2)) {
                scan_phase(lds, a, l, tid, lane, wave);
            } else if (sp == 3 && PHON(3)) {
                post_phase(a, l, lane, gw, NGW);
            } else if (sp == 6 && PHON(6)) {
                {
                    pg8::Gemm g{(const bf16_t*)(ws + OFF_Q), (const bf16_t*)(ws + OFF_MK) + (size_t)l * MMEM * D, D, D, 256};
                    pg8::GenOrder S; S.init(1, MP, D, D, D, G, (int)blockIdx.x);
                    pg8::EpiSm E{(bf16_t*)(ws + OFF_P)};
                    pg8::gemm_phase<pg8::EpiSm, pg8::GenOrder, false>(lds, g, S, E);
                }
                __syncthreads();
                sample_attn(lds, a, l, tid, lane, wave);
            } else if (sp == 10 && PHON(10)) {
                ffnconv_phase(a, l, tid);
            }
        }
        if (ph2 + 1 < 2 * a.ph_hi) { if (a.ph_lo < 0) grid.sync(); else xcd_barrier(xbar); }
        if (((REP_MASK >> 14) & 1) && ph2 == 0) { for (int q = 0; q < 40; ++q) xcd_barrier(xbar); }
    }
}

extern "C" void kernel_launch(void* const* d_in, const int* in_sizes, int n_in, void* d_out, int out_size, void* d_ws, size_t ws_size, hipStream_t stream) {
    static int grid = 0;
    if (grid == 0) {
        if (n_in != 38 || ws_size < WS_END) { fprintf(stderr, "kernel_launch: expected 38 inputs and >= %zu bytes of workspace (got %d, %zu)\n", (size_t)WS_END, n_in, ws_size); grid = -1; return; }
        int dev = 0, cus = 0, per_cu = 0;
        hipGetDevice(&dev);
        hipDeviceGetAttribute(&cus, hipDeviceAttributeMultiprocessorCount, dev);
        if (hipFuncSetAttribute((const void*)mega, hipFuncAttributeMaxDynamicSharedMemorySize, LDS_BYTES) != hipSuccess) { fprintf(stderr, "kernel_launch: hipFuncSetAttribute failed\n"); grid = -1; return; }
        hipOccupancyMaxActiveBlocksPerMultiprocessor(&per_cu, (const void*)mega, 512, LDS_BYTES);
        if (per_cu < 1) { fprintf(stderr, "kernel_launch: occupancy query says %d blocks per CU\n", per_cu); per_cu = 1; }
        (void)hipGetLastError();
        grid = cus;
        if (grid != 256) fprintf(stderr, "kernel_launch: built for 256 CUs, got %d\n", grid);
    }
    if (grid < 0) return;
    if (hipMemsetAsync((char*)d_ws + OFF_BAR, 0, BAR_BYTES, stream) != hipSuccess) { fprintf(stderr, "kernel_launch: hipMemsetAsync failed\n"); return; }
    Args a{};
    for (int i = 0; i < 38; ++i) a.in[i] = (const float*)d_in[i];
    a.out = (float*)d_out; a.ws = (unsigned char*)d_ws;
#if MK_PER_PHASE
    for (int ph = 0; ph < NPHASE; ++ph) {
        a.ph_lo = ph; a.ph_hi = ph + 1;
        void* args[] = {&a};
        hipError_t e = hipLaunchCooperativeKernel((const void*)mega, dim3(grid), dim3(512), args, LDS_BYTES, stream);
        if (e != hipSuccess) { fprintf(stderr, "cooperative launch failed: %s\n", hipGetErrorString(e)); break; }
    }
#else
    a.ph_lo = 0; a.ph_hi = NPHASE;
    void* args[] = {&a};
    hipError_t e = hipLaunchCooperativeKernel((const void*)mega, dim3(grid), dim3(512), args, LDS_BYTES, stream);
    if (e != hipSuccess) fprintf(stderr, "cooperative launch failed: %s (grid %d)\n", hipGetErrorString(e), grid);
#endif
    (void)in_sizes; (void)out_size;
}
```

```cpp
#include <hip/hip_runtime.h>
#include <hip/hip_cooperative_groups.h>
#include <cstdio>
#include <cstdint>
namespace cg = cooperative_groups;

#ifndef PH_MASK
#define PH_MASK 0xFFFFF
#endif
#define PHON(k) (((PH_MASK) >> (k)) & 1)
#ifndef REP_MASK
#define REP_MASK 0
#endif
#ifndef MK_PER_PHASE
#define MK_PER_PHASE 0
#endif

#define LAS __attribute__((address_space(3)))
typedef unsigned short bf16_t;
typedef short bf16x8 __attribute__((ext_vector_type(8)));
typedef float f32x4 __attribute__((ext_vector_type(4)));
typedef unsigned u32x4 __attribute__((ext_vector_type(4)));
typedef unsigned u32x2 __attribute__((ext_vector_type(2)));
#define LDS_WAIT() asm volatile("s_waitcnt lgkmcnt(0)" ::: "memory")

constexpr int D = 1024, NB = 8, TT = 2048, MP = NB * TT, NS = 128, MTOK = MP + NS, MROWS = 16640;
constexpr int INC = 3328, LDP = 3584, FW = 2816, FW2 = 5632, NMEM = 256, MMEM = NB * NMEM;
constexpr float EPS = 1e-6f, GN_EPS = 64e-5f;
constexpr int NPHASE = 26;
constexpr int LDS_BYTES = 147456;

constexpr size_t O_YP = 0, O_YS = 16777216, O_SHP = 16908288, O_WKVP = 16924672, O_CONVP = 17448960, O_FFNP = 17465344,
                 O_MKP = 17645568, O_MVP = 21839872, O_SHS = 26034176, O_WKVS = 26296320, O_CONVS = 34684928, O_FFNS = 34947072;

constexpr size_t al256(size_t x) { return (x + 255) & ~(size_t)255; }
constexpr size_t OFF_SS = 0;
constexpr size_t OFF_SSM = al256(OFF_SS + (size_t)7 * MROWS * 4);
constexpr size_t OFF_WIN = al256(OFF_SSM + 2048 * 4);
constexpr size_t OFF_WOUT = OFF_WIN + (size_t)2 * LDP * D * 2;
constexpr size_t OFF_WQ = OFF_WOUT + (size_t)2 * D * D * 2;
constexpr size_t OFF_WK = OFF_WQ + (size_t)2 * D * D * 2;
constexpr size_t OFF_WV = OFF_WK + (size_t)2 * D * D * 2;
constexpr size_t OFF_WO = OFF_WV + (size_t)2 * D * D * 2;
constexpr size_t OFF_WUP = OFF_WO + (size_t)2 * D * D * 2;
constexpr size_t OFF_WDN = OFF_WUP + (size_t)2 * FW2 * D * 2;
constexpr size_t OFF_W2 = OFF_WDN + (size_t)2 * D * FW * 2;
constexpr size_t OFF_A2 = OFF_W2 + (size_t)2 * 512 * 64 * 2;
constexpr size_t OFF_G2 = OFF_A2 + (size_t)2 * 512 * 64 * 2;
constexpr size_t OFF_V1 = OFF_G2 + (size_t)2 * 512 * 128 * 2;
constexpr size_t OFF_V2 = OFF_V1 + (size_t)32 * 512 * 2;
constexpr size_t OFF_X = al256(OFF_V2 + (size_t)512 * 32 * 2);
constexpr size_t OFF_XB = OFF_X + (size_t)MROWS * D * 4;
constexpr size_t OFF_MNB = OFF_XB + (size_t)MROWS * D * 2;
constexpr size_t OFF_MK = OFF_MNB + (size_t)MMEM * D * 2;
constexpr size_t OFF_MVT = OFF_MK + (size_t)2 * MMEM * D * 2;
constexpr size_t OFF_PROJ = OFF_MVT + (size_t)2 * MMEM * D * 2;
constexpr size_t OFF_H = OFF_PROJ;
constexpr size_t SCN = (size_t)MTOK * 512 * 4;
constexpr size_t OFF_SA = OFF_PROJ + (size_t)MROWS * LDP * 2;
constexpr size_t OFF_SB = OFF_SA + SCN, OFF_SD = OFF_SB + SCN, OFF_SK = OFF_SD + SCN, OFF_SRD = OFF_SK + SCN, OFF_G = OFF_SRD + SCN;
constexpr size_t OFF_UP = OFF_SA;
constexpr size_t OFF_SV0 = OFF_G + SCN, OFF_SV1 = OFF_SV0 + SCN;
constexpr size_t OFF_SBR = OFF_SV1 + SCN;
constexpr size_t OFF_SKR = OFF_SBR + (size_t)MTOK * 8 * 4, OFF_RKR = OFF_SKR + (size_t)MTOK * 8 * 4;
constexpr size_t OFF_Y = al256(OFF_RKR + (size_t)MTOK * 8 * 4);
constexpr size_t OFF_YAB = OFF_Y + SCN;
constexpr size_t OFF_Q = OFF_YAB + (size_t)MROWS * D * 2;
constexpr size_t OFF_P = OFF_Q + (size_t)MROWS * D * 2;
constexpr size_t OFF_O = OFF_P + (size_t)MROWS * D * 2;
constexpr size_t OFF_BAR = OFF_O + (size_t)MROWS * D * 2;
constexpr size_t BAR_BYTES = 16384;
constexpr size_t WS_END = OFF_BAR + BAR_BYTES;
static_assert((size_t)MROWS * FW2 * 2 <= 6 * SCN, "UP overlay");
static_assert((size_t)MROWS * FW * 2 <= (size_t)MROWS * LDP * 2, "H overlay");
static_assert(WS_END < (size_t)1050000000, "workspace");

__device__ __forceinline__ unsigned f2bf(float f) { unsigned u = __builtin_bit_cast(unsigned, f); return (u + 0x7fffu + ((u >> 16) & 1u)) >> 16; }
__device__ __forceinline__ unsigned pk2(float lo, float hi) { return f2bf(lo) | (f2bf(hi) << 16); }
__device__ __forceinline__ unsigned cvt_pk_bf16(float lo, float hi) { unsigned r; asm volatile("v_cvt_pk_bf16_f32 %0, %1, %2" : "=v"(r) : "v"(lo), "v"(hi)); return r; }
__device__ __forceinline__ float bflo(unsigned w) { return __builtin_bit_cast(float, w << 16); }
__device__ __forceinline__ float bfhi(unsigned w) { return __builtin_bit_cast(float, w & 0xffff0000u); }
__device__ __forceinline__ float wave_sum(float v) {
#pragma unroll
    for (int o = 1; o < 64; o <<= 1) v += __shfl_xor(v, o);
    return v;
}
__device__ __forceinline__ float wave_max(float v) {
#pragma unroll
    for (int o = 1; o < 64; o <<= 1) v = fmaxf(v, __shfl_xor(v, o));
    return v;
}
__device__ __forceinline__ float sigmoidf_(float x) { return 1.f / (1.f + __expf(-x)); }
__device__ __forceinline__ void unpack8(u32x4 w, float* f) { f[0] = bflo(w.x); f[1] = bfhi(w.x); f[2] = bflo(w.y); f[3] = bfhi(w.y); f[4] = bflo(w.z); f[5] = bfhi(w.z); f[6] = bflo(w.w); f[7] = bfhi(w.w); }
__device__ __forceinline__ f32x4 ld_bf4(const bf16_t* p) { const u32x2 w = *(const u32x2*)p; return (f32x4){bflo(w.x), bfhi(w.x), bflo(w.y), bfhi(w.y)}; }
__device__ __forceinline__ void st_bf4(bf16_t* p, const f32x4 v) { u32x2 w; w.x = cvt_pk_bf16(v[0], v[1]); w.y = cvt_pk_bf16(v[2], v[3]); *(u32x2*)p = w; }
__device__ __forceinline__ float bf2f(bf16_t h) { return __builtin_bit_cast(float, (unsigned)h << 16); }
template <int CTRL> __device__ __forceinline__ float dppf(float v) { return __builtin_bit_cast(float, __builtin_amdgcn_update_dpp(0, __builtin_bit_cast(int, v), CTRL, 0xF, 0xF, true)); }
__device__ __forceinline__ float red16(float v) { v += dppf<0xB1>(v); v += dppf<0x4E>(v); v += dppf<0x124>(v); v += dppf<0x128>(v); return v; }

namespace pg8 {
constexpr int BM = 256, BK = 64, HALF = 128, HTB = HALF * BK * 2, STAGE_BYTES = 8 * HTB, NXCD = 8, WGM = 8;
__host__ __device__ __forceinline__ int lds_byte(int r, int c) { const int st = (r >> 4) * 2 + (c >> 5), rr = r & 15, cc = c & 31, ob = rr * 64 + cc * 2; return st * 1024 + (ob ^ (((ob >> 9) & 1) << 5)); }
__host__ __device__ __forceinline__ void stage_rc(int b, int& R, int& C) { const int st = b / 1024, sb = b % 1024, swz = sb ^ (((sb >> 9) & 1) << 5); R = (st >> 1) * 16 + swz / 64; C = (st & 1) * 32 + (swz % 64) / 2; }
__host__ __device__ __forceinline__ int perm32(int rho) { const int n = rho >> 4, i = rho & 15; return 8 * (i >> 2) + 4 * n + (i & 3); }

struct Unit { int pm, pn; size_t offA, offB; };
struct Gemm { const bf16_t* A; const bf16_t* Bt; int lda, ldb, K; };

struct GenOrder {
    int mode, nM, nN, nwg, G, c; size_t sA, sB;
    __device__ void init(int mode_, int M, int N, int lda, int ldb, int G_, int c_) { mode = mode_; nM = M / BM; nN = N / BM; nwg = nM * nN; G = G_; c = c_; sA = (size_t)BM * lda * 2; sB = (size_t)BM * ldb * 2; }
    __device__ bool next(int i, Unit& u) const {
        const long L = (long)i * G + c; if (L >= nwg) return false;
        if (mode == 0) {
            int wgid = (int)L; { const int q = nwg / NXCD, r = nwg % NXCD, xcd = wgid % NXCD, off = wgid / NXCD; wgid = (xcd < r ? xcd * (q + 1) : r * (q + 1) + (xcd - r) * q) + off; }
            const int nig = WGM * nN, gid = wgid / nig, fm = gid * WGM, gsz = (nM - fm) < WGM ? (nM - fm) : WGM;
            u.pm = fm + ((wgid % nig) % gsz); u.pn = (wgid % nig) / gsz; u.offA = (size_t)u.pm * sA; u.offB = (size_t)u.pn * sB;
        } else {
            const int b = (int)L >> 5, qb = ((int)L >> 2) & 7, h = (int)L & 3;
            u.pm = b * 8 + qb; u.pn = h;
            u.offA = ((size_t)(b * 2048 + qb * 256) * 1024 + h * 256) * 2;
            u.offB = mode == 1 ? ((size_t)(b * 256) * 1024 + h * 256) * 2 : ((size_t)(b * 4 + h) * 256 * 256) * 2;
        }
        return true;
    }
};

template <class Epi, class Sched, bool ALIGN_EPI>
__device__ __forceinline__ void gemm_phase(LAS unsigned char* lds, const Gemm g, const Sched& S, const Epi& E) {
    int tid = threadIdx.x; asm volatile("" : "+v"(tid));
    const int wid = __builtin_amdgcn_readfirstlane(tid >> 6), lane = tid & 63, wr = wid >> 2, wc = wid & 3, fr = lane & 15, fq = lane >> 4;
    const int K = g.K, nt = K / BK;
    unsigned voffA[2], voffB[2];
#pragma unroll
    for (int i = 0; i < 2; ++i) { int R, C; stage_rc(tid * 16 + i * 8192, R, C); const int Rb = Epi::PERM ? ((R & ~31) + perm32(R & 31)) : R;
        voffA[i] = (unsigned)(R * g.lda + C) * 2u; voffB[i] = (unsigned)(Rb * g.ldb + C) * 2u; }
    const size_t kstep = (size_t)(BK * 2);
    const size_t hstepA = (size_t)HALF * g.lda * 2, hstepB = (size_t)HALF * g.ldb * 2;
    const unsigned ldsw = (unsigned)wid * 1024u;
    const int aoff = lds_byte(wr * 64 + fr, fq * 8), boff = lds_byte(wc * 32 + fr, fq * 8);
#define PG8_SA(b, h) (((b) * 2 + (h)) * HTB)
#define PG8_SB(b, h) ((4 + (b) * 2 + (h)) * HTB)
#define PG8_STAGE(bufoff, gbase, voff) do { _Pragma("unroll") for (int _i = 0; _i < 2; ++_i) \
        __builtin_amdgcn_global_load_lds((const unsigned*)((const char*)(gbase) + (voff)[_i]), (LAS unsigned*)(lds + (bufoff) + ldsw + _i * 8192), 16, 0, 0); } while (0)
#define PG8_LDA(dst, b, h) do { _Pragma("unroll") for (int m = 0; m < 4; ++m) _Pragma("unroll") for (int k = 0; k < 2; ++k) dst[m][k] = *(const LAS bf16x8*)(lds + PG8_SA(b, h) + aoff + m * 2048 + k * 1024); } while (0)
#define PG8_LDB(dst, b, h) do { _Pragma("unroll") for (int n = 0; n < 2; ++n) _Pragma("unroll") for (int k = 0; k < 2; ++k) dst[n][k] = *(const LAS bf16x8*)(lds + PG8_SB(b, h) + boff + n * 2048 + k * 1024); } while (0)
#define PG8_MMA(ai, bj, At, Bt) do { __builtin_amdgcn_s_setprio(1); _Pragma("unroll") for (int m = 0; m < 4; ++m) _Pragma("unroll") for (int n = 0; n < 2; ++n) _Pragma("unroll") for (int k = 0; k < 2; ++k) \
        acc[ai][bj][m][n] = __builtin_amdgcn_mfma_f32_16x16x32_bf16(Bt[n][k], At[m][k], acc[ai][bj][m][n], 0, 0, 0); __builtin_amdgcn_s_setprio(0); } while (0)
#define PG8_WAIT_V(n) asm volatile("s_waitcnt vmcnt(" #n ")" ::: "memory")
#define PG8_WAIT_L(n) asm volatile("s_waitcnt lgkmcnt(" #n ")" ::: "memory")
#define PG8_BAR __builtin_amdgcn_s_barrier()
#define PG8_SCHED __builtin_amdgcn_sched_barrier(0)
    Unit cur, nxt; int ui = 0;
    if (!S.next(0, cur)) return;
    f32x4 acc[2][2][4][2];
#pragma unroll
    for (int a = 0; a < 2; ++a)
#pragma unroll
        for (int b = 0; b < 2; ++b)
#pragma unroll
            for (int m = 0; m < 4; ++m)
#pragma unroll
                for (int n = 0; n < 2; ++n) acc[a][b][m][n] = (f32x4){0.f, 0.f, 0.f, 0.f};
    bf16x8 At[4][2], B0[2][2], B1[2][2];
    const char* cA = (const char*)g.A + cur.offA; const char* cB = (const char*)g.Bt + cur.offB;
    PG8_STAGE(PG8_SB(0, 0), cB, voffB); PG8_STAGE(PG8_SB(0, 1), cB + hstepB, voffB); PG8_STAGE(PG8_SA(0, 0), cA, voffA); PG8_STAGE(PG8_SA(0, 1), cA + hstepA, voffA);
    if (wr == 1) PG8_BAR;
    PG8_WAIT_V(2); PG8_BAR;
    PG8_STAGE(PG8_SB(1, 0), cB + kstep, voffB); PG8_STAGE(PG8_SA(1, 0), cA + kstep, voffA); PG8_STAGE(PG8_SB(1, 1), cB + hstepB + kstep, voffB);
    PG8_WAIT_V(6); PG8_BAR;
    for (;;) {
        const bool has_next = S.next(ui + 1, nxt);
        const char* nA = has_next ? (const char*)g.A + nxt.offA : cA; const char* nB = has_next ? (const char*)g.Bt + nxt.offB : cB;
        for (int t = 0; t < nt; t += 2) {
            const bool last = (t == nt - 2);
            const char* a1 = cA + (size_t)(t + 1) * kstep;
            const char* a2 = last ? nA : cA + (size_t)(t + 2) * kstep; const char* b2 = last ? nB : cB + (size_t)(t + 2) * kstep;
            const char* a3 = a2 + kstep; const char* b3 = b2 + kstep;
            PG8_LDB(B0, 0, 0); PG8_LDB(B1, 0, 1); PG8_SCHED; PG8_LDA(At, 0, 0); PG8_STAGE(PG8_SA(1, 1), a1 + hstepA, voffA);
            PG8_WAIT_V(8); PG8_WAIT_L(0); PG8_BAR; PG8_MMA(0, 0, At, B0); PG8_MMA(0, 1, At, B1); PG8_BAR; PG8_SCHED;
            PG8_LDA(At, 0, 1); PG8_STAGE(PG8_SB(0, 0), b2, voffB); PG8_STAGE(PG8_SB(0, 1), b2 + hstepB, voffB); PG8_STAGE(PG8_SA(0, 0), a2, voffA);
            PG8_WAIT_V(8); PG8_WAIT_L(0); PG8_BAR; PG8_MMA(1, 0, At, B0); PG8_MMA(1, 1, At, B1); PG8_BAR; PG8_SCHED;
            PG8_LDB(B0, 1, 0); PG8_LDB(B1, 1, 1); PG8_SCHED; PG8_LDA(At, 1, 0); PG8_STAGE(PG8_SA(0, 1), a2 + hstepA, voffA);
            PG8_WAIT_V(8); PG8_WAIT_L(0); PG8_BAR; PG8_MMA(0, 0, At, B0); PG8_MMA(0, 1, At, B1); PG8_BAR; PG8_SCHED;
            PG8_LDA(At, 1, 1); PG8_STAGE(PG8_SB(1, 0), b3, voffB); PG8_STAGE(PG8_SB(1, 1), b3 + hstepB, voffB); PG8_STAGE(PG8_SA(1, 0), a3, voffA);
            PG8_WAIT_V(8); PG8_WAIT_L(0); PG8_BAR; PG8_MMA(1, 0, At, B0); PG8_MMA(1, 1, At, B1); PG8_BAR; PG8_SCHED;
        }
        if constexpr (ALIGN_EPI) { if (wr == 0) PG8_BAR; }
        if constexpr (!Epi::AFTER_DRAIN) { E(acc, cur, wr, wc, fr, fq); }
        if (!has_next) break;
#pragma unroll
        for (int a = 0; a < 2; ++a)
#pragma unroll
            for (int b = 0; b < 2; ++b)
#pragma unroll
                for (int m = 0; m < 4; ++m)
#pragma unroll
                    for (int n = 0; n < 2; ++n) acc[a][b][m][n] = (f32x4){0.f, 0.f, 0.f, 0.f};
        cur = nxt; cA = nA; cB = nB; ++ui;
        if constexpr (ALIGN_EPI) { if (wr == 1) PG8_BAR; }
    }
    PG8_WAIT_V(0);
    if constexpr (!ALIGN_EPI) { if (wr == 0) PG8_BAR; }
    PG8_BAR;
    if constexpr (Epi::AFTER_DRAIN) { E.fused(acc, cur, wr, wc, fr, fq, lds, wid, lane); }
#undef PG8_SA
#undef PG8_SB
#undef PG8_STAGE
#undef PG8_LDA
#undef PG8_LDB
#undef PG8_MMA
#undef PG8_WAIT_V
#undef PG8_WAIT_L
#undef PG8_BAR
#undef PG8_SCHED
}

struct Epi {
    static constexpr bool PERM = true, AFTER_DRAIN = false;
    int mode;
    bf16_t* O; int ldc;
    const float* ss;
    float* X;
    float* ssn;
    float* F;
    int l; int dry;
    __device__ __forceinline__ void operator()(const f32x4 (&acc)[2][2][4][2], const Unit& u, int wr, int wc, int fr, int fq) const {
        const int row0 = u.pm * 256 + wr * 64 + fr, col0 = u.pn * 256 + wc * 32 + 8 * fq;
        if (dry) return;
        if (mode == 1) {
#pragma unroll
            for (int ai = 0; ai < 2; ++ai)
#pragma unroll
                for (int m = 0; m < 4; ++m) {
                    const int row = row0 + ai * 128 + m * 16; const bool valid = row < MTOK; float sq = 0.f;
#pragma unroll
                    for (int bj = 0; bj < 2; ++bj) {
                        const size_t idx = (size_t)row * 1024 + col0 + bj * 128;
                        if (valid) {
                            float xf[8]; unpack8(*(const u32x4*)(O + idx), xf);
                            const f32x4 x0 = (f32x4){xf[0], xf[1], xf[2], xf[3]} + acc[ai][bj][m][0], x1 = (f32x4){xf[4], xf[5], xf[6], xf[7]} + acc[ai][bj][m][1];
                            sq += (x0[0] * x0[0] + x0[1] * x0[1]) + (x0[2] * x0[2] + x0[3] * x0[3]) + (x1[0] * x1[0] + x1[1] * x1[1]) + (x1[2] * x1[2] + x1[3] * x1[3]);
                            u32x4 w; w.x = cvt_pk_bf16(x0[0], x0[1]); w.y = cvt_pk_bf16(x0[2], x0[3]); w.z = cvt_pk_bf16(x1[0], x1[1]); w.w = cvt_pk_bf16(x1[2], x1[3]);
                            *(u32x4*)(O + idx) = w;
                        }
                    }
                    sq += __shfl_xor(sq, 16); sq += __shfl_xor(sq, 32);
                    if (valid && fq == 0) atomicAdd(ssn + row, sq);
                }
        } else {
#pragma unroll
            for (int ai = 0; ai < 2; ++ai)
#pragma unroll
                for (int m = 0; m < 4; ++m) {
                    const int row = row0 + ai * 128 + m * 16;
                    float rs = 1.f;
                    if (ss != nullptr && (mode == 2 || mode == 3 || row < MTOK)) rs = rsqrtf(ss[row] * (1.f / 1024.f) + EPS);
#pragma unroll
                    for (int bj = 0; bj < 2; ++bj) {
                        const int col = col0 + bj * 128;
                        const f32x4 v0 = acc[ai][bj][m][0] * rs, v1 = acc[ai][bj][m][1] * rs;
                        u32x4 w; w.x = cvt_pk_bf16(v0[0], v0[1]); w.y = cvt_pk_bf16(v0[2], v0[3]); w.z = cvt_pk_bf16(v1[0], v1[1]); w.w = cvt_pk_bf16(v1[2], v1[3]);
                        if (mode == 3) {
                            const int b = row >> 8, mem = row & 255;
                            bf16_t* o = O + ((size_t)(b * 1024 + col)) * 256 + mem;
                            o[0] = (bf16_t)(w.x & 0xffff); o[256] = (bf16_t)(w.x >> 16); o[512] = (bf16_t)(w.y & 0xffff); o[768] = (bf16_t)(w.y >> 16);
                            o[1024] = (bf16_t)(w.z & 0xffff); o[1280] = (bf16_t)(w.z >> 16); o[1536] = (bf16_t)(w.w & 0xffff); o[1792] = (bf16_t)(w.w >> 16);
                        } else {
                            *(u32x4*)(O + (size_t)row * ldc + col) = w;
                        }
                        if (mode == 2 || mode == 3) { float* f = F + (size_t)row * 1024 + col; *(f32x4*)f = v0; *(f32x4*)(f + 4) = v1; }
                        if (mode == 4) {
                            float* f = nullptr;
                            if (row < MP) { const int t = row & 2047; if (t >= 2046) f = F + O_FFNP + ((size_t)((l * 8 + (row >> 11)) * 2 + (t - 2046))) * FW2 + col; }
                            else if (row < MTOK) f = F + O_FFNS + ((size_t)((l * 128 + (row - MP)) * 2 + 1)) * FW2 + col;
                            if (f) { *(f32x4*)f = v0; *(f32x4*)(f + 4) = v1; }
                        }
                    }
                }
        }
    }
};

struct EpiSm {
    static constexpr bool PERM = true, AFTER_DRAIN = true;
    bf16_t* P;
    __device__ __forceinline__ void operator()(const f32x4 (&)[2][2][4][2], const Unit&, int, int, int, int) const {}
    __device__ __forceinline__ void fused(f32x4 (&acc)[2][2][4][2], const Unit& u, int wr, int wc, int fr, int fq, LAS unsigned char* lds, int wid, int lane) const {
        LAS float* red = (LAS float*)lds; LAS float* red2 = red + 1024;
        float mx[2][4];
#pragma unroll
        for (int ai = 0; ai < 2; ++ai)
#pragma unroll
            for (int m = 0; m < 4; ++m) {
                float v = -3.0e38f;
#pragma unroll
                for (int bj = 0; bj < 2; ++bj)
#pragma unroll
                    for (int n = 0; n < 2; ++n) { const f32x4 x = acc[ai][bj][m][n]; v = fmaxf(v, fmaxf(fmaxf(x[0], x[1]), fmaxf(x[2], x[3]))); }
                v = fmaxf(v, __shfl_xor(v, 16)); v = fmaxf(v, __shfl_xor(v, 32));
                if (fq == 0) red[(ai * 128 + wr * 64 + m * 16 + fr) * 4 + wc] = v;
            }
        __syncthreads();
#pragma unroll
        for (int ai = 0; ai < 2; ++ai)
#pragma unroll
            for (int m = 0; m < 4; ++m) {
                const f32x4 r = *(const LAS f32x4*)(red + (ai * 128 + wr * 64 + m * 16 + fr) * 4);
                const float M = fmaxf(fmaxf(r[0], r[1]), fmaxf(r[2], r[3])); mx[ai][m] = M;
                float s = 0.f;
#pragma unroll
                for (int bj = 0; bj < 2; ++bj)
#pragma unroll
                    for (int n = 0; n < 2; ++n) { f32x4 x = acc[ai][bj][m][n];
                        x[0] = __expf(x[0] - M); x[1] = __expf(x[1] - M); x[2] = __expf(x[2] - M); x[3] = __expf(x[3] - M); acc[ai][bj][m][n] = x; s += (x[0] + x[1]) + (x[2] + x[3]); }
                s += __shfl_xor(s, 16); s += __shfl_xor(s, 32);
                if (fq == 0) red2[(ai * 128 + wr * 64 + m * 16 + fr) * 4 + wc] = s;
            }
        __syncthreads();
#pragma unroll
        for (int ai = 0; ai < 2; ++ai)
#pragma unroll
            for (int m = 0; m < 4; ++m) {
                const int rl = ai * 128 + wr * 64 + m * 16 + fr;
                const f32x4 r = *(const LAS f32x4*)(red2 + rl * 4);
                const float inv = 1.f / ((r[0] + r[1]) + (r[2] + r[3]));
#pragma unroll
                for (int bj = 0; bj < 2; ++bj) {
                    const f32x4 v0 = acc[ai][bj][m][0] * inv, v1 = acc[ai][bj][m][1] * inv;
                    u32x4 w; w.x = cvt_pk_bf16(v0[0], v0[1]); w.y = cvt_pk_bf16(v0[2], v0[3]); w.z = cvt_pk_bf16(v1[0], v1[1]); w.w = cvt_pk_bf16(v1[2], v1[3]);
                    *(u32x4*)(P + (size_t)(u.pm * 256 + rl) * 1024 + u.pn * 256 + bj * 128 + wc * 32 + 8 * fq) = w;
                }
            }
        (void)mx; (void)wid; (void)lane;
    }
};
}

struct Args { const float* in[38]; float* out; unsigned char* ws; int ph_lo, ph_hi; };
enum { I_XP = 0, I_XS, I_MEM, I_SSHIFT, I_SWKV, I_SCONV, I_SFFN, I_CK, I_CV, I_NMIX, I_WIN, I_MU, I_W0, I_W2, I_A0, I_A2, I_G2, I_V0, I_V1, I_V2,
       I_KK, I_KA, I_RK, I_LNW, I_LNB, I_CONVW, I_WOUT, I_NX, I_NMEM, I_WQ, I_WK, I_WV, I_WO, I_NFFN, I_WUP, I_FCW, I_WDN, I_NFIN };

__device__ __forceinline__ void tr_item(const float* W, int K, int N, bf16_t* WT, const float* gain, float scale, LAS float* scr, int item, int lane) {
    const int nblk = N / 32, kb = item / nblk, nb = item % nblk, k0 = 64 * kb, n0 = 32 * nb;
#pragma unroll
    for (int i = 0; i < 8; ++i) { const int kk = 8 * i + (lane >> 3); const float gk = gain ? gain[k0 + kk] * scale : scale;
        const f32x4 v = *(const f32x4*)(W + (size_t)(k0 + kk) * N + n0 + (lane & 7) * 4) * gk;
        LAS float* d = scr + kk * 33 + (lane & 7) * 4; d[0] = v[0]; d[1] = v[1]; d[2] = v[2]; d[3] = v[3]; }
    LDS_WAIT();
    const int c = lane & 7;
#pragma unroll
    for (int j = 0; j < 4; ++j) { const int n = (lane >> 3) + 8 * j; const LAS float* s = scr + (8 * c) * 33 + n;
        u32x4 o; o.x = pk2(s[0 * 33], s[1 * 33]); o.y = pk2(s[2 * 33], s[3 * 33]); o.z = pk2(s[4 * 33], s[5 * 33]); o.w = pk2(s[6 * 33], s[7 * 33]);
        *(u32x4*)(WT + (size_t)(n0 + n) * K + k0 + 8 * c) = o; }
    LDS_WAIT();
}

constexpr int TR_NL = 8512;
__device__ __forceinline__ void tr_dispatch(const Args& a, unsigned char* ws, int l, int r, LAS float* scr, int lane) {
    constexpr int I_IN_ = 16 * 104, I_SQ_ = 16 * 32, I_UP_ = 16 * 176, I_DN_ = 44 * 32, I_L64 = 16;
    if (r < I_IN_) { tr_item(a.in[I_WIN] + (size_t)l * D * INC, D, INC, (bf16_t*)(ws + OFF_WIN) + (size_t)l * LDP * D, a.in[I_NMIX] + l * D, 1.f, scr, r, lane); return; } r -= I_IN_;
    if (r < I_SQ_) { tr_item(a.in[I_WOUT] + (size_t)l * D * D, D, D, (bf16_t*)(ws + OFF_WOUT) + (size_t)l * D * D, nullptr, 1.f, scr, r, lane); return; } r -= I_SQ_;
    if (r < I_SQ_) { tr_item(a.in[I_WQ] + (size_t)l * D * D, D, D, (bf16_t*)(ws + OFF_WQ) + (size_t)l * D * D, a.in[I_NX] + l * D, 0.0625f, scr, r, lane); return; } r -= I_SQ_;
    if (r < I_SQ_) { tr_item(a.in[I_WK] + (size_t)l * D * D, D, D, (bf16_t*)(ws + OFF_WK) + (size_t)l * D * D, a.in[I_NMEM] + l * D, 1.f, scr, r, lane); return; } r -= I_SQ_;
    if (r < I_SQ_) { tr_item(a.in[I_WV] + (size_t)l * D * D, D, D, (bf16_t*)(ws + OFF_WV) + (size_t)l * D * D, a.in[I_NMEM] + l * D, 1.f, scr, r, lane); return; } r -= I_SQ_;
    if (r < I_SQ_) { tr_item(a.in[I_WO] + (size_t)l * D * D, D, D, (bf16_t*)(ws + OFF_WO) + (size_t)l * D * D, nullptr, 1.f, scr, r, lane); return; } r -= I_SQ_;
    if (r < I_UP_) { tr_item(a.in[I_WUP] + (size_t)l * D * FW2, D, FW2, (bf16_t*)(ws + OFF_WUP) + (size_t)l * FW2 * D, a.in[I_NFFN] + l * D, 1.f, scr, r, lane); return; } r -= I_UP_;
    if (r < I_DN_) { tr_item(a.in[I_WDN] + (size_t)l * FW * D, FW, D, (bf16_t*)(ws + OFF_WDN) + (size_t)l * D * FW, nullptr, 1.f, scr, r, lane); return; } r -= I_DN_;
    if (r < I_L64) { tr_item(a.in[I_W2] + (size_t)l * 64 * 512, 64, 512, (bf16_t*)(ws + OFF_W2) + (size_t)l * 512 * 64, nullptr, 1.f, scr, r, lane); return; } r -= I_L64;
    if (r < I_L64) { tr_item(a.in[I_A2] + (size_t)l * 64 * 512, 64, 512, (bf16_t*)(ws + OFF_A2) + (size_t)l * 512 * 64, nullptr, 1.f, scr, r, lane); return; } r -= I_L64;
    tr_item(a.in[I_G2] + (size_t)l * 128 * 512, 128, 512, (bf16_t*)(ws + OFF_G2) + (size_t)l * 512 * 128, nullptr, 1.f, scr, r, lane);
}
constexpr int TR_DEFERRED = TR_NL + 5760;
__device__ __forceinline__ void tr_deferred(const Args& a, unsigned char* ws, int d, LAS float* scr, int lane) {
    if (d < TR_NL) { tr_dispatch(a, ws, 1, d, scr, lane); return; }
    const int e = d - TR_NL;
    const int r = e < 1024 ? 1664 + e : (e < 1536 ? 3712 + (e - 1024) : 4224 + (e - 1536));
    tr_dispatch(a, ws, 0, r, scr, lane);
}

__device__ __forceinline__ void p0_prologue(LAS unsigned char* lds, const Args& a, int tid, int lane, int wave, int gw, int NGW) {
    unsigned char* ws = a.ws;
    LAS float* scr = (LAS float*)(lds + wave * 16384);
    for (int it = gw; it < 1664 + 1024 + 64; it += NGW) {
        const int r = it < 1664 ? it : (it < 2688 ? 2688 + (it - 1664) : 8448 + (it - 2688));
        tr_dispatch(a, ws, 0, r, scr, lane);
    }
    float* X = (float*)(ws + OFF_X); bf16_t* XB = (bf16_t*)(ws + OFF_XB); float* SS = (float*)(ws + OFF_SS);
    bf16_t* MNB = (bf16_t*)(ws + OFF_MNB); float* SSM = (float*)(ws + OFF_SSM);
    for (int m = gw; m < MROWS + MMEM; m += NGW) {
        const float* src; bf16_t* dstb; float* dstx = nullptr; float* dss = nullptr; bool shiftrow = false;
        if (m < MP) { src = a.in[I_XP] + (size_t)m * D; dstb = XB + (size_t)m * D; dstx = X + (size_t)m * D; dss = SS + m; }
        else if (m < MTOK) { src = a.in[I_XS] + (size_t)(m - MP) * D; dstb = XB + (size_t)m * D; dstx = X + (size_t)m * D; dss = SS + m; }
        else if (m < MROWS) { src = a.in[I_SSHIFT] + (size_t)(m - MTOK) * D; dstb = XB + (size_t)m * D; shiftrow = true; }
        else { src = a.in[I_MEM] + (size_t)(m - MROWS) * D; dstb = MNB + (size_t)(m - MROWS) * D; dss = SSM + (m - MROWS); }
        float s = 0.f;
#pragma unroll
        for (int j = 0; j < 4; ++j) {
            f32x4 v = *(const f32x4*)(src + 4 * lane + 256 * j);
            if (shiftrow) { const f32x4 gn = *(const f32x4*)(a.in[I_NMIX] + 4 * lane + 256 * j); v[0] /= gn[0]; v[1] /= gn[1]; v[2] /= gn[2]; v[3] /= gn[3]; }
            s += (v[0] * v[0] + v[1] * v[1]) + (v[2] * v[2] + v[3] * v[3]);
            u32x2 w; w.x = pk2(v[0], v[1]); w.y = pk2(v[2], v[3]);
            *(u32x2*)(dstb + 4 * lane + 256 * j) = w;
        }
        s = wave_sum(s);
        if (dss && lane == 0) *dss = s;
    }
    if (blockIdx.x * 8 < D) {
        __syncthreads();
        LAS float* M = (LAS float*)lds;
        const float* muv = a.in[I_MU] + 1792 + 1024; const float* v1 = a.in[I_V1];
#pragma unroll 8
        for (int i = tid; i < 512 * 64; i += 512) { const int c = i >> 6, o = i & 63; const float mv = muv[c]; M[i] = ((o >> 5) ? mv : 1.f - mv) * v1[c * 32 + (o & 31)]; }
        __syncthreads();
        for (int k = gw; k < D; k += NGW) {
            const float* wrow = a.in[I_WIN] + (size_t)1 * D * INC + (size_t)k * INC + 1024;
            float acc = 0.f;
#pragma unroll 4
            for (int c = 0; c < 512; c += 4) {
                const f32x4 w4 = *(const f32x4*)(wrow + c);
                acc += w4[0] * M[c * 64 + lane] + w4[1] * M[(c + 1) * 64 + lane] + w4[2] * M[(c + 2) * 64 + lane] + w4[3] * M[(c + 3) * 64 + lane];
            }
            ((bf16_t*)(ws + OFF_WIN))[(size_t)1 * LDP * D + (size_t)(INC + lane) * D + k] = (bf16_t)f2bf(acc * a.in[I_NMIX][D + k]);
        }
    }
    const int gt = blockIdx.x * 512 + tid, NGT = gridDim.x * 512;
    for (int i = gt; i < 6 * MROWS; i += NGT) SS[MROWS + i] = 0.f;
    bf16_t* V2T = (bf16_t*)(ws + OFF_V2);
    for (int i = gt; i < 512 * 32; i += NGT) { const int n = i >> 5, k = i & 31; V2T[i] = (bf16_t)f2bf(a.in[I_V2][k * 512 + n]); }
}

__device__ __forceinline__ const bf16_t* prev_row(const bf16_t* PROJ, int m) {
    if (m < MP) { if ((m & 2047) == 0) return nullptr; return PROJ + (size_t)(m - 1) * LDP; }
    return PROJ + (size_t)(m + NS) * LDP;
}
__device__ __forceinline__ void mix4(const bf16_t* cur, const bf16_t* prv, const float* mu, int col, float* z) {
    const u32x2 c = *(const u32x2*)(cur + col); const f32x4 m4 = *(const f32x4*)(mu + col);
    float cf[4] = {bflo(c.x), bfhi(c.x), bflo(c.y), bfhi(c.y)}; float pf[4] = {0.f, 0.f, 0.f, 0.f};
    if (prv) { const u32x2 p = *(const u32x2*)(prv + col); pf[0] = bflo(p.x); pf[1] = bfhi(p.x); pf[2] = bflo(p.y); pf[3] = bfhi(p.y); }
#pragma unroll
    for (int j = 0; j < 4; ++j) z[j] = cf[j] + (pf[j] - cf[j]) * m4[j];
}
__device__ __forceinline__ void mix8(const bf16_t* cur, const bf16_t* prv, const float* mu, int col, float* z) {
    const u32x4 c = *(const u32x4*)(cur + col); float cf[8], pf[8]; unpack8(c, cf);
#pragma unroll
    for (int j = 0; j < 8; ++j) pf[j] = 0.f;
    if (prv) { const u32x4 p = *(const u32x4*)(prv + col); unpack8(p, pf); }
    const f32x4 m0 = *(const f32x4*)(mu + col), m1 = *(const f32x4*)(mu + col + 4);
#pragma unroll
    for (int j = 0; j < 4; ++j) { z[j] = cf[j] + (pf[j] - cf[j]) * m0[j]; z[4 + j] = cf[4 + j] + (pf[4 + j] - cf[4 + j]) * m1[j]; }
}

__device__ __forceinline__ float fsig(float x) { return __builtin_amdgcn_rcpf(1.f + __expf(-x)); }
__device__ __forceinline__ void mixw(u32x2 c, u32x2 p, const LAS float* mu, float* z) {
    const f32x4 m4 = *(const LAS f32x4*)mu;
    const float cf[4] = {bflo(c.x), bfhi(c.x), bflo(c.y), bfhi(c.y)}, pf[4] = {bflo(p.x), bfhi(p.x), bflo(p.y), bfhi(p.y)};
#pragma unroll
    for (int j = 0; j < 4; ++j) z[j] = cf[j] + (pf[j] - cf[j]) * m4[j];
}
__device__ __forceinline__ void prep_phase(LAS unsigned char* lds, const Args& a, int l, int tid, int lane, int wave, int gw) {
    unsigned char* ws = a.ws;
    const bf16_t* PROJ = (const bf16_t*)(ws + OFF_PROJ);
    const float* mu = a.in[I_MU] + l * 1792;
    if (gw < NB + NS) {
        const int row = gw < NB ? gw * 2048 + 2047 : MP + (gw - NB);
        float* dst = gw < NB ? a.out + O_SHP + (size_t)(l * NB + gw) * D : a.out + O_SHS + (size_t)(l * NS + (gw - NB)) * D;
        const bf16_t* Xr = (const bf16_t*)(ws + OFF_XB) + (size_t)row * D;
        const float rs = rsqrtf(((const float*)(ws + OFF_SS))[3 * l * MROWS + row] * (1.f / 1024.f) + EPS);
#pragma unroll
        for (int j = 0; j < 4; ++j) { const u32x2 xw = *(const u32x2*)(Xr + 4 * lane + 256 * j); const f32x4 v = (f32x4){bflo(xw.x), bfhi(xw.x), bflo(xw.y), bfhi(xw.y)}, gn = *(const f32x4*)(a.in[I_NMIX] + l * D + 4 * lane + 256 * j);
            *(f32x4*)(dst + 4 * lane + 256 * j) = v * rs * gn; }
    }
    LAS bf16_t* WL2 = (LAS bf16_t*)lds;
    LAS bf16_t* WLA = (LAS bf16_t*)(lds + 18432);
    LAS bf16_t* WLG = (LAS bf16_t*)(lds + 36864);
    LAS bf16_t* WLV = (LAS bf16_t*)(lds + 71680);
    LAS float* PAR = (LAS float*)(lds + 81920);
    LAS bf16_t* LA = (LAS bf16_t*)(lds + 88064);
    LAS bf16_t* LW = (LAS bf16_t*)(lds + 121856);
    const int hp = blockIdx.x & 3;
    {
        const bf16_t* W2T = (const bf16_t*)(ws + OFF_W2) + (size_t)l * 512 * 64 + (size_t)hp * 128 * 64;
        const bf16_t* A2T = (const bf16_t*)(ws + OFF_A2) + (size_t)l * 512 * 64 + (size_t)hp * 128 * 64;
        const bf16_t* G2T = (const bf16_t*)(ws + OFF_G2) + (size_t)l * 512 * 128 + (size_t)hp * 128 * 128;
        const bf16_t* V2T = (const bf16_t*)(ws + OFF_V2) + (size_t)hp * 128 * 32;
#pragma unroll
        for (int q = 0; q < 2; ++q) { const int i = tid + 512 * q, n = i >> 3, c = (i & 7) * 8;
            *(LAS u32x4*)(WL2 + n * 72 + c) = *(const u32x4*)(W2T + n * 64 + c); *(LAS u32x4*)(WLA + n * 72 + c) = *(const u32x4*)(A2T + n * 64 + c); }
#pragma unroll
        for (int q = 0; q < 4; ++q) { const int i = tid + 512 * q, n = i >> 4, c = (i & 15) * 8; *(LAS u32x4*)(WLG + n * 136 + c) = *(const u32x4*)(G2T + n * 128 + c); }
        { const int n = tid >> 2, c = (tid & 3) * 8; *(LAS u32x4*)(WLV + n * 40 + c) = *(const u32x4*)(V2T + n * 32 + c); }
        if (tid < 128) {
            const int ch = hp * 128 + tid;
            PAR[tid] = a.in[I_W0][l * 512 + ch]; PAR[128 + tid] = a.in[I_A0][l * 512 + ch]; PAR[256 + tid] = a.in[I_KK][l * 512 + ch]; PAR[384 + tid] = a.in[I_KA][l * 512 + ch];
            PAR[512 + tid] = a.in[I_RK][l * 512 + ch]; PAR[640 + tid] = l == 1 ? a.in[I_V0][ch] : 0.f; PAR[768 + tid] = mu[ch]; PAR[896 + tid] = mu[512 + ch]; PAR[1024 + tid] = mu[1024 + ch];
        }
    }
    float* SA = (float*)(ws + OFF_SA); float* SB = (float*)(ws + OFF_SB); float* SD = (float*)(ws + OFF_SD); float* SK = (float*)(ws + OFF_SK);
    float* SRD = (float*)(ws + OFF_SRD); float* GG = (float*)(ws + OFF_G); float* SV = (float*)(ws + (l == 0 ? OFF_SV0 : OFF_SV1));
    const float* SV0 = (const float*)(ws + OFF_SV0);
    float* SBR = (float*)(ws + OFF_SBR); float* SKR = (float*)(ws + OFF_SKR); float* RKR = (float*)(ws + OFF_RKR);
    const int mt = wave & 3, hh = wave >> 2, h = hp * 2 + hh, fr = lane & 15, fq = lane >> 4;
    const int grp = blockIdx.x >> 2;
    const int nit = 4 + (blockIdx.x < 32 ? 1 : 0);
    for (int it = 0; it < nit; ++it) {
        const bool tailit = it >= 4;
        const int m0 = tailit ? MP + grp * 16 : (grp + 64 * it) * 64;
        const int nq = tailit ? 1 : 4;
        {
            u32x4 cu[4], pv[4];
#pragma unroll
            for (int q = 0; q < 4; ++q) {
                cu[q] = (u32x4){0u, 0u, 0u, 0u}; pv[q] = cu[q];
                if (q < nq) {
                    const int row = (tid >> 5) + 16 * q, ch = tid & 31, m = m0 + row;
                    const bf16_t* prv = prev_row(PROJ, m);
                    cu[q] = *(const u32x4*)(PROJ + (size_t)m * LDP + 1536 + ch * 8);
                    if (prv) pv[q] = *(const u32x4*)(prv + 1536 + ch * 8);
                }
            }
            u32x2 vc = (u32x2){0u, 0u}, vp = vc;
            if (l == 1 && (tid >> 3) < 16 * nq) {
                const int m = m0 + (tid >> 3), j4 = (tid & 7) * 4; const bf16_t* prv = prev_row(PROJ, m);
                vc = *(const u32x2*)(PROJ + (size_t)m * LDP + INC + j4); if (prv) vp = *(const u32x2*)(prv + INC + 32 + j4);
            }
            const int ch = tid & 31;
            const f32x4 m0v = *(const f32x4*)(mu + 1536 + ch * 8), m1v = *(const f32x4*)(mu + 1536 + ch * 8 + 4);
#pragma unroll
            for (int q = 0; q < 4; ++q) {
                if (q >= nq) continue;
                const int row = (tid >> 5) + 16 * q;
                float cf[8], pf[8], z[8]; unpack8(cu[q], cf); unpack8(pv[q], pf);
#pragma unroll
                for (int j = 0; j < 4; ++j) { z[j] = cf[j] + (pf[j] - cf[j]) * m0v[j]; z[4 + j] = cf[4 + j] + (pf[4 + j] - cf[4 + j]) * m1v[j]; }
                if (ch < 8) {
#pragma unroll
                    for (int j = 0; j < 8; ++j) z[j] = 2.f * fsig(2.f * z[j]) - 1.f;
                } else if (ch >= 16) {
#pragma unroll
                    for (int j = 0; j < 8; ++j) z[j] = fsig(z[j]);
                }
                u32x4 w; w.x = pk2(z[0], z[1]); w.y = pk2(z[2], z[3]); w.z = pk2(z[4], z[5]); w.w = pk2(z[6], z[7]);
                *(LAS u32x4*)(LA + row * 264 + ch * 8) = w;
            }
            if (l == 1 && (tid >> 3) < 16 * nq) {
                u32x2 w; w.x = pk2(bflo(vc.x) + bflo(vp.x), bfhi(vc.x) + bfhi(vp.x)); w.y = pk2(bflo(vc.y) + bflo(vp.y), bfhi(vc.y) + bfhi(vp.y));
                *(LAS u32x2*)(LW + (tid >> 3) * 40 + (tid & 7) * 4) = w;
            }
        }
        __syncthreads();
        if (mt < nq) {
        const int m = m0 + mt * 16 + fr;
        const bf16_t* cur = PROJ + (size_t)m * LDP; const bf16_t* prv = prev_row(PROJ, m);
        u32x2 cR[4], cK[4], cV[4], pR[4], pK[4], pV[4]; f32x4 vf[4];
#pragma unroll
        for (int nt = 0; nt < 4; ++nt) {
            const int ch = h * 64 + nt * 16 + fq * 4;
            cR[nt] = *(const u32x2*)(cur + ch); cK[nt] = *(const u32x2*)(cur + 512 + ch); cV[nt] = *(const u32x2*)(cur + 1024 + ch);
            pR[nt] = (u32x2){0u, 0u}; pK[nt] = pR[nt]; pV[nt] = pR[nt];
            if (prv) { pR[nt] = *(const u32x2*)(prv + ch); pK[nt] = *(const u32x2*)(prv + 512 + ch); pV[nt] = *(const u32x2*)(prv + 1024 + ch); }
            vf[nt] = (f32x4){0.f, 0.f, 0.f, 0.f};
            if (l == 1) vf[nt] = ld_bf4((const bf16_t*)SV0 + (size_t)m * 512 + ch);
        }
        float ssq = 0.f;
#pragma unroll
        for (int nt = 0; nt < 4; ++nt) {
            const int cl = hh * 64 + nt * 16 + fq * 4; float kz[4]; mixw(cK[nt], pK[nt], PAR + 896 + cl, kz);
            const f32x4 kk4 = *(const LAS f32x4*)(PAR + 256 + cl);
#pragma unroll
            for (int j = 0; j < 4; ++j) { const float kk = kz[j] * kk4[j]; ssq += kk * kk; }
        }
        ssq += __shfl_xor(ssq, 16); ssq += __shfl_xor(ssq, 32);
        const float inv = 1.f / fmaxf(sqrtf(ssq), 1e-12f);
        float br = 0.f, kr = 0.f, rkr = 0.f;
#pragma unroll
        for (int nt = 0; nt < 4; ++nt) {
            const int cl = hh * 64 + nt * 16 + fq * 4, ch = h * 64 + nt * 16 + fq * 4, nl = hh * 64 + nt * 16 + fr;
            f32x4 dl = (f32x4){0.f, 0.f, 0.f, 0.f}, al = dl, gl = dl, vm = dl;
            bf16x8 af[8];
#pragma unroll
            for (int ks = 0; ks < 8; ++ks) af[ks] = *(const LAS bf16x8*)(LA + (mt * 16 + fr) * 264 + ks * 32 + fq * 8);
            const bf16x8 avv = *(const LAS bf16x8*)(LW + (mt * 16 + fr) * 40 + fq * 8);
#pragma unroll
            for (int ks = 0; ks < 2; ++ks) {
                dl = __builtin_amdgcn_mfma_f32_16x16x32_bf16(*(const LAS bf16x8*)(WL2 + nl * 72 + ks * 32 + fq * 8), af[ks], dl, 0, 0, 0);
                al = __builtin_amdgcn_mfma_f32_16x16x32_bf16(*(const LAS bf16x8*)(WLA + nl * 72 + ks * 32 + fq * 8), af[2 + ks], al, 0, 0, 0);
            }
#pragma unroll
            for (int ks = 0; ks < 4; ++ks) gl = __builtin_amdgcn_mfma_f32_16x16x32_bf16(*(const LAS bf16x8*)(WLG + nl * 136 + ks * 32 + fq * 8), af[4 + ks], gl, 0, 0, 0);
            if (l == 1) vm = __builtin_amdgcn_mfma_f32_16x16x32_bf16(*(const LAS bf16x8*)(WLV + nl * 40 + fq * 8), avv, vm, 0, 0, 0);
            float rz[4], kz[4], vz[4];
            mixw(cR[nt], pR[nt], PAR + 768 + cl, rz); mixw(cK[nt], pK[nt], PAR + 896 + cl, kz); mixw(cV[nt], pV[nt], PAR + 1024 + cl, vz);
            const f32x4 w0 = *(const LAS f32x4*)(PAR + cl), a0 = *(const LAS f32x4*)(PAR + 128 + cl), kk4 = *(const LAS f32x4*)(PAR + 256 + cl);
            const f32x4 ka4 = *(const LAS f32x4*)(PAR + 384 + cl), rk4 = *(const LAS f32x4*)(PAR + 512 + cl), v04 = *(const LAS f32x4*)(PAR + 640 + cl);
            f32x4 oa, ob, od, ok, ord_, ov;
#pragma unroll
            for (int j = 0; j < 4; ++j) {
                const float dcy = __expf(-0.60653065971f * fsig(w0[j] + dl[j]));
                const float av_ = fsig(a0[j] + al[j]);
                float vj = vz[j];
                if (l == 1) { const float vmix = fsig(v04[j] + vm[j]); vj = vj + (vf[nt][j] - vj) * vmix; }
                const float kk = kz[j] * kk4[j] * inv, k2 = kz[j] * (1.f + (av_ - 1.f) * ka4[j]);
                oa[j] = -kk; ob[j] = kk * av_; od[j] = dcy; ok[j] = k2; ord_[j] = rz[j] * dcy; ov[j] = vj;
                br += ob[j] * rz[j]; kr += k2 * rz[j]; rkr += rz[j] * k2 * rk4[j];
            }
            const size_t o = (size_t)m * 512 + ch;
            st_bf4((bf16_t*)SA + o, oa); st_bf4((bf16_t*)SB + o, ob); *(f32x4*)(SD + o) = od; st_bf4((bf16_t*)SK + o, ok); st_bf4((bf16_t*)SRD + o, ord_); st_bf4((bf16_t*)SV + o, ov); { u32x2 gw2; gw2.x = cvt_pk_bf16(gl[0], gl[1]); gw2.y = cvt_pk_bf16(gl[2], gl[3]); *(u32x2*)((bf16_t*)GG + o) = gw2; }
            __builtin_amdgcn_sched_barrier(0);
        }
        br += __shfl_xor(br, 16); br += __shfl_xor(br, 32); kr += __shfl_xor(kr, 16); kr += __shfl_xor(kr, 32); rkr += __shfl_xor(rkr, 16); rkr += __shfl_xor(rkr, 32);
        if (fq == 0) { SBR[m * 8 + h] = br; SKR[m * 8 + h] = kr; RKR[m * 8 + h] = rkr; }
        }
        __syncthreads();
    }
}

__device__ __forceinline__ void convB_token(const Args& a, int l, int m, int lane) {
    unsigned char* ws = a.ws;
    const bf16_t* __restrict__ PROJ = (const bf16_t*)(ws + OFF_PROJ);
    bf16_t* __restrict__ YAB = (bf16_t*)(ws + OFF_YAB);
    const int cb = lane * 8;
        const bf16_t* pr = PROJ + (size_t)m * LDP;
        float gb[8], gc[8], hi[8], u0[8], u1[8], u2[8];
        unpack8(*(const u32x4*)(pr + 1792 + cb), gb); unpack8(*(const u32x4*)(pr + 2304 + cb), gc); unpack8(*(const u32x4*)(pr + 2816 + cb), hi);
#pragma unroll
        for (int j = 0; j < 8; ++j) { u0[j] = gc[j] * hi[j]; u1[j] = 0.f; u2[j] = 0.f; }
        if (m < MP) {
            const int t = m & 2047;
            if (t >= 1) { unpack8(*(const u32x4*)(pr - LDP + 2304 + cb), gc); unpack8(*(const u32x4*)(pr - LDP + 2816 + cb), hi);
#pragma unroll
                for (int j = 0; j < 8; ++j) u1[j] = gc[j] * hi[j]; }
            if (t >= 2) { unpack8(*(const u32x4*)(pr - 2 * LDP + 2304 + cb), gc); unpack8(*(const u32x4*)(pr - 2 * LDP + 2816 + cb), hi);
#pragma unroll
                for (int j = 0; j < 8; ++j) u2[j] = gc[j] * hi[j]; }
            if (t >= 2046) { float* dst = a.out + O_CONVP + (size_t)((l * NB + (m >> 11)) * 2 + (t - 2046)) * 512 + cb;
                *(f32x4*)dst = (f32x4){u0[0], u0[1], u0[2], u0[3]}; *(f32x4*)(dst + 4) = (f32x4){u0[4], u0[5], u0[6], u0[7]}; }
        } else {
            const int i = m - MP; const float* sc = a.in[I_SCONV] + (size_t)(l * NS + i) * 2 * 512 + cb;
            const f32x4 a0 = *(const f32x4*)sc, a1 = *(const f32x4*)(sc + 4), b0 = *(const f32x4*)(sc + 512), b1 = *(const f32x4*)(sc + 516);
#pragma unroll
            for (int j = 0; j < 4; ++j) { u2[j] = a0[j]; u2[4 + j] = a1[j]; u1[j] = b0[j]; u1[4 + j] = b1[j]; }
            float* dst = a.out + O_CONVS + (size_t)(l * NS + i) * 2 * 512 + cb;
            *(f32x4*)dst = b0; *(f32x4*)(dst + 4) = b1;
            *(f32x4*)(dst + 512) = (f32x4){u0[0], u0[1], u0[2], u0[3]}; *(f32x4*)(dst + 516) = (f32x4){u0[4], u0[5], u0[6], u0[7]};
        }
        const float* cw = a.in[I_CONVW] + (size_t)l * 3 * 512 + cb;
        float ob[8];
#pragma unroll
        for (int j = 0; j < 8; ++j) ob[j] = gb[j] * (cw[j] * u2[j] + cw[512 + j] * u1[j] + cw[1024 + j] * u0[j]);
        u32x4 w2; w2.x = pk2(ob[0], ob[1]); w2.y = pk2(ob[2], ob[3]); w2.z = pk2(ob[4], ob[5]); w2.w = pk2(ob[6], ob[7]);
        *(u32x4*)(YAB + (size_t)m * 1024 + 512 + cb) = w2;
}

typedef float f32x2 __attribute__((ext_vector_type(2)));
__device__ __forceinline__ float scan_step(float (&s)[4], const f32x4 av, const f32x4 bv, const f32x4 dv, const f32x4 kv, const f32x4 rd, float vi, float br, float kr) {
    f32x2 s01 = (f32x2){s[0], s[1]}, s23 = (f32x2){s[2], s[3]};
    f32x2 t = s01 * (f32x2){av[0], av[1]}; t = __builtin_elementwise_fma(s23, (f32x2){av[2], av[3]}, t);
    f32x2 u = s01 * (f32x2){rd[0], rd[1]}; u = __builtin_elementwise_fma(s23, (f32x2){rd[2], rd[3]}, u);
    float pa = t.x + t.y, py = u.x + u.y;
    pa = red16(pa); py = red16(py);
    const f32x2 pav = (f32x2){pa, pa}, viv = (f32x2){vi, vi};
    f32x2 w01 = (f32x2){kv[0], kv[1]} * viv; w01 = __builtin_elementwise_fma((f32x2){bv[0], bv[1]}, pav, w01);
    f32x2 w23 = (f32x2){kv[2], kv[3]} * viv; w23 = __builtin_elementwise_fma((f32x2){bv[2], bv[3]}, pav, w23);
    s01 = __builtin_elementwise_fma(s01, (f32x2){dv[0], dv[1]}, w01);
    s23 = __builtin_elementwise_fma(s23, (f32x2){dv[2], dv[3]}, w23);
    s[0] = s01.x; s[1] = s01.y; s[2] = s23.x; s[3] = s23.y;
    return py + pa * br + vi * kr;
}

__device__ __forceinline__ void scan_phase(LAS unsigned char* lds, const Args& a, int l, int tid, int lane, int wave) {
    unsigned char* ws = a.ws;
    const float* SA = (const float*)(ws + OFF_SA); const float* SB = (const float*)(ws + OFF_SB); const float* SD = (const float*)(ws + OFF_SD); const float* SK = (const float*)(ws + OFF_SK);
    const float* SRD = (const float*)(ws + OFF_SRD); const float* SV = (const float*)(ws + (l == 0 ? OFF_SV0 : OFF_SV1));
    const float* SBR = (const float*)(ws + OFF_SBR); const float* SKR = (const float*)(ws + OFF_SKR);
    float* Y = (float*)(ws + OFF_Y);
    constexpr int TC = 32, CB = 5 * TC * 64 + TC * 16 + 2 * TC;
    LAS float* L = (LAS float*)lds;
    const int j4 = lane >> 4, c = lane & 15;
    for (int ci = blockIdx.x; ci < 256; ci += gridDim.x) {
        const int hc = ci >> 2, rg = ci & 3, b = hc >> 3, h = hc & 7;
        const int st = tid >> 4, c16 = tid & 15;
        const int rl = (wave & 3) * 4 + j4;
        float s[4] = {0.f, 0.f, 0.f, 0.f};
        u32x2 pa, pb, pk, pr; f32x4 pd; bf16_t pv; float ps = 0.f;
        {
            const size_t m = (size_t)b * 2048 + st; const size_t o = m * 512 + h * 64 + c16 * 4;
            pa = *(const u32x2*)((const bf16_t*)SA + o); pb = *(const u32x2*)((const bf16_t*)SB + o); pd = *(const f32x4*)(SD + o); pk = *(const u32x2*)((const bf16_t*)SK + o); pr = *(const u32x2*)((const bf16_t*)SRD + o);
            pv = ((const bf16_t*)SV)[m * 512 + h * 64 + rg * 16 + c16];
            if (tid < 32) ps = SBR[((size_t)b * 2048 + tid) * 8 + h]; else if (tid < 64) ps = SKR[((size_t)b * 2048 + tid - 32) * 8 + h];
        }
        {
            LAS float* B0 = L;
            *(LAS f32x4*)(B0 + st * 64 + c16 * 4) = (f32x4){bflo(pa.x), bfhi(pa.x), bflo(pa.y), bfhi(pa.y)}; *(LAS f32x4*)(B0 + 2048 + st * 64 + c16 * 4) = (f32x4){bflo(pb.x), bfhi(pb.x), bflo(pb.y), bfhi(pb.y)}; *(LAS f32x4*)(B0 + 4096 + st * 64 + c16 * 4) = pd;
            *(LAS f32x4*)(B0 + 6144 + st * 64 + c16 * 4) = (f32x4){bflo(pk.x), bfhi(pk.x), bflo(pk.y), bfhi(pk.y)}; *(LAS f32x4*)(B0 + 8192 + st * 64 + c16 * 4) = (f32x4){bflo(pr.x), bfhi(pr.x), bflo(pr.y), bfhi(pr.y)}; B0[10240 + st * 16 + c16] = bf2f(pv);
            if (tid < 64) B0[10752 + tid] = ps;
        }
        __syncthreads();
        for (int n = 0; n < TT / TC; ++n) {
            LAS float* Bc = L + (n & 1) * CB; LAS float* Bn = L + ((n + 1) & 1) * CB; LAS float* yb = L + 2 * CB + (n & 1) * 512;
            const bool more = n + 1 < TT / TC;
            if (more) {
                const size_t m = (size_t)b * 2048 + (n + 1) * TC + st; const size_t o = m * 512 + h * 64 + c16 * 4;
                pa = *(const u32x2*)((const bf16_t*)SA + o); pb = *(const u32x2*)((const bf16_t*)SB + o); pd = *(const f32x4*)(SD + o); pk = *(const u32x2*)((const bf16_t*)SK + o); pr = *(const u32x2*)((const bf16_t*)SRD + o);
                pv = ((const bf16_t*)SV)[m * 512 + h * 64 + rg * 16 + c16];
                if (tid < 32) ps = SBR[((size_t)b * 2048 + (n + 1) * TC + tid) * 8 + h]; else if (tid < 64) ps = SKR[((size_t)b * 2048 + (n + 1) * TC + tid - 32) * 8 + h];
            }
            if (wave < 4) {
                LAS float* ybase = (c == 0) ? (yb + rl) : (L + 2 * CB + 1024 + lane);
                const LAS float* p0 = Bc + c * 4;
                f32x4 av = *(const LAS f32x4*)p0, bv = *(const LAS f32x4*)(p0 + 2048), dv = *(const LAS f32x4*)(p0 + 4096), kv = *(const LAS f32x4*)(p0 + 6144), rd = *(const LAS f32x4*)(p0 + 8192);
                float vi = Bc[10240 + rl], br = Bc[10752], kr = Bc[10784];
#pragma unroll 8
                for (int t = 0; t < TC; ++t) {
                    const int tn = (t + 1 < TC) ? t + 1 : t;
                    const LAS float* p = Bc + tn * 64 + c * 4;
                    const f32x4 av2 = *(const LAS f32x4*)p, bv2 = *(const LAS f32x4*)(p + 2048), dv2 = *(const LAS f32x4*)(p + 4096), kv2 = *(const LAS f32x4*)(p + 6144), rd2 = *(const LAS f32x4*)(p + 8192);
                    const float vi2 = Bc[10240 + tn * 16 + rl], br2 = Bc[10752 + tn], kr2 = Bc[10784 + tn];
                    const float y = scan_step(s, av, bv, dv, kv, rd, vi, br, kr);
                    ybase[t * 16] = y;
                    av = av2; bv = bv2; dv = dv2; kv = kv2; rd = rd2; vi = vi2; br = br2; kr = kr2;
                }
            }
            else {
                const int hw4 = wave - 4;
                if (l == 0 && n < 14) {
                    const int d = (blockIdx.x * 4 + hw4) + 1024 * n;
                    if (d < TR_DEFERRED) tr_deferred(a, ws, d, (LAS float*)(lds + 94208 + hw4 * 8448), lane);
                } else if (n >= 24 && n < 41) {
                    const int tt = (n - 24) * 4 + hw4;
                    int mB = -1;
                    if (tt < 64) mB = blockIdx.x * 64 + tt; else if (tt == 64 && blockIdx.x < NS) mB = MP + blockIdx.x;
                    if (mB >= 0) convB_token(a, l, mB, lane);
                } else if (n >= 20 && n < 24) {
                    const int q = blockIdx.x + gridDim.x * (n - 20);
                    if (q < NS * 8) {
                        const int i = q >> 3, hs = q & 7; const size_t ms = MP + i;
                        const size_t o = ms * 512 + hs * 64 + c * 4;
                        const f32x4 av = ld_bf4((const bf16_t*)SA + o), bv = ld_bf4((const bf16_t*)SB + o), dv = *(const f32x4*)(SD + o), kv = ld_bf4((const bf16_t*)SK + o), rd = ld_bf4((const bf16_t*)SRD + o);
                        const float br = SBR[ms * 8 + hs], kr = SKR[ms * 8 + hs];
#pragma unroll 1
                        for (int p4 = 0; p4 < 4; ++p4) {
                            const int row = p4 * 16 + hw4 * 4 + j4;
                            const size_t so = ((size_t)((l * NS + i) * 8 + hs)) * 4096 + row * 64 + c * 4;
                            const f32x4 s4 = *(const f32x4*)(a.in[I_SWKV] + so);
                            const float vi = bf2f(((const bf16_t*)SV)[ms * 512 + hs * 64 + row]);
                            float ss_[4] = {s4[0], s4[1], s4[2], s4[3]};
                            const float y = scan_step(ss_, av, bv, dv, kv, rd, vi, br, kr);
                            *(f32x4*)(a.out + O_WKVS + so) = (f32x4){ss_[0], ss_[1], ss_[2], ss_[3]};
                            if (c == 0) ((bf16_t*)Y)[ms * 512 + hs * 64 + row] = (bf16_t)f2bf(y);
                        }
                    }
                }
            }
            if (more) {
                *(LAS f32x4*)(Bn + st * 64 + c16 * 4) = (f32x4){bflo(pa.x), bfhi(pa.x), bflo(pa.y), bfhi(pa.y)}; *(LAS f32x4*)(Bn + 2048 + st * 64 + c16 * 4) = (f32x4){bflo(pb.x), bfhi(pb.x), bflo(pb.y), bfhi(pb.y)}; *(LAS f32x4*)(Bn + 4096 + st * 64 + c16 * 4) = pd;
                *(LAS f32x4*)(Bn + 6144 + st * 64 + c16 * 4) = (f32x4){bflo(pk.x), bfhi(pk.x), bflo(pk.y), bfhi(pk.y)}; *(LAS f32x4*)(Bn + 8192 + st * 64 + c16 * 4) = (f32x4){bflo(pr.x), bfhi(pr.x), bflo(pr.y), bfhi(pr.y)}; Bn[10240 + st * 16 + c16] = bf2f(pv);
                if (tid < 64) Bn[10752 + tid] = ps;
            }
            __syncthreads();
            ((bf16_t*)Y)[((size_t)b * 2048 + n * TC + st) * 512 + h * 64 + rg * 16 + c16] = (bf16_t)f2bf(yb[st * 16 + c16]);
        }
        if (wave < 4) {
            float* o = a.out + O_WKVP + ((size_t)((l * 8 + b) * 8 + h)) * 4096 + (rg * 16 + rl) * 64 + c * 4;
            *(f32x4*)o = (f32x4){s[0], s[1], s[2], s[3]};
        }
        __syncthreads();
    }
}

__device__ __forceinline__ void post_phase(const Args& a, int l, int lane, int gw, int NGW) {
    unsigned char* ws = a.ws;
    const bf16_t* __restrict__ PROJ = (const bf16_t*)(ws + OFF_PROJ);
    const float* __restrict__ Y = (const float*)(ws + OFF_Y); const float* __restrict__ SV = (const float*)(ws + (l == 0 ? OFF_SV0 : OFF_SV1)); const float* __restrict__ GG = (const float*)(ws + OFF_G);
    const float* __restrict__ RKR = (const float*)(ws + OFF_RKR);
    bf16_t* __restrict__ YAB = (bf16_t*)(ws + OFF_YAB);
    const int cb = lane * 8, h = lane >> 3;
#pragma unroll 4
    for (int m = gw; m < MTOK; m += NGW) {
        const size_t o = (size_t)m * 512 + cb;
        f32x4 y0, y1; { const u32x4 yq = *(const u32x4*)((const bf16_t*)Y + o); y0 = (f32x4){bflo(yq.x), bfhi(yq.x), bflo(yq.y), bfhi(yq.y)}; y1 = (f32x4){bflo(yq.z), bfhi(yq.z), bflo(yq.w), bfhi(yq.w)}; }
        float s = (y0[0] + y0[1]) + (y0[2] + y0[3]) + (y1[0] + y1[1]) + (y1[2] + y1[3]);
        s += __shfl_xor(s, 1); s += __shfl_xor(s, 2); s += __shfl_xor(s, 4);
        const float mean = s * (1.f / 64.f);
        const f32x4 d0 = y0 - mean, d1 = y1 - mean;
        float q = (d0[0] * d0[0] + d0[1] * d0[1]) + (d0[2] * d0[2] + d0[3] * d0[3]) + (d1[0] * d1[0] + d1[1] * d1[1]) + (d1[2] * d1[2] + d1[3] * d1[3]);
        q += __shfl_xor(q, 1); q += __shfl_xor(q, 2); q += __shfl_xor(q, 4);
        const float rstd = rsqrtf(q * (1.f / 64.f) + GN_EPS);
        const float rkr = RKR[m * 8 + h];
        f32x4 v0, v1; { const u32x4 vq = *(const u32x4*)((const bf16_t*)SV + o); v0 = (f32x4){bflo(vq.x), bfhi(vq.x), bflo(vq.y), bfhi(vq.y)}; v1 = (f32x4){bflo(vq.z), bfhi(vq.z), bflo(vq.w), bfhi(vq.w)}; } f32x4 g0, g1; { const u32x4 gq = *(const u32x4*)((const bf16_t*)GG + o); g0 = (f32x4){bflo(gq.x), bfhi(gq.x), bflo(gq.y), bfhi(gq.y)}; g1 = (f32x4){bflo(gq.z), bfhi(gq.z), bflo(gq.w), bfhi(gq.w)}; }
        const f32x4 lw0 = *(const f32x4*)(a.in[I_LNW] + l * 512 + cb), lw1 = *(const f32x4*)(a.in[I_LNW] + l * 512 + cb + 4);
        const f32x4 lb0 = *(const f32x4*)(a.in[I_LNB] + l * 512 + cb), lb1 = *(const f32x4*)(a.in[I_LNB] + l * 512 + cb + 4);
        const f32x4 r0 = (d0 * rstd * lw0 + lb0 + v0 * rkr) * g0, r1 = (d1 * rstd * lw1 + lb1 + v1 * rkr) * g1;
        u32x4 w; w.x = pk2(r0[0], r0[1]); w.y = pk2(r0[2], r0[3]); w.z = pk2(r1[0], r1[1]); w.w = pk2(r1[2], r1[3]);
        *(u32x4*)(YAB + (size_t)m * 1024 + cb) = w;
    }
    if (l + 1 < 2 && gw < NS) {
        bf16_t* XB = (bf16_t*)(ws + OFF_XB) + (size_t)(MTOK + gw) * D;
        const float* src = a.in[I_SSHIFT] + (size_t)((l + 1) * NS + gw) * D; const float* gn = a.in[I_NMIX] + (l + 1) * D;
#pragma unroll
        for (int j = 0; j < 4; ++j) { const f32x4 v = *(const f32x4*)(src + 4 * lane + 256 * j), g4 = *(const f32x4*)(gn + 4 * lane + 256 * j);
            u32x2 w; w.x = pk2(v[0] / g4[0], v[1] / g4[1]); w.y = pk2(v[2] / g4[2], v[3] / g4[3]); *(u32x2*)(XB + 4 * lane + 256 * j) = w; }
    }
}

__device__ __forceinline__ void sample_attn(LAS unsigned char* lds, const Args& a, int l, int tid, int lane, int wave) {
    unsigned char* ws = a.ws;
    const bf16_t* Q = (const bf16_t*)(ws + OFF_Q); bf16_t* O = (bf16_t*)(ws + OFF_O);
    LAS float* sc = (LAS float*)lds;
    LAS float* part = sc + 256;
    for (int q = blockIdx.x; q < NS * 4; q += gridDim.x) {
        const int i = q >> 2, h = q & 3;
        const u32x2 qw = *(const u32x2*)(Q + (size_t)(MP + i) * 1024 + h * 256 + lane * 4);
        const float q0 = bflo(qw.x), q1 = bfhi(qw.x), q2 = bflo(qw.y), q3 = bfhi(qw.y);
        const float* Kb = a.in[I_CK] + ((size_t)((l * NS + i) * 256) * 4 + h) * 256 + lane * 4;
        const float* Vb = a.in[I_CV] + ((size_t)((l * NS + i) * 256) * 4 + h) * 256 + lane * 4;
        {
            f32x4 kx[8], kn[8];
#pragma unroll
            for (int e = 0; e < 8; ++e) kx[e] = __builtin_nontemporal_load((const f32x4*)(Kb + (size_t)(wave * 32 + e) * 1024));
#pragma unroll
            for (int g8 = 0; g8 < 4; ++g8) {
                if (g8 < 3) {
#pragma unroll
                    for (int e = 0; e < 8; ++e) kn[e] = __builtin_nontemporal_load((const f32x4*)(Kb + (size_t)(wave * 32 + (g8 + 1) * 8 + e) * 1024));
                }
#pragma unroll
                for (int e = 0; e < 8; ++e) { float p = kx[e][0] * q0 + kx[e][1] * q1 + kx[e][2] * q2 + kx[e][3] * q3; p = wave_sum(p); if (lane == 0) sc[wave * 32 + g8 * 8 + e] = p; }
#pragma unroll
                for (int e = 0; e < 8; ++e) kx[e] = kn[e];
            }
        }
        __syncthreads();
        if (wave == 0) {
            const f32x4 s4 = *(const LAS f32x4*)(sc + lane * 4);
            const float mx = wave_max(fmaxf(fmaxf(s4[0], s4[1]), fmaxf(s4[2], s4[3])));
            f32x4 e4; e4[0] = __expf(s4[0] - mx); e4[1] = __expf(s4[1] - mx); e4[2] = __expf(s4[2] - mx); e4[3] = __expf(s4[3] - mx);
            const float inv = 1.f / wave_sum((e4[0] + e4[1]) + (e4[2] + e4[3]));
            *(LAS f32x4*)(sc + lane * 4) = e4 * inv;
        }
        __syncthreads();
        f32x4 acc = (f32x4){0.f, 0.f, 0.f, 0.f};
        {
            f32x4 vx[8], vn[8];
#pragma unroll
            for (int e = 0; e < 8; ++e) vx[e] = __builtin_nontemporal_load((const f32x4*)(Vb + (size_t)(wave * 32 + e) * 1024));
#pragma unroll
            for (int g8 = 0; g8 < 4; ++g8) {
                if (g8 < 3) {
#pragma unroll
                    for (int e = 0; e < 8; ++e) vn[e] = __builtin_nontemporal_load((const f32x4*)(Vb + (size_t)(wave * 32 + (g8 + 1) * 8 + e) * 1024));
                }
#pragma unroll
                for (int e = 0; e < 8; ++e) acc += vx[e] * sc[wave * 32 + g8 * 8 + e];
#pragma unroll
                for (int e = 0; e < 8; ++e) vx[e] = vn[e];
            }
        }
        *(LAS f32x4*)(part + wave * 256 + lane * 4) = acc;
        __syncthreads();
        if (tid < 256) {
            float s = 0.f;
#pragma unroll
            for (int w = 0; w < 8; ++w) s += part[w * 256 + tid];
            O[(size_t)(MP + i) * 1024 + h * 256 + tid] = (bf16_t)f2bf(s);
        }
        __syncthreads();
    }
}

__device__ __forceinline__ void ffnconv_phase(const Args& a, int l, int tid) {
    unsigned char* ws = a.ws;
    const bf16_t* __restrict__ UP = (const bf16_t*)(ws + OFF_UP); bf16_t* __restrict__ H = (bf16_t*)(ws + OFF_H);
    const float* __restrict__ cw = a.in[I_FCW] + (size_t)l * 3 * FW2;
    constexpr int CH = FW / 8;
    for (int rb = blockIdx.x; rb < MP / 64; rb += gridDim.x) {
        if (tid < CH) {
            const int c = tid * 8, r0 = rb * 64, t0 = r0 & 2047;
            float wu[3][8], wg[3][8];
#pragma unroll
            for (int k = 0; k < 3; ++k) {
                const f32x4 a0 = *(const f32x4*)(cw + k * FW2 + c), a1 = *(const f32x4*)(cw + k * FW2 + c + 4), b0 = *(const f32x4*)(cw + k * FW2 + FW + c), b1 = *(const f32x4*)(cw + k * FW2 + FW + c + 4);
#pragma unroll
                for (int j = 0; j < 4; ++j) { wu[k][j] = a0[j]; wu[k][4 + j] = a1[j]; wg[k][j] = b0[j]; wg[k][4 + j] = b1[j]; }
            }
            float u2[8], u1[8], g2[8], g1[8];
#pragma unroll
            for (int j = 0; j < 8; ++j) { u2[j] = 0.f; u1[j] = 0.f; g2[j] = 0.f; g1[j] = 0.f; }
            if (t0 >= 2) {
                const bf16_t* p = UP + (size_t)(r0 - 2) * FW2 + c;
                unpack8(*(const u32x4*)p, u2); unpack8(*(const u32x4*)(p + FW), g2); unpack8(*(const u32x4*)(p + FW2), u1); unpack8(*(const u32x4*)(p + FW2 + FW), g1);
            }
            const bf16_t* p = UP + (size_t)r0 * FW2 + c; bf16_t* hp = H + (size_t)r0 * FW + c;
#pragma unroll 1
            for (int r = 0; r < 64; r += 4) {
                u32x4 lu[4], lg[4];
#pragma unroll
                for (int e = 0; e < 4; ++e) { lu[e] = *(const u32x4*)(p + (size_t)(r + e) * FW2); lg[e] = *(const u32x4*)(p + (size_t)(r + e) * FW2 + FW); }
#pragma unroll
                for (int e = 0; e < 4; ++e) {
                    float u0[8], g0[8], hh[8]; unpack8(lu[e], u0); unpack8(lg[e], g0);
#pragma unroll
                    for (int j = 0; j < 8; ++j) {
                        const float uu = wu[0][j] * u2[j] + wu[1][j] * u1[j] + wu[2][j] * u0[j], gg = wg[0][j] * g2[j] + wg[1][j] * g1[j] + wg[2][j] * g0[j];
                        hh[j] = gg * __builtin_amdgcn_rcpf(1.f + __expf(-gg)) * uu;
                        u2[j] = u1[j]; u1[j] = u0[j]; g2[j] = g1[j]; g1[j] = g0[j];
                    }
                    u32x4 w; w.x = cvt_pk_bf16(hh[0], hh[1]); w.y = cvt_pk_bf16(hh[2], hh[3]); w.z = cvt_pk_bf16(hh[4], hh[5]); w.w = cvt_pk_bf16(hh[6], hh[7]);
                    *(u32x4*)(hp + (size_t)(r + e) * FW) = w;
                }
            }
        }
    }
    for (int it = blockIdx.x * 512 + tid; it < NS * CH; it += gridDim.x * 512) {
        const int i = it / CH, c = (it % CH) * 8, m = MP + i;
        const bf16_t* r0 = UP + (size_t)m * FW2;
        float u[8], g[8], t0[8], t1[8];
        unpack8(*(const u32x4*)(r0 + c), t0); unpack8(*(const u32x4*)(r0 + FW + c), t1);
        const float* sf = a.in[I_SFFN] + (size_t)(l * NS + i) * 2 * FW2;
        float* dst = a.out + O_FFNS + (size_t)(l * NS + i) * 2 * FW2;
        float hh[8];
#pragma unroll
        for (int q = 0; q < 2; ++q) {
            const int cc = c + 4 * q;
            const f32x4 p0u = *(const f32x4*)(sf + cc), p0g = *(const f32x4*)(sf + FW + cc), p1u = *(const f32x4*)(sf + FW2 + cc), p1g = *(const f32x4*)(sf + FW2 + FW + cc);
            const f32x4 w0u = *(const f32x4*)(cw + cc), w1u = *(const f32x4*)(cw + FW2 + cc), w2u = *(const f32x4*)(cw + 2 * FW2 + cc);
            const f32x4 w0g = *(const f32x4*)(cw + FW + cc), w1g = *(const f32x4*)(cw + FW2 + FW + cc), w2g = *(const f32x4*)(cw + 2 * FW2 + FW + cc);
            *(f32x4*)(dst + cc) = p1u; *(f32x4*)(dst + FW + cc) = p1g;
#pragma unroll
            for (int j = 0; j < 4; ++j) {
                u[4 * q + j] = w2u[j] * t0[4 * q + j] + w0u[j] * p0u[j] + w1u[j] * p1u[j]; g[4 * q + j] = w2g[j] * t1[4 * q + j] + w0g[j] * p0g[j] + w1g[j] * p1g[j];
                hh[4 * q + j] = g[4 * q + j] * sigmoidf_(g[4 * q + j]) * u[4 * q + j];
            }
        }
        u32x4 w; w.x = pk2(hh[0], hh[1]); w.y = pk2(hh[2], hh[3]); w.z = pk2(hh[4], hh[5]); w.w = pk2(hh[6], hh[7]);
        *(u32x4*)(H + (size_t)m * FW + c) = w;
    }
}

__device__ __forceinline__ void final_phase(const Args& a, int lane, int gw, int NGW) {
    unsigned char* ws = a.ws;
    const bf16_t* __restrict__ X = (const bf16_t*)(ws + OFF_XB); const float* __restrict__ SS = (const float*)(ws + OFF_SS) + (size_t)6 * MROWS;
    float* __restrict__ outp = a.out;
#pragma unroll 4
    for (int m = gw; m < MTOK; m += NGW) {
        const float rs = rsqrtf(SS[m] * (1.f / 1024.f) + EPS);
        float* __restrict__ dst = m < MP ? outp + O_YP + (size_t)m * D : outp + O_YS + (size_t)(m - MP) * D;
#pragma unroll
        for (int j = 0; j < 4; ++j) { const u32x2 xw = *(const u32x2*)(X + (size_t)m * D + 4 * lane + 256 * j); const f32x4 v = (f32x4){bflo(xw.x), bfhi(xw.x), bflo(xw.y), bfhi(xw.y)}, gn = *(const f32x4*)(a.in[I_NFIN] + 4 * lane + 256 * j);
            *(f32x4*)(dst + 4 * lane + 256 * j) = v * rs * gn; }
    }
}

__device__ __forceinline__ void skinny_gemm(LAS unsigned char* lds, const bf16_t* __restrict__ A, int lda, const bf16_t* __restrict__ Wt, int K, int mode, float* X, bf16_t* O, float* ssn, const float* ss, int lane, int wave) {
    LAS f32x4* part = (LAS f32x4*)lds;
    for (int item = blockIdx.x; item < 256; item += gridDim.x) {
        const int n0 = (item & 63) * 16, r0 = MP + (item >> 6) * 32, fr = lane & 15, fq = lane >> 4;
        const bf16_t* ap = A + (size_t)(r0 + fr) * lda + fq * 8;
        const bf16_t* bp = Wt + (size_t)(n0 + fr) * K + fq * 8;
        f32x4 acc0 = (f32x4){0.f, 0.f, 0.f, 0.f}, acc1 = acc0;
#pragma unroll 4
        for (int ks = wave; ks < K / 32; ks += 8) {
            const bf16x8 bf = *(const bf16x8*)(bp + ks * 32), a0 = *(const bf16x8*)(ap + ks * 32), a1 = *(const bf16x8*)(ap + (size_t)16 * lda + ks * 32);
            acc0 = __builtin_amdgcn_mfma_f32_16x16x32_bf16(bf, a0, acc0, 0, 0, 0);
            acc1 = __builtin_amdgcn_mfma_f32_16x16x32_bf16(bf, a1, acc1, 0, 0, 0);
        }
        part[(wave * 2 + 0) * 64 + lane] = acc0; part[(wave * 2 + 1) * 64 + lane] = acc1;
        __syncthreads();
        if (wave < 2) {
            f32x4 acc = part[wave * 64 + lane];
#pragma unroll
            for (int w = 1; w < 8; ++w) acc += part[(w * 2 + wave) * 64 + lane];
            const int row = r0 + wave * 16 + fr, col = n0 + fq * 4;
            const size_t idx = (size_t)row * 1024 + col;
            if (mode == 1) {
                const u32x2 xi = *(const u32x2*)(O + idx);
                const f32x4 x = (f32x4){bflo(xi.x), bfhi(xi.x), bflo(xi.y), bfhi(xi.y)} + acc;
                u32x2 w; w.x = cvt_pk_bf16(x[0], x[1]); w.y = cvt_pk_bf16(x[2], x[3]); *(u32x2*)(O + idx) = w;
                float sq = (x[0] * x[0] + x[1] * x[1]) + (x[2] * x[2] + x[3] * x[3]);
                sq += __shfl_xor(sq, 16); sq += __shfl_xor(sq, 32);
                if (fq == 0) atomicAdd(ssn + row, sq);
            } else {
                const float rs = rsqrtf(ss[row] * (1.f / 1024.f) + EPS);
                u32x2 w; w.x = cvt_pk_bf16(acc[0] * rs, acc[1] * rs); w.y = cvt_pk_bf16(acc[2] * rs, acc[3] * rs); *(u32x2*)(O + idx) = w;
            }
        }
        __syncthreads();
    }
}

#define XB_TMO      128
#define XB_XCNT(j)  (256  + 64 * (j))
#define XB_XSUB(j)  (1280 + 64 * (j))
#define XB_XGEN(j)  (2304 + 64 * (j))
#define XB_TOP      3328
#define XB_TOPGEN   3392
#define XCD_BAR_WORDS 3456
#define XB_SPIN_CAP (1u << 22)
__device__ __forceinline__ unsigned xb_ld(unsigned* p)              { return __hip_atomic_load(p, __ATOMIC_RELAXED, __HIP_MEMORY_SCOPE_AGENT); }
__device__ __forceinline__ unsigned xb_add(unsigned* p, unsigned v) { return __hip_atomic_fetch_add(p, v, __ATOMIC_RELAXED, __HIP_MEMORY_SCOPE_AGENT); }
__device__ __forceinline__ unsigned xb_xcc_id() { return (unsigned)__builtin_amdgcn_s_getreg((3 << 11) | 20) & 0xFu; }
#define XB_SPIN(cond, bar) do { unsigned _sp = 0; while (cond) { __builtin_amdgcn_s_sleep(1); \
    if ((++_sp & 255u) == 0u) { if (xb_ld(&(bar)[XB_TMO])) break; if (_sp > XB_SPIN_CAP) { atomicAdd(&(bar)[XB_TMO], 1u); break; } } } } while (0)
struct XcdBarrier { unsigned* bar; unsigned x; volatile LAS unsigned* st; };
__device__ __forceinline__ XcdBarrier xcd_barrier_post(unsigned* bar, volatile LAS unsigned* st) {
    XcdBarrier b; b.bar = bar; b.x = xb_xcc_id(); b.st = st;
    if (threadIdx.x == 0) (void)xb_add(&bar[XB_XCNT(b.x)], 1u);
    return b;
}
__device__ __forceinline__ void xcd_barrier_complete(unsigned* bar, unsigned x, unsigned& nloc, unsigned& nx) {
    const unsigned G = gridDim.x * gridDim.y * gridDim.z;
    unsigned sum, cnt, mine, sp = 0u;
    for (;;) {
        sum = 0u; cnt = 0u; mine = 0u;
#pragma unroll
        for (unsigned j = 0; j < 16; ++j) { const unsigned c = xb_ld(&bar[XB_XCNT(j)]); sum += c; cnt += (c > 0u) ? 1u : 0u; mine = (j == x) ? c : mine; }
        if (sum == G) break;
        __builtin_amdgcn_s_sleep(1);
        if ((++sp & 255u) == 0u) { if (xb_ld(&bar[XB_TMO])) break; if (sp > XB_SPIN_CAP) { atomicAdd(&bar[XB_TMO], 1u); break; } }
    }
    nloc = mine > 0u ? mine : 1u; nx = cnt > 0u ? cnt : 1u;
}
__device__ __forceinline__ void xcd_barrier(const XcdBarrier& b) {
    asm volatile("s_waitcnt vmcnt(0)" ::: "memory");
    __syncthreads();
    if (threadIdx.x == 0) {
        unsigned* bar = b.bar;
        __builtin_amdgcn_s_waitcnt(0);
        unsigned nloc = b.st[0], nx = b.st[1];
        if (nloc == 0u) { xcd_barrier_complete(bar, b.x, nloc, nx); b.st[0] = nloc; b.st[1] = nx; }
        const unsigned old = xb_add(&bar[XB_XSUB(b.x)], 1u);
        const unsigned gen = old / nloc;
        if (old + 1u == (gen + 1u) * nloc) {
            __builtin_amdgcn_fence(__ATOMIC_RELEASE, "agent");
            asm volatile("s_waitcnt vmcnt(0)" ::: "memory");
            const unsigned og = xb_add(&bar[XB_TOP], 1u);
            const unsigned tg = og / nx;
            if (og + 1u == (tg + 1u) * nx) xb_add(&bar[XB_TOPGEN], 1u);
            else XB_SPIN(xb_ld(&bar[XB_TOPGEN]) == tg, bar);
            __builtin_amdgcn_fence(__ATOMIC_ACQUIRE, "agent");
            xb_add(&bar[XB_XGEN(b.x)], 1u);
            asm volatile("s_waitcnt vmcnt(0)" ::: "memory");
        } else {
            XB_SPIN(xb_ld(&bar[XB_XGEN(b.x)]) == gen, bar);
            __builtin_amdgcn_fence(__ATOMIC_ACQUIRE, "agent");
            asm volatile("s_waitcnt vmcnt(0)" ::: "memory");
        }
    }
    __syncthreads();
}

__global__ void __launch_bounds__(512, 2) mega(Args a) {
    extern __shared__ __attribute__((aligned(16))) unsigned char lds_raw[];
    LAS unsigned char* lds = (LAS unsigned char*)lds_raw;
    cg::grid_group grid = cg::this_grid();
    volatile LAS unsigned* bst = (volatile LAS unsigned*)(lds + 131072 + 64);
    if (threadIdx.x == 0) { bst[0] = 0u; bst[1] = 0u; }
    __syncthreads();
    const XcdBarrier xbar = xcd_barrier_post((unsigned*)(a.ws + OFF_BAR), bst);
    for (int ph2 = 2 * a.ph_lo; ph2 < 2 * a.ph_hi; ++ph2) {
        const int ph = ph2 >> 1;
        if (ph2 & 1) { const int spx = (ph == 0) ? 12 : (ph == NPHASE - 1) ? 13 : (ph - 1) % 12; if (!((REP_MASK >> spx) & 1)) continue; }
        int tid = threadIdx.x; asm volatile("" : "+v"(tid));
        const int lane = tid & 63, wave = __builtin_amdgcn_readfirstlane(tid >> 6);
        const int G = gridDim.x, gw = blockIdx.x * 8 + wave, NGW = G * 8;
        unsigned char* ws = a.ws; asm volatile("" : "+s"(ws));
        float* SS = (float*)(ws + OFF_SS);
        bf16_t* XB = (bf16_t*)(ws + OFF_XB); float* X = (float*)(ws + OFF_X);
        if (ph == 0) {
            if (PHON(12)) p0_prologue(lds, a, tid, lane, wave, gw, NGW);
        } else if (ph == NPHASE - 1) {
            if (PHON(13)) final_phase(a, lane, gw, NGW);
        } else {
            const int l = (ph - 1) / 12, sp = (ph - 1) % 12;
            const bool is_gemm = (sp == 0 || sp == 4 || sp == 5 || sp == 7 || sp == 8 || sp == 9 || sp == 11);
            if (is_gemm && PHON(0)) {
                const int njobs = (l == 0 && (sp == 0 || sp == 9)) ? 3 : 1;
                for (int jb = 0; jb < njobs; ++jb) {
                    pg8::Gemm g; pg8::GenOrder S; pg8::Epi E;
                    E.mode = 0; E.O = nullptr; E.ldc = D; E.ss = nullptr; E.X = nullptr; E.ssn = nullptr; E.F = nullptr; E.l = l; E.dry = (ph2 & 1);
                    if (sp == 0 && jb == 0) {
                        g = pg8::Gemm{XB, (const bf16_t*)(ws + OFF_WIN) + (size_t)l * LDP * D, D, D, D};
                        S.init(0, MROWS, LDP, D, D, G, (int)blockIdx.x);
                        E.O = (bf16_t*)(ws + OFF_PROJ); E.ldc = LDP; E.ss = SS + (size_t)3 * l * MROWS;
                    } else if (jb > 0) {
                        const int kv = (sp == 0 ? 0 : 2) + jb - 1, ll = kv >> 1, isv = kv & 1;
                        g = pg8::Gemm{(const bf16_t*)(ws + OFF_MNB), (const bf16_t*)(ws + (isv ? OFF_WV : OFF_WK)) + (size_t)ll * D * D, D, D, D};
                        S.init(0, MMEM, D, D, D, G, (int)((blockIdx.x + G - 160 - 32 * (jb - 1)) % G));
                        E.mode = isv ? 3 : 2; E.O = (bf16_t*)(ws + (isv ? OFF_MVT : OFF_MK)) + (size_t)ll * MMEM * D; E.ss = (const float*)(ws + OFF_SSM);
                        E.F = a.out + (isv ? O_MVP : O_MKP) + (size_t)ll * MMEM * D; E.l = ll;
                    } else if (sp == 4 || sp == 8 || sp == 11) {
                        const bf16_t* A = (const bf16_t*)(ws + (sp == 4 ? OFF_YAB : sp == 8 ? OFF_O : OFF_H));
                        const bf16_t* B = sp == 4 ? (const bf16_t*)(ws + OFF_WOUT) + (size_t)l * D * D : sp == 8 ? (const bf16_t*)(ws + OFF_WO) + (size_t)l * D * D : (const bf16_t*)(ws + OFF_WDN) + (size_t)l * D * FW;
                        const int K = sp == 11 ? FW : D;
                        const int nrm = 3 * l + (sp == 4 ? 1 : sp == 8 ? 2 : 3);
                        g = pg8::Gemm{A, B, K, K, K};
                        S.init(0, MP, D, K, K, G, (int)blockIdx.x);
                        E.mode = 1; E.O = XB; E.X = X; E.ssn = SS + (size_t)nrm * MROWS;
                    } else if (sp == 5) {
                        g = pg8::Gemm{XB, (const bf16_t*)(ws + OFF_WQ) + (size_t)l * D * D, D, D, D};
                        S.init(0, MP, D, D, D, G, (int)blockIdx.x);
                        E.O = (bf16_t*)(ws + OFF_Q); E.ss = SS + (size_t)(3 * l + 1) * MROWS;
                    } else if (sp == 7) {
                        g = pg8::Gemm{(const bf16_t*)(ws + OFF_P), (const bf16_t*)(ws + OFF_MVT) + (size_t)l * MMEM * D, D, 256, 256};
                        S.init(2, MP, D, D, 256, G, (int)blockIdx.x);
                        E.O = (bf16_t*)(ws + OFF_O);
                    } else {
                        g = pg8::Gemm{XB, (const bf16_t*)(ws + OFF_WUP) + (size_t)l * FW2 * D, D, D, D};
                        S.init(0, MROWS, FW2, D, D, G, (int)blockIdx.x);
                        E.mode = 4; E.O = (bf16_t*)(ws + OFF_UP); E.ldc = FW2; E.ss = SS + (size_t)(3 * l + 2) * MROWS; E.F = a.out;
                    }
                    pg8::gemm_phase<pg8::Epi, pg8::GenOrder, true>(lds, g, S, E);
                    if (jb == 0 && !(ph2 & 1) && (sp == 4 || sp == 5 || sp == 8 || sp == 11))
                        skinny_gemm(lds, g.A, g.lda, g.Bt, g.K, E.mode, X, E.O, E.ssn, E.ss, lane, wave);
                }
            } else if (sp == 1 && PHON(1)) {
                prep_phase(lds, a, l, tid, lane, wave, gw);
            } else if (sp == 2 && PHON(2)) {
                scan_phase(lds, a, l, tid, lane, wave);
            } else if (sp == 3 && PHON(3)) {
                post_phase(a, l, lane, gw, NGW);
            } else if (sp == 6 && PHON(6)) {
                {
                    pg8::Gemm g{(const bf16_t*)(ws + OFF_Q), (const bf16_t*)(ws + OFF_MK) + (size_t)l * MMEM * D, D, D, 256};
                    pg8::GenOrder S; S.init(1, MP, D, D, D, G, (int)blockIdx.x);
                    pg8::EpiSm E{(bf16_t*)(ws + OFF_P)};
                    pg8::gemm_phase<pg8::EpiSm, pg8::GenOrder, false>(lds, g, S, E);
                }
                __syncthreads();
                sample_attn(lds, a, l, tid, lane, wave);
            } else if (sp == 10 && PHON(10)) {
                ffnconv_phase(a, l, tid);
            }
        }
        if (ph2 + 1 < 2 * a.ph_hi) { if (a.ph_lo < 0) grid.sync(); else xcd_barrier(xbar); }
        if (((REP_MASK >> 14) & 1) && ph2 == 0) { for (int q = 0; q < 40; ++q) xcd_barrier(xbar); }
    }
}

extern "C" void kernel_launch(void* const* d_in, const int* in_sizes, int n_in, void* d_out, int out_size, void* d_ws, size_t ws_size, hipStream_t stream) {
    static int grid = 0;
    if (grid == 0) {
        if (n_in != 38 || ws_size < WS_END) { fprintf(stderr, "kernel_launch: expected 38 inputs and >= %zu bytes of workspace (got %d, %zu)\n", (size_t)WS_END, n_in, ws_size); grid = -1; return; }
        int dev = 0, cus = 0, per_cu = 0;
        hipGetDevice(&dev);
        hipDeviceGetAttribute(&cus, hipDeviceAttributeMultiprocessorCount, dev);
        if (hipFuncSetAttribute((const void*)mega, hipFuncAttributeMaxDynamicSharedMemorySize, LDS_BYTES) != hipSuccess) { fprintf(stderr, "kernel_launch: hipFuncSetAttribute failed\n"); grid = -1; return; }
        hipOccupancyMaxActiveBlocksPerMultiprocessor(&per_cu, (const void*)mega, 512, LDS_BYTES);
        if (per_cu < 1) { fprintf(stderr, "kernel_launch: occupancy query says %d blocks per CU\n", per_cu); per_cu = 1; }
        (void)hipGetLastError();
        grid = cus;
        if (grid != 256) fprintf(stderr, "kernel_launch: built for 256 CUs, got %d\n", grid);
    }
    if (grid < 0) return;
    if (hipMemsetAsync((char*)d_ws + OFF_BAR, 0, BAR_BYTES, stream) != hipSuccess) { fprintf(stderr, "kernel_launch: hipMemsetAsync failed\n"); return; }
    Args a{};
    for (int i = 0; i < 38; ++i) a.in[i] = (const float*)d_in[i];
    a.out = (float*)d_out; a.ws = (unsigned char*)d_ws;
#if MK_PER_PHASE
    for (int ph = 0; ph < NPHASE; ++ph) {
        a.ph_lo = ph; a.ph_hi = ph + 1;
        void* args[] = {&a};
        hipError_t e = hipLaunchCooperativeKernel((const void*)mega, dim3(grid), dim3(512), args, LDS_BYTES, stream);
        if (e != hipSuccess) { fprintf(stderr, "cooperative launch failed: %s\n", hipGetErrorString(e)); break; }
    }
#else
    a.ph_lo = 0; a.ph_hi = NPHASE;
    void* args[] = {&a};
    hipError_t e = hipLaunchCooperativeKernel((const void*)mega, dim3(grid), dim3(512), args, LDS_BYTES, stream);
    if (e != hipSuccess) fprintf(stderr, "cooperative launch failed: %s (grid %d)\n", hipGetErrorString(e), grid);
#endif
    (void)in_sizes; (void)out_size;
}
```

```cpp
#include <hip/hip_runtime.h>
#include <hip/hip_cooperative_groups.h>
#include <cstdio>
#include <cstdint>
namespace cg = cooperative_groups;

#ifndef PH_MASK
#define PH_MASK 0xFFFFF
#endif
#define PHON(k) (((PH_MASK) >> (k)) & 1)
#ifndef REP_MASK
#define REP_MASK 0
#endif
#ifndef MK_PER_PHASE
#define MK_PER_PHASE 0
#endif

#define LAS __attribute__((address_space(3)))
typedef unsigned short bf16_t;
typedef short bf16x8 __attribute__((ext_vector_type(8)));
typedef float f32x4 __attribute__((ext_vector_type(4)));
typedef unsigned u32x4 __attribute__((ext_vector_type(4)));
typedef unsigned u32x2 __attribute__((ext_vector_type(2)));
#define LDS_WAIT() asm volatile("s_waitcnt lgkmcnt(0)" ::: "memory")

constexpr int D = 1024, NB = 8, TT = 2048, MP = NB * TT, NS = 128, MTOK = MP + NS, MROWS = 16640;
constexpr int INC = 3328, LDP = 3584, FW = 2816, FW2 = 5632, NMEM = 256, MMEM = NB * NMEM;
constexpr float EPS = 1e-6f, GN_EPS = 64e-5f;
constexpr int NPHASE = 26;
constexpr int LDS_BYTES = 147456;

constexpr size_t O_YP = 0, O_YS = 16777216, O_SHP = 16908288, O_WKVP = 16924672, O_CONVP = 17448960, O_FFNP = 17465344,
                 O_MKP = 17645568, O_MVP = 21839872, O_SHS = 26034176, O_WKVS = 26296320, O_CONVS = 34684928, O_FFNS = 34947072;

constexpr size_t al256(size_t x) { return (x + 255) & ~(size_t)255; }
constexpr size_t OFF_SS = 0;
constexpr size_t OFF_SSM = al256(OFF_SS + (size_t)7 * MROWS * 4);
constexpr size_t OFF_WIN = al256(OFF_SSM + 2048 * 4);
constexpr size_t OFF_WOUT = OFF_WIN + (size_t)2 * LDP * D * 2;
constexpr size_t OFF_WQ = OFF_WOUT + (size_t)2 * D * D * 2;
constexpr size_t OFF_WK = OFF_WQ + (size_t)2 * D * D * 2;
constexpr size_t OFF_WV = OFF_WK + (size_t)2 * D * D * 2;
constexpr size_t OFF_WO = OFF_WV + (size_t)2 * D * D * 2;
constexpr size_t OFF_WUP = OFF_WO + (size_t)2 * D * D * 2;
constexpr size_t OFF_WDN = OFF_WUP + (size_t)2 * FW2 * D * 2;
constexpr size_t OFF_W2 = OFF_WDN + (size_t)2 * D * FW * 2;
constexpr size_t OFF_A2 = OFF_W2 + (size_t)2 * 512 * 64 * 2;
constexpr size_t OFF_G2 = OFF_A2 + (size_t)2 * 512 * 64 * 2;
constexpr size_t OFF_V1 = OFF_G2 + (size_t)2 * 512 * 128 * 2;
constexpr size_t OFF_V2 = OFF_V1 + (size_t)32 * 512 * 2;
constexpr size_t OFF_X = al256(OFF_V2 + (size_t)512 * 32 * 2);
constexpr size_t OFF_XB = OFF_X + (size_t)MROWS * D * 4;
constexpr size_t OFF_MNB = OFF_XB + (size_t)MROWS * D * 2;
constexpr size_t OFF_MK = OFF_MNB + (size_t)MMEM * D * 2;
constexpr size_t OFF_MVT = OFF_MK + (size_t)2 * MMEM * D * 2;
constexpr size_t OFF_PROJ = OFF_MVT + (size_t)2 * MMEM * D * 2;
constexpr size_t OFF_H = OFF_PROJ;
constexpr size_t SCN = (size_t)MTOK * 512 * 4;
constexpr size_t OFF_SA = OFF_PROJ + (size_t)MROWS * LDP * 2;
constexpr size_t OFF_SB = OFF_SA + SCN, OFF_SD = OFF_SB + SCN, OFF_SK = OFF_SD + SCN, OFF_SRD = OFF_SK + SCN, OFF_G = OFF_SRD + SCN;
constexpr size_t OFF_UP = OFF_SA;
constexpr size_t OFF_SV0 = OFF_G + SCN, OFF_SV1 = OFF_SV0 + SCN;
constexpr size_t OFF_SBR = OFF_SV1 + SCN;
constexpr size_t OFF_SKR = OFF_SBR + (size_t)MTOK * 8 * 4, OFF_RKR = OFF_SKR + (size_t)MTOK * 8 * 4;
constexpr size_t OFF_Y = al256(OFF_RKR + (size_t)MTOK * 8 * 4);
constexpr size_t OFF_YAB = OFF_Y + SCN;
constexpr size_t OFF_Q = OFF_YAB + (size_t)MROWS * D * 2;
constexpr size_t OFF_P = OFF_Q + (size_t)MROWS * D * 2;
constexpr size_t OFF_O = OFF_P + (size_t)MROWS * D * 2;
constexpr size_t OFF_BAR = OFF_O + (size_t)MROWS * D * 2;
constexpr size_t BAR_BYTES = 16384;
constexpr size_t WS_END = OFF_BAR + BAR_BYTES;
static_assert((size_t)MROWS * FW2 * 2 <= 6 * SCN, "UP overlay");
static_assert((size_t)MROWS * FW * 2 <= (size_t)MROWS * LDP * 2, "H overlay");
static_assert(WS_END < (size_t)1050000000, "workspace");

__device__ __forceinline__ unsigned f2bf(float f) { unsigned u = __builtin_bit_cast(unsigned, f); return (u + 0x7fffu + ((u >> 16) & 1u)) >> 16; }
__device__ __forceinline__ unsigned pk2(float lo, float hi) { return f2bf(lo) | (f2bf(hi) << 16); }
__device__ __forceinline__ unsigned cvt_pk_bf16(float lo, float hi) { unsigned r; asm volatile("v_cvt_pk_bf16_f32 %0, %1, %2" : "=v"(r) : "v"(lo), "v"(hi)); return r; }
__device__ __forceinline__ float bflo(unsigned w) { return __builtin_bit_cast(float, w << 16); }
__device__ __forceinline__ float bfhi(unsigned w) { return __builtin_bit_cast(float, w & 0xffff0000u); }
__device__ __forceinline__ float wave_sum(float v) {
#pragma unroll
    for (int o = 1; o < 64; o <<= 1) v += __shfl_xor(v, o);
    return v;
}
__device__ __forceinline__ float wave_max(float v) {
#pragma unroll
    for (int o = 1; o < 64; o <<= 1) v = fmaxf(v, __shfl_xor(v, o));
    return v;
}
__device__ __forceinline__ float sigmoidf_(float x) { return 1.f / (1.f + __expf(-x)); }
__device__ __forceinline__ void unpack8(u32x4 w, float* f) { f[0] = bflo(w.x); f[1] = bfhi(w.x); f[2] = bflo(w.y); f[3] = bfhi(w.y); f[4] = bflo(w.z); f[5] = bfhi(w.z); f[6] = bflo(w.w); f[7] = bfhi(w.w); }
__device__ __forceinline__ f32x4 ld_bf4(const bf16_t* p) { const u32x2 w = *(const u32x2*)p; return (f32x4){bflo(w.x), bfhi(w.x), bflo(w.y), bfhi(w.y)}; }
__device__ __forceinline__ void st_bf4(bf16_t* p, const f32x4 v) { u32x2 w; w.x = cvt_pk_bf16(v[0], v[1]); w.y = cvt_pk_bf16(v[2], v[3]); *(u32x2*)p = w; }
__device__ __forceinline__ float bf2f(bf16_t h) { return __builtin_bit_cast(float, (unsigned)h << 16); }
template <int CTRL> __device__ __forceinline__ float dppf(float v) { return __builtin_bit_cast(float, __builtin_amdgcn_update_dpp(0, __builtin_bit_cast(int, v), CTRL, 0xF, 0xF, true)); }
__device__ __forceinline__ float red16(float v) { v += dppf<0xB1>(v); v += dppf<0x4E>(v); v += dppf<0x124>(v); v += dppf<0x128>(v); return v; }

namespace pg8 {
constexpr int BM = 256, BK = 64, HALF = 128, HTB = HALF * BK * 2, STAGE_BYTES = 8 * HTB, NXCD = 8, WGM = 8;
__host__ __device__ __forceinline__ int lds_byte(int r, int c) { const int st = (r >> 4) * 2 + (c >> 5), rr = r & 15, cc = c & 31, ob = rr * 64 + cc * 2; return st * 1024 + (ob ^ (((ob >> 9) & 1) << 5)); }
__host__ __device__ __forceinline__ void stage_rc(int b, int& R, int& C) { const int st = b / 1024, sb = b % 1024, swz = sb ^ (((sb >> 9) & 1) << 5); R = (st >> 1) * 16 + swz / 64; C = (st & 1) * 32 + (swz % 64) / 2; }
__host__ __device__ __forceinline__ int perm32(int rho) { const int n = rho >> 4, i = rho & 15; return 8 * (i >> 2) + 4 * n + (i & 3); }

struct Unit { int pm, pn; size_t offA, offB; };
struct Gemm { const bf16_t* A; const bf16_t* Bt; int lda, ldb, K; };

struct GenOrder {
    int mode, nM, nN, nwg, G, c; size_t sA, sB;
    __device__ void init(int mode_, int M, int N, int lda, int ldb, int G_, int c_) { mode = mode_; nM = M / BM; nN = N / BM; nwg = nM * nN; G = G_; c = c_; sA = (size_t)BM * lda * 2; sB = (size_t)BM * ldb * 2; }
    __device__ bool next(int i, Unit& u) const {
        const long L = (long)i * G + c; if (L >= nwg) return false;
        if (mode == 0) {
            int wgid = (int)L; { const int q = nwg / NXCD, r = nwg % NXCD, xcd = wgid % NXCD, off = wgid / NXCD; wgid = (xcd < r ? xcd * (q + 1) : r * (q + 1) + (xcd - r) * q) + off; }
            const int nig = WGM * nN, gid = wgid / nig, fm = gid * WGM, gsz = (nM - fm) < WGM ? (nM - fm) : WGM;
            u.pm = fm + ((wgid % nig) % gsz); u.pn = (wgid % nig) / gsz; u.offA = (size_t)u.pm * sA; u.offB = (size_t)u.pn * sB;
        } else {
            const int b = (int)L >> 5, qb = ((int)L >> 2) & 7, h = (int)L & 3;
            u.pm = b * 8 + qb; u.pn = h;
            u.offA = ((size_t)(b * 2048 + qb * 256) * 1024 + h * 256) * 2;
            u.offB = mode == 1 ? ((size_t)(b * 256) * 1024 + h * 256) * 2 : ((size_t)(b * 4 + h) * 256 * 256) * 2;
        }
        return true;
    }
};

template <class Epi, class Sched, bool ALIGN_EPI>
__device__ __forceinline__ void gemm_phase(LAS unsigned char* lds, const Gemm g, const Sched& S, const Epi& E) {
    int tid = threadIdx.x; asm volatile("" : "+v"(tid));
    const int wid = __builtin_amdgcn_readfirstlane(tid >> 6), lane = tid & 63, wr = wid >> 2, wc = wid & 3, fr = lane & 15, fq = lane >> 4;
    const int K = g.K, nt = K / BK;
    unsigned voffA[2], voffB[2];
#pragma unroll
    for (int i = 0; i < 2; ++i) { int R, C; stage_rc(tid * 16 + i * 8192, R, C); const int Rb = Epi::PERM ? ((R & ~31) + perm32(R & 31)) : R;
        voffA[i] = (unsigned)(R * g.lda + C) * 2u; voffB[i] = (unsigned)(Rb * g.ldb + C) * 2u; }
    const size_t kstep = (size_t)(BK * 2);
    const size_t hstepA = (size_t)HALF * g.lda * 2, hstepB = (size_t)HALF * g.ldb * 2;
    const unsigned ldsw = (unsigned)wid * 1024u;
    const int aoff = lds_byte(wr * 64 + fr, fq * 8), boff = lds_byte(wc * 32 + fr, fq * 8);
#define PG8_SA(b, h) (((b) * 2 + (h)) * HTB)
#define PG8_SB(b, h) ((4 + (b) * 2 + (h)) * HTB)
#define PG8_STAGE(bufoff, gbase, voff) do { _Pragma("unroll") for (int _i = 0; _i < 2; ++_i) \
        __builtin_amdgcn_global_load_lds((const unsigned*)((const char*)(gbase) + (voff)[_i]), (LAS unsigned*)(lds + (bufoff) + ldsw + _i * 8192), 16, 0, 0); } while (0)
#define PG8_LDA(dst, b, h) do { _Pragma("unroll") for (int m = 0; m < 4; ++m) _Pragma("unroll") for (int k = 0; k < 2; ++k) dst[m][k] = *(const LAS bf16x8*)(lds + PG8_SA(b, h) + aoff + m * 2048 + k * 1024); } while (0)
#define PG8_LDB(dst, b, h) do { _Pragma("unroll") for (int n = 0; n < 2; ++n) _Pragma("unroll") for (int k = 0; k < 2; ++k) dst[n][k] = *(const LAS bf16x8*)(lds + PG8_SB(b, h) + boff + n * 2048 + k * 1024); } while (0)
#define PG8_MMA(ai, bj, At, Bt) do { __builtin_amdgcn_s_setprio(1); _Pragma("unroll") for (int m = 0; m < 4; ++m) _Pragma("unroll") for (int n = 0; n < 2; ++n) _Pragma("unroll") for (int k = 0; k < 2; ++k) \
        acc[ai][bj][m][n] = __builtin_amdgcn_mfma_f32_16x16x32_bf16(Bt[n][k], At[m][k], acc[ai][bj][m][n], 0, 0, 0); __builtin_amdgcn_s_setprio(0); } while (0)
#define PG8_WAIT_V(n) asm volatile("s_waitcnt vmcnt(" #n ")" ::: "memory")
#define PG8_WAIT_L(n) asm volatile("s_waitcnt lgkmcnt(" #n ")" ::: "memory")
#define PG8_BAR __builtin_amdgcn_s_barrier()
#define PG8_SCHED __builtin_amdgcn_sched_barrier(0)
    Unit cur, nxt; int ui = 0;
    if (!S.next(0, cur)) return;
    f32x4 acc[2][2][4][2];
#pragma unroll
    for (int a = 0; a < 2; ++a)
#pragma unroll
        for (int b = 0; b < 2; ++b)
#pragma unroll
            for (int m = 0; m < 4; ++m)
#pragma unroll
                for (int n = 0; n < 2; ++n) acc[a][b][m][n] = (f32x4){0.f, 0.f, 0.f, 0.f};
    bf16x8 At[4][2], B0[2][2], B1[2][2];
    const char* cA = (const char*)g.A + cur.offA; const char* cB = (const char*)g.Bt + cur.offB;
    PG8_STAGE(PG8_SB(0, 0), cB, voffB); PG8_STAGE(PG8_SB(0, 1), cB + hstepB, voffB); PG8_STAGE(PG8_SA(0, 0), cA, voffA); PG8_STAGE(PG8_SA(0, 1), cA + hstepA, voffA);
    if (wr == 1) PG8_BAR;
    PG8_WAIT_V(2); PG8_BAR;
    PG8_STAGE(PG8_SB(1, 0), cB + kstep, voffB); PG8_STAGE(PG8_SA(1, 0), cA + kstep, voffA); PG8_STAGE(PG8_SB(1, 1), cB + hstepB + kstep, voffB);
    PG8_WAIT_V(6); PG8_BAR;
    for (;;) {
        const bool has_next = S.next(ui + 1, nxt);
        const char* nA = has_next ? (const char*)g.A + nxt.offA : cA; const char* nB = has_next ? (const char*)g.Bt + nxt.offB : cB;
        for (int t = 0; t < nt; t += 2) {
            const bool last = (t == nt - 2);
            const char* a1 = cA + (size_t)(t + 1) * kstep;
            const char* a2 = last ? nA : cA + (size_t)(t + 2) * kstep; const char* b2 = last ? nB : cB + (size_t)(t + 2) * kstep;
            const char* a3 = a2 + kstep; const char* b3 = b2 + kstep;
            PG8_LDB(B0, 0, 0); PG8_LDB(B1, 0, 1); PG8_SCHED; PG8_LDA(At, 0, 0); PG8_STAGE(PG8_SA(1, 1), a1 + hstepA, voffA);
            PG8_WAIT_V(8); PG8_WAIT_L(0); PG8_BAR; PG8_MMA(0, 0, At, B0); PG8_MMA(0, 1, At, B1); PG8_BAR; PG8_SCHED;
            PG8_LDA(At, 0, 1); PG8_STAGE(PG8_SB(0, 0), b2, voffB); PG8_STAGE(PG8_SB(0, 1), b2 + hstepB, voffB); PG8_STAGE(PG8_SA(0, 0), a2, voffA);
            PG8_WAIT_V(8); PG8_WAIT_L(0); PG8_BAR; PG8_MMA(1, 0, At, B0); PG8_MMA(1, 1, At, B1); PG8_BAR; PG8_SCHED;
            PG8_LDB(B0, 1, 0); PG8_LDB(B1, 1, 1); PG8_SCHED; PG8_LDA(At, 1, 0); PG8_STAGE(PG8_SA(0, 1), a2 + hstepA, voffA);
            PG8_WAIT_V(8); PG8_WAIT_L(0); PG8_BAR; PG8_MMA(0, 0, At, B0); PG8_MMA(0, 1, At, B1); PG8_BAR; PG8_SCHED;
            PG8_LDA(At, 1, 1); PG8_STAGE(PG8_SB(1, 0), b3, voffB); PG8_STAGE(PG8_SB(1, 1), b3 + hstepB, voffB); PG8_STAGE(PG8_SA(1, 0), a3, voffA);
            PG8_WAIT_V(8); PG8_WAIT_L(0); PG8_BAR; PG8_MMA(1, 0, At, B0); PG8_MMA(1, 1, At, B1); PG8_BAR; PG8_SCHED;
        }
        if constexpr (ALIGN_EPI) { if (wr == 0) PG8_BAR; }
        if constexpr (!Epi::AFTER_DRAIN) { E(acc, cur, wr, wc, fr, fq); }
        if (!has_next) break;
#pragma unroll
        for (int a = 0; a < 2; ++a)
#pragma unroll
            for (int b = 0; b < 2; ++b)
#pragma unroll
                for (int m = 0; m < 4; ++m)
#pragma unroll
                    for (int n = 0; n < 2; ++n) acc[a][b][m][n] = (f32x4){0.f, 0.f, 0.f, 0.f};
        cur = nxt; cA = nA; cB = nB; ++ui;
        if constexpr (ALIGN_EPI) { if (wr == 1) PG8_BAR; }
    }
    PG8_WAIT_V(0);
    if constexpr (!ALIGN_EPI) { if (wr == 0) PG8_BAR; }
    PG8_BAR;
    if constexpr (Epi::AFTER_DRAIN) { E.fused(acc, cur, wr, wc, fr, fq, lds, wid, lane); }
#undef PG8_SA
#undef PG8_SB
#undef PG8_STAGE
#undef PG8_LDA
#undef PG8_LDB
#undef PG8_MMA
#undef PG8_WAIT_V
#undef PG8_WAIT_L
#undef PG8_BAR
#undef PG8_SCHED
}

struct Epi {
    static constexpr bool PERM = true, AFTER_DRAIN = false;
    int mode;
    bf16_t* O; int ldc;
    const float* ss;
    float* X;
    float* ssn;
    float* F;
    int l; int dry;
    __device__ __forceinline__ void operator()(const f32x4 (&acc)[2][2][4][2], const Unit& u, int wr, int wc, int fr, int fq) const {
        const int row0 = u.pm * 256 + wr * 64 + fr, col0 = u.pn * 256 + wc * 32 + 8 * fq;
        if (dry) return;
        if (mode == 1) {
#pragma unroll
            for (int ai = 0; ai < 2; ++ai)
#pragma unroll
                for (int m = 0; m < 4; ++m) {
                    const int row = row0 + ai * 128 + m * 16; const bool valid = row < MTOK; float sq = 0.f;
#pragma unroll
                    for (int bj = 0; bj < 2; ++bj) {
                        const size_t idx = (size_t)row * 1024 + col0 + bj * 128;
                        if (valid) {
                            float xf[8]; unpack8(*(const u32x4*)(O + idx), xf);
                            const f32x4 x0 = (f32x4){xf[0], xf[1], xf[2], xf[3]} + acc[ai][bj][m][0], x1 = (f32x4){xf[4], xf[5], xf[6], xf[7]} + acc[ai][bj][m][1];
                            sq += (x0[0] * x0[0] + x0[1] * x0[1]) + (x0[2] * x0[2] + x0[3] * x0[3]) + (x1[0] * x1[0] + x1[1] * x1[1]) + (x1[2] * x1[2] + x1[3] * x1[3]);
                            u32x4 w; w.x = cvt_pk_bf16(x0[0], x0[1]); w.y = cvt_pk_bf16(x0[2], x0[3]); w.z = cvt_pk_bf16(x1[0], x1[1]); w.w = cvt_pk_bf16(x1[2], x1[3]);
                            *(u32x4*)(O + idx) = w;
                        }
                    }
                    sq += __shfl_xor(sq, 16); sq += __shfl_xor(sq, 32);
                    if (valid && fq == 0) atomicAdd(ssn + row, sq);
                }
        } else {
#pragma unroll
            for (int ai = 0; ai < 2; ++ai)
#pragma unroll
                for (int m = 0; m < 4; ++m) {
                    const int row = row0 + ai * 128 + m * 16;
                    float rs = 1.f;
                    if (ss != nullptr && (mode == 2 || mode == 3 || row < MTOK)) rs = rsqrtf(ss[row] * (1.f / 1024.f) + EPS);
#pragma unroll
                    for (int bj = 0; bj < 2; ++bj) {
                        const int col = col0 + bj * 128;
                        const f32x4 v0 = acc[ai][bj][m][0] * rs, v1 = acc[ai][bj][m][1] * rs;
                        u32x4 w; w.x = cvt_pk_bf16(v0[0], v0[1]); w.y = cvt_pk_bf16(v0[2], v0[3]); w.z = cvt_pk_bf16(v1[0], v1[1]); w.w = cvt_pk_bf16(v1[2], v1[3]);
                        if (mode == 3) {
                            const int b = row >> 8, mem = row & 255;
                            bf16_t* o = O + ((size_t)(b * 1024 + col)) * 256 + mem;
                            o[0] = (bf16_t)(w.x & 0xffff); o[256] = (bf16_t)(w.x >> 16); o[512] = (bf16_t)(w.y & 0xffff); o[768] = (bf16_t)(w.y >> 16);
                            o[1024] = (bf16_t)(w.z & 0xffff); o[1280] = (bf16_t)(w.z >> 16); o[1536] = (bf16_t)(w.w & 0xffff); o[1792] = (bf16_t)(w.w >> 16);
                        } else {
                            *(u32x4*)(O + (size_t)row * ldc + col) = w;
                        }
                        if (mode == 2 || mode == 3) { float* f = F + (size_t)row * 1024 + col; *(f32x4*)f = v0; *(f32x4*)(f + 4) = v1; }
                        if (mode == 4) {
                            float* f = nullptr;
                            if (row < MP) { const int t = row & 2047; if (t >= 2046) f = F + O_FFNP + ((size_t)((l * 8 + (row >> 11)) * 2 + (t - 2046))) * FW2 + col; }
                            else if (row < MTOK) f = F + O_FFNS + ((size_t)((l * 128 + (row - MP)) * 2 + 1)) * FW2 + col;
                            if (f) { *(f32x4*)f = v0; *(f32x4*)(f + 4) = v1; }
                        }
                    }
                }
        }
    }
};

struct EpiSm {
    static constexpr bool PERM = true, AFTER_DRAIN = true;
    bf16_t* P;
    __device__ __forceinline__ void operator()(const f32x4 (&)[2][2][4][2], const Unit&, int, int, int, int) const {}
    __device__ __forceinline__ void fused(f32x4 (&acc)[2][2][4][2], const Unit& u, int wr, int wc, int fr, int fq, LAS unsigned char* lds, int wid, int lane) const {
        LAS float* red = (LAS float*)lds; LAS float* red2 = red + 1024;
        float mx[2][4];
#pragma unroll
        for (int ai = 0; ai < 2; ++ai)
#pragma unroll
            for (int m = 0; m < 4; ++m) {
                float v = -3.0e38f;
#pragma unroll
                for (int bj = 0; bj < 2; ++bj)
#pragma unroll
                    for (int n = 0; n < 2; ++n) { const f32x4 x = acc[ai][bj][m][n]; v = fmaxf(v, fmaxf(fmaxf(x[0], x[1]), fmaxf(x[2], x[3]))); }
                v = fmaxf(v, __shfl_xor(v, 16)); v = fmaxf(v, __shfl_xor(v, 32));
                if (fq == 0) red[(ai * 128 + wr * 64 + m * 16 + fr) * 4 + wc] = v;
            }
        __syncthreads();
#pragma unroll
        for (int ai = 0; ai < 2; ++ai)
#pragma unroll
            for (int m = 0; m < 4; ++m) {
                const f32x4 r = *(const LAS f32x4*)(red + (ai * 128 + wr * 64 + m * 16 + fr) * 4);
                const float M = fmaxf(fmaxf(r[0], r[1]), fmaxf(r[2], r[3])); mx[ai][m] = M;
                float s = 0.f;
#pragma unroll
                for (int bj = 0; bj < 2; ++bj)
#pragma unroll
                    for (int n = 0; n < 2; ++n) { f32x4 x = acc[ai][bj][m][n];
                        x[0] = __expf(x[0] - M); x[1] = __expf(x[1] - M); x[2] = __expf(x[2] - M); x[3] = __expf(x[3] - M); acc[ai][bj][m][n] = x; s += (x[0] + x[1]) + (x[2] + x[3]); }
                s += __shfl_xor(s, 16); s += __shfl_xor(s, 32);
                if (fq == 0) red2[(ai * 128 + wr * 64 + m * 16 + fr) * 4 + wc] = s;
            }
        __syncthreads();
#pragma unroll
        for (int ai = 0; ai < 2; ++ai)
#pragma unroll
            for (int m = 0; m < 4; ++m) {
                const int rl = ai * 128 + wr * 64 + m * 16 + fr;
                const f32x4 r = *(const LAS f32x4*)(red2 + rl * 4);
                const float inv = 1.f / ((r[0] + r[1]) + (r[2] + r[3]));
#pragma unroll
                for (int bj = 0; bj < 2; ++bj) {
                    const f32x4 v0 = acc[ai][bj][m][0] * inv, v1 = acc[ai][bj][m][1] * inv;
                    u32x4 w; w.x = cvt_pk_bf16(v0[0], v0[1]); w.y = cvt_pk_bf16(v0[2], v0[3]); w.z = cvt_pk_bf16(v1[0], v1[1]); w.w = cvt_pk_bf16(v1[2], v1[3]);
                    *(u32x4*)(P + (size_t)(u.pm * 256 + rl) * 1024 + u.pn * 256 + bj * 128 + wc * 32 + 8 * fq) = w;
                }
            }
        (void)mx; (void)wid; (void)lane;
    }
};
}

struct Args { const float* in[38]; float* out; unsigned char* ws; int ph_lo, ph_hi; };
enum { I_XP = 0, I_XS, I_MEM, I_SSHIFT, I_SWKV, I_SCONV, I_SFFN, I_CK, I_CV, I_NMIX, I_WIN, I_MU, I_W0, I_W2, I_A0, I_A2, I_G2, I_V0, I_V1, I_V2,
       I_KK, I_KA, I_RK, I_LNW, I_LNB, I_CONVW, I_WOUT, I_NX, I_NMEM, I_WQ, I_WK, I_WV, I_WO, I_NFFN, I_WUP, I_FCW, I_WDN, I_NFIN };

__device__ __forceinline__ void tr_item(const float* W, int K, int N, bf16_t* WT, const float* gain, float scale, LAS float* scr, int item, int lane) {
    const int nblk = N / 32, kb = item / nblk, nb = item % nblk, k0 = 64 * kb, n0 = 32 * nb;
#pragma unroll
    for (int i = 0; i < 8; ++i) { const int kk = 8 * i + (lane >> 3); const float gk = gain ? gain[k0 + kk] * scale : scale;
        const f32x4 v = *(const f32x4*)(W + (size_t)(k0 + kk) * N + n0 + (lane & 7) * 4) * gk;
        LAS float* d = scr + kk * 33 + (lane & 7) * 4; d[0] = v[0]; d[1] = v[1]; d[2] = v[2]; d[3] = v[3]; }
    LDS_WAIT();
    const int c = lane & 7;
#pragma unroll
    for (int j = 0; j < 4; ++j) { const int n = (lane >> 3) + 8 * j; const LAS float* s = scr + (8 * c) * 33 + n;
        u32x4 o; o.x = pk2(s[0 * 33], s[1 * 33]); o.y = pk2(s[2 * 33], s[3 * 33]); o.z = pk2(s[4 * 33], s[5 * 33]); o.w = pk2(s[6 * 33], s[7 * 33]);
        *(u32x4*)(WT + (size_t)(n0 + n) * K + k0 + 8 * c) = o; }
    LDS_WAIT();
}

constexpr int TR_NL = 8512;
__device__ __forceinline__ void tr_dispatch(const Args& a, unsigned char* ws, int l, int r, LAS float* scr, int lane) {
    constexpr int I_IN_ = 16 * 104, I_SQ_ = 16 * 32, I_UP_ = 16 * 176, I_DN_ = 44 * 32, I_L64 = 16;
    if (r < I_IN_) { tr_item(a.in[I_WIN] + (size_t)l * D * INC, D, INC, (bf16_t*)(ws + OFF_WIN) + (size_t)l * LDP * D, a.in[I_NMIX] + l * D, 1.f, scr, r, lane); return; } r -= I_IN_;
    if (r < I_SQ_) { tr_item(a.in[I_WOUT] + (size_t)l * D * D, D, D, (bf16_t*)(ws + OFF_WOUT) + (size_t)l * D * D, nullptr, 1.f, scr, r, lane); return; } r -= I_SQ_;
    if (r < I_SQ_) { tr_item(a.in[I_WQ] + (size_t)l * D * D, D, D, (bf16_t*)(ws + OFF_WQ) + (size_t)l * D * D, a.in[I_NX] + l * D, 0.0625f, scr, r, lane); return; } r -= I_SQ_;
    if (r < I_SQ_) { tr_item(a.in[I_WK] + (size_t)l * D * D, D, D, (bf16_t*)(ws + OFF_WK) + (size_t)l * D * D, a.in[I_NMEM] + l * D, 1.f, scr, r, lane); return; } r -= I_SQ_;
    if (r < I_SQ_) { tr_item(a.in[I_WV] + (size_t)l * D * D, D, D, (bf16_t*)(ws + OFF_WV) + (size_t)l * D * D, a.in[I_NMEM] + l * D, 1.f, scr, r, lane); return; } r -= I_SQ_;
    if (r < I_SQ_) { tr_item(a.in[I_WO] + (size_t)l * D * D, D, D, (bf16_t*)(ws + OFF_WO) + (size_t)l * D * D, nullptr, 1.f, scr, r, lane); return; } r -= I_SQ_;
    if (r < I_UP_) { tr_item(a.in[I_WUP] + (size_t)l * D * FW2, D, FW2, (bf16_t*)(ws + OFF_WUP) + (size_t)l * FW2 * D, a.in[I_NFFN] + l * D, 1.f, scr, r, lane); return; } r -= I_UP_;
    if (r < I_DN_) { tr_item(a.in[I_WDN] + (size_t)l * FW * D, FW, D, (bf16_t*)(ws + OFF_WDN) + (size_t)l * D * FW, nullptr, 1.f, scr, r, lane); return; } r -= I_DN_;
    if (r < I_L64) { tr_item(a.in[I_W2] + (size_t)l * 64 * 512, 64, 512, (bf16_t*)(ws + OFF_W2) + (size_t)l * 512 * 64, nullptr, 1.f, scr, r, lane); return; } r -= I_L64;
    if (r < I_L64) { tr_item(a.in[I_A2] + (size_t)l * 64 * 512, 64, 512, (bf16_t*)(ws + OFF_A2) + (size_t)l * 512 * 64, nullptr, 1.f, scr, r, lane); return; } r -= I_L64;
    tr_item(a.in[I_G2] + (size_t)l * 128 * 512, 128, 512, (bf16_t*)(ws + OFF_G2) + (size_t)l * 512 * 128, nullptr, 1.f, scr, r, lane);
}
constexpr int TR_DEFERRED = TR_NL + 5760;
__device__ __forceinline__ void tr_deferred(const Args& a, unsigned char* ws, int d, LAS float* scr, int lane) {
    if (d < TR_NL) { tr_dispatch(a, ws, 1, d, scr, lane); return; }
    const int e = d - TR_NL;
    const int r = e < 1024 ? 1664 + e : (e < 1536 ? 3712 + (e - 1024) : 4224 + (e - 1536));
    tr_dispatch(a, ws, 0, r, scr, lane);
}

__device__ __forceinline__ void p0_prologue(LAS unsigned char* lds, const Args& a, int tid, int lane, int wave, int gw, int NGW) {
    unsigned char* ws = a.ws;
    LAS float* scr = (LAS float*)(lds + wave * 16384);
    for (int it = gw; it < 1664 + 1024 + 64; it += NGW) {
        const int r = it < 1664 ? it : (it < 2688 ? 2688 + (it - 1664) : 8448 + (it - 2688));
        tr_dispatch(a, ws, 0, r, scr, lane);
    }
    float* X = (float*)(ws + OFF_X); bf16_t* XB = (bf16_t*)(ws + OFF_XB); float* SS = (float*)(ws + OFF_SS);
    bf16_t* MNB = (bf16_t*)(ws + OFF_MNB); float* SSM = (float*)(ws + OFF_SSM);
    for (int m = gw; m < MROWS + MMEM; m += NGW) {
        const float* src; bf16_t* dstb; float* dstx = nullptr; float* dss = nullptr; bool shiftrow = false;
        if (m < MP) { src = a.in[I_XP] + (size_t)m * D; dstb = XB + (size_t)m * D; dstx = X + (size_t)m * D; dss = SS + m; }
        else if (m < MTOK) { src = a.in[I_XS] + (size_t)(m - MP) * D; dstb = XB + (size_t)m * D; dstx = X + (size_t)m * D; dss = SS + m; }
        else if (m < MROWS) { src = a.in[I_SSHIFT] + (size_t)(m - MTOK) * D; dstb = XB + (size_t)m * D; shiftrow = true; }
        else { src = a.in[I_MEM] + (size_t)(m - MROWS) * D; dstb = MNB + (size_t)(m - MROWS) * D; dss = SSM + (m - MROWS); }
        float s = 0.f;
#pragma unroll
        for (int j = 0; j < 4; ++j) {
            f32x4 v = *(const f32x4*)(src + 4 * lane + 256 * j);
            if (shiftrow) { const f32x4 gn = *(const f32x4*)(a.in[I_NMIX] + 4 * lane + 256 * j); v[0] /= gn[0]; v[1] /= gn[1]; v[2] /= gn[2]; v[3] /= gn[3]; }
            s += (v[0] * v[0] + v[1] * v[1]) + (v[2] * v[2] + v[3] * v[3]);
            u32x2 w; w.x = pk2(v[0], v[1]); w.y = pk2(v[2], v[3]);
            *(u32x2*)(dstb + 4 * lane + 256 * j) = w;
        }
        s = wave_sum(s);
        if (dss && lane == 0) *dss = s;
    }
    if (blockIdx.x * 8 < D) {
        __syncthreads();
        LAS float* M = (LAS float*)lds;
        const float* muv = a.in[I_MU] + 1792 + 1024; const float* v1 = a.in[I_V1];
#pragma unroll 8
        for (int i = tid; i < 512 * 64; i += 512) { const int c = i >> 6, o = i & 63; const float mv = muv[c]; M[i] = ((o >> 5) ? mv : 1.f - mv) * v1[c * 32 + (o & 31)]; }
        __syncthreads();
        for (int k = gw; k < D; k += NGW) {
            const float* wrow = a.in[I_WIN] + (size_t)1 * D * INC + (size_t)k * INC + 1024;
            float acc = 0.f;
#pragma unroll 4
            for (int c = 0; c < 512; c += 4) {
                const f32x4 w4 = *(const f32x4*)(wrow + c);
                acc += w4[0] * M[c * 64 + lane] + w4[1] * M[(c + 1) * 64 + lane] + w4[2] * M[(c + 2) * 64 + lane] + w4[3] * M[(c + 3) * 64 + lane];
            }
            ((bf16_t*)(ws + OFF_WIN))[(size_t)1 * LDP * D + (size_t)(INC + lane) * D + k] = (bf16_t)f2bf(acc * a.in[I_NMIX][D + k]);
        }
    }
    const int gt = blockIdx.x * 512 + tid, NGT = gridDim.x * 512;
    for (int i = gt; i < 6 * MROWS; i += NGT) SS[MROWS + i] = 0.f;
    bf16_t* V2T = (bf16_t*)(ws + OFF_V2);
    for (int i = gt; i < 512 * 32; i += NGT) { const int n = i >> 5, k = i & 31; V2T[i] = (bf16_t)f2bf(a.in[I_V2][k * 512 + n]); }
}

__device__ __forceinline__ const bf16_t* prev_row(const bf16_t* PROJ, int m) {
    if (m < MP) { if ((m & 2047) == 0) return nullptr; return PROJ + (size_t)(m - 1) * LDP; }
    return PROJ + (size_t)(m + NS) * LDP;
}
__device__ __forceinline__ void mix4(const bf16_t* cur, const bf16_t* prv, const float* mu, int col, float* z) {
    const u32x2 c = *(const u32x2*)(cur + col); const f32x4 m4 = *(const f32x4*)(mu + col);
    float cf[4] = {bflo(c.x), bfhi(c.x), bflo(c.y), bfhi(c.y)}; float pf[4] = {0.f, 0.f, 0.f, 0.f};
    if (prv) { const u32x2 p = *(const u32x2*)(prv + col); pf[0] = bflo(p.x); pf[1] = bfhi(p.x); pf[2] = bflo(p.y); pf[3] = bfhi(p.y); }
#pragma unroll
    for (int j = 0; j < 4; ++j) z[j] = cf[j] + (pf[j] - cf[j]) * m4[j];
}
__device__ __forceinline__ void mix8(const bf16_t* cur, const bf16_t* prv, const float* mu, int col, float* z) {
    const u32x4 c = *(const u32x4*)(cur + col); float cf[8], pf[8]; unpack8(c, cf);
#pragma unroll
    for (int j = 0; j < 8; ++j) pf[j] = 0.f;
    if (prv) { const u32x4 p = *(const u32x4*)(prv + col); unpack8(p, pf); }
    const f32x4 m0 = *(const f32x4*)(mu + col), m1 = *(const f32x4*)(mu + col + 4);
#pragma unroll
    for (int j = 0; j < 4; ++j) { z[j] = cf[j] + (pf[j] - cf[j]) * m0[j]; z[4 + j] = cf[4 + j] + (pf[4 + j] - cf[4 + j]) * m1[j]; }
}

__device__ __forceinline__ float fsig(float x) { return __builtin_amdgcn_rcpf(1.f + __expf(-x)); }
__device__ __forceinline__ void mixw(u32x2 c, u32x2 p, const LAS float* mu, float* z) {
    const f32x4 m4 = *(const LAS f32x4*)mu;
    const float cf[4] = {bflo(c.x), bfhi(c.x), bflo(c.y), bfhi(c.y)}, pf[4] = {bflo(p.x), bfhi(p.x), bflo(p.y), bfhi(p.y)};
#pragma unroll
    for (int j = 0; j < 4; ++j) z[j] = cf[j] + (pf[j] - cf[j]) * m4[j];
}
__device__ __forceinline__ void prep_phase(LAS unsigned char* lds, const Args& a, int l, int tid, int lane, int wave, int gw) {
    unsigned char* ws = a.ws;
    const bf16_t* PROJ = (const bf16_t*)(ws + OFF_PROJ);
    const float* mu = a.in[I_MU] + l * 1792;
    if (gw < NB + NS) {
        const int row = gw < NB ? gw * 2048 + 2047 : MP + (gw - NB);
        float* dst = gw < NB ? a.out + O_SHP + (size_t)(l * NB + gw) * D : a.out + O_SHS + (size_t)(l * NS + (gw - NB)) * D;
        const bf16_t* Xr = (const bf16_t*)(ws + OFF_XB) + (size_t)row * D;
        const float rs = rsqrtf(((const float*)(ws + OFF_SS))[3 * l * MROWS + row] * (1.f / 1024.f) + EPS);
#pragma unroll
        for (int j = 0; j < 4; ++j) { const u32x2 xw = *(const u32x2*)(Xr + 4 * lane + 256 * j); const f32x4 v = (f32x4){bflo(xw.x), bfhi(xw.x), bflo(xw.y), bfhi(xw.y)}, gn = *(const f32x4*)(a.in[I_NMIX] + l * D + 4 * lane + 256 * j);
            *(f32x4*)(dst + 4 * lane + 256 * j) = v * rs * gn; }
    }
    LAS bf16_t* WL2 = (LAS bf16_t*)lds;
    LAS bf16_t* WLA = (LAS bf16_t*)(lds + 18432);
    LAS bf16_t* WLG = (LAS bf16_t*)(lds + 36864);
    LAS bf16_t* WLV = (LAS bf16_t*)(lds + 71680);
    LAS float* PAR = (LAS float*)(lds + 81920);
    LAS bf16_t* LA = (LAS bf16_t*)(lds + 88064);
    LAS bf16_t* LW = (LAS bf16_t*)(lds + 121856);
    const int hp = blockIdx.x & 3;
    {
        const bf16_t* W2T = (const bf16_t*)(ws + OFF_W2) + (size_t)l * 512 * 64 + (size_t)hp * 128 * 64;
        const bf16_t* A2T = (const bf16_t*)(ws + OFF_A2) + (size_t)l * 512 * 64 + (size_t)hp * 128 * 64;
        const bf16_t* G2T = (const bf16_t*)(ws + OFF_G2) + (size_t)l * 512 * 128 + (size_t)hp * 128 * 128;
        const bf16_t* V2T = (const bf16_t*)(ws + OFF_V2) + (size_t)hp * 128 * 32;
#pragma unroll
        for (int q = 0; q < 2; ++q) { const int i = tid + 512 * q, n = i >> 3, c = (i & 7) * 8;
            *(LAS u32x4*)(WL2 + n * 72 + c) = *(const u32x4*)(W2T + n * 64 + c); *(LAS u32x4*)(WLA + n * 72 + c) = *(const u32x4*)(A2T + n * 64 + c); }
#pragma unroll
        for (int q = 0; q < 4; ++q) { const int i = tid + 512 * q, n = i >> 4, c = (i & 15) * 8; *(LAS u32x4*)(WLG + n * 136 + c) = *(const u32x4*)(G2T + n * 128 + c); }
        { const int n = tid >> 2, c = (tid & 3) * 8; *(LAS u32x4*)(WLV + n * 40 + c) = *(const u32x4*)(V2T + n * 32 + c); }
        if (tid < 128) {
            const int ch = hp * 128 + tid;
            PAR[tid] = a.in[I_W0][l * 512 + ch]; PAR[128 + tid] = a.in[I_A0][l * 512 + ch]; PAR[256 + tid] = a.in[I_KK][l * 512 + ch]; PAR[384 + tid] = a.in[I_KA][l * 512 + ch];
            PAR[512 + tid] = a.in[I_RK][l * 512 + ch]; PAR[640 + tid] = l == 1 ? a.in[I_V0][ch] : 0.f; PAR[768 + tid] = mu[ch]; PAR[896 + tid] = mu[512 + ch]; PAR[1024 + tid] = mu[1024 + ch];
        }
    }
    float* SA = (float*)(ws + OFF_SA); float* SB = (float*)(ws + OFF_SB); float* SD = (float*)(ws + OFF_SD); float* SK = (float*)(ws + OFF_SK);
    float* SRD = (float*)(ws + OFF_SRD); float* GG = (float*)(ws + OFF_G); float* SV = (float*)(ws + (l == 0 ? OFF_SV0 : OFF_SV1));
    const float* SV0 = (const float*)(ws + OFF_SV0);
    float* SBR = (float*)(ws + OFF_SBR); float* SKR = (float*)(ws + OFF_SKR); float* RKR = (float*)(ws + OFF_RKR);
    const int mt = wave & 3, hh = wave >> 2, h = hp * 2 + hh, fr = lane & 15, fq = lane >> 4;
    const int grp = blockIdx.x >> 2;
    const int nit = 4 + (blockIdx.x < 32 ? 1 : 0);
    for (int it = 0; it < nit; ++it) {
        const bool tailit = it >= 4;
        const int m0 = tailit ? MP + grp * 16 : (grp + 64 * it) * 64;
        const int nq = tailit ? 1 : 4;
        {
            u32x4 cu[4], pv[4];
#pragma unroll
            for (int q = 0; q < 4; ++q) {
                cu[q] = (u32x4){0u, 0u, 0u, 0u}; pv[q] = cu[q];
                if (q < nq) {
                    const int row = (tid >> 5) + 16 * q, ch = tid & 31, m = m0 + row;
                    const bf16_t* prv = prev_row(PROJ, m);
                    cu[q] = *(const u32x4*)(PROJ + (size_t)m * LDP + 1536 + ch * 8);
                    if (prv) pv[q] = *(const u32x4*)(prv + 1536 + ch * 8);
                }
            }
            u32x2 vc = (u32x2){0u, 0u}, vp = vc;
            if (l == 1 && (tid >> 3) < 16 * nq) {
                const int m = m0 + (tid >> 3), j4 = (tid & 7) * 4; const bf16_t* prv = prev_row(PROJ, m);
                vc = *(const u32x2*)(PROJ + (size_t)m * LDP + INC + j4); if (prv) vp = *(const u32x2*)(prv + INC + 32 + j4);
            }
            const int ch = tid & 31;
            const f32x4 m0v = *(const f32x4*)(mu + 1536 + ch * 8), m1v = *(const f32x4*)(mu + 1536 + ch * 8 + 4);
#pragma unroll
            for (int q = 0; q < 4; ++q) {
                if (q >= nq) continue;
                const int row = (tid >> 5) + 16 * q;
                float cf[8], pf[8], z[8]; unpack8(cu[q], cf); unpack8(pv[q], pf);
#pragma unroll
                for (int j = 0; j < 4; ++j) { z[j] = cf[j] + (pf[j] - cf[j]) * m0v[j]; z[4 + j] = cf[4 + j] + (pf[4 + j] - cf[4 + j]) * m1v[j]; }
                if (ch < 8) {
#pragma unroll
                    for (int j = 0; j < 8; ++j) z[j] = 2.f * fsig(2.f * z[j]) - 1.f;
                } else if (ch >= 16) {
#pragma unroll
                    for (int j = 0; j < 8; ++j) z[j] = fsig(z[j]);
                }
                u32x4 w; w.x = pk2(z[0], z[1]); w.y = pk2(z[2], z[3]); w.z = pk2(z[4], z[5]); w.w = pk2(z[6], z[7]);
                *(LAS u32x4*)(LA + row * 264 + ch * 8) = w;
            }
            if (l == 1 && (tid >> 3) < 16 * nq) {
                u32x2 w; w.x = pk2(bflo(vc.x) + bflo(vp.x), bfhi(vc.x) + bfhi(vp.x)); w.y = pk2(bflo(vc.y) + bflo(vp.y), bfhi(vc.y) + bfhi(vp.y));
                *(LAS u32x2*)(LW + (tid >> 3) * 40 + (tid & 7) * 4) = w;
            }
        }
        __syncthreads();
        if (mt < nq) {
        const int m = m0 + mt * 16 + fr;
        const bf16_t* cur = PROJ + (size_t)m * LDP; const bf16_t* prv = prev_row(PROJ, m);
        u32x2 cR[4], cK[4], cV[4], pR[4], pK[4], pV[4]; f32x4 vf[4];
#pragma unroll
        for (int nt = 0; nt < 4; ++nt) {
            const int ch = h * 64 + nt * 16 + fq * 4;
            cR[nt] = *(const u32x2*)(cur + ch); cK[nt] = *(const u32x2*)(cur + 512 + ch); cV[nt] = *(const u32x2*)(cur + 1024 + ch);
            pR[nt] = (u32x2){0u, 0u}; pK[nt] = pR[nt]; pV[nt] = pR[nt];
            if (prv) { pR[nt] = *(const u32x2*)(prv + ch); pK[nt] = *(const u32x2*)(prv + 512 + ch); pV[nt] = *(const u32x2*)(prv + 1024 + ch); }
            vf[nt] = (f32x4){0.f, 0.f, 0.f, 0.f};
            if (l == 1) vf[nt] = ld_bf4((const bf16_t*)SV0 + (size_t)m * 512 + ch);
        }
        float ssq = 0.f;
#pragma unroll
        for (int nt = 0; nt < 4; ++nt) {
            const int cl = hh * 64 + nt * 16 + fq * 4; float kz[4]; mixw(cK[nt], pK[nt], PAR + 896 + cl, kz);
            const f32x4 kk4 = *(const LAS f32x4*)(PAR + 256 + cl);
#pragma unroll
            for (int j = 0; j < 4; ++j) { const float kk = kz[j] * kk4[j]; ssq += kk * kk; }
        }
        ssq += __shfl_xor(ssq, 16); ssq += __shfl_xor(ssq, 32);
        const float inv = 1.f / fmaxf(sqrtf(ssq), 1e-12f);
        float br = 0.f, kr = 0.f, rkr = 0.f;
#pragma unroll
        for (int nt = 0; nt < 4; ++nt) {
            const int cl = hh * 64 + nt * 16 + fq * 4, ch = h * 64 + nt * 16 + fq * 4, nl = hh * 64 + nt * 16 + fr;
            f32x4 dl = (f32x4){0.f, 0.f, 0.f, 0.f}, al = dl, gl = dl, vm = dl;
            bf16x8 af[8];
#pragma unroll
            for (int ks = 0; ks < 8; ++ks) af[ks] = *(const LAS bf16x8*)(LA + (mt * 16 + fr) * 264 + ks * 32 + fq * 8);
            const bf16x8 avv = *(const LAS bf16x8*)(LW + (mt * 16 + fr) * 40 + fq * 8);
#pragma unroll
            for (int ks = 0; ks < 2; ++ks) {
                dl = __builtin_amdgcn_mfma_f32_16x16x32_bf16(*(const LAS bf16x8*)(WL2 + nl * 72 + ks * 32 + fq * 8), af[ks], dl, 0, 0, 0);
                al = __builtin_amdgcn_mfma_f32_16x16x32_bf16(*(const LAS bf16x8*)(WLA + nl * 72 + ks * 32 + fq * 8), af[2 + ks], al, 0, 0, 0);
            }
#pragma unroll
            for (int ks = 0; ks < 4; ++ks) gl = __builtin_amdgcn_mfma_f32_16x16x32_bf16(*(const LAS bf16x8*)(WLG + nl * 136 + ks * 32 + fq * 8), af[4 + ks], gl, 0, 0, 0);
            if (l == 1) vm = __builtin_amdgcn_mfma_f32_16x16x32_bf16(*(const LAS bf16x8*)(WLV + nl * 40 + fq * 8), avv, vm, 0, 0, 0);
            float rz[4], kz[4], vz[4];
            mixw(cR[nt], pR[nt], PAR + 768 + cl, rz); mixw(cK[nt], pK[nt], PAR + 896 + cl, kz); mixw(cV[nt], pV[nt], PAR + 1024 + cl, vz);
            const f32x4 w0 = *(const LAS f32x4*)(PAR + cl), a0 = *(const LAS f32x4*)(PAR + 128 + cl), kk4 = *(const LAS f32x4*)(PAR + 256 + cl);
            const f32x4 ka4 = *(const LAS f32x4*)(PAR + 384 + cl), rk4 = *(const LAS f32x4*)(PAR + 512 + cl), v04 = *(const LAS f32x4*)(PAR + 640 + cl);
            f32x4 oa, ob, od, ok, ord_, ov;
#pragma unroll
            for (int j = 0; j < 4; ++j) {
                const float dcy = __expf(-0.60653065971f * fsig(w0[j] + dl[j]));
                const float av_ = fsig(a0[j] + al[j]);
                float vj = vz[j];
                if (l == 1) { const float vmix = fsig(v04[j] + vm[j]); vj = vj + (vf[nt][j] - vj) * vmix; }
                const float kk = kz[j] * kk4[j] * inv, k2 = kz[j] * (1.f + (av_ - 1.f) * ka4[j]);
                oa[j] = -kk; ob[j] = kk * av_; od[j] = dcy; ok[j] = k2; ord_[j] = rz[j] * dcy; ov[j] = vj;
                br += ob[j] * rz[j]; kr += k2 * rz[j]; rkr += rz[j] * k2 * rk4[j];
            }
            const size_t o = (size_t)m * 512 + ch;
            st_bf4((bf16_t*)SA + o, oa); st_bf4((bf16_t*)SB + o, ob); *(f32x4*)(SD + o) = od; st_bf4((bf16_t*)SK + o, ok); st_bf4((bf16_t*)SRD + o, ord_); st_bf4((bf16_t*)SV + o, ov); { u32x2 gw2; gw2.x = cvt_pk_bf16(gl[0], gl[1]); gw2.y = cvt_pk_bf16(gl[2], gl[3]); *(u32x2*)((bf16_t*)GG + o) = gw2; }
            __builtin_amdgcn_sched_barrier(0);
        }
        br += __shfl_xor(br, 16); br += __shfl_xor(br, 32); kr += __shfl_xor(kr, 16); kr += __shfl_xor(kr, 32); rkr += __shfl_xor(rkr, 16); rkr += __shfl_xor(rkr, 32);
        if (fq == 0) { SBR[m * 8 + h] = br; SKR[m * 8 + h] = kr; RKR[m * 8 + h] = rkr; }
        }
        __syncthreads();
    }
}

__device__ __forceinline__ void convB_token(const Args& a, int l, int m, int lane) {
    unsigned char* ws = a.ws;
    const bf16_t* __restrict__ PROJ = (const bf16_t*)(ws + OFF_PROJ);
    bf16_t* __restrict__ YAB = (bf16_t*)(ws + OFF_YAB);
    const int cb = lane * 8;
        const bf16_t* pr = PROJ + (size_t)m * LDP;
        float gb[8], gc[8], hi[8], u0[8], u1[8], u2[8];
        unpack8(*(const u32x4*)(pr + 1792 + cb), gb); unpack8(*(const u32x4*)(pr + 2304 + cb), gc); unpack8(*(const u32x4*)(pr + 2816 + cb), hi);
#pragma unroll
        for (int j = 0; j < 8; ++j) { u0[j] = gc[j] * hi[j]; u1[j] = 0.f; u2[j] = 0.f; }
        if (m < MP) {
            const int t = m & 2047;
            if (t >= 1) { unpack8(*(const u32x4*)(pr - LDP + 2304 + cb), gc); unpack8(*(const u32x4*)(pr - LDP + 2816 + cb), hi);
#pragma unroll
                for (int j = 0; j < 8; ++j) u1[j] = gc[j] * hi[j]; }
            if (t >= 2) { unpack8(*(const u32x4*)(pr - 2 * LDP + 2304 + cb), gc); unpack8(*(const u32x4*)(pr - 2 * LDP + 2816 + cb), hi);
#pragma unroll
                for (int j = 0; j < 8; ++j) u2[j] = gc[j] * hi[j]; }
            if (t >= 2046) { float* dst = a.out + O_CONVP + (size_t)((l * NB + (m >> 11)) * 2 + (t - 2046)) * 512 + cb;
                *(f32x4*)dst = (f32x4){u0[0], u0[1], u0[2], u0[3]}; *(f32x4*)(dst + 4) = (f32x4){u0[4], u0[5], u0[6], u0[7]}; }
        } else {
            const int i = m - MP; const float* sc = a.in[I_SCONV] + (size_t)(l * NS + i) * 2 * 512 + cb;
            const f32x4 a0 = *(const f32x4*)sc, a1 = *(const f32x4*)(sc + 4), b0 = *(const f32x4*)(sc + 512), b1 = *(const f32x4*)(sc + 516);
#pragma unroll
            for (int j = 0; j < 4; ++j) { u2[j] = a0[j]; u2[4 + j] = a1[j]; u1[j] = b0[j]; u1[4 + j] = b1[j]; }
            float* dst = a.out + O_CONVS + (size_t)(l * NS + i) * 2 * 512 + cb;
            *(f32x4*)dst = b0; *(f32x4*)(dst + 4) = b1;
            *(f32x4*)(dst + 512) = (f32x4){u0[0], u0[1], u0[2], u0[3]}; *(f32x4*)(dst + 516) = (f32x4){u0[4], u0[5], u0[6], u0[7]};
        }
        const float* cw = a.in[I_CONVW] + (size_t)l * 3 * 512 + cb;
        float ob[8];
#pragma unroll
        for (int j = 0; j < 8; ++j) ob[j] = gb[j] * (cw[j] * u2[j] + cw[512 + j] * u1[j] + cw[1024 + j] * u0[j]);
        u32x4 w2; w2.x = pk2(ob[0], ob[1]); w2.y = pk2(ob[2], ob[3]); w2.z = pk2(ob[4], ob[5]); w2.w = pk2(ob[6], ob[7]);
        *(u32x4*)(YAB + (size_t)m * 1024 + 512 + cb) = w2;
}

typedef float f32x2 __attribute__((ext_vector_type(2)));
__device__ __forceinline__ float scan_step(float (&s)[4], const f32x4 av, const f32x4 bv, const f32x4 dv, const f32x4 kv, const f32x4 rd, float vi, float br, float kr) {
    f32x2 s01 = (f32x2){s[0], s[1]}, s23 = (f32x2){s[2], s[3]};
    f32x2 t = s01 * (f32x2){av[0], av[1]}; t = __builtin_elementwise_fma(s23, (f32x2){av[2], av[3]}, t);
    f32x2 u = s01 * (f32x2){rd[0], rd[1]}; u = __builtin_elementwise_fma(s23, (f32x2){rd[2], rd[3]}, u);
    float pa = t.x + t.y, py = u.x + u.y;
    pa = red16(pa); py = red16(py);
    const f32x2 pav = (f32x2){pa, pa}, viv = (f32x2){vi, vi};
    f32x2 w01 = (f32x2){kv[0], kv[1]} * viv; w01 = __builtin_elementwise_fma((f32x2){bv[0], bv[1]}, pav, w01);
    f32x2 w23 = (f32x2){kv[2], kv[3]} * viv; w23 = __builtin_elementwise_fma((f32x2){bv[2], bv[3]}, pav, w23);
    s01 = __builtin_elementwise_fma(s01, (f32x2){dv[0], dv[1]}, w01);
    s23 = __builtin_elementwise_fma(s23, (f32x2){dv[2], dv[3]}, w23);
    s[0] = s01.x; s[1] = s01.y; s[2] = s23.x; s[3] = s23.y;
    return py + pa * br + vi * kr;
}

__device__ __forceinline__ void scan_phase(LAS unsigned char* lds, const Args& a, int l, int tid, int lane, int wave) {
    unsigned char* ws = a.ws;
    const float* SA = (const float*)(ws + OFF_SA); const float* SB = (const float*)(ws + OFF_SB); const float* SD = (const float*)(ws + OFF_SD); const float* SK = (const float*)(ws + OFF_SK);
    const float* SRD = (const float*)(ws + OFF_SRD); const float* SV = (const float*)(ws + (l == 0 ? OFF_SV0 : OFF_SV1));
    const float* SBR = (const float*)(ws + OFF_SBR); const float* SKR = (const float*)(ws + OFF_SKR);
    float* Y = (float*)(ws + OFF_Y);
    constexpr int TC = 32, CB = 5 * TC * 64 + TC * 16 + 2 * TC;
    LAS float* L = (LAS float*)lds;
    const int j4 = lane >> 4, c = lane & 15;
    for (int ci = blockIdx.x; ci < 256; ci += gridDim.x) {
        const int hc = ci >> 2, rg = ci & 3, b = hc >> 3, h = hc & 7;
        const int st = tid >> 4, c16 = tid & 15;
        const int rl = (wave & 3) * 4 + j4;
        float s[4] = {0.f, 0.f, 0.f, 0.f};
        u32x2 pa, pb, pk, pr; f32x4 pd; bf16_t pv; float ps = 0.f;
        {
            const size_t m = (size_t)b * 2048 + st; const size_t o = m * 512 + h * 64 + c16 * 4;
            pa = *(const u32x2*)((const bf16_t*)SA + o); pb = *(const u32x2*)((const bf16_t*)SB + o); pd = *(const f32x4*)(SD + o); pk = *(const u32x2*)((const bf16_t*)SK + o); pr = *(const u32x2*)((const bf16_t*)SRD + o);
            pv = ((const bf16_t*)SV)[m * 512 + h * 64 + rg * 16 + c16];
            if (tid < 32) ps = SBR[((size_t)b * 2048 + tid) * 8 + h]; else if (tid < 64) ps = SKR[((size_t)b * 2048 + tid - 32) * 8 + h];
        }
        {
            LAS float* B0 = L;
            *(LAS f32x4*)(B0 + st * 64 + c16 * 4) = (f32x4){bflo(pa.x), bfhi(pa.x), bflo(pa.y), bfhi(pa.y)}; *(LAS f32x4*)(B0 + 2048 + st * 64 + c16 * 4) = (f32x4){bflo(pb.x), bfhi(pb.x), bflo(pb.y), bfhi(pb.y)}; *(LAS f32x4*)(B0 + 4096 + st * 64 + c16 * 4) = pd;
            *(LAS f32x4*)(B0 + 6144 + st * 64 + c16 * 4) = (f32x4){bflo(pk.x), bfhi(pk.x), bflo(pk.y), bfhi(pk.y)}; *(LAS f32x4*)(B0 + 8192 + st * 64 + c16 * 4) = (f32x4){bflo(pr.x), bfhi(pr.x), bflo(pr.y), bfhi(pr.y)}; B0[10240 + st * 16 + c16] = bf2f(pv);
            if (tid < 64) B0[10752 + tid] = ps;
        }
        __syncthreads();
        for (int n = 0; n < TT / TC; ++n) {
            LAS float* Bc = L + (n & 1) * CB; LAS float* Bn = L + ((n + 1) & 1) * CB; LAS float* yb = L + 2 * CB + (n & 1) * 512;
            const bool more = n + 1 < TT / TC;
            if (more) {
                const size_t m = (size_t)b * 2048 + (n + 1) * TC + st; const size_t o = m * 512 + h * 64 + c16 * 4;
                pa = *(const u32x2*)((const bf16_t*)SA + o); pb = *(const u32x2*)((const bf16_t*)SB + o); pd = *(const f32x4*)(SD + o); pk = *(const u32x2*)((const bf16_t*)SK + o); pr = *(const u32x2*)((const bf16_t*)SRD + o);
                pv = ((const bf16_t*)SV)[m * 512 + h * 64 + rg * 16 + c16];
                if (tid < 32) ps = SBR[((size_t)b * 2048 + (n + 1) * TC + tid) * 8 + h]; else if (tid < 64) ps = SKR[((size_t)b * 2048 + (n + 1) * TC + tid - 32) * 8 + h];
            }
            if (wave < 4) {
                LAS float* ybase = (c == 0) ? (yb + rl) : (L + 2 * CB + 1024 + lane);
                const LAS float* p0 = Bc + c * 4;
                f32x4 av = *(const LAS f32x4*)p0, bv = *(const LAS f32x4*)(p0 + 2048), dv = *(const LAS f32x4*)(p0 + 4096), kv = *(const LAS f32x4*)(p0 + 6144), rd = *(const LAS f32x4*)(p0 + 8192);
                float vi = Bc[10240 + rl], br = Bc[10752], kr = Bc[10784];
#pragma unroll 8
                for (int t = 0; t < TC; ++t) {
                    const int tn = (t + 1 < TC) ? t + 1 : t;
                    const LAS float* p = Bc + tn * 64 + c * 4;
                    const f32x4 av2 = *(const LAS f32x4*)p, bv2 = *(const LAS f32x4*)(p + 2048), dv2 = *(const LAS f32x4*)(p + 4096), kv2 = *(const LAS f32x4*)(p + 6144), rd2 = *(const LAS f32x4*)(p + 8192);
                    const float vi2 = Bc[10240 + tn * 16 + rl], br2 = Bc[10752 + tn], kr2 = Bc[10784 + tn];
                    const float y = scan_step(s, av, bv, dv, kv, rd, vi, br, kr);
                    ybase[t * 16] = y;
                    av = av2; bv = bv2; dv = dv2; kv = kv2; rd = rd2; vi = vi2; br = br2; kr = kr2;
                }
            }
            else {
                const int hw4 = wave - 4;
                if (l == 0 && n < 14) {
                    const int d = (blockIdx.x * 4 + hw4) + 1024 * n;
                    if (d < TR_DEFERRED) tr_deferred(a, ws, d, (LAS float*)(lds + 94208 + hw4 * 8448), lane);
                } else if (n >= 24 && n < 41) {
                    const int tt = (n - 24) * 4 + hw4;
                    int mB = -1;
                    if (tt < 64) mB = blockIdx.x * 64 + tt; else if (tt == 64 && blockIdx.x < NS) mB = MP + blockIdx.x;
                    if (mB >= 0) convB_token(a, l, mB, lane);
                } else if (n >= 20 && n < 24) {
                    const int q = blockIdx.x + gridDim.x * (n - 20);
                    if (q < NS * 8) {
                        const int i = q >> 3, hs = q & 7; const size_t ms = MP + i;
                        const size_t o = ms * 512 + hs * 64 + c * 4;
                        const f32x4 av = ld_bf4((const bf16_t*)SA + o), bv = ld_bf4((const bf16_t*)SB + o), dv = *(const f32x4*)(SD + o), kv = ld_bf4((const bf16_t*)SK + o), rd = ld_bf4((const bf16_t*)SRD + o);
                        const float br = SBR[ms * 8 + hs], kr = SKR[ms * 8 + hs];
#pragma unroll 1
                        for (int p4 = 0; p4 < 4; ++p4) {
                            const int row = p4 * 16 + hw4 * 4 + j4;
                            const size_t so = ((size_t)((l * NS + i) * 8 + hs)) * 4096 + row * 64 + c * 4;
                            const f32x4 s4 = *(const f32x4*)(a.in[I_SWKV] + so);
                            const float vi = bf2f(((const bf16_t*)SV)[ms * 512 + hs * 64 + row]);
                            float ss_[4] = {s4[0], s4[1], s4[2], s4[3]};
                            const float y = scan_step(ss_, av, bv, dv, kv, rd, vi, br, kr);
                            *(f32x4*)(a.out + O_WKVS + so) = (f32x4){ss_[0], ss_[1], ss_[2], ss_[3]};
                            if (c == 0) ((bf16_t*)Y)[ms * 512 + hs * 64 + row] = (bf16_t)f2bf(y);
                        }
                    }
                }
            }
            if (more) {
                *(LAS f32x4*)(Bn + st * 64 + c16 * 4) = (f32x4){bflo(pa.x), bfhi(pa.x), bflo(pa.y), bfhi(pa.y)}; *(LAS f32x4*)(Bn + 2048 + st * 64 + c16 * 4) = (f32x4){bflo(pb.x), bfhi(pb.x), bflo(pb.y), bfhi(pb.y)}; *(LAS f32x4*)(Bn + 4096 + st * 64 + c16 * 4) = pd;
                *(LAS f32x4*)(Bn + 6144 + st * 64 + c16 * 4) = (f32x4){bflo(pk.x), bfhi(pk.x), bflo(pk.y), bfhi(pk.y)}; *(LAS f32x4*)(Bn + 8192 + st * 64 + c16 * 4) = (f32x4){bflo(pr.x), bfhi(pr.x), bflo(pr.y), bfhi(pr.y)}; Bn[10240 + st * 16 + c16] = bf2f(pv);
                if (tid < 64) Bn[10752 + tid] = ps;
            }
            __syncthreads();
            ((bf16_t*)Y)[((size_t)b * 2048 + n * TC + st) * 512 + h * 64 + rg * 16 + c16] = (bf16_t)f2bf(yb[st * 16 + c16]);
        }
        if (wave < 4) {
            float* o = a.out + O_WKVP + ((size_t)((l * 8 + b) * 8 + h)) * 4096 + (rg * 16 + rl) * 64 + c * 4;
            *(f32x4*)o = (f32x4){s[0], s[1], s[2], s[3]};
        }
        __syncthreads();
    }
}

__device__ __forceinline__ void post_phase(const Args& a, int l, int lane, int gw, int NGW) {
    unsigned char* ws = a.ws;
    const bf16_t* __restrict__ PROJ = (const bf16_t*)(ws + OFF_PROJ);
    const float* __restrict__ Y = (const float*)(ws + OFF_Y); const float* __restrict__ SV = (const float*)(ws + (l == 0 ? OFF_SV0 : OFF_SV1)); const float* __restrict__ GG = (const float*)(ws + OFF_G);
    const float* __restrict__ RKR = (const float*)(ws + OFF_RKR);
    bf16_t* __restrict__ YAB = (bf16_t*)(ws + OFF_YAB);
    const int cb = lane * 8, h = lane >> 3;
#pragma unroll 4
    for (int m = gw; m < MTOK; m += NGW) {
        const size_t o = (size_t)m * 512 + cb;
        f32x4 y0, y1; { const u32x4 yq = *(const u32x4*)((const bf16_t*)Y + o); y0 = (f32x4){bflo(yq.x), bfhi(yq.x), bflo(yq.y), bfhi(yq.y)}; y1 = (f32x4){bflo(yq.z), bfhi(yq.z), bflo(yq.w), bfhi(yq.w)}; }
        float s = (y0[0] + y0[1]) + (y0[2] + y0[3]) + (y1[0] + y1[1]) + (y1[2] + y1[3]);
        s += __shfl_xor(s, 1); s += __shfl_xor(s, 2); s += __shfl_xor(s, 4);
        const float mean = s * (1.f / 64.f);
        const f32x4 d0 = y0 - mean, d1 = y1 - mean;
        float q = (d0[0] * d0[0] + d0[1] * d0[1]) + (d0[2] * d0[2] + d0[3] * d0[3]) + (d1[0] * d1[0] + d1[1] * d1[1]) + (d1[2] * d1[2] + d1[3] * d1[3]);
        q += __shfl_xor(q, 1); q += __shfl_xor(q, 2); q += __shfl_xor(q, 4);
        const float rstd = rsqrtf(q * (1.f / 64.f) + GN_EPS);
        const float rkr = RKR[m * 8 + h];
        f32x4 v0, v1; { const u32x4 vq = *(const u32x4*)((const bf16_t*)SV + o); v0 = (f32x4){bflo(vq.x), bfhi(vq.x), bflo(vq.y), bfhi(vq.y)}; v1 = (f32x4){bflo(vq.z), bfhi(vq.z), bflo(vq.w), bfhi(vq.w)}; } f32x4 g0, g1; { const u32x4 gq = *(const u32x4*)((const bf16_t*)GG + o); g0 = (f32x4){bflo(gq.x), bfhi(gq.x), bflo(gq.y), bfhi(gq.y)}; g1 = (f32x4){bflo(gq.z), bfhi(gq.z), bflo(gq.w), bfhi(gq.w)}; }
        const f32x4 lw0 = *(const f32x4*)(a.in[I_LNW] + l * 512 + cb), lw1 = *(const f32x4*)(a.in[I_LNW] + l * 512 + cb + 4);
        const f32x4 lb0 = *(const f32x4*)(a.in[I_LNB] + l * 512 + cb), lb1 = *(const f32x4*)(a.in[I_LNB] + l * 512 + cb + 4);
        const f32x4 r0 = (d0 * rstd * lw0 + lb0 + v0 * rkr) * g0, r1 = (d1 * rstd * lw1 + lb1 + v1 * rkr) * g1;
        u32x4 w; w.x = pk2(r0[0], r0[1]); w.y = pk2(r0[2], r0[3]); w.z = pk2(r1[0], r1[1]); w.w = pk2(r1[2], r1[3]);
        *(u32x4*)(YAB + (size_t)m * 1024 + cb) = w;
    }
    if (l + 1 < 2 && gw < NS) {
        bf16_t* XB = (bf16_t*)(ws + OFF_XB) + (size_t)(MTOK + gw) * D;
        const float* src = a.in[I_SSHIFT] + (size_t)((l + 1) * NS + gw) * D; const float* gn = a.in[I_NMIX] + (l + 1) * D;
#pragma unroll
        for (int j = 0; j < 4; ++j) { const f32x4 v = *(const f32x4*)(src + 4 * lane + 256 * j), g4 = *(const f32x4*)(gn + 4 * lane + 256 * j);
            u32x2 w; w.x = pk2(v[0] / g4[0], v[1] / g4[1]); w.y = pk2(v[2] / g4[2], v[3] / g4[3]); *(u32x2*)(XB + 4 * lane + 256 * j) = w; }
    }
}

__device__ __forceinline__ void sample_attn(LAS unsigned char* lds, const Args& a, int l, int tid, int lane, int wave) {
    unsigned char* ws = a.ws;
    const bf16_t* Q = (const bf16_t*)(ws + OFF_Q); bf16_t* O = (bf16_t*)(ws + OFF_O);
    LAS float* sc = (LAS float*)lds;
    LAS float* part = sc + 256;
    for (int q = blockIdx.x; q < NS * 4; q += gridDim.x) {
        const int i = q >> 2, h = q & 3;
        const u32x2 qw = *(const u32x2*)(Q + (size_t)(MP + i) * 1024 + h * 256 + lane * 4);
        const float q0 = bflo(qw.x), q1 = bfhi(qw.x), q2 = bflo(qw.y), q3 = bfhi(qw.y);
        const float* Kb = a.in[I_CK] + ((size_t)((l * NS + i) * 256) * 4 + h) * 256 + lane * 4;
        const float* Vb = a.in[I_CV] + ((size_t)((l * NS + i) * 256) * 4 + h) * 256 + lane * 4;
        {
            f32x4 kx[8], kn[8];
#pragma unroll
            for (int e = 0; e < 8; ++e) kx[e] = __builtin_nontemporal_load((const f32x4*)(Kb + (size_t)(wave * 32 + e) * 1024));
#pragma unroll
            for (int g8 = 0; g8 < 4; ++g8) {
                if (g8 < 3) {
#pragma unroll
                    for (int e = 0; e < 8; ++e) kn[e] = __builtin_nontemporal_load((const f32x4*)(Kb + (size_t)(wave * 32 + (g8 + 1) * 8 + e) * 1024));
                }
#pragma unroll
                for (int e = 0; e < 8; ++e) { float p = kx[e][0] * q0 + kx[e][1] * q1 + kx[e][2] * q2 + kx[e][3] * q3; p = wave_sum(p); if (lane == 0) sc[wave * 32 + g8 * 8 + e] = p; }
#pragma unroll
                for (int e = 0; e < 8; ++e) kx[e] = kn[e];
            }
        }
        __syncthreads();
        if (wave == 0) {
            const f32x4 s4 = *(const LAS f32x4*)(sc + lane * 4);
            const float mx = wave_max(fmaxf(fmaxf(s4[0], s4[1]), fmaxf(s4[2], s4[3])));
            f32x4 e4; e4[0] = __expf(s4[0] - mx); e4[1] = __expf(s4[1] - mx); e4[2] = __expf(s4[2] - mx); e4[3] = __expf(s4[3] - mx);
            const float inv = 1.f / wave_sum((e4[0] + e4[1]) + (e4[2] + e4[3]));
            *(LAS f32x4*)(sc + lane * 4) = e4 * inv;
        }
        __syncthreads();
        f32x4 acc = (f32x4){0.f, 0.f, 0.f, 0.f};
        {
            f32x4 vx[8], vn[8];
#pragma unroll
            for (int e = 0; e < 8; ++e) vx[e] = __builtin_nontemporal_load((const f32x4*)(Vb + (size_t)(wave * 32 + e) * 1024));
#pragma unroll
            for (int g8 = 0; g8 < 4; ++g8) {
                if (g8 < 3) {
#pragma unroll
                    for (int e = 0; e < 8; ++e) vn[e] = __builtin_nontemporal_load((const f32x4*)(Vb + (size_t)(wave * 32 + (g8 + 1) * 8 + e) * 1024));
                }
#pragma unroll
                for (int e = 0; e < 8; ++e) acc += vx[e] * sc[wave * 32 + g8 * 8 + e];
#pragma unroll
                for (int e = 0; e < 8; ++e) vx[e] = vn[e];
            }
        }
        *(LAS f32x4*)(part + wave * 256 + lane * 4) = acc;
        __syncthreads();
        if (tid < 256) {
            float s = 0.f;
#pragma unroll
            for (int w = 0; w < 8; ++w) s += part[w * 256 + tid];
            O[(size_t)(MP + i) * 1024 + h * 256 + tid] = (bf16_t)f2bf(s);
        }
        __syncthreads();
    }
}

__device__ __forceinline__ void ffnconv_phase(const Args& a, int l, int tid) {
    unsigned char* ws = a.ws;
    const bf16_t* __restrict__ UP = (const bf16_t*)(ws + OFF_UP); bf16_t* __restrict__ H = (bf16_t*)(ws + OFF_H);
    const float* __restrict__ cw = a.in[I_FCW] + (size_t)l * 3 * FW2;
    constexpr int CH = FW / 8;
    for (int rb = blockIdx.x; rb < MP / 64; rb += gridDim.x) {
        if (tid < CH) {
            const int c = tid * 8, r0 = rb * 64, t0 = r0 & 2047;
            float wu[3][8], wg[3][8];
#pragma unroll
            for (int k = 0; k < 3; ++k) {
                const f32x4 a0 = *(const f32x4*)(cw + k * FW2 + c), a1 = *(const f32x4*)(cw + k * FW2 + c + 4), b0 = *(const f32x4*)(cw + k * FW2 + FW + c), b1 = *(const f32x4*)(cw + k * FW2 + FW + c + 4);
#pragma unroll
                for (int j = 0; j < 4; ++j) { wu[k][j] = a0[j]; wu[k][4 + j] = a1[j]; wg[k][j] = b0[j]; wg[k][4 + j] = b1[j]; }
            }
            float u2[8], u1[8], g2[8], g1[8];
#pragma unroll
            for (int j = 0; j < 8; ++j) { u2[j] = 0.f; u1[j] = 0.f; g2[j] = 0.f; g1[j] = 0.f; }
            if (t0 >= 2) {
                const bf16_t* p = UP + (size_t)(r0 - 2) * FW2 + c;
                unpack8(*(const u32x4*)p, u2); unpack8(*(const u32x4*)(p + FW), g2); unpack8(*(const u32x4*)(p + FW2), u1); unpack8(*(const u32x4*)(p + FW2 + FW), g1);
            }
            const bf16_t* p = UP + (size_t)r0 * FW2 + c; bf16_t* hp = H + (size_t)r0 * FW + c;
#pragma unroll 1
            for (int r = 0; r < 64; r += 4) {
                u32x4 lu[4], lg[4];
#pragma unroll
                for (int e = 0; e < 4; ++e) { lu[e] = __builtin_nontemporal_load((const u32x4*)(p + (size_t)(r + e) * FW2)); lg[e] = __builtin_nontemporal_load((const u32x4*)(p + (size_t)(r + e) * FW2 + FW)); }
#pragma unroll
                for (int e = 0; e < 4; ++e) {
                    float u0[8], g0[8], hh[8]; unpack8(lu[e], u0); unpack8(lg[e], g0);
#pragma unroll
                    for (int j = 0; j < 8; ++j) {
                        const float uu = wu[0][j] * u2[j] + wu[1][j] * u1[j] + wu[2][j] * u0[j], gg = wg[0][j] * g2[j] + wg[1][j] * g1[j] + wg[2][j] * g0[j];
                        hh[j] = gg * __builtin_amdgcn_rcpf(1.f + __expf(-gg)) * uu;
                        u2[j] = u1[j]; u1[j] = u0[j]; g2[j] = g1[j]; g1[j] = g0[j];
                    }
                    u32x4 w; w.x = cvt_pk_bf16(hh[0], hh[1]); w.y = cvt_pk_bf16(hh[2], hh[3]); w.z = cvt_pk_bf16(hh[4], hh[5]); w.w = cvt_pk_bf16(hh[6], hh[7]);
                    *(u32x4*)(hp + (size_t)(r + e) * FW) = w;
                }
            }
        }
    }
    for (int it = blockIdx.x * 512 + tid; it < NS * CH; it += gridDim.x * 512) {
        const int i = it / CH, c = (it % CH) * 8, m = MP + i;
        const bf16_t* r0 = UP + (size_t)m * FW2;
        float u[8], g[8], t0[8], t1[8];
        unpack8(*(const u32x4*)(r0 + c), t0); unpack8(*(const u32x4*)(r0 + FW + c), t1);
        const float* sf = a.in[I_SFFN] + (size_t)(l * NS + i) * 2 * FW2;
        float* dst = a.out + O_FFNS + (size_t)(l * NS + i) * 2 * FW2;
        float hh[8];
#pragma unroll
        for (int q = 0; q < 2; ++q) {
            const int cc = c + 4 * q;
            const f32x4 p0u = *(const f32x4*)(sf + cc), p0g = *(const f32x4*)(sf + FW + cc), p1u = *(const f32x4*)(sf + FW2 + cc), p1g = *(const f32x4*)(sf + FW2 + FW + cc);
            const f32x4 w0u = *(const f32x4*)(cw + cc), w1u = *(const f32x4*)(cw + FW2 + cc), w2u = *(const f32x4*)(cw + 2 * FW2 + cc);
            const f32x4 w0g = *(const f32x4*)(cw + FW + cc), w1g = *(const f32x4*)(cw + FW2 + FW + cc), w2g = *(const f32x4*)(cw + 2 * FW2 + FW + cc);
            *(f32x4*)(dst + cc) = p1u; *(f32x4*)(dst + FW + cc) = p1g;
#pragma unroll
            for (int j = 0; j < 4; ++j) {
                u[4 * q + j] = w2u[j] * t0[4 * q + j] + w0u[j] * p0u[j] + w1u[j] * p1u[j]; g[4 * q + j] = w2g[j] * t1[4 * q + j] + w0g[j] * p0g[j] + w1g[j] * p1g[j];
                hh[4 * q + j] = g[4 * q + j] * sigmoidf_(g[4 * q + j]) * u[4 * q + j];
            }
        }
        u32x4 w; w.x = pk2(hh[0], hh[1]); w.y = pk2(hh[2], hh[3]); w.z = pk2(hh[4], hh[5]); w.w = pk2(hh[6], hh[7]);
        *(u32x4*)(H + (size_t)m * FW + c) = w;
    }
}

__device__ __forceinline__ void final_phase(const Args& a, int lane, int gw, int NGW) {
    unsigned char* ws = a.ws;
    const bf16_t* __restrict__ X = (const bf16_t*)(ws + OFF_XB); const float* __restrict__ SS = (const float*)(ws + OFF_SS) + (size_t)6 * MROWS;
    float* __restrict__ outp = a.out;
#pragma unroll 4
    for (int m = gw; m < MTOK; m += NGW) {
        const float rs = rsqrtf(SS[m] * (1.f / 1024.f) + EPS);
        float* __restrict__ dst = m < MP ? outp + O_YP + (size_t)m * D : outp + O_YS + (size_t)(m - MP) * D;
#pragma unroll
        for (int j = 0; j < 4; ++j) { const u32x2 xw = *(const u32x2*)(X + (size_t)m * D + 4 * lane + 256 * j); const f32x4 v = (f32x4){bflo(xw.x), bfhi(xw.x), bflo(xw.y), bfhi(xw.y)}, gn = *(const f32x4*)(a.in[I_NFIN] + 4 * lane + 256 * j);
            *(f32x4*)(dst + 4 * lane + 256 * j) = v * rs * gn; }
    }
}

__device__ __forceinline__ void skinny_gemm(LAS unsigned char* lds, const bf16_t* __restrict__ A, int lda, const bf16_t* __restrict__ Wt, int K, int mode, float* X, bf16_t* O, float* ssn, const float* ss, int lane, int wave) {
    LAS f32x4* part = (LAS f32x4*)lds;
    for (int item = blockIdx.x; item < 256; item += gridDim.x) {
        const int n0 = (item & 63) * 16, r0 = MP + (item >> 6) * 32, fr = lane & 15, fq = lane >> 4;
        const bf16_t* ap = A + (size_t)(r0 + fr) * lda + fq * 8;
        const bf16_t* bp = Wt + (size_t)(n0 + fr) * K + fq * 8;
        f32x4 acc0 = (f32x4){0.f, 0.f, 0.f, 0.f}, acc1 = acc0;
#pragma unroll 4
        for (int ks = wave; ks < K / 32; ks += 8) {
            const bf16x8 bf = *(const bf16x8*)(bp + ks * 32), a0 = *(const bf16x8*)(ap + ks * 32), a1 = *(const bf16x8*)(ap + (size_t)16 * lda + ks * 32);
            acc0 = __builtin_amdgcn_mfma_f32_16x16x32_bf16(bf, a0, acc0, 0, 0, 0);
            acc1 = __builtin_amdgcn_mfma_f32_16x16x32_bf16(bf, a1, acc1, 0, 0, 0);
        }
        part[(wave * 2 + 0) * 64 + lane] = acc0; part[(wave * 2 + 1) * 64 + lane] = acc1;
        __syncthreads();
        if (wave < 2) {
            f32x4 acc = part[wave * 64 + lane];
#pragma unroll
            for (int w = 1; w < 8; ++w) acc += part[(w * 2 + wave) * 64 + lane];
            const int row = r0 + wave * 16 + fr, col = n0 + fq * 4;
            const size_t idx = (size_t)row * 1024 + col;
            if (mode == 1) {
                const u32x2 xi = *(const u32x2*)(O + idx);
                const f32x4 x = (f32x4){bflo(xi.x), bfhi(xi.x), bflo(xi.y), bfhi(xi.y)} + acc;
                u32x2 w; w.x = cvt_pk_bf16(x[0], x[1]); w.y = cvt_pk_bf16(x[2], x[3]); *(u32x2*)(O + idx) = w;
                float sq = (x[0] * x[0] + x[1] * x[1]) + (x[2] * x[2] + x[3] * x[3]);
                sq += __shfl_xor(sq, 16); sq += __shfl_xor(sq, 32);
                if (fq == 0) atomicAdd(ssn + row, sq);
            } else {
                const float rs = rsqrtf(ss[row] * (1.f / 1024.f) + EPS);
                u32x2 w; w.x = cvt_pk_bf16(acc[0] * rs, acc[1] * rs); w.y = cvt_pk_bf16(acc[2] * rs, acc[3] * rs); *(u32x2*)(O + idx) = w;
            }
        }
        __syncthreads();
    }
}

#define XB_TMO      128
#define XB_XCNT(j)  (256  + 64 * (j))
#define XB_XSUB(j)  (1280 + 64 * (j))
#define XB_XGEN(j)  (2304 + 64 * (j))
#define XB_TOP      3328
#define XB_TOPGEN   3392
#define XCD_BAR_WORDS 3456
#define XB_SPIN_CAP (1u << 22)
__device__ __forceinline__ unsigned xb_ld(unsigned* p)              { return __hip_atomic_load(p, __ATOMIC_RELAXED, __HIP_MEMORY_SCOPE_AGENT); }
__device__ __forceinline__ unsigned xb_add(unsigned* p, unsigned v) { return __hip_atomic_fetch_add(p, v, __ATOMIC_RELAXED, __HIP_MEMORY_SCOPE_AGENT); }
__device__ __forceinline__ unsigned xb_xcc_id() { return (unsigned)__builtin_amdgcn_s_getreg((3 << 11) | 20) & 0xFu; }
#define XB_SPIN(cond, bar) do { unsigned _sp = 0; while (cond) { __builtin_amdgcn_s_sleep(1); \
    if ((++_sp & 255u) == 0u) { if (xb_ld(&(bar)[XB_TMO])) break; if (_sp > XB_SPIN_CAP) { atomicAdd(&(bar)[XB_TMO], 1u); break; } } } } while (0)
struct XcdBarrier { unsigned* bar; unsigned x; volatile LAS unsigned* st; };
__device__ __forceinline__ XcdBarrier xcd_barrier_post(unsigned* bar, volatile LAS unsigned* st) {
    XcdBarrier b; b.bar = bar; b.x = xb_xcc_id(); b.st = st;
    if (threadIdx.x == 0) (void)xb_add(&bar[XB_XCNT(b.x)], 1u);
    return b;
}
__device__ __forceinline__ void xcd_barrier_complete(unsigned* bar, unsigned x, unsigned& nloc, unsigned& nx) {
    const unsigned G = gridDim.x * gridDim.y * gridDim.z;
    unsigned sum, cnt, mine, sp = 0u;
    for (;;) {
        sum = 0u; cnt = 0u; mine = 0u;
#pragma unroll
        for (unsigned j = 0; j < 16; ++j) { const unsigned c = xb_ld(&bar[XB_XCNT(j)]); sum += c; cnt += (c > 0u) ? 1u : 0u; mine = (j == x) ? c : mine; }
        if (sum == G) break;
        __builtin_amdgcn_s_sleep(1);
        if ((++sp & 255u) == 0u) { if (xb_ld(&bar[XB_TMO])) break; if (sp > XB_SPIN_CAP) { atomicAdd(&bar[XB_TMO], 1u); break; } }
    }
    nloc = mine > 0u ? mine : 1u; nx = cnt > 0u ? cnt : 1u;
}
__device__ __forceinline__ void xcd_barrier(const XcdBarrier& b) {
    asm volatile("s_waitcnt vmcnt(0)" ::: "memory");
    __syncthreads();
    if (threadIdx.x == 0) {
        unsigned* bar = b.bar;
        __builtin_amdgcn_s_waitcnt(0);
        unsigned nloc = b.st[0], nx = b.st[1];
        if (nloc == 0u) { xcd_barrier_complete(bar, b.x, nloc, nx); b.st[0] = nloc; b.st[1] = nx; }
        const unsigned old = xb_add(&bar[XB_XSUB(b.x)], 1u);
        const unsigned gen = old / nloc;
        if (old + 1u == (gen + 1u) * nloc) {
            __builtin_amdgcn_fence(__ATOMIC_RELEASE, "agent");
            asm volatile("s_waitcnt vmcnt(0)" ::: "memory");
            const unsigned og = xb_add(&bar[XB_TOP], 1u);
            const unsigned tg = og / nx;
            if (og + 1u == (tg + 1u) * nx) xb_add(&bar[XB_TOPGEN], 1u);
            else XB_SPIN(xb_ld(&bar[XB_TOPGEN]) == tg, bar);
            __builtin_amdgcn_fence(__ATOMIC_ACQUIRE, "agent");
            xb_add(&bar[XB_XGEN(b.x)], 1u);
            asm volatile("s_waitcnt vmcnt(0)" ::: "memory");
        } else {
            XB_SPIN(xb_ld(&bar[XB_XGEN(b.x)]) == gen, bar);
            __builtin_amdgcn_fence(__ATOMIC_ACQUIRE, "agent");
            asm volatile("s_waitcnt vmcnt(0)" ::: "memory");
        }
    }
    __syncthreads();
}

__global__ void __launch_bounds__(512, 2) mega(Args a) {
    extern __shared__ __attribute__((aligned(16))) unsigned char lds_raw[];
    LAS unsigned char* lds = (LAS unsigned char*)lds_raw;
    cg::grid_group grid = cg::this_grid();
    volatile LAS unsigned* bst = (volatile LAS unsigned*)(lds + 131072 + 64);
    if (threadIdx.x == 0) { bst[0] = 0u; bst[1] = 0u; }
    __syncthreads();
    const XcdBarrier xbar = xcd_barrier_post((unsigned*)(a.ws + OFF_BAR), bst);
    for (int ph2 = 2 * a.ph_lo; ph2 < 2 * a.ph_hi; ++ph2) {
        const int ph = ph2 >> 1;
        if (ph2 & 1) { const int spx = (ph == 0) ? 12 : (ph == NPHASE - 1) ? 13 : (ph - 1) % 12; if (!((REP_MASK >> spx) & 1)) continue; }
        int tid = threadIdx.x; asm volatile("" : "+v"(tid));
        const int lane = tid & 63, wave = __builtin_amdgcn_readfirstlane(tid >> 6);
        const int G = gridDim.x, gw = blockIdx.x * 8 + wave, NGW = G * 8;
        unsigned char* ws = a.ws; asm volatile("" : "+s"(ws));
        float* SS = (float*)(ws + OFF_SS);
        bf16_t* XB = (bf16_t*)(ws + OFF_XB); float* X = (float*)(ws + OFF_X);
        if (ph == 0) {
            if (PHON(12)) p0_prologue(lds, a, tid, lane, wave, gw, NGW);
        } else if (ph == NPHASE - 1) {
            if (PHON(13)) final_phase(a, lane, gw, NGW);
        } else {
            const int l = (ph - 1) / 12, sp = (ph - 1) % 12;
            const bool is_gemm = (sp == 0 || sp == 4 || sp == 5 || sp == 7 || sp == 8 || sp == 9 || sp == 11);
            if (is_gemm && PHON(0)) {
                const int njobs = (l == 0 && (sp == 0 || sp == 9)) ? 3 : 1;
                for (int jb = 0; jb < njobs; ++jb) {
                    pg8::Gemm g; pg8::GenOrder S; pg8::Epi E;
                    E.mode = 0; E.O = nullptr; E.ldc = D; E.ss = nullptr; E.X = nullptr; E.ssn = nullptr; E.F = nullptr; E.l = l; E.dry = (ph2 & 1);
                    if (sp == 0 && jb == 0) {
                        g = pg8::Gemm{XB, (const bf16_t*)(ws + OFF_WIN) + (size_t)l * LDP * D, D, D, D};
                        S.init(0, MROWS, LDP, D, D, G, (int)blockIdx.x);
                        E.O = (bf16_t*)(ws + OFF_PROJ); E.ldc = LDP; E.ss = SS + (size_t)3 * l * MROWS;
                    } else if (jb > 0) {
                        const int kv = (sp == 0 ? 0 : 2) + jb - 1, ll = kv >> 1, isv = kv & 1;
                        g = pg8::Gemm{(const bf16_t*)(ws + OFF_MNB), (const bf16_t*)(ws + (isv ? OFF_WV : OFF_WK)) + (size_t)ll * D * D, D, D, D};
                        S.init(0, MMEM, D, D, D, G, (int)((blockIdx.x + G - 160 - 32 * (jb - 1)) % G));
                        E.mode = isv ? 3 : 2; E.O = (bf16_t*)(ws + (isv ? OFF_MVT : OFF_MK)) + (size_t)ll * MMEM * D; E.ss = (const float*)(ws + OFF_SSM);
                        E.F = a.out + (isv ? O_MVP : O_MKP) + (size_t)ll * MMEM * D; E.l = ll;
                    } else if (sp == 4 || sp == 8 || sp == 11) {
                        const bf16_t* A = (const bf16_t*)(ws + (sp == 4 ? OFF_YAB : sp == 8 ? OFF_O : OFF_H));
                        const bf16_t* B = sp == 4 ? (const bf16_t*)(ws + OFF_WOUT) + (size_t)l * D * D : sp == 8 ? (const bf16_t*)(ws + OFF_WO) + (size_t)l * D * D : (const bf16_t*)(ws + OFF_WDN) + (size_t)l * D * FW;
                        const int K = sp == 11 ? FW : D;
                        const int nrm = 3 * l + (sp == 4 ? 1 : sp == 8 ? 2 : 3);
                        g = pg8::Gemm{A, B, K, K, K};
                        S.init(0, MP, D, K, K, G, (int)blockIdx.x);
                        E.mode = 1; E.O = XB; E.X = X; E.ssn = SS + (size_t)nrm * MROWS;
                    } else if (sp == 5) {
                        g = pg8::Gemm{XB, (const bf16_t*)(ws + OFF_WQ) + (size_t)l * D * D, D, D, D};
                        S.init(0, MP, D, D, D, G, (int)blockIdx.x);
                        E.O = (bf16_t*)(ws + OFF_Q); E.ss = SS + (size_t)(3 * l + 1) * MROWS;
                    } else if (sp == 7) {
                        g = pg8::Gemm{(const bf16_t*)(ws + OFF_P), (const bf16_t*)(ws + OFF_MVT) + (size_t)l * MMEM * D, D, 256, 256};
                        S.init(2, MP, D, D, 256, G, (int)blockIdx.x);
                        E.O = (bf16_t*)(ws + OFF_O);
                    } else {
                        g = pg8::Gemm{XB, (const bf16_t*)(ws + OFF_WUP) + (size_t)l * FW2 * D, D, D, D};
                        S.init(0, MROWS, FW2, D, D, G, (int)blockIdx.x);
                        E.mode = 4; E.O = (bf16_t*)(ws + OFF_UP); E.ldc = FW2; E.ss = SS + (size_t)(3 * l + 2) * MROWS; E.F = a.out;
                    }
                    pg8::gemm_phase<pg8::Epi, pg8::GenOrder, true>(lds, g, S, E);
                    if (jb == 0 && !(ph2 & 1) && (sp == 4 || sp == 5 || sp == 8 || sp == 11))
                        skinny_gemm(lds, g.A, g.lda, g.Bt, g.K, E.mode, X, E.O, E.ssn, E.ss, lane, wave);
                }
            } else if (sp == 1 && PHON(1)) {
                prep_phase(lds, a, l, tid, lane, wave, gw);
            } else if (sp == 2 && PHON(2)) {
                scan_phase(lds, a, l, tid, lane, wave);
            } else if (sp == 3 && PHON(3)) {
                post_phase(a, l, lane, gw, NGW);
            } else if (sp == 6 && PHON(6)) {
                {
                    pg8::Gemm g{(const bf16_t*)(ws + OFF_Q), (const bf16_t*)(ws + OFF_MK) + (size_t)l * MMEM * D, D, D, 256};
                    pg8::GenOrder S; S.init(1, MP, D, D, D, G, (int)blockIdx.x);
                    pg8::EpiSm E{(bf16_t*)(ws + OFF_P)};
                    pg8::gemm_phase<pg8::EpiSm, pg8::GenOrder, false>(lds, g, S, E);
                }
                __syncthreads();
                sample_attn(lds, a, l, tid, lane, wave);
            } else if (sp == 10 && PHON(10)) {
                ffnconv_phase(a, l, tid);
            }
        }
        if (ph2 + 1 < 2 * a.ph_hi) { if (a.ph_lo < 0) grid.sync(); else xcd_barrier(xbar); }
        if (((REP_MASK >> 14) & 1) && ph2 == 0) { for (int q = 0; q < 40; ++q) xcd_barrier(xbar); }
    }
}

extern "C" void kernel_launch(void* const* d_in, const int* in_sizes, int n_in, void* d_out, int out_size, void* d_ws, size_t ws_size, hipStream_t stream) {
    static int grid = 0;
    if (grid == 0) {
        if (n_in != 38 || ws_size < WS_END) { fprintf(stderr, "kernel_launch: expected 38 inputs and >= %zu bytes of workspace (got %d, %zu)\n", (size_t)WS_END, n_in, ws_size); grid = -1; return; }
        int dev = 0, cus = 0, per_cu = 0;
        hipGetDevice(&dev);
        hipDeviceGetAttribute(&cus, hipDeviceAttributeMultiprocessorCount, dev);
        if (hipFuncSetAttribute((const void*)mega, hipFuncAttributeMaxDynamicSharedMemorySize, LDS_BYTES) != hipSuccess) { fprintf(stderr, "kernel_launch: hipFuncSetAttribute failed\n"); grid = -1; return; }
        hipOccupancyMaxActiveBlocksPerMultiprocessor(&per_cu, (const void*)mega, 512, LDS_BYTES);
        if (per_cu < 1) { fprintf(stderr, "kernel_launch: occupancy query says %d blocks per CU\n", per_cu); per_cu = 1; }
        (void)hipGetLastError();
        grid = cus;
        if (grid != 256) fprintf(stderr, "kernel_launch: built for 256 CUs, got %d\n", grid);
    }
    if (grid < 0) return;
    if (hipMemsetAsync((char*)d_ws + OFF_BAR, 0, BAR_BYTES, stream) != hipSuccess) { fprintf(stderr, "kernel_launch: hipMemsetAsync failed\n"); return; }
    Args a{};
    for (int i = 0; i < 38; ++i) a.in[i] = (const float*)d_in[i];
    a.out = (float*)d_out; a.ws = (unsigned char*)d_ws;
#if MK_PER_PHASE
    for (int ph = 0; ph < NPHASE; ++ph) {
        a.ph_lo = ph; a.ph_hi = ph + 1;
        void* args[] = {&a};
        hipError_t e = hipLaunchCooperativeKernel((const void*)mega, dim3(grid), dim3(512), args, LDS_BYTES, stream);
        if (e != hipSuccess) { fprintf(stderr, "cooperative launch failed: %s\n", hipGetErrorString(e)); break; }
    }
#else
    a.ph_lo = 0; a.ph_hi = NPHASE;
    void* args[] = {&a};
    hipError_t e = hipLaunchCooperativeKernel((const void*)mega, dim3(grid), dim3(512), args, LDS_BYTES, stream);
    if (e != hipSuccess) fprintf(stderr, "cooperative launch failed: %s (grid %d)\n", hipGetErrorString(e), grid);
#endif
    (void)in_sizes; (void)out_size;
}
```

```cpp
#include <hip/hip_runtime.h>
#include <hip/hip_cooperative_groups.h>
#include <cstdio>
#include <cstdint>
namespace cg = cooperative_groups;

#ifndef PH_MASK
#define PH_MASK 0xFFFFF
#endif
#define PHON(k) (((PH_MASK) >> (k)) & 1)
#ifndef REP_MASK
#define REP_MASK 0
#endif
#ifndef MK_PER_PHASE
#define MK_PER_PHASE 0
#endif

#define LAS __attribute__((address_space(3)))
typedef unsigned short bf16_t;
typedef short bf16x8 __attribute__((ext_vector_type(8)));
typedef float f32x4 __attribute__((ext_vector_type(4)));
typedef unsigned u32x4 __attribute__((ext_vector_type(4)));
typedef unsigned u32x2 __attribute__((ext_vector_type(2)));
#define LDS_WAIT() asm volatile("s_waitcnt lgkmcnt(0)" ::: "memory")

constexpr int D = 1024, NB = 8, TT = 2048, MP = NB * TT, NS = 128, MTOK = MP + NS, MROWS = 16640;
constexpr int INC = 3328, LDP = 3584, FW = 2816, FW2 = 5632, NMEM = 256, MMEM = NB * NMEM;
constexpr float EPS = 1e-6f, GN_EPS = 64e-5f;
constexpr int NPHASE = 26;
constexpr int LDS_BYTES = 147456;

constexpr size_t O_YP = 0, O_YS = 16777216, O_SHP = 16908288, O_WKVP = 16924672, O_CONVP = 17448960, O_FFNP = 17465344,
                 O_MKP = 17645568, O_MVP = 21839872, O_SHS = 26034176, O_WKVS = 26296320, O_CONVS = 34684928, O_FFNS = 34947072;

constexpr size_t al256(size_t x) { return (x + 255) & ~(size_t)255; }
constexpr size_t OFF_SS = 0;
constexpr size_t OFF_SSM = al256(OFF_SS + (size_t)7 * MROWS * 4);
constexpr size_t OFF_WIN = al256(OFF_SSM + 2048 * 4);
constexpr size_t OFF_WOUT = OFF_WIN + (size_t)2 * LDP * D * 2;
constexpr size_t OFF_WQ = OFF_WOUT + (size_t)2 * D * D * 2;
constexpr size_t OFF_WK = OFF_WQ + (size_t)2 * D * D * 2;
constexpr size_t OFF_WV = OFF_WK + (size_t)2 * D * D * 2;
constexpr size_t OFF_WO = OFF_WV + (size_t)2 * D * D * 2;
constexpr size_t OFF_WUP = OFF_WO + (size_t)2 * D * D * 2;
constexpr size_t OFF_WDN = OFF_WUP + (size_t)2 * FW2 * D * 2;
constexpr size_t OFF_W2 = OFF_WDN + (size_t)2 * D * FW * 2;
constexpr size_t OFF_A2 = OFF_W2 + (size_t)2 * 512 * 64 * 2;
constexpr size_t OFF_G2 = OFF_A2 + (size_t)2 * 512 * 64 * 2;
constexpr size_t OFF_V1 = OFF_G2 + (size_t)2 * 512 * 128 * 2;
constexpr size_t OFF_V2 = OFF_V1 + (size_t)32 * 512 * 2;
constexpr size_t OFF_X = al256(OFF_V2 + (size_t)512 * 32 * 2);
constexpr size_t OFF_XB = OFF_X + (size_t)MROWS * D * 4;
constexpr size_t OFF_MNB = OFF_XB + (size_t)MROWS * D * 2;
constexpr size_t OFF_MK = OFF_MNB + (size_t)MMEM * D * 2;
constexpr size_t OFF_MVT = OFF_MK + (size_t)2 * MMEM * D * 2;
constexpr size_t OFF_PROJ = OFF_MVT + (size_t)2 * MMEM * D * 2;
constexpr size_t OFF_H = OFF_PROJ;
constexpr size_t SCN = (size_t)MTOK * 512 * 4;
constexpr size_t OFF_SA = OFF_PROJ + (size_t)MROWS * LDP * 2;
constexpr size_t OFF_SB = OFF_SA + SCN, OFF_SD = OFF_SB + SCN, OFF_SK = OFF_SD + SCN, OFF_SRD = OFF_SK + SCN, OFF_G = OFF_SRD + SCN;
constexpr size_t OFF_UP = OFF_SA;
constexpr size_t OFF_SV0 = OFF_G + SCN, OFF_SV1 = OFF_SV0 + SCN;
constexpr size_t OFF_SBR = OFF_SV1 + SCN;
constexpr size_t OFF_SKR = OFF_SBR + (size_t)MTOK * 8 * 4, OFF_RKR = OFF_SKR + (size_t)MTOK * 8 * 4;
constexpr size_t OFF_Y = al256(OFF_RKR + (size_t)MTOK * 8 * 4);
constexpr size_t OFF_YAB = OFF_Y + SCN;
constexpr size_t OFF_Q = OFF_YAB + (size_t)MROWS * D * 2;
constexpr size_t OFF_P = OFF_Q + (size_t)MROWS * D * 2;
constexpr size_t OFF_O = OFF_P + (size_t)MROWS * D * 2;
constexpr size_t OFF_BAR = OFF_O + (size_t)MROWS * D * 2;
constexpr size_t BAR_BYTES = 16384;
constexpr size_t WS_END = OFF_BAR + BAR_BYTES;
static_assert((size_t)MROWS * FW2 * 2 <= 6 * SCN, "UP overlay");
static_assert((size_t)MROWS * FW * 2 <= (size_t)MROWS * LDP * 2, "H overlay");
static_assert(WS_END < (size_t)1050000000, "workspace");

__device__ __forceinline__ unsigned f2bf(float f) { unsigned u = __builtin_bit_cast(unsigned, f); return (u + 0x7fffu + ((u >> 16) & 1u)) >> 16; }
__device__ __forceinline__ unsigned pk2(float lo, float hi) { return f2bf(lo) | (f2bf(hi) << 16); }
__device__ __forceinline__ unsigned cvt_pk_bf16(float lo, float hi) { unsigned r; asm volatile("v_cvt_pk_bf16_f32 %0, %1, %2" : "=v"(r) : "v"(lo), "v"(hi)); return r; }
__device__ __forceinline__ float bflo(unsigned w) { return __builtin_bit_cast(float, w << 16); }
__device__ __forceinline__ float bfhi(unsigned w) { return __builtin_bit_cast(float, w & 0xffff0000u); }
__device__ __forceinline__ float wave_sum(float v) {
#pragma unroll
    for (int o = 1; o < 64; o <<= 1) v += __shfl_xor(v, o);
    return v;
}
__device__ __forceinline__ float wave_max(float v) {
#pragma unroll
    for (int o = 1; o < 64; o <<= 1) v = fmaxf(v, __shfl_xor(v, o));
    return v;
}
__device__ __forceinline__ float sigmoidf_(float x) { return 1.f / (1.f + __expf(-x)); }
__device__ __forceinline__ void unpack8(u32x4 w, float* f) { f[0] = bflo(w.x); f[1] = bfhi(w.x); f[2] = bflo(w.y); f[3] = bfhi(w.y); f[4] = bflo(w.z); f[5] = bfhi(w.z); f[6] = bflo(w.w); f[7] = bfhi(w.w); }
__device__ __forceinline__ f32x4 ld_bf4(const bf16_t* p) { const u32x2 w = *(const u32x2*)p; return (f32x4){bflo(w.x), bfhi(w.x), bflo(w.y), bfhi(w.y)}; }
__device__ __forceinline__ void st_bf4(bf16_t* p, const f32x4 v) { u32x2 w; w.x = cvt_pk_bf16(v[0], v[1]); w.y = cvt_pk_bf16(v[2], v[3]); *(u32x2*)p = w; }
__device__ __forceinline__ float bf2f(bf16_t h) { return __builtin_bit_cast(float, (unsigned)h << 16); }
template <int CTRL> __device__ __forceinline__ float dppf(float v) { return __builtin_bit_cast(float, __builtin_amdgcn_update_dpp(0, __builtin_bit_cast(int, v), CTRL, 0xF, 0xF, true)); }
__device__ __forceinline__ float red16(float v) { v += dppf<0xB1>(v); v += dppf<0x4E>(v); v += dppf<0x124>(v); v += dppf<0x128>(v); return v; }

namespace pg8 {
constexpr int BM = 256, BK = 64, HALF = 128, HTB = HALF * BK * 2, STAGE_BYTES = 8 * HTB, NXCD = 8, WGM = 8;
__host__ __device__ __forceinline__ int lds_byte(int r, int c) { const int st = (r >> 4) * 2 + (c >> 5), rr = r & 15, cc = c & 31, ob = rr * 64 + cc * 2; return st * 1024 + (ob ^ (((ob >> 9) & 1) << 5)); }
__host__ __device__ __forceinline__ void stage_rc(int b, int& R, int& C) { const int st = b / 1024, sb = b % 1024, swz = sb ^ (((sb >> 9) & 1) << 5); R = (st >> 1) * 16 + swz / 64; C = (st & 1) * 32 + (swz % 64) / 2; }
__host__ __device__ __forceinline__ int perm32(int rho) { const int n = rho >> 4, i = rho & 15; return 8 * (i >> 2) + 4 * n + (i & 3); }

struct Unit { int pm, pn; size_t offA, offB; };
struct Gemm { const bf16_t* A; const bf16_t* Bt; int lda, ldb, K; };

struct GenOrder {
    int mode, nM, nN, nwg, G, c; size_t sA, sB;
    __device__ void init(int mode_, int M, int N, int lda, int ldb, int G_, int c_) { mode = mode_; nM = M / BM; nN = N / BM; nwg = nM * nN; G = G_; c = c_; sA = (size_t)BM * lda * 2; sB = (size_t)BM * ldb * 2; }
    __device__ bool next(int i, Unit& u) const {
        const long L = (long)i * G + c; if (L >= nwg) return false;
        if (mode == 0) {
            int wgid = (int)L; { const int q = nwg / NXCD, r = nwg % NXCD, xcd = wgid % NXCD, off = wgid / NXCD; wgid = (xcd < r ? xcd * (q + 1) : r * (q + 1) + (xcd - r) * q) + off; }
            const int nig = WGM * nN, gid = wgid / nig, fm = gid * WGM, gsz = (nM - fm) < WGM ? (nM - fm) : WGM;
            u.pm = fm + ((wgid % nig) % gsz); u.pn = (wgid % nig) / gsz; u.offA = (size_t)u.pm * sA; u.offB = (size_t)u.pn * sB;
        } else {
            const int b = (int)L >> 5, qb = ((int)L >> 2) & 7, h = (int)L & 3;
            u.pm = b * 8 + qb; u.pn = h;
            u.offA = ((size_t)(b * 2048 + qb * 256) * 1024 + h * 256) * 2;
            u.offB = mode == 1 ? ((size_t)(b * 256) * 1024 + h * 256) * 2 : ((size_t)(b * 4 + h) * 256 * 256) * 2;
        }
        return true;
    }
};

template <class Epi, class Sched, bool ALIGN_EPI>
__device__ __forceinline__ void gemm_phase(LAS unsigned char* lds, const Gemm g, const Sched& S, const Epi& E) {
    int tid = threadIdx.x; asm volatile("" : "+v"(tid));
    const int wid = __builtin_amdgcn_readfirstlane(tid >> 6), lane = tid & 63, wr = wid >> 2, wc = wid & 3, fr = lane & 15, fq = lane >> 4;
    const int K = g.K, nt = K / BK;
    unsigned voffA[2], voffB[2];
#pragma unroll
    for (int i = 0; i < 2; ++i) { int R, C; stage_rc(tid * 16 + i * 8192, R, C); const int Rb = Epi::PERM ? ((R & ~31) + perm32(R & 31)) : R;
        voffA[i] = (unsigned)(R * g.lda + C) * 2u; voffB[i] = (unsigned)(Rb * g.ldb + C) * 2u; }
    const size_t kstep = (size_t)(BK * 2);
    const size_t hstepA = (size_t)HALF * g.lda * 2, hstepB = (size_t)HALF * g.ldb * 2;
    const unsigned ldsw = (unsigned)wid * 1024u;
    const int aoff = lds_byte(wr * 64 + fr, fq * 8), boff = lds_byte(wc * 32 + fr, fq * 8);
#define PG8_SA(b, h) (((b) * 2 + (h)) * HTB)
#define PG8_SB(b, h) ((4 + (b) * 2 + (h)) * HTB)
#define PG8_STAGE(bufoff, gbase, voff) do { _Pragma("unroll") for (int _i = 0; _i < 2; ++_i) \
        __builtin_amdgcn_global_load_lds((const unsigned*)((const char*)(gbase) + (voff)[_i]), (LAS unsigned*)(lds + (bufoff) + ldsw + _i * 8192), 16, 0, 0); } while (0)
#define PG8_LDA(dst, b, h) do { _Pragma("unroll") for (int m = 0; m < 4; ++m) _Pragma("unroll") for (int k = 0; k < 2; ++k) dst[m][k] = *(const LAS bf16x8*)(lds + PG8_SA(b, h) + aoff + m * 2048 + k * 1024); } while (0)
#define PG8_LDB(dst, b, h) do { _Pragma("unroll") for (int n = 0; n < 2; ++n) _Pragma("unroll") for (int k = 0; k < 2; ++k) dst[n][k] = *(const LAS bf16x8*)(lds + PG8_SB(b, h) + boff + n * 2048 + k * 1024); } while (0)
#define PG8_MMA(ai, bj, At, Bt) do { __builtin_amdgcn_s_setprio(1); _Pragma("unroll") for (int m = 0; m < 4; ++m) _Pragma("unroll") for (int n = 0; n < 2; ++n) _Pragma("unroll") for (int k = 0; k < 2; ++k) \
        acc[ai][bj][m][n] = __builtin_amdgcn_mfma_f32_16x16x32_bf16(Bt[n][k], At[m][k], acc[ai][bj][m][n], 0, 0, 0); __builtin_amdgcn_s_setprio(0); } while (0)
#define PG8_WAIT_V(n) asm volatile("s_waitcnt vmcnt(" #n ")" ::: "memory")
#define PG8_WAIT_L(n) asm volatile("s_waitcnt lgkmcnt(" #n ")" ::: "memory")
#define PG8_BAR __builtin_amdgcn_s_barrier()
#define PG8_SCHED __builtin_amdgcn_sched_barrier(0)
    Unit cur, nxt; int ui = 0;
    if (!S.next(0, cur)) return;
    f32x4 acc[2][2][4][2];
#pragma unroll
    for (int a = 0; a < 2; ++a)
#pragma unroll
        for (int b = 0; b < 2; ++b)
#pragma unroll
            for (int m = 0; m < 4; ++m)
#pragma unroll
                for (int n = 0; n < 2; ++n) acc[a][b][m][n] = (f32x4){0.f, 0.f, 0.f, 0.f};
    bf16x8 At[4][2], B0[2][2], B1[2][2];
    const char* cA = (const char*)g.A + cur.offA; const char* cB = (const char*)g.Bt + cur.offB;
    PG8_STAGE(PG8_SB(0, 0), cB, voffB); PG8_STAGE(PG8_SB(0, 1), cB + hstepB, voffB); PG8_STAGE(PG8_SA(0, 0), cA, voffA); PG8_STAGE(PG8_SA(0, 1), cA + hstepA, voffA);
    if (wr == 1) PG8_BAR;
    PG8_WAIT_V(2); PG8_BAR;
    PG8_STAGE(PG8_SB(1, 0), cB + kstep, voffB); PG8_STAGE(PG8_SA(1, 0), cA + kstep, voffA); PG8_STAGE(PG8_SB(1, 1), cB + hstepB + kstep, voffB);
    PG8_WAIT_V(6); PG8_BAR;
    for (;;) {
        const bool has_next = S.next(ui + 1, nxt);
        const char* nA = has_next ? (const char*)g.A + nxt.offA : cA; const char* nB = has_next ? (const char*)g.Bt + nxt.offB : cB;
        for (int t = 0; t < nt; t += 2) {
            const bool last = (t == nt - 2);
            const char* a1 = cA + (size_t)(t + 1) * kstep;
            const char* a2 = last ? nA : cA + (size_t)(t + 2) * kstep; const char* b2 = last ? nB : cB + (size_t)(t + 2) * kstep;
            const char* a3 = a2 + kstep; const char* b3 = b2 + kstep;
            PG8_LDB(B0, 0, 0); PG8_LDB(B1, 0, 1); PG8_SCHED; PG8_LDA(At, 0, 0); PG8_STAGE(PG8_SA(1, 1), a1 + hstepA, voffA);
            PG8_WAIT_V(8); PG8_WAIT_L(0); PG8_BAR; PG8_MMA(0, 0, At, B0); PG8_MMA(0, 1, At, B1); PG8_BAR; PG8_SCHED;
            PG8_LDA(At, 0, 1); PG8_STAGE(PG8_SB(0, 0), b2, voffB); PG8_STAGE(PG8_SB(0, 1), b2 + hstepB, voffB); PG8_STAGE(PG8_SA(0, 0), a2, voffA);
            PG8_WAIT_V(8); PG8_WAIT_L(0); PG8_BAR; PG8_MMA(1, 0, At, B0); PG8_MMA(1, 1, At, B1); PG8_BAR; PG8_SCHED;
            PG8_LDB(B0, 1, 0); PG8_LDB(B1, 1, 1); PG8_SCHED; PG8_LDA(At, 1, 0); PG8_STAGE(PG8_SA(0, 1), a2 + hstepA, voffA);
            PG8_WAIT_V(8); PG8_WAIT_L(0); PG8_BAR; PG8_MMA(0, 0, At, B0); PG8_MMA(0, 1, At, B1); PG8_BAR; PG8_SCHED;
            PG8_LDA(At, 1, 1); PG8_STAGE(PG8_SB(1, 0), b3, voffB); PG8_STAGE(PG8_SB(1, 1), b3 + hstepB, voffB); PG8_STAGE(PG8_SA(1, 0), a3, voffA);
            PG8_WAIT_V(8); PG8_WAIT_L(0); PG8_BAR; PG8_MMA(1, 0, At, B0); PG8_MMA(1, 1, At, B1); PG8_BAR; PG8_SCHED;
        }
        if constexpr (ALIGN_EPI) { if (wr == 0) PG8_BAR; }
        if constexpr (!Epi::AFTER_DRAIN) { E(acc, cur, wr, wc, fr, fq); }
        if (!has_next) break;
#pragma unroll
        for (int a = 0; a < 2; ++a)
#pragma unroll
            for (int b = 0; b < 2; ++b)
#pragma unroll
                for (int m = 0; m < 4; ++m)
#pragma unroll
                    for (int n = 0; n < 2; ++n) acc[a][b][m][n] = (f32x4){0.f, 0.f, 0.f, 0.f};
        cur = nxt; cA = nA; cB = nB; ++ui;
        if constexpr (ALIGN_EPI) { if (wr == 1) PG8_BAR; }
    }
    PG8_WAIT_V(0);
    if constexpr (!ALIGN_EPI) { if (wr == 0) PG8_BAR; }
    PG8_BAR;
    if constexpr (Epi::AFTER_DRAIN) { E.fused(acc, cur, wr, wc, fr, fq, lds, wid, lane); }
#undef PG8_SA
#undef PG8_SB
#undef PG8_STAGE
#undef PG8_LDA
#undef PG8_LDB
#undef PG8_MMA
#undef PG8_WAIT_V
#undef PG8_WAIT_L
#undef PG8_BAR
#undef PG8_SCHED
}

struct Epi {
    static constexpr bool PERM = true, AFTER_DRAIN = false;
    int mode;
    bf16_t* O; int ldc;
    const float* ss;
    float* X;
    float* ssn;
    float* F;
    int l; int dry;
    __device__ __forceinline__ void operator()(const f32x4 (&acc)[2][2][4][2], const Unit& u, int wr, int wc, int fr, int fq) const {
        const int row0 = u.pm * 256 + wr * 64 + fr, col0 = u.pn * 256 + wc * 32 + 8 * fq;
        if (dry) return;
        if (mode == 1) {
#pragma unroll
            for (int ai = 0; ai < 2; ++ai)
#pragma unroll
                for (int m = 0; m < 4; ++m) {
                    const int row = row0 + ai * 128 + m * 16; const bool valid = row < MTOK; float sq = 0.f;
#pragma unroll
                    for (int bj = 0; bj < 2; ++bj) {
                        const size_t idx = (size_t)row * 1024 + col0 + bj * 128;
                        if (valid) {
                            float xf[8]; unpack8(*(const u32x4*)(O + idx), xf);
                            const f32x4 x0 = (f32x4){xf[0], xf[1], xf[2], xf[3]} + acc[ai][bj][m][0], x1 = (f32x4){xf[4], xf[5], xf[6], xf[7]} + acc[ai][bj][m][1];
                            sq += (x0[0] * x0[0] + x0[1] * x0[1]) + (x0[2] * x0[2] + x0[3] * x0[3]) + (x1[0] * x1[0] + x1[1] * x1[1]) + (x1[2] * x1[2] + x1[3] * x1[3]);
                            u32x4 w; w.x = cvt_pk_bf16(x0[0], x0[1]); w.y = cvt_pk_bf16(x0[2], x0[3]); w.z = cvt_pk_bf16(x1[0], x1[1]); w.w = cvt_pk_bf16(x1[2], x1[3]);
                            *(u32x4*)(O + idx) = w;
                        }
                    }
                    sq += __shfl_xor(sq, 16); sq += __shfl_xor(sq, 32);
                    if (valid && fq == 0) atomicAdd(ssn + row, sq);
                }
        } else {
#pragma unroll
            for (int ai = 0; ai < 2; ++ai)
#pragma unroll
                for (int m = 0; m < 4; ++m) {
                    const int row = row0 + ai * 128 + m * 16;
                    float rs = 1.f;
                    if (ss != nullptr && (mode == 2 || mode == 3 || row < MTOK)) rs = rsqrtf(ss[row] * (1.f / 1024.f) + EPS);
#pragma unroll
                    for (int bj = 0; bj < 2; ++bj) {
                        const int col = col0 + bj * 128;
                        const f32x4 v0 = acc[ai][bj][m][0] * rs, v1 = acc[ai][bj][m][1] * rs;
                        u32x4 w; w.x = cvt_pk_bf16(v0[0], v0[1]); w.y = cvt_pk_bf16(v0[2], v0[3]); w.z = cvt_pk_bf16(v1[0], v1[1]); w.w = cvt_pk_bf16(v1[2], v1[3]);
                        if (mode == 3) {
                            const int b = row >> 8, mem = row & 255;
                            bf16_t* o = O + ((size_t)(b * 1024 + col)) * 256 + mem;
                            o[0] = (bf16_t)(w.x & 0xffff); o[256] = (bf16_t)(w.x >> 16); o[512] = (bf16_t)(w.y & 0xffff); o[768] = (bf16_t)(w.y >> 16);
                            o[1024] = (bf16_t)(w.z & 0xffff); o[1280] = (bf16_t)(w.z >> 16); o[1536] = (bf16_t)(w.w & 0xffff); o[1792] = (bf16_t)(w.w >> 16);
                        } else {
                            *(u32x4*)(O + (size_t)row * ldc + col) = w;
                        }
                        if (mode == 2 || mode == 3) { float* f = F + (size_t)row * 1024 + col; *(f32x4*)f = v0; *(f32x4*)(f + 4) = v1; }
                        if (mode == 4) {
                            float* f = nullptr;
                            if (row < MP) { const int t = row & 2047; if (t >= 2046) f = F + O_FFNP + ((size_t)((l * 8 + (row >> 11)) * 2 + (t - 2046))) * FW2 + col; }
                            else if (row < MTOK) f = F + O_FFNS + ((size_t)((l * 128 + (row - MP)) * 2 + 1)) * FW2 + col;
                            if (f) { *(f32x4*)f = v0; *(f32x4*)(f + 4) = v1; }
                        }
                    }
                }
        }
    }
};

struct EpiSm {
    static constexpr bool PERM = true, AFTER_DRAIN = true;
    bf16_t* P;
    __device__ __forceinline__ void operator()(const f32x4 (&)[2][2][4][2], const Unit&, int, int, int, int) const {}
    __device__ __forceinline__ void fused(f32x4 (&acc)[2][2][4][2], const Unit& u, int wr, int wc, int fr, int fq, LAS unsigned char* lds, int wid, int lane) const {
        LAS float* red = (LAS float*)lds; LAS float* red2 = red + 1024;
        float mx[2][4];
#pragma unroll
        for (int ai = 0; ai < 2; ++ai)
#pragma unroll
            for (int m = 0; m < 4; ++m) {
                float v = -3.0e38f;
#pragma unroll
                for (int bj = 0; bj < 2; ++bj)
#pragma unroll
                    for (int n = 0; n < 2; ++n) { const f32x4 x = acc[ai][bj][m][n]; v = fmaxf(v, fmaxf(fmaxf(x[0], x[1]), fmaxf(x[2], x[3]))); }
                v = fmaxf(v, __shfl_xor(v, 16)); v = fmaxf(v, __shfl_xor(v, 32));
                if (fq == 0) red[(ai * 128 + wr * 64 + m * 16 + fr) * 4 + wc] = v;
            }
        __syncthreads();
#pragma unroll
        for (int ai = 0; ai < 2; ++ai)
#pragma unroll
            for (int m = 0; m < 4; ++m) {
                const f32x4 r = *(const LAS f32x4*)(red + (ai * 128 + wr * 64 + m * 16 + fr) * 4);
                const float M = fmaxf(fmaxf(r[0], r[1]), fmaxf(r[2], r[3])); mx[ai][m] = M;
                float s = 0.f;
#pragma unroll
                for (int bj = 0; bj < 2; ++bj)
#pragma unroll
                    for (int n = 0; n < 2; ++n) { f32x4 x = acc[ai][bj][m][n];
                        x[0] = __expf(x[0] - M); x[1] = __expf(x[1] - M); x[2] = __expf(x[2] - M); x[3] = __expf(x[3] - M); acc[ai][bj][m][n] = x; s += (x[0] + x[1]) + (x[2] + x[3]); }
                s += __shfl_xor(s, 16); s += __shfl_xor(s, 32);
                if (fq == 0) red2[(ai * 128 + wr * 64 + m * 16 + fr) * 4 + wc] = s;
            }
        __syncthreads();
#pragma unroll
        for (int ai = 0; ai < 2; ++ai)
#pragma unroll
            for (int m = 0; m < 4; ++m) {
                const int rl = ai * 128 + wr * 64 + m * 16 + fr;
                const f32x4 r = *(const LAS f32x4*)(red2 + rl * 4);
                const float inv = 1.f / ((r[0] + r[1]) + (r[2] + r[3]));
#pragma unroll
                for (int bj = 0; bj < 2; ++bj) {
                    const f32x4 v0 = acc[ai][bj][m][0] * inv, v1 = acc[ai][bj][m][1] * inv;
                    u32x4 w; w.x = cvt_pk_bf16(v0[0], v0[1]); w.y = cvt_pk_bf16(v0[2], v0[3]); w.z = cvt_pk_bf16(v1[0], v1[1]); w.w = cvt_pk_bf16(v1[2], v1[3]);
                    *(u32x4*)(P + (size_t)(u.pm * 256 + rl) * 1024 + u.pn * 256 + bj * 128 + wc * 32 + 8 * fq) = w;
                }
            }
        (void)mx; (void)wid; (void)lane;
    }
};
}

struct Args { const float* in[38]; float* out; unsigned char* ws; int ph_lo, ph_hi; };
enum { I_XP = 0, I_XS, I_MEM, I_SSHIFT, I_SWKV, I_SCONV, I_SFFN, I_CK, I_CV, I_NMIX, I_WIN, I_MU, I_W0, I_W2, I_A0, I_A2, I_G2, I_V0, I_V1, I_V2,
       I_KK, I_KA, I_RK, I_LNW, I_LNB, I_CONVW, I_WOUT, I_NX, I_NMEM, I_WQ, I_WK, I_WV, I_WO, I_NFFN, I_WUP, I_FCW, I_WDN, I_NFIN };

__device__ __forceinline__ void tr_item(const float* W, int K, int N, bf16_t* WT, const float* gain, float scale, LAS float* scr, int item, int lane) {
    const int nblk = N / 32, kb = item / nblk, nb = item % nblk, k0 = 64 * kb, n0 = 32 * nb;
#pragma unroll
    for (int i = 0; i < 8; ++i) { const int kk = 8 * i + (lane >> 3); const float gk = gain ? gain[k0 + kk] * scale : scale;
        const f32x4 v = __builtin_nontemporal_load((const f32x4*)(W + (size_t)(k0 + kk) * N + n0 + (lane & 7) * 4)) * gk;
        LAS float* d = scr + kk * 33 + (lane & 7) * 4; d[0] = v[0]; d[1] = v[1]; d[2] = v[2]; d[3] = v[3]; }
    LDS_WAIT();
    const int c = lane & 7;
#pragma unroll
    for (int j = 0; j < 4; ++j) { const int n = (lane >> 3) + 8 * j; const LAS float* s = scr + (8 * c) * 33 + n;
        u32x4 o; o.x = pk2(s[0 * 33], s[1 * 33]); o.y = pk2(s[2 * 33], s[3 * 33]); o.z = pk2(s[4 * 33], s[5 * 33]); o.w = pk2(s[6 * 33], s[7 * 33]);
        *(u32x4*)(WT + (size_t)(n0 + n) * K + k0 + 8 * c) = o; }
    LDS_WAIT();
}

constexpr int TR_NL = 8512;
__device__ __forceinline__ void tr_dispatch(const Args& a, unsigned char* ws, int l, int r, LAS float* scr, int lane) {
    constexpr int I_IN_ = 16 * 104, I_SQ_ = 16 * 32, I_UP_ = 16 * 176, I_DN_ = 44 * 32, I_L64 = 16;
    if (r < I_IN_) { tr_item(a.in[I_WIN] + (size_t)l * D * INC, D, INC, (bf16_t*)(ws + OFF_WIN) + (size_t)l * LDP * D, a.in[I_NMIX] + l * D, 1.f, scr, r, lane); return; } r -= I_IN_;
    if (r < I_SQ_) { tr_item(a.in[I_WOUT] + (size_t)l * D * D, D, D, (bf16_t*)(ws + OFF_WOUT) + (size_t)l * D * D, nullptr, 1.f, scr, r, lane); return; } r -= I_SQ_;
    if (r < I_SQ_) { tr_item(a.in[I_WQ] + (size_t)l * D * D, D, D, (bf16_t*)(ws + OFF_WQ) + (size_t)l * D * D, a.in[I_NX] + l * D, 0.0625f, scr, r, lane); return; } r -= I_SQ_;
    if (r < I_SQ_) { tr_item(a.in[I_WK] + (size_t)l * D * D, D, D, (bf16_t*)(ws + OFF_WK) + (size_t)l * D * D, a.in[I_NMEM] + l * D, 1.f, scr, r, lane); return; } r -= I_SQ_;
    if (r < I_SQ_) { tr_item(a.in[I_WV] + (size_t)l * D * D, D, D, (bf16_t*)(ws + OFF_WV) + (size_t)l * D * D, a.in[I_NMEM] + l * D, 1.f, scr, r, lane); return; } r -= I_SQ_;
    if (r < I_SQ_) { tr_item(a.in[I_WO] + (size_t)l * D * D, D, D, (bf16_t*)(ws + OFF_WO) + (size_t)l * D * D, nullptr, 1.f, scr, r, lane); return; } r -= I_SQ_;
    if (r < I_UP_) { tr_item(a.in[I_WUP] + (size_t)l * D * FW2, D, FW2, (bf16_t*)(ws + OFF_WUP) + (size_t)l * FW2 * D, a.in[I_NFFN] + l * D, 1.f, scr, r, lane); return; } r -= I_UP_;
    if (r < I_DN_) { tr_item(a.in[I_WDN] + (size_t)l * FW * D, FW, D, (bf16_t*)(ws + OFF_WDN) + (size_t)l * D * FW, nullptr, 1.f, scr, r, lane); return; } r -= I_DN_;
    if (r < I_L64) { tr_item(a.in[I_W2] + (size_t)l * 64 * 512, 64, 512, (bf16_t*)(ws + OFF_W2) + (size_t)l * 512 * 64, nullptr, 1.f, scr, r, lane); return; } r -= I_L64;
    if (r < I_L64) { tr_item(a.in[I_A2] + (size_t)l * 64 * 512, 64, 512, (bf16_t*)(ws + OFF_A2) + (size_t)l * 512 * 64, nullptr, 1.f, scr, r, lane); return; } r -= I_L64;
    tr_item(a.in[I_G2] + (size_t)l * 128 * 512, 128, 512, (bf16_t*)(ws + OFF_G2) + (size_t)l * 512 * 128, nullptr, 1.f, scr, r, lane);
}
constexpr int TR_DEFERRED = TR_NL + 5760;
__device__ __forceinline__ void tr_deferred(const Args& a, unsigned char* ws, int d, LAS float* scr, int lane) {
    if (d < TR_NL) { tr_dispatch(a, ws, 1, d, scr, lane); return; }
    const int e = d - TR_NL;
    const int r = e < 1024 ? 1664 + e : (e < 1536 ? 3712 + (e - 1024) : 4224 + (e - 1536));
    tr_dispatch(a, ws, 0, r, scr, lane);
}

__device__ __forceinline__ void p0_prologue(LAS unsigned char* lds, const Args& a, int tid, int lane, int wave, int gw, int NGW) {
    unsigned char* ws = a.ws;
    LAS float* scr = (LAS float*)(lds + wave * 16384);
    for (int it = gw; it < 1664 + 1024 + 64; it += NGW) {
        const int r = it < 1664 ? it : (it < 2688 ? 2688 + (it - 1664) : 8448 + (it - 2688));
        tr_dispatch(a, ws, 0, r, scr, lane);
    }
    float* X = (float*)(ws + OFF_X); bf16_t* XB = (bf16_t*)(ws + OFF_XB); float* SS = (float*)(ws + OFF_SS);
    bf16_t* MNB = (bf16_t*)(ws + OFF_MNB); float* SSM = (float*)(ws + OFF_SSM);
    for (int m = gw; m < MROWS + MMEM; m += NGW) {
        const float* src; bf16_t* dstb; float* dstx = nullptr; float* dss = nullptr; bool shiftrow = false;
        if (m < MP) { src = a.in[I_XP] + (size_t)m * D; dstb = XB + (size_t)m * D; dstx = X + (size_t)m * D; dss = SS + m; }
        else if (m < MTOK) { src = a.in[I_XS] + (size_t)(m - MP) * D; dstb = XB + (size_t)m * D; dstx = X + (size_t)m * D; dss = SS + m; }
        else if (m < MROWS) { src = a.in[I_SSHIFT] + (size_t)(m - MTOK) * D; dstb = XB + (size_t)m * D; shiftrow = true; }
        else { src = a.in[I_MEM] + (size_t)(m - MROWS) * D; dstb = MNB + (size_t)(m - MROWS) * D; dss = SSM + (m - MROWS); }
        float s = 0.f;
#pragma unroll
        for (int j = 0; j < 4; ++j) {
            f32x4 v = *(const f32x4*)(src + 4 * lane + 256 * j);
            if (shiftrow) { const f32x4 gn = *(const f32x4*)(a.in[I_NMIX] + 4 * lane + 256 * j); v[0] /= gn[0]; v[1] /= gn[1]; v[2] /= gn[2]; v[3] /= gn[3]; }
            s += (v[0] * v[0] + v[1] * v[1]) + (v[2] * v[2] + v[3] * v[3]);
            u32x2 w; w.x = pk2(v[0], v[1]); w.y = pk2(v[2], v[3]);
            *(u32x2*)(dstb + 4 * lane + 256 * j) = w;
        }
        s = wave_sum(s);
        if (dss && lane == 0) *dss = s;
    }
    if (blockIdx.x * 8 < D) {
        __syncthreads();
        LAS float* M = (LAS float*)lds;
        const float* muv = a.in[I_MU] + 1792 + 1024; const float* v1 = a.in[I_V1];
#pragma unroll 8
        for (int i = tid; i < 512 * 64; i += 512) { const int c = i >> 6, o = i & 63; const float mv = muv[c]; M[i] = ((o >> 5) ? mv : 1.f - mv) * v1[c * 32 + (o & 31)]; }
        __syncthreads();
        for (int k = gw; k < D; k += NGW) {
            const float* wrow = a.in[I_WIN] + (size_t)1 * D * INC + (size_t)k * INC + 1024;
            float acc = 0.f;
#pragma unroll 4
            for (int c = 0; c < 512; c += 4) {
                const f32x4 w4 = *(const f32x4*)(wrow + c);
                acc += w4[0] * M[c * 64 + lane] + w4[1] * M[(c + 1) * 64 + lane] + w4[2] * M[(c + 2) * 64 + lane] + w4[3] * M[(c + 3) * 64 + lane];
            }
            ((bf16_t*)(ws + OFF_WIN))[(size_t)1 * LDP * D + (size_t)(INC + lane) * D + k] = (bf16_t)f2bf(acc * a.in[I_NMIX][D + k]);
        }
    }
    const int gt = blockIdx.x * 512 + tid, NGT = gridDim.x * 512;
    for (int i = gt; i < 6 * MROWS; i += NGT) SS[MROWS + i] = 0.f;
    bf16_t* V2T = (bf16_t*)(ws + OFF_V2);
    for (int i = gt; i < 512 * 32; i += NGT) { const int n = i >> 5, k = i & 31; V2T[i] = (bf16_t)f2bf(a.in[I_V2][k * 512 + n]); }
}

__device__ __forceinline__ const bf16_t* prev_row(const bf16_t* PROJ, int m) {
    if (m < MP) { if ((m & 2047) == 0) return nullptr; return PROJ + (size_t)(m - 1) * LDP; }
    return PROJ + (size_t)(m + NS) * LDP;
}
__device__ __forceinline__ void mix4(const bf16_t* cur, const bf16_t* prv, const float* mu, int col, float* z) {
    const u32x2 c = *(const u32x2*)(cur + col); const f32x4 m4 = *(const f32x4*)(mu + col);
    float cf[4] = {bflo(c.x), bfhi(c.x), bflo(c.y), bfhi(c.y)}; float pf[4] = {0.f, 0.f, 0.f, 0.f};
    if (prv) { const u32x2 p = *(const u32x2*)(prv + col); pf[0] = bflo(p.x); pf[1] = bfhi(p.x); pf[2] = bflo(p.y); pf[3] = bfhi(p.y); }
#pragma unroll
    for (int j = 0; j < 4; ++j) z[j] = cf[j] + (pf[j] - cf[j]) * m4[j];
}
__device__ __forceinline__ void mix8(const bf16_t* cur, const bf16_t* prv, const float* mu, int col, float* z) {
    const u32x4 c = *(const u32x4*)(cur + col); float cf[8], pf[8]; unpack8(c, cf);
#pragma unroll
    for (int j = 0; j < 8; ++j) pf[j] = 0.f;
    if (prv) { const u32x4 p = *(const u32x4*)(prv + col); unpack8(p, pf); }
    const f32x4 m0 = *(const f32x4*)(mu + col), m1 = *(const f32x4*)(mu + col + 4);
#pragma unroll
    for (int j = 0; j < 4; ++j) { z[j] = cf[j] + (pf[j] - cf[j]) * m0[j]; z[4 + j] = cf[4 + j] + (pf[4 + j] - cf[4 + j]) * m1[j]; }
}

__device__ __forceinline__ float fsig(float x) { return __builtin_amdgcn_rcpf(1.f + __expf(-x)); }
__device__ __forceinline__ void mixw(u32x2 c, u32x2 p, const LAS float* mu, float* z) {
    const f32x4 m4 = *(const LAS f32x4*)mu;
    const float cf[4] = {bflo(c.x), bfhi(c.x), bflo(c.y), bfhi(c.y)}, pf[4] = {bflo(p.x), bfhi(p.x), bflo(p.y), bfhi(p.y)};
#pragma unroll
    for (int j = 0; j < 4; ++j) z[j] = cf[j] + (pf[j] - cf[j]) * m4[j];
}
__device__ __forceinline__ void prep_phase(LAS unsigned char* lds, const Args& a, int l, int tid, int lane, int wave, int gw) {
    unsigned char* ws = a.ws;
    const bf16_t* PROJ = (const bf16_t*)(ws + OFF_PROJ);
    const float* mu = a.in[I_MU] + l * 1792;
    if (gw < NB + NS) {
        const int row = gw < NB ? gw * 2048 + 2047 : MP + (gw - NB);
        float* dst = gw < NB ? a.out + O_SHP + (size_t)(l * NB + gw) * D : a.out + O_SHS + (size_t)(l * NS + (gw - NB)) * D;
        const bf16_t* Xr = (const bf16_t*)(ws + OFF_XB) + (size_t)row * D;
        const float rs = rsqrtf(((const float*)(ws + OFF_SS))[3 * l * MROWS + row] * (1.f / 1024.f) + EPS);
#pragma unroll
        for (int j = 0; j < 4; ++j) { const u32x2 xw = *(const u32x2*)(Xr + 4 * lane + 256 * j); const f32x4 v = (f32x4){bflo(xw.x), bfhi(xw.x), bflo(xw.y), bfhi(xw.y)}, gn = *(const f32x4*)(a.in[I_NMIX] + l * D + 4 * lane + 256 * j);
            *(f32x4*)(dst + 4 * lane + 256 * j) = v * rs * gn; }
    }
    LAS bf16_t* WL2 = (LAS bf16_t*)lds;
    LAS bf16_t* WLA = (LAS bf16_t*)(lds + 18432);
    LAS bf16_t* WLG = (LAS bf16_t*)(lds + 36864);
    LAS bf16_t* WLV = (LAS bf16_t*)(lds + 71680);
    LAS float* PAR = (LAS float*)(lds + 81920);
    LAS bf16_t* LA = (LAS bf16_t*)(lds + 88064);
    LAS bf16_t* LW = (LAS bf16_t*)(lds + 121856);
    const int hp = blockIdx.x & 3;
    {
        const bf16_t* W2T = (const bf16_t*)(ws + OFF_W2) + (size_t)l * 512 * 64 + (size_t)hp * 128 * 64;
        const bf16_t* A2T = (const bf16_t*)(ws + OFF_A2) + (size_t)l * 512 * 64 + (size_t)hp * 128 * 64;
        const bf16_t* G2T = (const bf16_t*)(ws + OFF_G2) + (size_t)l * 512 * 128 + (size_t)hp * 128 * 128;
        const bf16_t* V2T = (const bf16_t*)(ws + OFF_V2) + (size_t)hp * 128 * 32;
#pragma unroll
        for (int q = 0; q < 2; ++q) { const int i = tid + 512 * q, n = i >> 3, c = (i & 7) * 8;
            *(LAS u32x4*)(WL2 + n * 72 + c) = *(const u32x4*)(W2T + n * 64 + c); *(LAS u32x4*)(WLA + n * 72 + c) = *(const u32x4*)(A2T + n * 64 + c); }
#pragma unroll
        for (int q = 0; q < 4; ++q) { const int i = tid + 512 * q, n = i >> 4, c = (i & 15) * 8; *(LAS u32x4*)(WLG + n * 136 + c) = *(const u32x4*)(G2T + n * 128 + c); }
        { const int n = tid >> 2, c = (tid & 3) * 8; *(LAS u32x4*)(WLV + n * 40 + c) = *(const u32x4*)(V2T + n * 32 + c); }
        if (tid < 128) {
            const int ch = hp * 128 + tid;
            PAR[tid] = a.in[I_W0][l * 512 + ch]; PAR[128 + tid] = a.in[I_A0][l * 512 + ch]; PAR[256 + tid] = a.in[I_KK][l * 512 + ch]; PAR[384 + tid] = a.in[I_KA][l * 512 + ch];
            PAR[512 + tid] = a.in[I_RK][l * 512 + ch]; PAR[640 + tid] = l == 1 ? a.in[I_V0][ch] : 0.f; PAR[768 + tid] = mu[ch]; PAR[896 + tid] = mu[512 + ch]; PAR[1024 + tid] = mu[1024 + ch];
        }
    }
    float* SA = (float*)(ws + OFF_SA); float* SB = (float*)(ws + OFF_SB); float* SD = (float*)(ws + OFF_SD); float* SK = (float*)(ws + OFF_SK);
    float* SRD = (float*)(ws + OFF_SRD); float* GG = (float*)(ws + OFF_G); float* SV = (float*)(ws + (l == 0 ? OFF_SV0 : OFF_SV1));
    const float* SV0 = (const float*)(ws + OFF_SV0);
    float* SBR = (float*)(ws + OFF_SBR); float* SKR = (float*)(ws + OFF_SKR); float* RKR = (float*)(ws + OFF_RKR);
    const int mt = wave & 3, hh = wave >> 2, h = hp * 2 + hh, fr = lane & 15, fq = lane >> 4;
    const int grp = blockIdx.x >> 2;
    const int nit = 4 + (blockIdx.x < 32 ? 1 : 0);
    for (int it = 0; it < nit; ++it) {
        const bool tailit = it >= 4;
        const int m0 = tailit ? MP + grp * 16 : (grp + 64 * it) * 64;
        const int nq = tailit ? 1 : 4;
        {
            u32x4 cu[4], pv[4];
#pragma unroll
            for (int q = 0; q < 4; ++q) {
                cu[q] = (u32x4){0u, 0u, 0u, 0u}; pv[q] = cu[q];
                if (q < nq) {
                    const int row = (tid >> 5) + 16 * q, ch = tid & 31, m = m0 + row;
                    const bf16_t* prv = prev_row(PROJ, m);
                    cu[q] = *(const u32x4*)(PROJ + (size_t)m * LDP + 1536 + ch * 8);
                    if (prv) pv[q] = *(const u32x4*)(prv + 1536 + ch * 8);
                }
            }
            u32x2 vc = (u32x2){0u, 0u}, vp = vc;
            if (l == 1 && (tid >> 3) < 16 * nq) {
                const int m = m0 + (tid >> 3), j4 = (tid & 7) * 4; const bf16_t* prv = prev_row(PROJ, m);
                vc = *(const u32x2*)(PROJ + (size_t)m * LDP + INC + j4); if (prv) vp = *(const u32x2*)(prv + INC + 32 + j4);
            }
            const int ch = tid & 31;
            const f32x4 m0v = *(const f32x4*)(mu + 1536 + ch * 8), m1v = *(const f32x4*)(mu + 1536 + ch * 8 + 4);
#pragma unroll
            for (int q = 0; q < 4; ++q) {
                if (q >= nq) continue;
                const int row = (tid >> 5) + 16 * q;
                float cf[8], pf[8], z[8]; unpack8(cu[q], cf); unpack8(pv[q], pf);
#pragma unroll
                for (int j = 0; j < 4; ++j) { z[j] = cf[j] + (pf[j] - cf[j]) * m0v[j]; z[4 + j] = cf[4 + j] + (pf[4 + j] - cf[4 + j]) * m1v[j]; }
                if (ch < 8) {
#pragma unroll
                    for (int j = 0; j < 8; ++j) z[j] = 2.f * fsig(2.f * z[j]) - 1.f;
                } else if (ch >= 16) {
#pragma unroll
                    for (int j = 0; j < 8; ++j) z[j] = fsig(z[j]);
                }
                u32x4 w; w.x = pk2(z[0], z[1]); w.y = pk2(z[2], z[3]); w.z = pk2(z[4], z[5]); w.w = pk2(z[6], z[7]);
                *(LAS u32x4*)(LA + row * 264 + ch * 8) = w;
            }
            if (l == 1 && (tid >> 3) < 16 * nq) {
                u32x2 w; w.x = pk2(bflo(vc.x) + bflo(vp.x), bfhi(vc.x) + bfhi(vp.x)); w.y = pk2(bflo(vc.y) + bflo(vp.y), bfhi(vc.y) + bfhi(vp.y));
                *(LAS u32x2*)(LW + (tid >> 3) * 40 + (tid & 7) * 4) = w;
            }
        }
        __syncthreads();
        if (mt < nq) {
        const int m = m0 + mt * 16 + fr;
        const bf16_t* cur = PROJ + (size_t)m * LDP; const bf16_t* prv = prev_row(PROJ, m);
        u32x2 cR[4], cK[4], cV[4], pR[4], pK[4], pV[4]; f32x4 vf[4];
#pragma unroll
        for (int nt = 0; nt < 4; ++nt) {
            const int ch = h * 64 + nt * 16 + fq * 4;
            cR[nt] = *(const u32x2*)(cur + ch); cK[nt] = *(const u32x2*)(cur + 512 + ch); cV[nt] = *(const u32x2*)(cur + 1024 + ch);
            pR[nt] = (u32x2){0u, 0u}; pK[nt] = pR[nt]; pV[nt] = pR[nt];
            if (prv) { pR[nt] = *(const u32x2*)(prv + ch); pK[nt] = *(const u32x2*)(prv + 512 + ch); pV[nt] = *(const u32x2*)(prv + 1024 + ch); }
            vf[nt] = (f32x4){0.f, 0.f, 0.f, 0.f};
            if (l == 1) vf[nt] = ld_bf4((const bf16_t*)SV0 + (size_t)m * 512 + ch);
        }
        float ssq = 0.f;
#pragma unroll
        for (int nt = 0; nt < 4; ++nt) {
            const int cl = hh * 64 + nt * 16 + fq * 4; float kz[4]; mixw(cK[nt], pK[nt], PAR + 896 + cl, kz);
            const f32x4 kk4 = *(const LAS f32x4*)(PAR + 256 + cl);
#pragma unroll
            for (int j = 0; j < 4; ++j) { const float kk = kz[j] * kk4[j]; ssq += kk * kk; }
        }
        ssq += __shfl_xor(ssq, 16); ssq += __shfl_xor(ssq, 32);
        const float inv = 1.f / fmaxf(sqrtf(ssq), 1e-12f);
        float br = 0.f, kr = 0.f, rkr = 0.f;
#pragma unroll
        for (int nt = 0; nt < 4; ++nt) {
            const int cl = hh * 64 + nt * 16 + fq * 4, ch = h * 64 + nt * 16 + fq * 4, nl = hh * 64 + nt * 16 + fr;
            f32x4 dl = (f32x4){0.f, 0.f, 0.f, 0.f}, al = dl, gl = dl, vm = dl;
            bf16x8 af[8];
#pragma unroll
            for (int ks = 0; ks < 8; ++ks) af[ks] = *(const LAS bf16x8*)(LA + (mt * 16 + fr) * 264 + ks * 32 + fq * 8);
            const bf16x8 avv = *(const LAS bf16x8*)(LW + (mt * 16 + fr) * 40 + fq * 8);
#pragma unroll
            for (int ks = 0; ks < 2; ++ks) {
                dl = __builtin_amdgcn_mfma_f32_16x16x32_bf16(*(const LAS bf16x8*)(WL2 + nl * 72 + ks * 32 + fq * 8), af[ks], dl, 0, 0, 0);
                al = __builtin_amdgcn_mfma_f32_16x16x32_bf16(*(const LAS bf16x8*)(WLA + nl * 72 + ks * 32 + fq * 8), af[2 + ks], al, 0, 0, 0);
            }
#pragma unroll
            for (int ks = 0; ks < 4; ++ks) gl = __builtin_amdgcn_mfma_f32_16x16x32_bf16(*(const LAS bf16x8*)(WLG + nl * 136 + ks * 32 + fq * 8), af[4 + ks], gl, 0, 0, 0);
            if (l == 1) vm = __builtin_amdgcn_mfma_f32_16x16x32_bf16(*(const LAS bf16x8*)(WLV + nl * 40 + fq * 8), avv, vm, 0, 0, 0);
            float rz[4], kz[4], vz[4];
            mixw(cR[nt], pR[nt], PAR + 768 + cl, rz); mixw(cK[nt], pK[nt], PAR + 896 + cl, kz); mixw(cV[nt], pV[nt], PAR + 1024 + cl, vz);
            const f32x4 w0 = *(const LAS f32x4*)(PAR + cl), a0 = *(const LAS f32x4*)(PAR + 128 + cl), kk4 = *(const LAS f32x4*)(PAR + 256 + cl);
            const f32x4 ka4 = *(const LAS f32x4*)(PAR + 384 + cl), rk4 = *(const LAS f32x4*)(PAR + 512 + cl), v04 = *(const LAS f32x4*)(PAR + 640 + cl);
            f32x4 oa, ob, od, ok, ord_, ov;
#pragma unroll
            for (int j = 0; j < 4; ++j) {
                const float dcy = __expf(-0.60653065971f * fsig(w0[j] + dl[j]));
                const float av_ = fsig(a0[j] + al[j]);
                float vj = vz[j];
                if (l == 1) { const float vmix = fsig(v04[j] + vm[j]); vj = vj + (vf[nt][j] - vj) * vmix; }
                const float kk = kz[j] * kk4[j] * inv, k2 = kz[j] * (1.f + (av_ - 1.f) * ka4[j]);
                oa[j] = -kk; ob[j] = kk * av_; od[j] = dcy; ok[j] = k2; ord_[j] = rz[j] * dcy; ov[j] = vj;
                br += ob[j] * rz[j]; kr += k2 * rz[j]; rkr += rz[j] * k2 * rk4[j];
            }
            const size_t o = (size_t)m * 512 + ch;
            st_bf4((bf16_t*)SA + o, oa); st_bf4((bf16_t*)SB + o, ob); *(f32x4*)(SD + o) = od; st_bf4((bf16_t*)SK + o, ok); st_bf4((bf16_t*)SRD + o, ord_); st_bf4((bf16_t*)SV + o, ov); { u32x2 gw2; gw2.x = cvt_pk_bf16(gl[0], gl[1]); gw2.y = cvt_pk_bf16(gl[2], gl[3]); *(u32x2*)((bf16_t*)GG + o) = gw2; }
            __builtin_amdgcn_sched_barrier(0);
        }
        br += __shfl_xor(br, 16); br += __shfl_xor(br, 32); kr += __shfl_xor(kr, 16); kr += __shfl_xor(kr, 32); rkr += __shfl_xor(rkr, 16); rkr += __shfl_xor(rkr, 32);
        if (fq == 0) { SBR[m * 8 + h] = br; SKR[m * 8 + h] = kr; RKR[m * 8 + h] = rkr; }
        }
        __syncthreads();
    }
}

__device__ __forceinline__ void convB_token(const Args& a, int l, int m, int lane) {
    unsigned char* ws = a.ws;
    const bf16_t* __restrict__ PROJ = (const bf16_t*)(ws + OFF_PROJ);
    bf16_t* __restrict__ YAB = (bf16_t*)(ws + OFF_YAB);
    const int cb = lane * 8;
        const bf16_t* pr = PROJ + (size_t)m * LDP;
        float gb[8], gc[8], hi[8], u0[8], u1[8], u2[8];
        unpack8(*(const u32x4*)(pr + 1792 + cb), gb); unpack8(*(const u32x4*)(pr + 2304 + cb), gc); unpack8(*(const u32x4*)(pr + 2816 + cb), hi);
#pragma unroll
        for (int j = 0; j < 8; ++j) { u0[j] = gc[j] * hi[j]; u1[j] = 0.f; u2[j] = 0.f; }
        if (m < MP) {
            const int t = m & 2047;
            if (t >= 1) { unpack8(*(const u32x4*)(pr - LDP + 2304 + cb), gc); unpack8(*(const u32x4*)(pr - LDP + 2816 + cb), hi);
#pragma unroll
                for (int j = 0; j < 8; ++j) u1[j] = gc[j] * hi[j]; }
            if (t >= 2) { unpack8(*(const u32x4*)(pr - 2 * LDP + 2304 + cb), gc); unpack8(*(const u32x4*)(pr - 2 * LDP + 2816 + cb), hi);
#pragma unroll
                for (int j = 0; j < 8; ++j) u2[j] = gc[j] * hi[j]; }
            if (t >= 2046) { float* dst = a.out + O_CONVP + (size_t)((l * NB + (m >> 11)) * 2 + (t - 2046)) * 512 + cb;
                *(f32x4*)dst = (f32x4){u0[0], u0[1], u0[2], u0[3]}; *(f32x4*)(dst + 4) = (f32x4){u0[4], u0[5], u0[6], u0[7]}; }
        } else {
            const int i = m - MP; const float* sc = a.in[I_SCONV] + (size_t)(l * NS + i) * 2 * 512 + cb;
            const f32x4 a0 = *(const f32x4*)sc, a1 = *(const f32x4*)(sc + 4), b0 = *(const f32x4*)(sc + 512), b1 = *(const f32x4*)(sc + 516);
#pragma unroll
            for (int j = 0; j < 4; ++j) { u2[j] = a0[j]; u2[4 + j] = a1[j]; u1[j] = b0[j]; u1[4 + j] = b1[j]; }
            float* dst = a.out + O_CONVS + (size_t)(l * NS + i) * 2 * 512 + cb;
            *(f32x4*)dst = b0; *(f32x4*)(dst + 4) = b1;
            *(f32x4*)(dst + 512) = (f32x4){u0[0], u0[1], u0[2], u0[3]}; *(f32x4*)(dst + 516) = (f32x4){u0[4], u0[5], u0[6], u0[7]};
        }
        const float* cw = a.in[I_CONVW] + (size_t)l * 3 * 512 + cb;
        float ob[8];
#pragma unroll
        for (int j = 0; j < 8; ++j) ob[j] = gb[j] * (cw[j] * u2[j] + cw[512 + j] * u1[j] + cw[1024 + j] * u0[j]);
        u32x4 w2; w2.x = pk2(ob[0], ob[1]); w2.y = pk2(ob[2], ob[3]); w2.z = pk2(ob[4], ob[5]); w2.w = pk2(ob[6], ob[7]);
        *(u32x4*)(YAB + (size_t)m * 1024 + 512 + cb) = w2;
}

typedef float f32x2 __attribute__((ext_vector_type(2)));
__device__ __forceinline__ float scan_step(float (&s)[4], const f32x4 av, const f32x4 bv, const f32x4 dv, const f32x4 kv, const f32x4 rd, float vi, float br, float kr) {
    f32x2 s01 = (f32x2){s[0], s[1]}, s23 = (f32x2){s[2], s[3]};
    f32x2 t = s01 * (f32x2){av[0], av[1]}; t = __builtin_elementwise_fma(s23, (f32x2){av[2], av[3]}, t);
    f32x2 u = s01 * (f32x2){rd[0], rd[1]}; u = __builtin_elementwise_fma(s23, (f32x2){rd[2], rd[3]}, u);
    float pa = t.x + t.y, py = u.x + u.y;
    pa = red16(pa); py = red16(py);
    const f32x2 pav = (f32x2){pa, pa}, viv = (f32x2){vi, vi};
    f32x2 w01 = (f32x2){kv[0], kv[1]} * viv; w01 = __builtin_elementwise_fma((f32x2){bv[0], bv[1]}, pav, w01);
    f32x2 w23 = (f32x2){kv[2], kv[3]} * viv; w23 = __builtin_elementwise_fma((f32x2){bv[2], bv[3]}, pav, w23);
    s01 = __builtin_elementwise_fma(s01, (f32x2){dv[0], dv[1]}, w01);
    s23 = __builtin_elementwise_fma(s23, (f32x2){dv[2], dv[3]}, w23);
    s[0] = s01.x; s[1] = s01.y; s[2] = s23.x; s[3] = s23.y;
    return py + pa * br + vi * kr;
}

__device__ __forceinline__ void scan_phase(LAS unsigned char* lds, const Args& a, int l, int tid, int lane, int wave) {
    unsigned char* ws = a.ws;
    const float* SA = (const float*)(ws + OFF_SA); const float* SB = (const float*)(ws + OFF_SB); const float* SD = (const float*)(ws + OFF_SD); const float* SK = (const float*)(ws + OFF_SK);
    const float* SRD = (const float*)(ws + OFF_SRD); const float* SV = (const float*)(ws + (l == 0 ? OFF_SV0 : OFF_SV1));
    const float* SBR = (const float*)(ws + OFF_SBR); const float* SKR = (const float*)(ws + OFF_SKR);
    float* Y = (float*)(ws + OFF_Y);
    constexpr int TC = 32, CB = 5 * TC * 64 + TC * 16 + 2 * TC;
    LAS float* L = (LAS float*)lds;
    const int j4 = lane >> 4, c = lane & 15;
    for (int ci = blockIdx.x; ci < 256; ci += gridDim.x) {
        const int hc = ci >> 2, rg = ci & 3, b = hc >> 3, h = hc & 7;
        const int st = tid >> 4, c16 = tid & 15;
        const int rl = (wave & 3) * 4 + j4;
        float s[4] = {0.f, 0.f, 0.f, 0.f};
        u32x2 pa, pb, pk, pr; f32x4 pd; bf16_t pv; float ps = 0.f;
        {
            const size_t m = (size_t)b * 2048 + st; const size_t o = m * 512 + h * 64 + c16 * 4;
            pa = *(const u32x2*)((const bf16_t*)SA + o); pb = *(const u32x2*)((const bf16_t*)SB + o); pd = *(const f32x4*)(SD + o); pk = *(const u32x2*)((const bf16_t*)SK + o); pr = *(const u32x2*)((const bf16_t*)SRD + o);
            pv = ((const bf16_t*)SV)[m * 512 + h * 64 + rg * 16 + c16];
            if (tid < 32) ps = SBR[((size_t)b * 2048 + tid) * 8 + h]; else if (tid < 64) ps = SKR[((size_t)b * 2048 + tid - 32) * 8 + h];
        }
        {
            LAS float* B0 = L;
            *(LAS f32x4*)(B0 + st * 64 + c16 * 4) = (f32x4){bflo(pa.x), bfhi(pa.x), bflo(pa.y), bfhi(pa.y)}; *(LAS f32x4*)(B0 + 2048 + st * 64 + c16 * 4) = (f32x4){bflo(pb.x), bfhi(pb.x), bflo(pb.y), bfhi(pb.y)}; *(LAS f32x4*)(B0 + 4096 + st * 64 + c16 * 4) = pd;
            *(LAS f32x4*)(B0 + 6144 + st * 64 + c16 * 4) = (f32x4){bflo(pk.x), bfhi(pk.x), bflo(pk.y), bfhi(pk.y)}; *(LAS f32x4*)(B0 + 8192 + st * 64 + c16 * 4) = (f32x4){bflo(pr.x), bfhi(pr.x), bflo(pr.y), bfhi(pr.y)}; B0[10240 + st * 16 + c16] = bf2f(pv);
            if (tid < 64) B0[10752 + tid] = ps;
        }
        __syncthreads();
        for (int n = 0; n < TT / TC; ++n) {
            LAS float* Bc = L + (n & 1) * CB; LAS float* Bn = L + ((n + 1) & 1) * CB; LAS float* yb = L + 2 * CB + (n & 1) * 512;
            const bool more = n + 1 < TT / TC;
            if (more) {
                const size_t m = (size_t)b * 2048 + (n + 1) * TC + st; const size_t o = m * 512 + h * 64 + c16 * 4;
                pa = *(const u32x2*)((const bf16_t*)SA + o); pb = *(const u32x2*)((const bf16_t*)SB + o); pd = *(const f32x4*)(SD + o); pk = *(const u32x2*)((const bf16_t*)SK + o); pr = *(const u32x2*)((const bf16_t*)SRD + o);
                pv = ((const bf16_t*)SV)[m * 512 + h * 64 + rg * 16 + c16];
                if (tid < 32) ps = SBR[((size_t)b * 2048 + (n + 1) * TC + tid) * 8 + h]; else if (tid < 64) ps = SKR[((size_t)b * 2048 + (n + 1) * TC + tid - 32) * 8 + h];
            }
            if (wave < 4) {
                LAS float* ybase = (c == 0) ? (yb + rl) : (L + 2 * CB + 1024 + lane);
                const LAS float* p0 = Bc + c * 4;
                f32x4 av = *(const LAS f32x4*)p0, bv = *(const LAS f32x4*)(p0 + 2048), dv = *(const LAS f32x4*)(p0 + 4096), kv = *(const LAS f32x4*)(p0 + 6144), rd = *(const LAS f32x4*)(p0 + 8192);
                float vi = Bc[10240 + rl], br = Bc[10752], kr = Bc[10784];
#pragma unroll 8
                for (int t = 0; t < TC; ++t) {
                    const int tn = (t + 1 < TC) ? t + 1 : t;
                    const LAS float* p = Bc + tn * 64 + c * 4;
                    const f32x4 av2 = *(const LAS f32x4*)p, bv2 = *(const LAS f32x4*)(p + 2048), dv2 = *(const LAS f32x4*)(p + 4096), kv2 = *(const LAS f32x4*)(p + 6144), rd2 = *(const LAS f32x4*)(p + 8192);
                    const float vi2 = Bc[10240 + tn * 16 + rl], br2 = Bc[10752 + tn], kr2 = Bc[10784 + tn];
                    const float y = scan_step(s, av, bv, dv, kv, rd, vi, br, kr);
                    ybase[t * 16] = y;
                    av = av2; bv = bv2; dv = dv2; kv = kv2; rd = rd2; vi = vi2; br = br2; kr = kr2;
                }
            }
            else {
                const int hw4 = wave - 4;
                if (l == 0 && n < 14) {
                    const int d = (blockIdx.x * 4 + hw4) + 1024 * n;
                    if (d < TR_DEFERRED) tr_deferred(a, ws, d, (LAS float*)(lds + 94208 + hw4 * 8448), lane);
                } else if (n >= 24 && n < 41) {
                    const int tt = (n - 24) * 4 + hw4;
                    int mB = -1;
                    if (tt < 64) mB = blockIdx.x * 64 + tt; else if (tt == 64 && blockIdx.x < NS) mB = MP + blockIdx.x;
                    if (mB >= 0) convB_token(a, l, mB, lane);
                } else if (n >= 20 && n < 24) {
                    const int q = blockIdx.x + gridDim.x * (n - 20);
                    if (q < NS * 8) {
                        const int i = q >> 3, hs = q & 7; const size_t ms = MP + i;
                        const size_t o = ms * 512 + hs * 64 + c * 4;
                        const f32x4 av = ld_bf4((const bf16_t*)SA + o), bv = ld_bf4((const bf16_t*)SB + o), dv = *(const f32x4*)(SD + o), kv = ld_bf4((const bf16_t*)SK + o), rd = ld_bf4((const bf16_t*)SRD + o);
                        const float br = SBR[ms * 8 + hs], kr = SKR[ms * 8 + hs];
#pragma unroll 1
                        for (int p4 = 0; p4 < 4; ++p4) {
                            const int row = p4 * 16 + hw4 * 4 + j4;
                            const size_t so = ((size_t)((l * NS + i) * 8 + hs)) * 4096 + row * 64 + c * 4;
                            const f32x4 s4 = *(const f32x4*)(a.in[I_SWKV] + so);
                            const float vi = bf2f(((const bf16_t*)SV)[ms * 512 + hs * 64 + row]);
                            float ss_[4] = {s4[0], s4[1], s4[2], s4[3]};
                            const float y = scan_step(ss_, av, bv, dv, kv, rd, vi, br, kr);
                            *(f32x4*)(a.out + O_WKVS + so) = (f32x4){ss_[0], ss_[1], ss_[2], ss_[3]};
                            if (c == 0) ((bf16_t*)Y)[ms * 512 + hs * 64 + row] = (bf16_t)f2bf(y);
                        }
                    }
                }
            }
            if (more) {
                *(LAS f32x4*)(Bn + st * 64 + c16 * 4) = (f32x4){bflo(pa.x), bfhi(pa.x), bflo(pa.y), bfhi(pa.y)}; *(LAS f32x4*)(Bn + 2048 + st * 64 + c16 * 4) = (f32x4){bflo(pb.x), bfhi(pb.x), bflo(pb.y), bfhi(pb.y)}; *(LAS f32x4*)(Bn + 4096 + st * 64 + c16 * 4) = pd;
                *(LAS f32x4*)(Bn + 6144 + st * 64 + c16 * 4) = (f32x4){bflo(pk.x), bfhi(pk.x), bflo(pk.y), bfhi(pk.y)}; *(LAS f32x4*)(Bn + 8192 + st * 64 + c16 * 4) = (f32x4){bflo(pr.x), bfhi(pr.x), bflo(pr.y), bfhi(pr.y)}; Bn[10240 + st * 16 + c16] = bf2f(pv);
                if (tid < 64) Bn[10752 + tid] = ps;
            }
            __syncthreads();
            ((bf16_t*)Y)[((size_t)b * 2048 + n * TC + st) * 512 + h * 64 + rg * 16 + c16] = (bf16_t)f2bf(yb[st * 16 + c16]);
        }
        if (wave < 4) {
            float* o = a.out + O_WKVP + ((size_t)((l * 8 + b) * 8 + h)) * 4096 + (rg * 16 + rl) * 64 + c * 4;
            *(f32x4*)o = (f32x4){s[0], s[1], s[2], s[3]};
        }
        __syncthreads();
    }
}

__device__ __forceinline__ void post_phase(const Args& a, int l, int lane, int gw, int NGW) {
    unsigned char* ws = a.ws;
    const bf16_t* __restrict__ PROJ = (const bf16_t*)(ws + OFF_PROJ);
    const float* __restrict__ Y = (const float*)(ws + OFF_Y); const float* __restrict__ SV = (const float*)(ws + (l == 0 ? OFF_SV0 : OFF_SV1)); const float* __restrict__ GG = (const float*)(ws + OFF_G);
    const float* __restrict__ RKR = (const float*)(ws + OFF_RKR);
    bf16_t* __restrict__ YAB = (bf16_t*)(ws + OFF_YAB);
    const int cb = lane * 8, h = lane >> 3;
#pragma unroll 4
    for (int m = gw; m < MTOK; m += NGW) {
        const size_t o = (size_t)m * 512 + cb;
        f32x4 y0, y1; { const u32x4 yq = __builtin_nontemporal_load((const u32x4*)((const bf16_t*)Y + o)); y0 = (f32x4){bflo(yq.x), bfhi(yq.x), bflo(yq.y), bfhi(yq.y)}; y1 = (f32x4){bflo(yq.z), bfhi(yq.z), bflo(yq.w), bfhi(yq.w)}; }
        float s = (y0[0] + y0[1]) + (y0[2] + y0[3]) + (y1[0] + y1[1]) + (y1[2] + y1[3]);
        s += __shfl_xor(s, 1); s += __shfl_xor(s, 2); s += __shfl_xor(s, 4);
        const float mean = s * (1.f / 64.f);
        const f32x4 d0 = y0 - mean, d1 = y1 - mean;
        float q = (d0[0] * d0[0] + d0[1] * d0[1]) + (d0[2] * d0[2] + d0[3] * d0[3]) + (d1[0] * d1[0] + d1[1] * d1[1]) + (d1[2] * d1[2] + d1[3] * d1[3]);
        q += __shfl_xor(q, 1); q += __shfl_xor(q, 2); q += __shfl_xor(q, 4);
        const float rstd = rsqrtf(q * (1.f / 64.f) + GN_EPS);
        const float rkr = RKR[m * 8 + h];
        f32x4 v0, v1; { const u32x4 vq = __builtin_nontemporal_load((const u32x4*)((const bf16_t*)SV + o)); v0 = (f32x4){bflo(vq.x), bfhi(vq.x), bflo(vq.y), bfhi(vq.y)}; v1 = (f32x4){bflo(vq.z), bfhi(vq.z), bflo(vq.w), bfhi(vq.w)}; } f32x4 g0, g1; { const u32x4 gq = __builtin_nontemporal_load((const u32x4*)((const bf16_t*)GG + o)); g0 = (f32x4){bflo(gq.x), bfhi(gq.x), bflo(gq.y), bfhi(gq.y)}; g1 = (f32x4){bflo(gq.z), bfhi(gq.z), bflo(gq.w), bfhi(gq.w)}; }
        const f32x4 lw0 = *(const f32x4*)(a.in[I_LNW] + l * 512 + cb), lw1 = *(const f32x4*)(a.in[I_LNW] + l * 512 + cb + 4);
        const f32x4 lb0 = *(const f32x4*)(a.in[I_LNB] + l * 512 + cb), lb1 = *(const f32x4*)(a.in[I_LNB] + l * 512 + cb + 4);
        const f32x4 r0 = (d0 * rstd * lw0 + lb0 + v0 * rkr) * g0, r1 = (d1 * rstd * lw1 + lb1 + v1 * rkr) * g1;
        u32x4 w; w.x = pk2(r0[0], r0[1]); w.y = pk2(r0[2], r0[3]); w.z = pk2(r1[0], r1[1]); w.w = pk2(r1[2], r1[3]);
        *(u32x4*)(YAB + (size_t)m * 1024 + cb) = w;
    }
    if (l + 1 < 2 && gw < NS) {
        bf16_t* XB = (bf16_t*)(ws + OFF_XB) + (size_t)(MTOK + gw) * D;
        const float* src = a.in[I_SSHIFT] + (size_t)((l + 1) * NS + gw) * D; const float* gn = a.in[I_NMIX] + (l + 1) * D;
#pragma unroll
        for (int j = 0; j < 4; ++j) { const f32x4 v = *(const f32x4*)(src + 4 * lane + 256 * j), g4 = *(const f32x4*)(gn + 4 * lane + 256 * j);
            u32x2 w; w.x = pk2(v[0] / g4[0], v[1] / g4[1]); w.y = pk2(v[2] / g4[2], v[3] / g4[3]); *(u32x2*)(XB + 4 * lane + 256 * j) = w; }
    }
}

__device__ __forceinline__ void sample_attn(LAS unsigned char* lds, const Args& a, int l, int tid, int lane, int wave) {
    unsigned char* ws = a.ws;
    const bf16_t* Q = (const bf16_t*)(ws + OFF_Q); bf16_t* O = (bf16_t*)(ws + OFF_O);
    LAS float* sc = (LAS float*)lds;
    LAS float* part = sc + 256;
    for (int q = blockIdx.x; q < NS * 4; q += gridDim.x) {
        const int i = q >> 2, h = q & 3;
        const u32x2 qw = *(const u32x2*)(Q + (size_t)(MP + i) * 1024 + h * 256 + lane * 4);
        const float q0 = bflo(qw.x), q1 = bfhi(qw.x), q2 = bflo(qw.y), q3 = bfhi(qw.y);
        const float* Kb = a.in[I_CK] + ((size_t)((l * NS + i) * 256) * 4 + h) * 256 + lane * 4;
        const float* Vb = a.in[I_CV] + ((size_t)((l * NS + i) * 256) * 4 + h) * 256 + lane * 4;
        {
            f32x4 kx[8], kn[8];
#pragma unroll
            for (int e = 0; e < 8; ++e) kx[e] = __builtin_nontemporal_load((const f32x4*)(Kb + (size_t)(wave * 32 + e) * 1024));
#pragma unroll
            for (int g8 = 0; g8 < 4; ++g8) {
                if (g8 < 3) {
#pragma unroll
                    for (int e = 0; e < 8; ++e) kn[e] = __builtin_nontemporal_load((const f32x4*)(Kb + (size_t)(wave * 32 + (g8 + 1) * 8 + e) * 1024));
                }
#pragma unroll
                for (int e = 0; e < 8; ++e) { float p = kx[e][0] * q0 + kx[e][1] * q1 + kx[e][2] * q2 + kx[e][3] * q3; p = wave_sum(p); if (lane == 0) sc[wave * 32 + g8 * 8 + e] = p; }
#pragma unroll
                for (int e = 0; e < 8; ++e) kx[e] = kn[e];
            }
        }
        __syncthreads();
        if (wave == 0) {
            const f32x4 s4 = *(const LAS f32x4*)(sc + lane * 4);
            const float mx = wave_max(fmaxf(fmaxf(s4[0], s4[1]), fmaxf(s4[2], s4[3])));
            f32x4 e4; e4[0] = __expf(s4[0] - mx); e4[1] = __expf(s4[1] - mx); e4[2] = __expf(s4[2] - mx); e4[3] = __expf(s4[3] - mx);
            const float inv = 1.f / wave_sum((e4[0] + e4[1]) + (e4[2] + e4[3]));
            *(LAS f32x4*)(sc + lane * 4) = e4 * inv;
        }
        __syncthreads();
        f32x4 acc = (f32x4){0.f, 0.f, 0.f, 0.f};
        {
            f32x4 vx[8], vn[8];
#pragma unroll
            for (int e = 0; e < 8; ++e) vx[e] = __builtin_nontemporal_load((const f32x4*)(Vb + (size_t)(wave * 32 + e) * 1024));
#pragma unroll
            for (int g8 = 0; g8 < 4; ++g8) {
                if (g8 < 3) {
#pragma unroll
                    for (int e = 0; e < 8; ++e) vn[e] = __builtin_nontemporal_load((const f32x4*)(Vb + (size_t)(wave * 32 + (g8 + 1) * 8 + e) * 1024));
                }
#pragma unroll
                for (int e = 0; e < 8; ++e) acc += vx[e] * sc[wave * 32 + g8 * 8 + e];
#pragma unroll
                for (int e = 0; e < 8; ++e) vx[e] = vn[e];
            }
        }
        *(LAS f32x4*)(part + wave * 256 + lane * 4) = acc;
        __syncthreads();
        if (tid < 256) {
            float s = 0.f;
#pragma unroll
            for (int w = 0; w < 8; ++w) s += part[w * 256 + tid];
            O[(size_t)(MP + i) * 1024 + h * 256 + tid] = (bf16_t)f2bf(s);
        }
        __syncthreads();
    }
}

__device__ __forceinline__ void ffnconv_phase(const Args& a, int l, int tid) {
    unsigned char* ws = a.ws;
    const bf16_t* __restrict__ UP = (const bf16_t*)(ws + OFF_UP); bf16_t* __restrict__ H = (bf16_t*)(ws + OFF_H);
    const float* __restrict__ cw = a.in[I_FCW] + (size_t)l * 3 * FW2;
    constexpr int CH = FW / 8;
    for (int rb = blockIdx.x; rb < MP / 64; rb += gridDim.x) {
        if (tid < CH) {
            const int c = tid * 8, r0 = rb * 64, t0 = r0 & 2047;
            float wu[3][8], wg[3][8];
#pragma unroll
            for (int k = 0; k < 3; ++k) {
                const f32x4 a0 = *(const f32x4*)(cw + k * FW2 + c), a1 = *(const f32x4*)(cw + k * FW2 + c + 4), b0 = *(const f32x4*)(cw + k * FW2 + FW + c), b1 = *(const f32x4*)(cw + k * FW2 + FW + c + 4);
#pragma unroll
                for (int j = 0; j < 4; ++j) { wu[k][j] = a0[j]; wu[k][4 + j] = a1[j]; wg[k][j] = b0[j]; wg[k][4 + j] = b1[j]; }
            }
            float u2[8], u1[8], g2[8], g1[8];
#pragma unroll
            for (int j = 0; j < 8; ++j) { u2[j] = 0.f; u1[j] = 0.f; g2[j] = 0.f; g1[j] = 0.f; }
            if (t0 >= 2) {
                const bf16_t* p = UP + (size_t)(r0 - 2) * FW2 + c;
                unpack8(*(const u32x4*)p, u2); unpack8(*(const u32x4*)(p + FW), g2); unpack8(*(const u32x4*)(p + FW2), u1); unpack8(*(const u32x4*)(p + FW2 + FW), g1);
            }
            const bf16_t* p = UP + (size_t)r0 * FW2 + c; bf16_t* hp = H + (size_t)r0 * FW + c;
#pragma unroll 1
            for (int r = 0; r < 64; r += 4) {
                u32x4 lu[4], lg[4];
#pragma unroll
                for (int e = 0; e < 4; ++e) { lu[e] = __builtin_nontemporal_load((const u32x4*)(p + (size_t)(r + e) * FW2)); lg[e] = __builtin_nontemporal_load((const u32x4*)(p + (size_t)(r + e) * FW2 + FW)); }
#pragma unroll
                for (int e = 0; e < 4; ++e) {
                    float u0[8], g0[8], hh[8]; unpack8(lu[e], u0); unpack8(lg[e], g0);
#pragma unroll
                    for (int j = 0; j < 8; ++j) {
                        const float uu = wu[0][j] * u2[j] + wu[1][j] * u1[j] + wu[2][j] * u0[j], gg = wg[0][j] * g2[j] + wg[1][j] * g1[j] + wg[2][j] * g0[j];
                        hh[j] = gg * __builtin_amdgcn_rcpf(1.f + __expf(-gg)) * uu;
                        u2[j] = u1[j]; u1[j] = u0[j]; g2[j] = g1[j]; g1[j] = g0[j];
                    }
                    u32x4 w; w.x = cvt_pk_bf16(hh[0], hh[1]); w.y = cvt_pk_bf16(hh[2], hh[3]); w.z = cvt_pk_bf16(hh[4], hh[5]); w.w = cvt_pk_bf16(hh[6], hh[7]);
                    *(u32x4*)(hp + (size_t)(r + e) * FW) = w;
                }
            }
        }
    }
    for (int it = blockIdx.x * 512 + tid; it < NS * CH; it += gridDim.x * 512) {
        const int i = it / CH, c = (it % CH) * 8, m = MP + i;
        const bf16_t* r0 = UP + (size_t)m * FW2;
        float u[8], g[8], t0[8], t1[8];
        unpack8(*(const u32x4*)(r0 + c), t0); unpack8(*(const u32x4*)(r0 + FW + c), t1);
        const float* sf = a.in[I_SFFN] + (size_t)(l * NS + i) * 2 * FW2;
        float* dst = a.out + O_FFNS + (size_t)(l * NS + i) * 2 * FW2;
        float hh[8];
#pragma unroll
        for (int q = 0; q < 2; ++q) {
            const int cc = c + 4 * q;
            const f32x4 p0u = *(const f32x4*)(sf + cc), p0g = *(const f32x4*)(sf + FW + cc), p1u = *(const f32x4*)(sf + FW2 + cc), p1g = *(const f32x4*)(sf + FW2 + FW + cc);
            const f32x4 w0u = *(const f32x4*)(cw + cc), w1u = *(const f32x4*)(cw + FW2 + cc), w2u = *(const f32x4*)(cw + 2 * FW2 + cc);
            const f32x4 w0g = *(const f32x4*)(cw + FW + cc), w1g = *(const f32x4*)(cw + FW2 + FW + cc), w2g = *(const f32x4*)(cw + 2 * FW2 + FW + cc);
            *(f32x4*)(dst + cc) = p1u; *(f32x4*)(dst + FW + cc) = p1g;
#pragma unroll
            for (int j = 0; j < 4; ++j) {
                u[4 * q + j] = w2u[j] * t0[4 * q + j] + w0u[j] * p0u[j] + w1u[j] * p1u[j]; g[4 * q + j] = w2g[j] * t1[4 * q + j] + w0g[j] * p0g[j] + w1g[j] * p1g[j];
                hh[4 * q + j] = g[4 * q + j] * sigmoidf_(g[4 * q + j]) * u[4 * q + j];
            }
        }
        u32x4 w; w.x = pk2(hh[0], hh[1]); w.y = pk2(hh[2], hh[3]); w.z = pk2(hh[4], hh[5]); w.w = pk2(hh[6], hh[7]);
        *(u32x4*)(H + (size_t)m * FW + c) = w;
    }
}

__device__ __forceinline__ void final_phase(const Args& a, int lane, int gw, int NGW) {
    unsigned char* ws = a.ws;
    const bf16_t* __restrict__ X = (const bf16_t*)(ws + OFF_XB); const float* __restrict__ SS = (const float*)(ws + OFF_SS) + (size_t)6 * MROWS;
    float* __restrict__ outp = a.out;
#pragma unroll 4
    for (int m = gw; m < MTOK; m += NGW) {
        const float rs = rsqrtf(SS[m] * (1.f / 1024.f) + EPS);
        float* __restrict__ dst = m < MP ? outp + O_YP + (size_t)m * D : outp + O_YS + (size_t)(m - MP) * D;
#pragma unroll
        for (int j = 0; j < 4; ++j) { const u32x2 xw = __builtin_nontemporal_load((const u32x2*)(X + (size_t)m * D + 4 * lane + 256 * j)); const f32x4 v = (f32x4){bflo(xw.x), bfhi(xw.x), bflo(xw.y), bfhi(xw.y)}, gn = *(const f32x4*)(a.in[I_NFIN] + 4 * lane + 256 * j);
            __builtin_nontemporal_store(v * rs * gn, (f32x4*)(dst + 4 * lane + 256 * j)); }
    }
}

__device__ __forceinline__ void skinny_gemm(LAS unsigned char* lds, const bf16_t* __restrict__ A, int lda, const bf16_t* __restrict__ Wt, int K, int mode, float* X, bf16_t* O, float* ssn, const float* ss, int lane, int wave) {
    LAS f32x4* part = (LAS f32x4*)lds;
    for (int item = blockIdx.x; item < 256; item += gridDim.x) {
        const int n0 = (item & 63) * 16, r0 = MP + (item >> 6) * 32, fr = lane & 15, fq = lane >> 4;
        const bf16_t* ap = A + (size_t)(r0 + fr) * lda + fq * 8;
        const bf16_t* bp = Wt + (size_t)(n0 + fr) * K + fq * 8;
        f32x4 acc0 = (f32x4){0.f, 0.f, 0.f, 0.f}, acc1 = acc0;
#pragma unroll 4
        for (int ks = wave; ks < K / 32; ks += 8) {
            const bf16x8 bf = *(const bf16x8*)(bp + ks * 32), a0 = *(const bf16x8*)(ap + ks * 32), a1 = *(const bf16x8*)(ap + (size_t)16 * lda + ks * 32);
            acc0 = __builtin_amdgcn_mfma_f32_16x16x32_bf16(bf, a0, acc0, 0, 0, 0);
            acc1 = __builtin_amdgcn_mfma_f32_16x16x32_bf16(bf, a1, acc1, 0, 0, 0);
        }
        part[(wave * 2 + 0) * 64 + lane] = acc0; part[(wave * 2 + 1) * 64 + lane] = acc1;
        __syncthreads();
        if (wave < 2) {
            f32x4 acc = part[wave * 64 + lane];
#pragma unroll
            for (int w = 1; w < 8; ++w) acc += part[(w * 2 + wave) * 64 + lane];
            const int row = r0 + wave * 16 + fr, col = n0 + fq * 4;
            const size_t idx = (size_t)row * 1024 + col;
            if (mode == 1) {
                const u32x2 xi = *(const u32x2*)(O + idx);
                const f32x4 x = (f32x4){bflo(xi.x), bfhi(xi.x), bflo(xi.y), bfhi(xi.y)} + acc;
                u32x2 w; w.x = cvt_pk_bf16(x[0], x[1]); w.y = cvt_pk_bf16(x[2], x[3]); *(u32x2*)(O + idx) = w;
                float sq = (x[0] * x[0] + x[1] * x[1]) + (x[2] * x[2] + x[3] * x[3]);
                sq += __shfl_xor(sq, 16); sq += __shfl_xor(sq, 32);
                if (fq == 0) atomicAdd(ssn + row, sq);
            } else {
                const float rs = rsqrtf(ss[row] * (1.f / 1024.f) + EPS);
                u32x2 w; w.x = cvt_pk_bf16(acc[0] * rs, acc[1] * rs); w.y = cvt_pk_bf16(acc[2] * rs, acc[3] * rs); *(u32x2*)(O + idx) = w;
            }
        }
        __syncthreads();
    }
}

#define XB_TMO      128
#define XB_XCNT(j)  (256  + 64 * (j))
#define XB_XSUB(j)  (1280 + 64 * (j))
#define XB_XGEN(j)  (2304 + 64 * (j))
#define XB_TOP      3328
#define XB_TOPGEN   3392
#define XCD_BAR_WORDS 3456
#define XB_SPIN_CAP (1u << 22)
__device__ __forceinline__ unsigned xb_ld(unsigned* p)              { return __hip_atomic_load(p, __ATOMIC_RELAXED, __HIP_MEMORY_SCOPE_AGENT); }
__device__ __forceinline__ unsigned xb_add(unsigned* p, unsigned v) { return __hip_atomic_fetch_add(p, v, __ATOMIC_RELAXED, __HIP_MEMORY_SCOPE_AGENT); }
__device__ __forceinline__ unsigned xb_xcc_id() { return (unsigned)__builtin_amdgcn_s_getreg((3 << 11) | 20) & 0xFu; }
#define XB_SPIN(cond, bar) do { unsigned _sp = 0; while (cond) { __builtin_amdgcn_s_sleep(1); \
    if ((++_sp & 255u) == 0u) { if (xb_ld(&(bar)[XB_TMO])) break; if (_sp > XB_SPIN_CAP) { atomicAdd(&(bar)[XB_TMO], 1u); break; } } } } while (0)
struct XcdBarrier { unsigned* bar; unsigned x; volatile LAS unsigned* st; };
__device__ __forceinline__ XcdBarrier xcd_barrier_post(unsigned* bar, volatile LAS unsigned* st) {
    XcdBarrier b; b.bar = bar; b.x = xb_xcc_id(); b.st = st;
    if (threadIdx.x == 0) (void)xb_add(&bar[XB_XCNT(b.x)], 1u);
    return b;
}
__device__ __forceinline__ void xcd_barrier_complete(unsigned* bar, unsigned x, unsigned& nloc, unsigned& nx) {
    const unsigned G = gridDim.x * gridDim.y * gridDim.z;
    unsigned sum, cnt, mine, sp = 0u;
    for (;;) {
        sum = 0u; cnt = 0u; mine = 0u;
#pragma unroll
        for (unsigned j = 0; j < 16; ++j) { const unsigned c = xb_ld(&bar[XB_XCNT(j)]); sum += c; cnt += (c > 0u) ? 1u : 0u; mine = (j == x) ? c : mine; }
        if (sum == G) break;
        __builtin_amdgcn_s_sleep(1);
        if ((++sp & 255u) == 0u) { if (xb_ld(&bar[XB_TMO])) break; if (sp > XB_SPIN_CAP) { atomicAdd(&bar[XB_TMO], 1u); break; } }
    }
    nloc = mine > 0u ? mine : 1u; nx = cnt > 0u ? cnt : 1u;
}
__device__ __forceinline__ void xcd_barrier(const XcdBarrier& b) {
    asm volatile("s_waitcnt vmcnt(0)" ::: "memory");
    __syncthreads();
    if (threadIdx.x == 0) {
        unsigned* bar = b.bar;
        __builtin_amdgcn_s_waitcnt(0);
        unsigned nloc = b.st[0], nx = b.st[1];
        if (nloc == 0u) { xcd_barrier_complete(bar, b.x, nloc, nx); b.st[0] = nloc; b.st[1] = nx; }
        const unsigned old = xb_add(&bar[XB_XSUB(b.x)], 1u);
        const unsigned gen = old / nloc;
        if (old + 1u == (gen + 1u) * nloc) {
            __builtin_amdgcn_fence(__ATOMIC_RELEASE, "agent");
            asm volatile("s_waitcnt vmcnt(0)" ::: "memory");
            const unsigned og = xb_add(&bar[XB_TOP], 1u);
            const unsigned tg = og / nx;
            if (og + 1u == (tg + 1u) * nx) xb_add(&bar[XB_TOPGEN], 1u);
            else XB_SPIN(xb_ld(&bar[XB_TOPGEN]) == tg, bar);
            __builtin_amdgcn_fence(__ATOMIC_ACQUIRE, "agent");
            xb_add(&bar[XB_XGEN(b.x)], 1u);
            asm volatile("s_waitcnt vmcnt(0)" ::: "memory");
        } else {
            XB_SPIN(xb_ld(&bar[XB_XGEN(b.x)]) == gen, bar);
            __builtin_amdgcn_fence(__ATOMIC_ACQUIRE, "agent");
            asm volatile("s_waitcnt vmcnt(0)" ::: "memory");
        }
    }
    __syncthreads();
}

__global__ void __launch_bounds__(512, 2) mega(Args a) {
    extern __shared__ __attribute__((aligned(16))) unsigned char lds_raw[];
    LAS unsigned char* lds = (LAS unsigned char*)lds_raw;
    cg::grid_group grid = cg::this_grid();
    volatile LAS unsigned* bst = (volatile LAS unsigned*)(lds + 131072 + 64);
    if (threadIdx.x == 0) { bst[0] = 0u; bst[1] = 0u; }
    __syncthreads();
    const XcdBarrier xbar = xcd_barrier_post((unsigned*)(a.ws + OFF_BAR), bst);
    for (int ph2 = 2 * a.ph_lo; ph2 < 2 * a.ph_hi; ++ph2) {
        const int ph = ph2 >> 1;
        if (ph2 & 1) { const int spx = (ph == 0) ? 12 : (ph == NPHASE - 1) ? 13 : (ph - 1) % 12; if (!((REP_MASK >> spx) & 1)) continue; }
        int tid = threadIdx.x; asm volatile("" : "+v"(tid));
        const int lane = tid & 63, wave = __builtin_amdgcn_readfirstlane(tid >> 6);
        const int G = gridDim.x, gw = blockIdx.x * 8 + wave, NGW = G * 8;
        unsigned char* ws = a.ws; asm volatile("" : "+s"(ws));
        float* SS = (float*)(ws + OFF_SS);
        bf16_t* XB = (bf16_t*)(ws + OFF_XB); float* X = (float*)(ws + OFF_X);
        if (ph == 0) {
            if (PHON(12)) p0_prologue(lds, a, tid, lane, wave, gw, NGW);
        } else if (ph == NPHASE - 1) {
            if (PHON(13)) final_phase(a, lane, gw, NGW);
        } else {
            const int l = (ph - 1) / 12, sp = (ph - 1) % 12;
            const bool is_gemm = (sp == 0 || sp == 4 || sp == 5 || sp == 7 || sp == 8 || sp == 9 || sp == 11);
            if (is_gemm && PHON(0)) {
                const int njobs = (l == 0 && (sp == 0 || sp == 9)) ? 3 : 1;
                for (int jb = 0; jb < njobs; ++jb) {
                    pg8::Gemm g; pg8::GenOrder S; pg8::Epi E;
                    E.mode = 0; E.O = nullptr; E.ldc = D; E.ss = nullptr; E.X = nullptr; E.ssn = nullptr; E.F = nullptr; E.l = l; E.dry = (ph2 & 1);
                    if (sp == 0 && jb == 0) {
                        g = pg8::Gemm{XB, (const bf16_t*)(ws + OFF_WIN) + (size_t)l * LDP * D, D, D, D};
                        S.init(0, MROWS, LDP, D, D, G, (int)blockIdx.x);
                        E.O = (bf16_t*)(ws + OFF_PROJ); E.ldc = LDP; E.ss = SS + (size_t)3 * l * MROWS;
                    } else if (jb > 0) {
                        const int kv = (sp == 0 ? 0 : 2) + jb - 1, ll = kv >> 1, isv = kv & 1;
                        g = pg8::Gemm{(const bf16_t*)(ws + OFF_MNB), (const bf16_t*)(ws + (isv ? OFF_WV : OFF_WK)) + (size_t)ll * D * D, D, D, D};
                        S.init(0, MMEM, D, D, D, G, (int)((blockIdx.x + G - 160 - 32 * (jb - 1)) % G));
                        E.mode = isv ? 3 : 2; E.O = (bf16_t*)(ws + (isv ? OFF_MVT : OFF_MK)) + (size_t)ll * MMEM * D; E.ss = (const float*)(ws + OFF_SSM);
                        E.F = a.out + (isv ? O_MVP : O_MKP) + (size_t)ll * MMEM * D; E.l = ll;
                    } else if (sp == 4 || sp == 8 || sp == 11) {
                        const bf16_t* A = (const bf16_t*)(ws + (sp == 4 ? OFF_YAB : sp == 8 ? OFF_O : OFF_H));
                        const bf16_t* B = sp == 4 ? (const bf16_t*)(ws + OFF_WOUT) + (size_t)l * D * D : sp == 8 ? (const bf16_t*)(ws + OFF_WO) + (size_t)l * D * D : (const bf16_t*)(ws + OFF_WDN) + (size_t)l * D * FW;
                        const int K = sp == 11 ? FW : D;
                        const int nrm = 3 * l + (sp == 4 ? 1 : sp == 8 ? 2 : 3);
                        g = pg8::Gemm{A, B, K, K, K};
                        S.init(0, MP, D, K, K, G, (int)blockIdx.x);
                        E.mode = 1; E.O = XB; E.X = X; E.ssn = SS + (size_t)nrm * MROWS;
                    } else if (sp == 5) {
                        g = pg8::Gemm{XB, (const bf16_t*)(ws + OFF_WQ) + (size_t)l * D * D, D, D, D};
                        S.init(0, MP, D, D, D, G, (int)blockIdx.x);
                        E.O = (bf16_t*)(ws + OFF_Q); E.ss = SS + (size_t)(3 * l + 1) * MROWS;
                    } else if (sp == 7) {
                        g = pg8::Gemm{(const bf16_t*)(ws + OFF_P), (const bf16_t*)(ws + OFF_MVT) + (size_t)l * MMEM * D, D, 256, 256};
                        S.init(2, MP, D, D, 256, G, (int)blockIdx.x);
                        E.O = (bf16_t*)(ws + OFF_O);
                    } else {
                        g = pg8::Gemm{XB, (const bf16_t*)(ws + OFF_WUP) + (size_t)l * FW2 * D, D, D, D};
                        S.init(0, MROWS, FW2, D, D, G, (int)blockIdx.x);
                        E.mode = 4; E.O = (bf16_t*)(ws + OFF_UP); E.ldc = FW2; E.ss = SS + (size_t)(3 * l + 2) * MROWS; E.F = a.out;
                    }
                    pg8::gemm_phase<pg8::Epi, pg8::GenOrder, true>(lds, g, S, E);
                    if (jb == 0 && !(ph2 & 1) && (sp == 4 || sp == 5 || sp == 8 || sp == 11))
                        skinny_gemm(lds, g.A, g.lda, g.Bt, g.K, E.mode, X, E.O, E.ssn, E.ss, lane, wave);
                }
            } else if (sp == 1 && PHON(1)) {
                prep_phase(lds, a, l, tid, lane, wave, gw);
            } else if (sp == 2 && PHON(2)) {
                scan_phase(lds, a, l, tid, lane, wave);
            } else if (sp == 3 && PHON(3)) {
                post_phase(a, l, lane, gw, NGW);
            } else if (sp == 6 && PHON(6)) {
                {
                    pg8::Gemm g{(const bf16_t*)(ws + OFF_Q), (const bf16_t*)(ws + OFF_MK) + (size_t)l * MMEM * D, D, D, 256};
                    pg8::GenOrder S; S.init(1, MP, D, D, D, G, (int)blockIdx.x);
                    pg8::EpiSm E{(bf16_t*)(ws + OFF_P)};
                    pg8::gemm_phase<pg8::EpiSm, pg8::GenOrder, false>(lds, g, S, E);
                }
                __syncthreads();
                sample_attn(lds, a, l, tid, lane, wave);
            } else if (sp == 10 && PHON(10)) {
                ffnconv_phase(a, l, tid);
            }
        }
        if (ph2 + 1 < 2 * a.ph_hi) { if (a.ph_lo < 0) grid.sync(); else xcd_barrier(xbar); }
        if (((REP_MASK >> 14) & 1) && ph2 == 0) { for (int q = 0; q < 40; ++q) xcd_barrier(xbar); }
    }
}

extern "C" void kernel_launch(void* const* d_in, const int* in_sizes, int n_in, void* d_out, int out_size, void* d_ws, size_t ws_size, hipStream_t stream) {
    static int grid = 0;
    if (grid == 0) {
        if (n_in != 38 || ws_size < WS_END) { fprintf(stderr, "kernel_launch: expected 38 inputs and >= %zu bytes of workspace (got %d, %zu)\n", (size_t)WS_END, n_in, ws_size); grid = -1; return; }
        int dev = 0, cus = 0, per_cu = 0;
        hipGetDevice(&dev);
        hipDeviceGetAttribute(&cus, hipDeviceAttributeMultiprocessorCount, dev);
        if (hipFuncSetAttribute((const void*)mega, hipFuncAttributeMaxDynamicSharedMemorySize, LDS_BYTES) != hipSuccess) { fprintf(stderr, "kernel_launch: hipFuncSetAttribute failed\n"); grid = -1; return; }
        hipOccupancyMaxActiveBlocksPerMultiprocessor(&per_cu, (const void*)mega, 512, LDS_BYTES);
        if (per_cu < 1) { fprintf(stderr, "kernel_launch: occupancy query says %d blocks per CU\n", per_cu); per_cu = 1; }
        (void)hipGetLastError();
        grid = cus;
        if (grid != 256) fprintf(stderr, "kernel_launch: built for 256 CUs, got %d\n", grid);
    }
    if (grid < 0) return;
    if (hipMemsetAsync((char*)d_ws + OFF_BAR, 0, BAR_BYTES, stream) != hipSuccess) { fprintf(stderr, "kernel_launch: hipMemsetAsync failed\n"); return; }
    Args a{};
    for (int i = 0; i < 38; ++i) a.in[i] = (const float*)d_in[i];
    a.out = (float*)d_out; a.ws = (unsigned char*)d_ws;
#if MK_PER_PHASE
    for (int ph = 0; ph < NPHASE; ++ph) {
        a.ph_lo = ph; a.ph_hi = ph + 1;
        void* args[] = {&a};
        hipError_t e = hipLaunchCooperativeKernel((const void*)mega, dim3(grid), dim3(512), args, LDS_BYTES, stream);
        if (e != hipSuccess) { fprintf(stderr, "cooperative launch failed: %s\n", hipGetErrorString(e)); break; }
    }
#else
    a.ph_lo = 0; a.ph_hi = NPHASE;
    void* args[] = {&a};
    hipError_t e = hipLaunchCooperativeKernel((const void*)mega, dim3(grid), dim3(512), args, LDS_BYTES, stream);
    if (e != hipSuccess) fprintf(stderr, "cooperative launch failed: %s (grid %d)\n", hipGetErrorString(e), grid);
#endif
    (void)in_sizes; (void)out_size;
}
```

```cpp
#include <hip/hip_runtime.h>
#include <hip/hip_cooperative_groups.h>
#include <cstdio>
#include <cstdint>
namespace cg = cooperative_groups;

#ifndef PH_MASK
#define PH_MASK 0xFFFFF
#endif
#define PHON(k) (((PH_MASK) >> (k)) & 1)
#ifndef REP_MASK
#define REP_MASK 0
#endif
#ifndef MK_PER_PHASE
#define MK_PER_PHASE 0
#endif

#define LAS __attribute__((address_space(3)))
typedef unsigned short bf16_t;
typedef short bf16x8 __attribute__((ext_vector_type(8)));
typedef float f32x4 __attribute__((ext_vector_type(4)));
typedef unsigned u32x4 __attribute__((ext_vector_type(4)));
typedef unsigned u32x2 __attribute__((ext_vector_type(2)));
#define LDS_WAIT() asm volatile("s_waitcnt lgkmcnt(0)" ::: "memory")

constexpr int D = 1024, NB = 8, TT = 2048, MP = NB * TT, NS = 128, MTOK = MP + NS, MROWS = 16640;
constexpr int INC = 3328, LDP = 3584, FW = 2816, FW2 = 5632, NMEM = 256, MMEM = NB * NMEM;
constexpr float EPS = 1e-6f, GN_EPS = 64e-5f;
constexpr int NPHASE = 26;
constexpr int LDS_BYTES = 147456;

constexpr size_t O_YP = 0, O_YS = 16777216, O_SHP = 16908288, O_WKVP = 16924672, O_CONVP = 17448960, O_FFNP = 17465344,
                 O_MKP = 17645568, O_MVP = 21839872, O_SHS = 26034176, O_WKVS = 26296320, O_CONVS = 34684928, O_FFNS = 34947072;

constexpr size_t al256(size_t x) { return (x + 255) & ~(size_t)255; }
constexpr size_t OFF_SS = 0;
constexpr size_t OFF_SSM = al256(OFF_SS + (size_t)7 * MROWS * 4);
constexpr size_t OFF_WIN = al256(OFF_SSM + 2048 * 4);
constexpr size_t OFF_WOUT = OFF_WIN + (size_t)2 * LDP * D * 2;
constexpr size_t OFF_WQ = OFF_WOUT + (size_t)2 * D * D * 2;
constexpr size_t OFF_WK = OFF_WQ + (size_t)2 * D * D * 2;
constexpr size_t OFF_WV = OFF_WK + (size_t)2 * D * D * 2;
constexpr size_t OFF_WO = OFF_WV + (size_t)2 * D * D * 2;
constexpr size_t OFF_WUP = OFF_WO + (size_t)2 * D * D * 2;
constexpr size_t OFF_WDN = OFF_WUP + (size_t)2 * FW2 * D * 2;
constexpr size_t OFF_W2 = OFF_WDN + (size_t)2 * D * FW * 2;
constexpr size_t OFF_A2 = OFF_W2 + (size_t)2 * 512 * 64 * 2;
constexpr size_t OFF_G2 = OFF_A2 + (size_t)2 * 512 * 64 * 2;
constexpr size_t OFF_V1 = OFF_G2 + (size_t)2 * 512 * 128 * 2;
constexpr size_t OFF_V2 = OFF_V1 + (size_t)32 * 512 * 2;
constexpr size_t OFF_X = al256(OFF_V2 + (size_t)512 * 32 * 2);
constexpr size_t OFF_XB = OFF_X + (size_t)MROWS * D * 4;
constexpr size_t OFF_MNB = OFF_XB + (size_t)MROWS * D * 2;
constexpr size_t OFF_MK = OFF_MNB + (size_t)MMEM * D * 2;
constexpr size_t OFF_MVT = OFF_MK + (size_t)2 * MMEM * D * 2;
constexpr size_t OFF_PROJ = OFF_MVT + (size_t)2 * MMEM * D * 2;
constexpr size_t OFF_H = OFF_PROJ;
constexpr size_t SCN = (size_t)MTOK * 512 * 4;
constexpr size_t OFF_SA = OFF_PROJ + (size_t)MROWS * LDP * 2;
constexpr size_t OFF_SB = OFF_SA + SCN, OFF_SD = OFF_SB + SCN, OFF_SK = OFF_SD + SCN, OFF_SRD = OFF_SK + SCN, OFF_G = OFF_SRD + SCN;
constexpr size_t OFF_UP = OFF_SA;
constexpr size_t OFF_SV0 = OFF_G + SCN, OFF_SV1 = OFF_SV0 + SCN;
constexpr size_t OFF_SBR = OFF_SV1 + SCN;
constexpr size_t OFF_SKR = OFF_SBR + (size_t)MTOK * 8 * 4, OFF_RKR = OFF_SKR + (size_t)MTOK * 8 * 4;
constexpr size_t OFF_Y = al256(OFF_RKR + (size_t)MTOK * 8 * 4);
constexpr size_t OFF_YAB = OFF_Y + SCN;
constexpr size_t OFF_Q = OFF_YAB + (size_t)MROWS * D * 2;
constexpr size_t OFF_P = OFF_Q + (size_t)MROWS * D * 2;
constexpr size_t OFF_O = OFF_P + (size_t)MROWS * D * 2;
constexpr size_t OFF_BAR = OFF_O + (size_t)MROWS * D * 2;
constexpr size_t BAR_BYTES = 16384;
constexpr size_t WS_END = OFF_BAR + BAR_BYTES;
static_assert((size_t)MROWS * FW2 * 2 <= 6 * SCN, "UP overlay");
static_assert((size_t)MROWS * FW * 2 <= (size_t)MROWS * LDP * 2, "H overlay");
static_assert(WS_END < (size_t)1050000000, "workspace");

__device__ __forceinline__ unsigned f2bf(float f) { unsigned u = __builtin_bit_cast(unsigned, f); return (u + 0x7fffu + ((u >> 16) & 1u)) >> 16; }
__device__ __forceinline__ unsigned pk2(float lo, float hi) { return f2bf(lo) | (f2bf(hi) << 16); }
__device__ __forceinline__ unsigned cvt_pk_bf16(float lo, float hi) { unsigned r; asm volatile("v_cvt_pk_bf16_f32 %0, %1, %2" : "=v"(r) : "v"(lo), "v"(hi)); return r; }
__device__ __forceinline__ float bflo(unsigned w) { return __builtin_bit_cast(float, w << 16); }
__device__ __forceinline__ float bfhi(unsigned w) { return __builtin_bit_cast(float, w & 0xffff0000u); }
__device__ __forceinline__ float wave_sum(float v) {
#pragma unroll
    for (int o = 1; o < 64; o <<= 1) v += __shfl_xor(v, o);
    return v;
}
__device__ __forceinline__ float wave_max(float v) {
#pragma unroll
    for (int o = 1; o < 64; o <<= 1) v = fmaxf(v, __shfl_xor(v, o));
    return v;
}
__device__ __forceinline__ float sigmoidf_(float x) { return 1.f / (1.f + __expf(-x)); }
__device__ __forceinline__ void unpack8(u32x4 w, float* f) { f[0] = bflo(w.x); f[1] = bfhi(w.x); f[2] = bflo(w.y); f[3] = bfhi(w.y); f[4] = bflo(w.z); f[5] = bfhi(w.z); f[6] = bflo(w.w); f[7] = bfhi(w.w); }
__device__ __forceinline__ f32x4 ld_bf4(const bf16_t* p) { const u32x2 w = *(const u32x2*)p; return (f32x4){bflo(w.x), bfhi(w.x), bflo(w.y), bfhi(w.y)}; }
__device__ __forceinline__ void st_bf4(bf16_t* p, const f32x4 v) { u32x2 w; w.x = cvt_pk_bf16(v[0], v[1]); w.y = cvt_pk_bf16(v[2], v[3]); *(u32x2*)p = w; }
__device__ __forceinline__ float bf2f(bf16_t h) { return __builtin_bit_cast(float, (unsigned)h << 16); }
template <int CTRL> __device__ __forceinline__ float dppf(float v) { return __builtin_bit_cast(float, __builtin_amdgcn_update_dpp(0, __builtin_bit_cast(int, v), CTRL, 0xF, 0xF, true)); }
__device__ __forceinline__ float red16(float v) { v += dppf<0xB1>(v); v += dppf<0x4E>(v); v += dppf<0x124>(v); v += dppf<0x128>(v); return v; }

namespace pg8 {
constexpr int BM = 256, BK = 64, HALF = 128, HTB = HALF * BK * 2, STAGE_BYTES = 8 * HTB, NXCD = 8, WGM = 8;
__host__ __device__ __forceinline__ int lds_byte(int r, int c) { const int st = (r >> 4) * 2 + (c >> 5), rr = r & 15, cc = c & 31, ob = rr * 64 + cc * 2; return st * 1024 + (ob ^ (((ob >> 9) & 1) << 5)); }
__host__ __device__ __forceinline__ void stage_rc(int b, int& R, int& C) { const int st = b / 1024, sb = b % 1024, swz = sb ^ (((sb >> 9) & 1) << 5); R = (st >> 1) * 16 + swz / 64; C = (st & 1) * 32 + (swz % 64) / 2; }
__host__ __device__ __forceinline__ int perm32(int rho) { const int n = rho >> 4, i = rho & 15; return 8 * (i >> 2) + 4 * n + (i & 3); }

struct Unit { int pm, pn; size_t offA, offB; };
struct Gemm { const bf16_t* A; const bf16_t* Bt; int lda, ldb, K; };

struct GenOrder {
    int mode, nM, nN, nwg, G, c; size_t sA, sB;
    __device__ void init(int mode_, int M, int N, int lda, int ldb, int G_, int c_) { mode = mode_; nM = M / BM; nN = N / BM; nwg = nM * nN; G = G_; c = c_; sA = (size_t)BM * lda * 2; sB = (size_t)BM * ldb * 2; }
    __device__ bool next(int i, Unit& u) const {
        const long L = (long)i * G + c; if (L >= nwg) return false;
        if (mode == 0) {
            int wgid = (int)L; { const int q = nwg / NXCD, r = nwg % NXCD, xcd = wgid % NXCD, off = wgid / NXCD; wgid = (xcd < r ? xcd * (q + 1) : r * (q + 1) + (xcd - r) * q) + off; }
            const int nig = WGM * nN, gid = wgid / nig, fm = gid * WGM, gsz = (nM - fm) < WGM ? (nM - fm) : WGM;
            u.pm = fm + ((wgid % nig) % gsz); u.pn = (wgid % nig) / gsz; u.offA = (size_t)u.pm * sA; u.offB = (size_t)u.pn * sB;
        } else {
            const int b = (int)L >> 5, qb = ((int)L >> 2) & 7, h = (int)L & 3;
            u.pm = b * 8 + qb; u.pn = h;
            u.offA = ((size_t)(b * 2048 + qb * 256) * 1024 + h * 256) * 2;
            u.offB = mode == 1 ? ((size_t)(b * 256) * 1024 + h * 256) * 2 : ((size_t)(b * 4 + h) * 256 * 256) * 2;
        }
        return true;
    }
};

template <class Epi, class Sched, bool ALIGN_EPI>
__device__ __forceinline__ void gemm_phase(LAS unsigned char* lds, const Gemm g, const Sched& S, const Epi& E) {
    int tid = threadIdx.x; asm volatile("" : "+v"(tid));
    const int wid = __builtin_amdgcn_readfirstlane(tid >> 6), lane = tid & 63, wr = wid >> 2, wc = wid & 3, fr = lane & 15, fq = lane >> 4;
    const int K = g.K, nt = K / BK;
    unsigned voffA[2], voffB[2];
#pragma unroll
    for (int i = 0; i < 2; ++i) { int R, C; stage_rc(tid * 16 + i * 8192, R, C); const int Rb = Epi::PERM ? ((R & ~31) + perm32(R & 31)) : R;
        voffA[i] = (unsigned)(R * g.lda + C) * 2u; voffB[i] = (unsigned)(Rb * g.ldb + C) * 2u; }
    const size_t kstep = (size_t)(BK * 2);
    const size_t hstepA = (size_t)HALF * g.lda * 2, hstepB = (size_t)HALF * g.ldb * 2;
    const unsigned ldsw = (unsigned)wid * 1024u;
    const int aoff = lds_byte(wr * 64 + fr, fq * 8), boff = lds_byte(wc * 32 + fr, fq * 8);
#define PG8_SA(b, h) (((b) * 2 + (h)) * HTB)
#define PG8_SB(b, h) ((4 + (b) * 2 + (h)) * HTB)
#define PG8_STAGE(bufoff, gbase, voff) do { _Pragma("unroll") for (int _i = 0; _i < 2; ++_i) \
        __builtin_amdgcn_global_load_lds((const unsigned*)((const char*)(gbase) + (voff)[_i]), (LAS unsigned*)(lds + (bufoff) + ldsw + _i * 8192), 16, 0, 0); } while (0)
#define PG8_LDA(dst, b, h) do { _Pragma("unroll") for (int m = 0; m < 4; ++m) _Pragma("unroll") for (int k = 0; k < 2; ++k) dst[m][k] = *(const LAS bf16x8*)(lds + PG8_SA(b, h) + aoff + m * 2048 + k * 1024); } while (0)
#define PG8_LDB(dst, b, h) do { _Pragma("unroll") for (int n = 0; n < 2; ++n) _Pragma("unroll") for (int k = 0; k < 2; ++k) dst[n][k] = *(const LAS bf16x8*)(lds + PG8_SB(b, h) + boff + n * 2048 + k * 1024); } while (0)
#define PG8_MMA(ai, bj, At, Bt) do { __builtin_amdgcn_s_setprio(1); _Pragma("unroll") for (int m = 0; m < 4; ++m) _Pragma("unroll") for (int n = 0; n < 2; ++n) _Pragma("unroll") for (int k = 0; k < 2; ++k) \
        acc[ai][bj][m][n] = __builtin_amdgcn_mfma_f32_16x16x32_bf16(Bt[n][k], At[m][k], acc[ai][bj][m][n], 0, 0, 0); __builtin_amdgcn_s_setprio(0); } while (0)
#define PG8_WAIT_V(n) asm volatile("s_waitcnt vmcnt(" #n ")" ::: "memory")
#define PG8_WAIT_L(n) asm volatile("s_waitcnt lgkmcnt(" #n ")" ::: "memory")
#define PG8_BAR __builtin_amdgcn_s_barrier()
#define PG8_SCHED __builtin_amdgcn_sched_barrier(0)
    Unit cur, nxt; int ui = 0;
    if (!S.next(0, cur)) return;
    f32x4 acc[2][2][4][2];
#pragma unroll
    for (int a = 0; a < 2; ++a)
#pragma unroll
        for (int b = 0; b < 2; ++b)
#pragma unroll
            for (int m = 0; m < 4; ++m)
#pragma unroll
                for (int n = 0; n < 2; ++n) acc[a][b][m][n] = (f32x4){0.f, 0.f, 0.f, 0.f};
    bf16x8 At[4][2], B0[2][2], B1[2][2];
    const char* cA = (const char*)g.A + cur.offA; const char* cB = (const char*)g.Bt + cur.offB;
    PG8_STAGE(PG8_SB(0, 0), cB, voffB); PG8_STAGE(PG8_SB(0, 1), cB + hstepB, voffB); PG8_STAGE(PG8_SA(0, 0), cA, voffA); PG8_STAGE(PG8_SA(0, 1), cA + hstepA, voffA);
    if (wr == 1) PG8_BAR;
    PG8_WAIT_V(2); PG8_BAR;
    PG8_STAGE(PG8_SB(1, 0), cB + kstep, voffB); PG8_STAGE(PG8_SA(1, 0), cA + kstep, voffA); PG8_STAGE(PG8_SB(1, 1), cB + hstepB + kstep, voffB);
    PG8_WAIT_V(6); PG8_BAR;
    for (;;) {
        const bool has_next = S.next(ui + 1, nxt);
        const char* nA = has_next ? (const char*)g.A + nxt.offA : cA; const char* nB = has_next ? (const char*)g.Bt + nxt.offB : cB;
        for (int t = 0; t < nt; t += 2) {
            const bool last = (t == nt - 2);
            const char* a1 = cA + (size_t)(t + 1) * kstep;
            const char* a2 = last ? nA : cA + (size_t)(t + 2) * kstep; const char* b2 = last ? nB : cB + (size_t)(t + 2) * kstep;
            const char* a3 = a2 + kstep; const char* b3 = b2 + kstep;
            PG8_LDB(B0, 0, 0); PG8_LDB(B1, 0, 1); PG8_SCHED; PG8_LDA(At, 0, 0); PG8_STAGE(PG8_SA(1, 1), a1 + hstepA, voffA);
            PG8_WAIT_V(8); PG8_WAIT_L(0); PG8_BAR; PG8_MMA(0, 0, At, B0); PG8_MMA(0, 1, At, B1); PG8_BAR; PG8_SCHED;
            PG8_LDA(At, 0, 1); PG8_STAGE(PG8_SB(0, 0), b2, voffB); PG8_STAGE(PG8_SB(0, 1), b2 + hstepB, voffB); PG8_STAGE(PG8_SA(0, 0), a2, voffA);
            PG8_WAIT_V(8); PG8_WAIT_L(0); PG8_BAR; PG8_MMA(1, 0, At, B0); PG8_MMA(1, 1, At, B1); PG8_BAR; PG8_SCHED;
            PG8_LDB(B0, 1, 0); PG8_LDB(B1, 1, 1); PG8_SCHED; PG8_LDA(At, 1, 0); PG8_STAGE(PG8_SA(0, 1), a2 + hstepA, voffA);
            PG8_WAIT_V(8); PG8_WAIT_L(0); PG8_BAR; PG8_MMA(0, 0, At, B0); PG8_MMA(0, 1, At, B1); PG8_BAR; PG8_SCHED;
            PG8_LDA(At, 1, 1); PG8_STAGE(PG8_SB(1, 0), b3, voffB); PG8_STAGE(PG8_SB(1, 1), b3 + hstepB, voffB); PG8_STAGE(PG8_SA(1, 0), a3, voffA);
            PG8_WAIT_V(8); PG8_WAIT_L(0); PG8_BAR; PG8_MMA(1, 0, At, B0); PG8_MMA(1, 1, At, B1); PG8_BAR; PG8_SCHED;
        }
        if constexpr (ALIGN_EPI) { if (wr == 0) PG8_BAR; }
        if constexpr (!Epi::AFTER_DRAIN) { E(acc, cur, wr, wc, fr, fq); }
        if (!has_next) break;
#pragma unroll
        for (int a = 0; a < 2; ++a)
#pragma unroll
            for (int b = 0; b < 2; ++b)
#pragma unroll
                for (int m = 0; m < 4; ++m)
#pragma unroll
                    for (int n = 0; n < 2; ++n) acc[a][b][m][n] = (f32x4){0.f, 0.f, 0.f, 0.f};
        cur = nxt; cA = nA; cB = nB; ++ui;
        if constexpr (ALIGN_EPI) { if (wr == 1) PG8_BAR; }
    }
    PG8_WAIT_V(0);
    if constexpr (!ALIGN_EPI) { if (wr == 0) PG8_BAR; }
    PG8_BAR;
    if constexpr (Epi::AFTER_DRAIN) { E.fused(acc, cur, wr, wc, fr, fq, lds, wid, lane); }
#undef PG8_SA
#undef PG8_SB
#undef PG8_STAGE
#undef PG8_LDA
#undef PG8_LDB
#undef PG8_MMA
#undef PG8_WAIT_V
#undef PG8_WAIT_L
#undef PG8_BAR
#undef PG8_SCHED
}

struct Epi {
    static constexpr bool PERM = true, AFTER_DRAIN = false;
    int mode;
    bf16_t* O; int ldc;
    const float* ss;
    float* X;
    float* ssn;
    float* F;
    int l; int dry;
    __device__ __forceinline__ void operator()(const f32x4 (&acc)[2][2][4][2], const Unit& u, int wr, int wc, int fr, int fq) const {
        const int row0 = u.pm * 256 + wr * 64 + fr, col0 = u.pn * 256 + wc * 32 + 8 * fq;
        if (dry) return;
        if (mode == 1) {
#pragma unroll
            for (int ai = 0; ai < 2; ++ai)
#pragma unroll
                for (int m = 0; m < 4; ++m) {
                    const int row = row0 + ai * 128 + m * 16; const bool valid = row < MTOK; float sq = 0.f;
#pragma unroll
                    for (int bj = 0; bj < 2; ++bj) {
                        const size_t idx = (size_t)row * 1024 + col0 + bj * 128;
                        if (valid) {
                            float xf[8]; unpack8(*(const u32x4*)(O + idx), xf);
                            const f32x4 x0 = (f32x4){xf[0], xf[1], xf[2], xf[3]} + acc[ai][bj][m][0], x1 = (f32x4){xf[4], xf[5], xf[6], xf[7]} + acc[ai][bj][m][1];
                            sq += (x0[0] * x0[0] + x0[1] * x0[1]) + (x0[2] * x0[2] + x0[3] * x0[3]) + (x1[0] * x1[0] + x1[1] * x1[1]) + (x1[2] * x1[2] + x1[3] * x1[3]);
                            u32x4 w; w.x = cvt_pk_bf16(x0[0], x0[1]); w.y = cvt_pk_bf16(x0[2], x0[3]); w.z = cvt_pk_bf16(x1[0], x1[1]); w.w = cvt_pk_bf16(x1[2], x1[3]);
                            *(u32x4*)(O + idx) = w;
                        }
                    }
                    sq += __shfl_xor(sq, 16); sq += __shfl_xor(sq, 32);
                    if (valid && fq == 0) atomicAdd(ssn + row, sq);
                }
        } else {
#pragma unroll
            for (int ai = 0; ai < 2; ++ai)
#pragma unroll
                for (int m = 0; m < 4; ++m) {
                    const int row = row0 + ai * 128 + m * 16;
                    float rs = 1.f;
                    if (ss != nullptr && (mode == 2 || mode == 3 || row < MTOK)) rs = rsqrtf(ss[row] * (1.f / 1024.f) + EPS);
#pragma unroll
                    for (int bj = 0; bj < 2; ++bj) {
                        const int col = col0 + bj * 128;
                        const f32x4 v0 = acc[ai][bj][m][0] * rs, v1 = acc[ai][bj][m][1] * rs;
                        u32x4 w; w.x = cvt_pk_bf16(v0[0], v0[1]); w.y = cvt_pk_bf16(v0[2], v0[3]); w.z = cvt_pk_bf16(v1[0], v1[1]); w.w = cvt_pk_bf16(v1[2], v1[3]);
                        if (mode == 3) {
                            const int b = row >> 8, mem = row & 255;
                            bf16_t* o = O + ((size_t)(b * 1024 + col)) * 256 + mem;
                            o[0] = (bf16_t)(w.x & 0xffff); o[256] = (bf16_t)(w.x >> 16); o[512] = (bf16_t)(w.y & 0xffff); o[768] = (bf16_t)(w.y >> 16);
                            o[1024] = (bf16_t)(w.z & 0xffff); o[1280] = (bf16_t)(w.z >> 16); o[1536] = (bf16_t)(w.w & 0xffff); o[1792] = (bf16_t)(w.w >> 16);
                        } else {
                            *(u32x4*)(O + (size_t)row * ldc + col) = w;
                        }
                        if (mode == 2 || mode == 3) { float* f = F + (size_t)row * 1024 + col; *(f32x4*)f = v0; *(f32x4*)(f + 4) = v1; }
                        if (mode == 4) {
                            float* f = nullptr;
                            if (row < MP) { const int t = row & 2047; if (t >= 2046) f = F + O_FFNP + ((size_t)((l * 8 + (row >> 11)) * 2 + (t - 2046))) * FW2 + col; }
                            else if (row < MTOK) f = F + O_FFNS + ((size_t)((l * 128 + (row - MP)) * 2 + 1)) * FW2 + col;
                            if (f) { *(f32x4*)f = v0; *(f32x4*)(f + 4) = v1; }
                        }
                    }
                }
        }
    }
};

struct EpiSm {
    static constexpr bool PERM = true, AFTER_DRAIN = true;
    bf16_t* P;
    __device__ __forceinline__ void operator()(const f32x4 (&)[2][2][4][2], const Unit&, int, int, int, int) const {}
    __device__ __forceinline__ void fused(f32x4 (&acc)[2][2][4][2], const Unit& u, int wr, int wc, int fr, int fq, LAS unsigned char* lds, int wid, int lane) const {
        LAS float* red = (LAS float*)lds; LAS float* red2 = red + 1024;
        float mx[2][4];
#pragma unroll
        for (int ai = 0; ai < 2; ++ai)
#pragma unroll
            for (int m = 0; m < 4; ++m) {
                float v = -3.0e38f;
#pragma unroll
                for (int bj = 0; bj < 2; ++bj)
#pragma unroll
                    for (int n = 0; n < 2; ++n) { const f32x4 x = acc[ai][bj][m][n]; v = fmaxf(v, fmaxf(fmaxf(x[0], x[1]), fmaxf(x[2], x[3]))); }
                v = fmaxf(v, __shfl_xor(v, 16)); v = fmaxf(v, __shfl_xor(v, 32));
                if (fq == 0) red[(ai * 128 + wr * 64 + m * 16 + fr) * 4 + wc] = v;
            }
        __syncthreads();
#pragma unroll
        for (int ai = 0; ai < 2; ++ai)
#pragma unroll
            for (int m = 0; m < 4; ++m) {
                const f32x4 r = *(const LAS f32x4*)(red + (ai * 128 + wr * 64 + m * 16 + fr) * 4);
                const float M = fmaxf(fmaxf(r[0], r[1]), fmaxf(r[2], r[3])); mx[ai][m] = M;
                float s = 0.f;
#pragma unroll
                for (int bj = 0; bj < 2; ++bj)
#pragma unroll
                    for (int n = 0; n < 2; ++n) { f32x4 x = acc[ai][bj][m][n];
                        x[0] = __expf(x[0] - M); x[1] = __expf(x[1] - M); x[2] = __expf(x[2] - M); x[3] = __expf(x[3] - M); acc[ai][bj][m][n] = x; s += (x[0] + x[1]) + (x[2] + x[3]); }
                s += __shfl_xor(s, 16); s += __shfl_xor(s, 32);
                if (fq == 0) red2[(ai * 128 + wr * 64 + m * 16 + fr) * 4 + wc] = s;
            }
        __syncthreads();
#pragma unroll
        for (int ai = 0; ai < 2; ++ai)
#pragma unroll
            for (int m = 0; m < 4; ++m) {
                const int rl = ai * 128 + wr * 64 + m * 16 + fr;
                const f32x4 r = *(const LAS f32x4*)(red2 + rl * 4);
                const float inv = 1.f / ((r[0] + r[1]) + (r[2] + r[3]));
#pragma unroll
                for (int bj = 0; bj < 2; ++bj) {
                    const f32x4 v0 = acc[ai][bj][m][0] * inv, v1 = acc[ai][bj][m][1] * inv;
                    u32x4 w; w.x = cvt_pk_bf16(v0[0], v0[1]); w.y = cvt_pk_bf16(v0[2], v0[3]); w.z = cvt_pk_bf16(v1[0], v1[1]); w.w = cvt_pk_bf16(v1[2], v1[3]);
                    *(u32x4*)(P + (size_t)(u.pm * 256 + rl) * 1024 + u.pn * 256 + bj * 128 + wc * 32 + 8 * fq) = w;
                }
            }
        (void)mx; (void)wid; (void)lane;
    }
};
}

struct Args { const float* in[38]; float* out; unsigned char* ws; int ph_lo, ph_hi; };
enum { I_XP = 0, I_XS, I_MEM, I_SSHIFT, I_SWKV, I_SCONV, I_SFFN, I_CK, I_CV, I_NMIX, I_WIN, I_MU, I_W0, I_W2, I_A0, I_A2, I_G2, I_V0, I_V1, I_V2,
       I_KK, I_KA, I_RK, I_LNW, I_LNB, I_CONVW, I_WOUT, I_NX, I_NMEM, I_WQ, I_WK, I_WV, I_WO, I_NFFN, I_WUP, I_FCW, I_WDN, I_NFIN };

__device__ __forceinline__ void tr_item(const float* W, int K, int N, bf16_t* WT, const float* gain, float scale, LAS float* scr, int item, int lane) {
    const int nblk = N / 32, kb = item / nblk, nb = item % nblk, k0 = 64 * kb, n0 = 32 * nb;
#pragma unroll
    for (int i = 0; i < 8; ++i) { const int kk = 8 * i + (lane >> 3); const float gk = gain ? gain[k0 + kk] * scale : scale;
        const f32x4 v = __builtin_nontemporal_load((const f32x4*)(W + (size_t)(k0 + kk) * N + n0 + (lane & 7) * 4)) * gk;
        LAS float* d = scr + kk * 33 + (lane & 7) * 4; d[0] = v[0]; d[1] = v[1]; d[2] = v[2]; d[3] = v[3]; }
    LDS_WAIT();
    const int c = lane & 7;
#pragma unroll
    for (int j = 0; j < 4; ++j) { const int n = (lane >> 3) + 8 * j; const LAS float* s = scr + (8 * c) * 33 + n;
        u32x4 o; o.x = pk2(s[0 * 33], s[1 * 33]); o.y = pk2(s[2 * 33], s[3 * 33]); o.z = pk2(s[4 * 33], s[5 * 33]); o.w = pk2(s[6 * 33], s[7 * 33]);
        *(u32x4*)(WT + (size_t)(n0 + n) * K + k0 + 8 * c) = o; }
    LDS_WAIT();
}

constexpr int TR_NL = 8512;
__device__ __forceinline__ void tr_dispatch(const Args& a, unsigned char* ws, int l, int r, LAS float* scr, int lane) {
    constexpr int I_IN_ = 16 * 104, I_SQ_ = 16 * 32, I_UP_ = 16 * 176, I_DN_ = 44 * 32, I_L64 = 16;
    if (r < I_IN_) { tr_item(a.in[I_WIN] + (size_t)l * D * INC, D, INC, (bf16_t*)(ws + OFF_WIN) + (size_t)l * LDP * D, a.in[I_NMIX] + l * D, 1.f, scr, r, lane); return; } r -= I_IN_;
    if (r < I_SQ_) { tr_item(a.in[I_WOUT] + (size_t)l * D * D, D, D, (bf16_t*)(ws + OFF_WOUT) + (size_t)l * D * D, nullptr, 1.f, scr, r, lane); return; } r -= I_SQ_;
    if (r < I_SQ_) { tr_item(a.in[I_WQ] + (size_t)l * D * D, D, D, (bf16_t*)(ws + OFF_WQ) + (size_t)l * D * D, a.in[I_NX] + l * D, 0.0625f, scr, r, lane); return; } r -= I_SQ_;
    if (r < I_SQ_) { tr_item(a.in[I_WK] + (size_t)l * D * D, D, D, (bf16_t*)(ws + OFF_WK) + (size_t)l * D * D, a.in[I_NMEM] + l * D, 1.f, scr, r, lane); return; } r -= I_SQ_;
    if (r < I_SQ_) { tr_item(a.in[I_WV] + (size_t)l * D * D, D, D, (bf16_t*)(ws + OFF_WV) + (size_t)l * D * D, a.in[I_NMEM] + l * D, 1.f, scr, r, lane); return; } r -= I_SQ_;
    if (r < I_SQ_) { tr_item(a.in[I_WO] + (size_t)l * D * D, D, D, (bf16_t*)(ws + OFF_WO) + (size_t)l * D * D, nullptr, 1.f, scr, r, lane); return; } r -= I_SQ_;
    if (r < I_UP_) { tr_item(a.in[I_WUP] + (size_t)l * D * FW2, D, FW2, (bf16_t*)(ws + OFF_WUP) + (size_t)l * FW2 * D, a.in[I_NFFN] + l * D, 1.f, scr, r, lane); return; } r -= I_UP_;
    if (r < I_DN_) { tr_item(a.in[I_WDN] + (size_t)l * FW * D, FW, D, (bf16_t*)(ws + OFF_WDN) + (size_t)l * D * FW, nullptr, 1.f, scr, r, lane); return; } r -= I_DN_;
    if (r < I_L64) { tr_item(a.in[I_W2] + (size_t)l * 64 * 512, 64, 512, (bf16_t*)(ws + OFF_W2) + (size_t)l * 512 * 64, nullptr, 1.f, scr, r, lane); return; } r -= I_L64;
    if (r < I_L64) { tr_item(a.in[I_A2] + (size_t)l * 64 * 512, 64, 512, (bf16_t*)(ws + OFF_A2) + (size_t)l * 512 * 64, nullptr, 1.f, scr, r, lane); return; } r -= I_L64;
    tr_item(a.in[I_G2] + (size_t)l * 128 * 512, 128, 512, (bf16_t*)(ws + OFF_G2) + (size_t)l * 512 * 128, nullptr, 1.f, scr, r, lane);
}
constexpr int TR_DEFERRED = TR_NL + 5760;
__device__ __forceinline__ void tr_deferred(const Args& a, unsigned char* ws, int d, LAS float* scr, int lane) {
    if (d < TR_NL) { tr_dispatch(a, ws, 1, d, scr, lane); return; }
    const int e = d - TR_NL;
    const int r = e < 1024 ? 1664 + e : (e < 1536 ? 3712 + (e - 1024) : 4224 + (e - 1536));
    tr_dispatch(a, ws, 0, r, scr, lane);
}

__device__ __forceinline__ void p0_prologue(LAS unsigned char* lds, const Args& a, int tid, int lane, int wave, int gw, int NGW) {
    unsigned char* ws = a.ws;
    LAS float* scr = (LAS float*)(lds + wave * 16384);
    for (int it = gw; it < 1664 + 1024 + 64; it += NGW) {
        const int r = it < 1664 ? it : (it < 2688 ? 2688 + (it - 1664) : 8448 + (it - 2688));
        tr_dispatch(a, ws, 0, r, scr, lane);
    }
    float* X = (float*)(ws + OFF_X); bf16_t* XB = (bf16_t*)(ws + OFF_XB); float* SS = (float*)(ws + OFF_SS);
    bf16_t* MNB = (bf16_t*)(ws + OFF_MNB); float* SSM = (float*)(ws + OFF_SSM);
    for (int m = gw; m < MROWS + MMEM; m += NGW) {
        const float* src; bf16_t* dstb; float* dstx = nullptr; float* dss = nullptr; bool shiftrow = false;
        if (m < MP) { src = a.in[I_XP] + (size_t)m * D; dstb = XB + (size_t)m * D; dstx = X + (size_t)m * D; dss = SS + m; }
        else if (m < MTOK) { src = a.in[I_XS] + (size_t)(m - MP) * D; dstb = XB + (size_t)m * D; dstx = X + (size_t)m * D; dss = SS + m; }
        else if (m < MROWS) { src = a.in[I_SSHIFT] + (size_t)(m - MTOK) * D; dstb = XB + (size_t)m * D; shiftrow = true; }
        else { src = a.in[I_MEM] + (size_t)(m - MROWS) * D; dstb = MNB + (size_t)(m - MROWS) * D; dss = SSM + (m - MROWS); }
        float s = 0.f;
#pragma unroll
        for (int j = 0; j < 4; ++j) {
            f32x4 v = *(const f32x4*)(src + 4 * lane + 256 * j);
            if (shiftrow) { const f32x4 gn = *(const f32x4*)(a.in[I_NMIX] + 4 * lane + 256 * j); v[0] /= gn[0]; v[1] /= gn[1]; v[2] /= gn[2]; v[3] /= gn[3]; }
            s += (v[0] * v[0] + v[1] * v[1]) + (v[2] * v[2] + v[3] * v[3]);
            u32x2 w; w.x = pk2(v[0], v[1]); w.y = pk2(v[2], v[3]);
            *(u32x2*)(dstb + 4 * lane + 256 * j) = w;
        }
        s = wave_sum(s);
        if (dss && lane == 0) *dss = s;
    }
    if (blockIdx.x * 8 < D) {
        __syncthreads();
        LAS float* M = (LAS float*)lds;
        const float* muv = a.in[I_MU] + 1792 + 1024; const float* v1 = a.in[I_V1];
#pragma unroll 8
        for (int i = tid; i < 512 * 64; i += 512) { const int c = i >> 6, o = i & 63; const float mv = muv[c]; M[i] = ((o >> 5) ? mv : 1.f - mv) * v1[c * 32 + (o & 31)]; }
        __syncthreads();
        for (int k = gw; k < D; k += NGW) {
            const float* wrow = a.in[I_WIN] + (size_t)1 * D * INC + (size_t)k * INC + 1024;
            float acc = 0.f;
#pragma unroll 4
            for (int c = 0; c < 512; c += 4) {
                const f32x4 w4 = *(const f32x4*)(wrow + c);
                acc += w4[0] * M[c * 64 + lane] + w4[1] * M[(c + 1) * 64 + lane] + w4[2] * M[(c + 2) * 64 + lane] + w4[3] * M[(c + 3) * 64 + lane];
            }
            ((bf16_t*)(ws + OFF_WIN))[(size_t)1 * LDP * D + (size_t)(INC + lane) * D + k] = (bf16_t)f2bf(acc * a.in[I_NMIX][D + k]);
        }
    }
    const int gt = blockIdx.x * 512 + tid, NGT = gridDim.x * 512;
    for (int i = gt; i < 6 * MROWS; i += NGT) SS[MROWS + i] = 0.f;
    bf16_t* V2T = (bf16_t*)(ws + OFF_V2);
    for (int i = gt; i < 512 * 32; i += NGT) { const int n = i >> 5, k = i & 31; V2T[i] = (bf16_t)f2bf(a.in[I_V2][k * 512 + n]); }
}

__device__ __forceinline__ const bf16_t* prev_row(const bf16_t* PROJ, int m) {
    if (m < MP) { if ((m & 2047) == 0) return nullptr; return PROJ + (size_t)(m - 1) * LDP; }
    return PROJ + (size_t)(m + NS) * LDP;
}
__device__ __forceinline__ void mix4(const bf16_t* cur, const bf16_t* prv, const float* mu, int col, float* z) {
    const u32x2 c = *(const u32x2*)(cur + col); const f32x4 m4 = *(const f32x4*)(mu + col);
    float cf[4] = {bflo(c.x), bfhi(c.x), bflo(c.y), bfhi(c.y)}; float pf[4] = {0.f, 0.f, 0.f, 0.f};
    if (prv) { const u32x2 p = *(const u32x2*)(prv + col); pf[0] = bflo(p.x); pf[1] = bfhi(p.x); pf[2] = bflo(p.y); pf[3] = bfhi(p.y); }
#pragma unroll
    for (int j = 0; j < 4; ++j) z[j] = cf[j] + (pf[j] - cf[j]) * m4[j];
}
__device__ __forceinline__ void mix8(const bf16_t* cur, const bf16_t* prv, const float* mu, int col, float* z) {
    const u32x4 c = *(const u32x4*)(cur + col); float cf[8], pf[8]; unpack8(c, cf);
#pragma unroll
    for (int j = 0; j < 8; ++j) pf[j] = 0.f;
    if (prv) { const u32x4 p = *(const u32x4*)(prv + col); unpack8(p, pf); }
    const f32x4 m0 = *(const f32x4*)(mu + col), m1 = *(const f32x4*)(mu + col + 4);
#pragma unroll
    for (int j = 0; j < 4; ++j) { z[j] = cf[j] + (pf[j] - cf[j]) * m0[j]; z[4 + j] = cf[4 + j] + (pf[4 + j] - cf[4 + j]) * m1[j]; }
}

__device__ __forceinline__ float fsig(float x) { return __builtin_amdgcn_rcpf(1.f + __expf(-x)); }
__device__ __forceinline__ void mixw(u32x2 c, u32x2 p, const LAS float* mu, float* z) {
    const f32x4 m4 = *(const LAS f32x4*)mu;
    const float cf[4] = {bflo(c.x), bfhi(c.x), bflo(c.y), bfhi(c.y)}, pf[4] = {bflo(p.x), bfhi(p.x), bflo(p.y), bfhi(p.y)};
#pragma unroll
    for (int j = 0; j < 4; ++j) z[j] = cf[j] + (pf[j] - cf[j]) * m4[j];
}
__device__ __forceinline__ void prep_phase(LAS unsigned char* lds, const Args& a, int l, int tid, int lane, int wave, int gw) {
    unsigned char* ws = a.ws;
    const bf16_t* PROJ = (const bf16_t*)(ws + OFF_PROJ);
    const float* mu = a.in[I_MU] + l * 1792;
    if (gw < NB + NS) {
        const int row = gw < NB ? gw * 2048 + 2047 : MP + (gw - NB);
        float* dst = gw < NB ? a.out + O_SHP + (size_t)(l * NB + gw) * D : a.out + O_SHS + (size_t)(l * NS + (gw - NB)) * D;
        const bf16_t* Xr = (const bf16_t*)(ws + OFF_XB) + (size_t)row * D;
        const float rs = rsqrtf(((const float*)(ws + OFF_SS))[3 * l * MROWS + row] * (1.f / 1024.f) + EPS);
#pragma unroll
        for (int j = 0; j < 4; ++j) { const u32x2 xw = *(const u32x2*)(Xr + 4 * lane + 256 * j); const f32x4 v = (f32x4){bflo(xw.x), bfhi(xw.x), bflo(xw.y), bfhi(xw.y)}, gn = *(const f32x4*)(a.in[I_NMIX] + l * D + 4 * lane + 256 * j);
            *(f32x4*)(dst + 4 * lane + 256 * j) = v * rs * gn; }
    }
    LAS bf16_t* WL2 = (LAS bf16_t*)lds;
    LAS bf16_t* WLA = (LAS bf16_t*)(lds + 18432);
    LAS bf16_t* WLG = (LAS bf16_t*)(lds + 36864);
    LAS bf16_t* WLV = (LAS bf16_t*)(lds + 71680);
    LAS float* PAR = (LAS float*)(lds + 81920);
    LAS bf16_t* LA = (LAS bf16_t*)(lds + 88064);
    LAS bf16_t* LW = (LAS bf16_t*)(lds + 121856);
    const int hp = blockIdx.x & 3;
    {
        const bf16_t* W2T = (const bf16_t*)(ws + OFF_W2) + (size_t)l * 512 * 64 + (size_t)hp * 128 * 64;
        const bf16_t* A2T = (const bf16_t*)(ws + OFF_A2) + (size_t)l * 512 * 64 + (size_t)hp * 128 * 64;
        const bf16_t* G2T = (const bf16_t*)(ws + OFF_G2) + (size_t)l * 512 * 128 + (size_t)hp * 128 * 128;
        const bf16_t* V2T = (const bf16_t*)(ws + OFF_V2) + (size_t)hp * 128 * 32;
#pragma unroll
        for (int q = 0; q < 2; ++q) { const int i = tid + 512 * q, n = i >> 3, c = (i & 7) * 8;
            *(LAS u32x4*)(WL2 + n * 72 + c) = *(const u32x4*)(W2T + n * 64 + c); *(LAS u32x4*)(WLA + n * 72 + c) = *(const u32x4*)(A2T + n * 64 + c); }
#pragma unroll
        for (int q = 0; q < 4; ++q) { const int i = tid + 512 * q, n = i >> 4, c = (i & 15) * 8; *(LAS u32x4*)(WLG + n * 136 + c) = *(const u32x4*)(G2T + n * 128 + c); }
        { const int n = tid >> 2, c = (tid & 3) * 8; *(LAS u32x4*)(WLV + n * 40 + c) = *(const u32x4*)(V2T + n * 32 + c); }
        if (tid < 128) {
            const int ch = hp * 128 + tid;
            PAR[tid] = a.in[I_W0][l * 512 + ch]; PAR[128 + tid] = a.in[I_A0][l * 512 + ch]; PAR[256 + tid] = a.in[I_KK][l * 512 + ch]; PAR[384 + tid] = a.in[I_KA][l * 512 + ch];
            PAR[512 + tid] = a.in[I_RK][l * 512 + ch]; PAR[640 + tid] = l == 1 ? a.in[I_V0][ch] : 0.f; PAR[768 + tid] = mu[ch]; PAR[896 + tid] = mu[512 + ch]; PAR[1024 + tid] = mu[1024 + ch];
        }
    }
    float* SA = (float*)(ws + OFF_SA); float* SB = (float*)(ws + OFF_SB); float* SD = (float*)(ws + OFF_SD); float* SK = (float*)(ws + OFF_SK);
    float* SRD = (float*)(ws + OFF_SRD); float* GG = (float*)(ws + OFF_G); float* SV = (float*)(ws + (l == 0 ? OFF_SV0 : OFF_SV1));
    const float* SV0 = (const float*)(ws + OFF_SV0);
    float* SBR = (float*)(ws + OFF_SBR); float* SKR = (float*)(ws + OFF_SKR); float* RKR = (float*)(ws + OFF_RKR);
    const int mt = wave & 3, hh = wave >> 2, h = hp * 2 + hh, fr = lane & 15, fq = lane >> 4;
    const int grp = blockIdx.x >> 2;
    const int nit = 4 + (blockIdx.x < 32 ? 1 : 0);
    for (int it = 0; it < nit; ++it) {
        const bool tailit = it >= 4;
        const int m0 = tailit ? MP + grp * 16 : (grp + 64 * it) * 64;
        const int nq = tailit ? 1 : 4;
        {
            u32x4 cu[4], pv[4];
#pragma unroll
            for (int q = 0; q < 4; ++q) {
                cu[q] = (u32x4){0u, 0u, 0u, 0u}; pv[q] = cu[q];
                if (q < nq) {
                    const int row = (tid >> 5) + 16 * q, ch = tid & 31, m = m0 + row;
                    const bf16_t* prv = prev_row(PROJ, m);
                    cu[q] = *(const u32x4*)(PROJ + (size_t)m * LDP + 1536 + ch * 8);
                    if (prv) pv[q] = *(const u32x4*)(prv + 1536 + ch * 8);
                }
            }
            u32x2 vc = (u32x2){0u, 0u}, vp = vc;
            if (l == 1 && (tid >> 3) < 16 * nq) {
                const int m = m0 + (tid >> 3), j4 = (tid & 7) * 4; const bf16_t* prv = prev_row(PROJ, m);
                vc = *(const u32x2*)(PROJ + (size_t)m * LDP + INC + j4); if (prv) vp = *(const u32x2*)(prv + INC + 32 + j4);
            }
            const int ch = tid & 31;
            const f32x4 m0v = *(const f32x4*)(mu + 1536 + ch * 8), m1v = *(const f32x4*)(mu + 1536 + ch * 8 + 4);
#pragma unroll
            for (int q = 0; q < 4; ++q) {
                if (q >= nq) continue;
                const int row = (tid >> 5) + 16 * q;
                float cf[8], pf[8], z[8]; unpack8(cu[q], cf); unpack8(pv[q], pf);
#pragma unroll
                for (int j = 0; j < 4; ++j) { z[j] = cf[j] + (pf[j] - cf[j]) * m0v[j]; z[4 + j] = cf[4 + j] + (pf[4 + j] - cf[4 + j]) * m1v[j]; }
                if (ch < 8) {
#pragma unroll
                    for (int j = 0; j < 8; ++j) z[j] = 2.f * fsig(2.f * z[j]) - 1.f;
                } else if (ch >= 16) {
#pragma unroll
                    for (int j = 0; j < 8; ++j) z[j] = fsig(z[j]);
                }
                u32x4 w; w.x = pk2(z[0], z[1]); w.y = pk2(z[2], z[3]); w.z = pk2(z[4], z[5]); w.w = pk2(z[6], z[7]);
                *(LAS u32x4*)(LA + row * 264 + ch * 8) = w;
            }
            if (l == 1 && (tid >> 3) < 16 * nq) {
                u32x2 w; w.x = pk2(bflo(vc.x) + bflo(vp.x), bfhi(vc.x) + bfhi(vp.x)); w.y = pk2(bflo(vc.y) + bflo(vp.y), bfhi(vc.y) + bfhi(vp.y));
                *(LAS u32x2*)(LW + (tid >> 3) * 40 + (tid & 7) * 4) = w;
            }
        }
        __syncthreads();
        if (mt < nq) {
        const int m = m0 + mt * 16 + fr;
        const bf16_t* cur = PROJ + (size_t)m * LDP; const bf16_t* prv = prev_row(PROJ, m);
        u32x2 cR[4], cK[4], cV[4], pR[4], pK[4], pV[4]; f32x4 vf[4];
#pragma unroll
        for (int nt = 0; nt < 4; ++nt) {
            const int ch = h * 64 + nt * 16 + fq * 4;
            cR[nt] = *(const u32x2*)(cur + ch); cK[nt] = *(const u32x2*)(cur + 512 + ch); cV[nt] = *(const u32x2*)(cur + 1024 + ch);
            pR[nt] = (u32x2){0u, 0u}; pK[nt] = pR[nt]; pV[nt] = pR[nt];
            if (prv) { pR[nt] = *(const u32x2*)(prv + ch); pK[nt] = *(const u32x2*)(prv + 512 + ch); pV[nt] = *(const u32x2*)(prv + 1024 + ch); }
            vf[nt] = (f32x4){0.f, 0.f, 0.f, 0.f};
            if (l == 1) vf[nt] = ld_bf4((const bf16_t*)SV0 + (size_t)m * 512 + ch);
        }
        float ssq = 0.f;
#pragma unroll
        for (int nt = 0; nt < 4; ++nt) {
            const int cl = hh * 64 + nt * 16 + fq * 4; float kz[4]; mixw(cK[nt], pK[nt], PAR + 896 + cl, kz);
            const f32x4 kk4 = *(const LAS f32x4*)(PAR + 256 + cl);
#pragma unroll
            for (int j = 0; j < 4; ++j) { const float kk = kz[j] * kk4[j]; ssq += kk * kk; }
        }
        ssq += __shfl_xor(ssq, 16); ssq += __shfl_xor(ssq, 32);
        const float inv = 1.f / fmaxf(sqrtf(ssq), 1e-12f);
        float br = 0.f, kr = 0.f, rkr = 0.f;
#pragma unroll
        for (int nt = 0; nt < 4; ++nt) {
            const int cl = hh * 64 + nt * 16 + fq * 4, ch = h * 64 + nt * 16 + fq * 4, nl = hh * 64 + nt * 16 + fr;
            f32x4 dl = (f32x4){0.f, 0.f, 0.f, 0.f}, al = dl, gl = dl, vm = dl;
            bf16x8 af[8];
#pragma unroll
            for (int ks = 0; ks < 8; ++ks) af[ks] = *(const LAS bf16x8*)(LA + (mt * 16 + fr) * 264 + ks * 32 + fq * 8);
            const bf16x8 avv = *(const LAS bf16x8*)(LW + (mt * 16 + fr) * 40 + fq * 8);
#pragma unroll
            for (int ks = 0; ks < 2; ++ks) {
                dl = __builtin_amdgcn_mfma_f32_16x16x32_bf16(*(const LAS bf16x8*)(WL2 + nl * 72 + ks * 32 + fq * 8), af[ks], dl, 0, 0, 0);
                al = __builtin_amdgcn_mfma_f32_16x16x32_bf16(*(const LAS bf16x8*)(WLA + nl * 72 + ks * 32 + fq * 8), af[2 + ks], al, 0, 0, 0);
            }
#pragma unroll
            for (int ks = 0; ks < 4; ++ks) gl = __builtin_amdgcn_mfma_f32_16x16x32_bf16(*(const LAS bf16x8*)(WLG + nl * 136 + ks * 32 + fq * 8), af[4 + ks], gl, 0, 0, 0);
            if (l == 1) vm = __builtin_amdgcn_mfma_f32_16x16x32_bf16(*(const LAS bf16x8*)(WLV + nl * 40 + fq * 8), avv, vm, 0, 0, 0);
            float rz[4], kz[4], vz[4];
            mixw(cR[nt], pR[nt], PAR + 768 + cl, rz); mixw(cK[nt], pK[nt], PAR + 896 + cl, kz); mixw(cV[nt], pV[nt], PAR + 1024 + cl, vz);
            const f32x4 w0 = *(const LAS f32x4*)(PAR + cl), a0 = *(const LAS f32x4*)(PAR + 128 + cl), kk4 = *(const LAS f32x4*)(PAR + 256 + cl);
            const f32x4 ka4 = *(const LAS f32x4*)(PAR + 384 + cl), rk4 = *(const LAS f32x4*)(PAR + 512 + cl), v04 = *(const LAS f32x4*)(PAR + 640 + cl);
            f32x4 oa, ob, od, ok, ord_, ov;
#pragma unroll
            for (int j = 0; j < 4; ++j) {
                const float dcy = __expf(-0.60653065971f * fsig(w0[j] + dl[j]));
                const float av_ = fsig(a0[j] + al[j]);
                float vj = vz[j];
                if (l == 1) { const float vmix = fsig(v04[j] + vm[j]); vj = vj + (vf[nt][j] - vj) * vmix; }
                const float kk = kz[j] * kk4[j] * inv, k2 = kz[j] * (1.f + (av_ - 1.f) * ka4[j]);
                oa[j] = -kk; ob[j] = kk * av_; od[j] = dcy; ok[j] = k2; ord_[j] = rz[j] * dcy; ov[j] = vj;
                br += ob[j] * rz[j]; kr += k2 * rz[j]; rkr += rz[j] * k2 * rk4[j];
            }
            const size_t o = (size_t)m * 512 + ch;
            st_bf4((bf16_t*)SA + o, oa); st_bf4((bf16_t*)SB + o, ob); *(f32x4*)(SD + o) = od; st_bf4((bf16_t*)SK + o, ok); st_bf4((bf16_t*)SRD + o, ord_); st_bf4((bf16_t*)SV + o, ov); { u32x2 gw2; gw2.x = cvt_pk_bf16(gl[0], gl[1]); gw2.y = cvt_pk_bf16(gl[2], gl[3]); *(u32x2*)((bf16_t*)GG + o) = gw2; }
            __builtin_amdgcn_sched_barrier(0);
        }
        br += __shfl_xor(br, 16); br += __shfl_xor(br, 32); kr += __shfl_xor(kr, 16); kr += __shfl_xor(kr, 32); rkr += __shfl_xor(rkr, 16); rkr += __shfl_xor(rkr, 32);
        if (fq == 0) { SBR[m * 8 + h] = br; SKR[m * 8 + h] = kr; RKR[m * 8 + h] = rkr; }
        }
        __syncthreads();
    }
}

__device__ __forceinline__ void convB_token(const Args& a, int l, int m, int lane) {
    unsigned char* ws = a.ws;
    const bf16_t* __restrict__ PROJ = (const bf16_t*)(ws + OFF_PROJ);
    bf16_t* __restrict__ YAB = (bf16_t*)(ws + OFF_YAB);
    const int cb = lane * 8;
        const bf16_t* pr = PROJ + (size_t)m * LDP;
        float gb[8], gc[8], hi[8], u0[8], u1[8], u2[8];
        unpack8(*(const u32x4*)(pr + 1792 + cb), gb); unpack8(*(const u32x4*)(pr + 2304 + cb), gc); unpack8(*(const u32x4*)(pr + 2816 + cb), hi);
#pragma unroll
        for (int j = 0; j < 8; ++j) { u0[j] = gc[j] * hi[j]; u1[j] = 0.f; u2[j] = 0.f; }
        if (m < MP) {
            const int t = m & 2047;
            if (t >= 1) { unpack8(*(const u32x4*)(pr - LDP + 2304 + cb), gc); unpack8(*(const u32x4*)(pr - LDP + 2816 + cb), hi);
#pragma unroll
                for (int j = 0; j < 8; ++j) u1[j] = gc[j] * hi[j]; }
            if (t >= 2) { unpack8(*(const u32x4*)(pr - 2 * LDP + 2304 + cb), gc); unpack8(*(const u32x4*)(pr - 2 * LDP + 2816 + cb), hi);
#pragma unroll
                for (int j = 0; j < 8; ++j) u2[j] = gc[j] * hi[j]; }
            if (t >= 2046) { float* dst = a.out + O_CONVP + (size_t)((l * NB + (m >> 11)) * 2 + (t - 2046)) * 512 + cb;
                *(f32x4*)dst = (f32x4){u0[0], u0[1], u0[2], u0[3]}; *(f32x4*)(dst + 4) = (f32x4){u0[4], u0[5], u0[6], u0[7]}; }
        } else {
            const int i = m - MP; const float* sc = a.in[I_SCONV] + (size_t)(l * NS + i) * 2 * 512 + cb;
            const f32x4 a0 = *(const f32x4*)sc, a1 = *(const f32x4*)(sc + 4), b0 = *(const f32x4*)(sc + 512), b1 = *(const f32x4*)(sc + 516);
#pragma unroll
            for (int j = 0; j < 4; ++j) { u2[j] = a0[j]; u2[4 + j] = a1[j]; u1[j] = b0[j]; u1[4 + j] = b1[j]; }
            float* dst = a.out + O_CONVS + (size_t)(l * NS + i) * 2 * 512 + cb;
            *(f32x4*)dst = b0; *(f32x4*)(dst + 4) = b1;
            *(f32x4*)(dst + 512) = (f32x4){u0[0], u0[1], u0[2], u0[3]}; *(f32x4*)(dst + 516) = (f32x4){u0[4], u0[5], u0[6], u0[7]};
        }
        const float* cw = a.in[I_CONVW] + (size_t)l * 3 * 512 + cb;
        float ob[8];
#pragma unroll
        for (int j = 0; j < 8; ++j) ob[j] = gb[j] * (cw[j] * u2[j] + cw[512 + j] * u1[j] + cw[1024 + j] * u0[j]);
        u32x4 w2; w2.x = pk2(ob[0], ob[1]); w2.y = pk2(ob[2], ob[3]); w2.z = pk2(ob[4], ob[5]); w2.w = pk2(ob[6], ob[7]);
        *(u32x4*)(YAB + (size_t)m * 1024 + 512 + cb) = w2;
}

typedef float f32x2 __attribute__((ext_vector_type(2)));
__device__ __forceinline__ float scan_step(float (&s)[4], const f32x4 av, const f32x4 bv, const f32x4 dv, const f32x4 kv, const f32x4 rd, float vi, float br, float kr) {
    f32x2 s01 = (f32x2){s[0], s[1]}, s23 = (f32x2){s[2], s[3]};
    f32x2 t = s01 * (f32x2){av[0], av[1]}; t = __builtin_elementwise_fma(s23, (f32x2){av[2], av[3]}, t);
    f32x2 u = s01 * (f32x2){rd[0], rd[1]}; u = __builtin_elementwise_fma(s23, (f32x2){rd[2], rd[3]}, u);
    float pa = t.x + t.y, py = u.x + u.y;
    pa = red16(pa); py = red16(py);
    const f32x2 pav = (f32x2){pa, pa}, viv = (f32x2){vi, vi};
    f32x2 w01 = (f32x2){kv[0], kv[1]} * viv; w01 = __builtin_elementwise_fma((f32x2){bv[0], bv[1]}, pav, w01);
    f32x2 w23 = (f32x2){kv[2], kv[3]} * viv; w23 = __builtin_elementwise_fma((f32x2){bv[2], bv[3]}, pav, w23);
    s01 = __builtin_elementwise_fma(s01, (f32x2){dv[0], dv[1]}, w01);
    s23 = __builtin_elementwise_fma(s23, (f32x2){dv[2], dv[3]}, w23);
    s[0] = s01.x; s[1] = s01.y; s[2] = s23.x; s[3] = s23.y;
    return py + pa * br + vi * kr;
}

__device__ __forceinline__ void scan_phase(LAS unsigned char* lds, const Args& a, int l, int tid, int lane, int wave) {
    unsigned char* ws = a.ws;
    const float* SA = (const float*)(ws + OFF_SA); const float* SB = (const float*)(ws + OFF_SB); const float* SD = (const float*)(ws + OFF_SD); const float* SK = (const float*)(ws + OFF_SK);
    const float* SRD = (const float*)(ws + OFF_SRD); const float* SV = (const float*)(ws + (l == 0 ? OFF_SV0 : OFF_SV1));
    const float* SBR = (const float*)(ws + OFF_SBR); const float* SKR = (const float*)(ws + OFF_SKR);
    float* Y = (float*)(ws + OFF_Y);
    constexpr int TC = 32, CB = 5 * TC * 64 + TC * 16 + 2 * TC;
    LAS float* L = (LAS float*)lds;
    const int j4 = lane >> 4, c = lane & 15;
    for (int ci = blockIdx.x; ci < 256; ci += gridDim.x) {
        const int hc = ci >> 2, rg = ci & 3, b = hc >> 3, h = hc & 7;
        const int st = tid >> 4, c16 = tid & 15;
        const int rl = (wave & 3) * 4 + j4;
        float s[4] = {0.f, 0.f, 0.f, 0.f};
        u32x2 pa, pb, pk, pr; f32x4 pd; bf16_t pv; float ps = 0.f;
        {
            const size_t m = (size_t)b * 2048 + st; const size_t o = m * 512 + h * 64 + c16 * 4;
            pa = *(const u32x2*)((const bf16_t*)SA + o); pb = *(const u32x2*)((const bf16_t*)SB + o); pd = *(const f32x4*)(SD + o); pk = *(const u32x2*)((const bf16_t*)SK + o); pr = *(const u32x2*)((const bf16_t*)SRD + o);
            pv = ((const bf16_t*)SV)[m * 512 + h * 64 + rg * 16 + c16];
            if (tid < 32) ps = SBR[((size_t)b * 2048 + tid) * 8 + h]; else if (tid < 64) ps = SKR[((size_t)b * 2048 + tid - 32) * 8 + h];
        }
        {
            LAS float* B0 = L;
            *(LAS f32x4*)(B0 + st * 64 + c16 * 4) = (f32x4){bflo(pa.x), bfhi(pa.x), bflo(pa.y), bfhi(pa.y)}; *(LAS f32x4*)(B0 + 2048 + st * 64 + c16 * 4) = (f32x4){bflo(pb.x), bfhi(pb.x), bflo(pb.y), bfhi(pb.y)}; *(LAS f32x4*)(B0 + 4096 + st * 64 + c16 * 4) = pd;
            *(LAS f32x4*)(B0 + 6144 + st * 64 + c16 * 4) = (f32x4){bflo(pk.x), bfhi(pk.x), bflo(pk.y), bfhi(pk.y)}; *(LAS f32x4*)(B0 + 8192 + st * 64 + c16 * 4) = (f32x4){bflo(pr.x), bfhi(pr.x), bflo(pr.y), bfhi(pr.y)}; B0[10240 + st * 16 + c16] = bf2f(pv);
            if (tid < 64) B0[10752 + tid] = ps;
        }
        __syncthreads();
        for (int n = 0; n < TT / TC; ++n) {
            LAS float* Bc = L + (n & 1) * CB; LAS float* Bn = L + ((n + 1) & 1) * CB; LAS float* yb = L + 2 * CB + (n & 1) * 512;
            const bool more = n + 1 < TT / TC;
            if (more) {
                const size_t m = (size_t)b * 2048 + (n + 1) * TC + st; const size_t o = m * 512 + h * 64 + c16 * 4;
                pa = *(const u32x2*)((const bf16_t*)SA + o); pb = *(const u32x2*)((const bf16_t*)SB + o); pd = *(const f32x4*)(SD + o); pk = *(const u32x2*)((const bf16_t*)SK + o); pr = *(const u32x2*)((const bf16_t*)SRD + o);
                pv = ((const bf16_t*)SV)[m * 512 + h * 64 + rg * 16 + c16];
                if (tid < 32) ps = SBR[((size_t)b * 2048 + (n + 1) * TC + tid) * 8 + h]; else if (tid < 64) ps = SKR[((size_t)b * 2048 + (n + 1) * TC + tid - 32) * 8 + h];
            }
            if (wave < 4) {
                LAS float* ybase = (c == 0) ? (yb + rl) : (L + 2 * CB + 1024 + lane);
                const LAS float* p0 = Bc + c * 4;
                f32x4 av = *(const LAS f32x4*)p0, bv = *(const LAS f32x4*)(p0 + 2048), dv = *(const LAS f32x4*)(p0 + 4096), kv = *(const LAS f32x4*)(p0 + 6144), rd = *(const LAS f32x4*)(p0 + 8192);
                float vi = Bc[10240 + rl], br = Bc[10752], kr = Bc[10784];
#pragma unroll 16
                for (int t = 0; t < TC; ++t) {
                    const int tn = (t + 1 < TC) ? t + 1 : t;
                    const LAS float* p = Bc + tn * 64 + c * 4;
                    const f32x4 av2 = *(const LAS f32x4*)p, bv2 = *(const LAS f32x4*)(p + 2048), dv2 = *(const LAS f32x4*)(p + 4096), kv2 = *(const LAS f32x4*)(p + 6144), rd2 = *(const LAS f32x4*)(p + 8192);
                    const float vi2 = Bc[10240 + tn * 16 + rl], br2 = Bc[10752 + tn], kr2 = Bc[10784 + tn];
                    const float y = scan_step(s, av, bv, dv, kv, rd, vi, br, kr);
                    ybase[t * 16] = y;
                    av = av2; bv = bv2; dv = dv2; kv = kv2; rd = rd2; vi = vi2; br = br2; kr = kr2;
                }
            }
            else {
                const int hw4 = wave - 4;
                if (l == 0 && n < 14) {
                    const int d = (blockIdx.x * 4 + hw4) + 1024 * n;
                    if (d < TR_DEFERRED) tr_deferred(a, ws, d, (LAS float*)(lds + 94208 + hw4 * 8448), lane);
                } else if (n >= 24 && n < 41) {
                    const int tt = (n - 24) * 4 + hw4;
                    int mB = -1;
                    if (tt < 64) mB = blockIdx.x * 64 + tt; else if (tt == 64 && blockIdx.x < NS) mB = MP + blockIdx.x;
                    if (mB >= 0) convB_token(a, l, mB, lane);
                } else if (n >= 20 && n < 24) {
                    const int q = blockIdx.x + gridDim.x * (n - 20);
                    if (q < NS * 8) {
                        const int i = q >> 3, hs = q & 7; const size_t ms = MP + i;
                        const size_t o = ms * 512 + hs * 64 + c * 4;
                        const f32x4 av = ld_bf4((const bf16_t*)SA + o), bv = ld_bf4((const bf16_t*)SB + o), dv = *(const f32x4*)(SD + o), kv = ld_bf4((const bf16_t*)SK + o), rd = ld_bf4((const bf16_t*)SRD + o);
                        const float br = SBR[ms * 8 + hs], kr = SKR[ms * 8 + hs];
#pragma unroll 1
                        for (int p4 = 0; p4 < 4; ++p4) {
                            const int row = p4 * 16 + hw4 * 4 + j4;
                            const size_t so = ((size_t)((l * NS + i) * 8 + hs)) * 4096 + row * 64 + c * 4;
                            const f32x4 s4 = *(const f32x4*)(a.in[I_SWKV] + so);
                            const float vi = bf2f(((const bf16_t*)SV)[ms * 512 + hs * 64 + row]);
                            float ss_[4] = {s4[0], s4[1], s4[2], s4[3]};
                            const float y = scan_step(ss_, av, bv, dv, kv, rd, vi, br, kr);
                            *(f32x4*)(a.out + O_WKVS + so) = (f32x4){ss_[0], ss_[1], ss_[2], ss_[3]};
                            if (c == 0) ((bf16_t*)Y)[ms * 512 + hs * 64 + row] = (bf16_t)f2bf(y);
                        }
                    }
                }
            }
            if (more) {
                *(LAS f32x4*)(Bn + st * 64 + c16 * 4) = (f32x4){bflo(pa.x), bfhi(pa.x), bflo(pa.y), bfhi(pa.y)}; *(LAS f32x4*)(Bn + 2048 + st * 64 + c16 * 4) = (f32x4){bflo(pb.x), bfhi(pb.x), bflo(pb.y), bfhi(pb.y)}; *(LAS f32x4*)(Bn + 4096 + st * 64 + c16 * 4) = pd;
                *(LAS f32x4*)(Bn + 6144 + st * 64 + c16 * 4) = (f32x4){bflo(pk.x), bfhi(pk.x), bflo(pk.y), bfhi(pk.y)}; *(LAS f32x4*)(Bn + 8192 + st * 64 + c16 * 4) = (f32x4){bflo(pr.x), bfhi(pr.x), bflo(pr.y), bfhi(pr.y)}; Bn[10240 + st * 16 + c16] = bf2f(pv);
                if (tid < 64) Bn[10752 + tid] = ps;
            }
            __syncthreads();
            ((bf16_t*)Y)[((size_t)b * 2048 + n * TC + st) * 512 + h * 64 + rg * 16 + c16] = (bf16_t)f2bf(yb[st * 16 + c16]);
        }
        if (wave < 4) {
            float* o = a.out + O_WKVP + ((size_t)((l * 8 + b) * 8 + h)) * 4096 + (rg * 16 + rl) * 64 + c * 4;
            *(f32x4*)o = (f32x4){s[0], s[1], s[2], s[3]};
        }
        __syncthreads();
    }
}

__device__ __forceinline__ void post_phase(const Args& a, int l, int lane, int gw, int NGW) {
    unsigned char* ws = a.ws;
    const bf16_t* __restrict__ PROJ = (const bf16_t*)(ws + OFF_PROJ);
    const float* __restrict__ Y = (const float*)(ws + OFF_Y); const float* __restrict__ SV = (const float*)(ws + (l == 0 ? OFF_SV0 : OFF_SV1)); const float* __restrict__ GG = (const float*)(ws + OFF_G);
    const float* __restrict__ RKR = (const float*)(ws + OFF_RKR);
    bf16_t* __restrict__ YAB = (bf16_t*)(ws + OFF_YAB);
    const int cb = lane * 8, h = lane >> 3;
#pragma unroll 4
    for (int m = gw; m < MTOK; m += NGW) {
        const size_t o = (size_t)m * 512 + cb;
        f32x4 y0, y1; { const u32x4 yq = __builtin_nontemporal_load((const u32x4*)((const bf16_t*)Y + o)); y0 = (f32x4){bflo(yq.x), bfhi(yq.x), bflo(yq.y), bfhi(yq.y)}; y1 = (f32x4){bflo(yq.z), bfhi(yq.z), bflo(yq.w), bfhi(yq.w)}; }
        float s = (y0[0] + y0[1]) + (y0[2] + y0[3]) + (y1[0] + y1[1]) + (y1[2] + y1[3]);
        s += __shfl_xor(s, 1); s += __shfl_xor(s, 2); s += __shfl_xor(s, 4);
        const float mean = s * (1.f / 64.f);
        const f32x4 d0 = y0 - mean, d1 = y1 - mean;
        float q = (d0[0] * d0[0] + d0[1] * d0[1]) + (d0[2] * d0[2] + d0[3] * d0[3]) + (d1[0] * d1[0] + d1[1] * d1[1]) + (d1[2] * d1[2] + d1[3] * d1[3]);
        q += __shfl_xor(q, 1); q += __shfl_xor(q, 2); q += __shfl_xor(q, 4);
        const float rstd = rsqrtf(q * (1.f / 64.f) + GN_EPS);
        const float rkr = RKR[m * 8 + h];
        f32x4 v0, v1; { const u32x4 vq = __builtin_nontemporal_load((const u32x4*)((const bf16_t*)SV + o)); v0 = (f32x4){bflo(vq.x), bfhi(vq.x), bflo(vq.y), bfhi(vq.y)}; v1 = (f32x4){bflo(vq.z), bfhi(vq.z), bflo(vq.w), bfhi(vq.w)}; } f32x4 g0, g1; { const u32x4 gq = __builtin_nontemporal_load((const u32x4*)((const bf16_t*)GG + o)); g0 = (f32x4){bflo(gq.x), bfhi(gq.x), bflo(gq.y), bfhi(gq.y)}; g1 = (f32x4){bflo(gq.z), bfhi(gq.z), bflo(gq.w), bfhi(gq.w)}; }
        const f32x4 lw0 = *(const f32x4*)(a.in[I_LNW] + l * 512 + cb), lw1 = *(const f32x4*)(a.in[I_LNW] + l * 512 + cb + 4);
        const f32x4 lb0 = *(const f32x4*)(a.in[I_LNB] + l * 512 + cb), lb1 = *(const f32x4*)(a.in[I_LNB] + l * 512 + cb + 4);
        const f32x4 r0 = (d0 * rstd * lw0 + lb0 + v0 * rkr) * g0, r1 = (d1 * rstd * lw1 + lb1 + v1 * rkr) * g1;
        u32x4 w; w.x = pk2(r0[0], r0[1]); w.y = pk2(r0[2], r0[3]); w.z = pk2(r1[0], r1[1]); w.w = pk2(r1[2], r1[3]);
        *(u32x4*)(YAB + (size_t)m * 1024 + cb) = w;
    }
    if (l + 1 < 2 && gw < NS) {
        bf16_t* XB = (bf16_t*)(ws + OFF_XB) + (size_t)(MTOK + gw) * D;
        const float* src = a.in[I_SSHIFT] + (size_t)((l + 1) * NS + gw) * D; const float* gn = a.in[I_NMIX] + (l + 1) * D;
#pragma unroll
        for (int j = 0; j < 4; ++j) { const f32x4 v = *(const f32x4*)(src + 4 * lane + 256 * j), g4 = *(const f32x4*)(gn + 4 * lane + 256 * j);
            u32x2 w; w.x = pk2(v[0] / g4[0], v[1] / g4[1]); w.y = pk2(v[2] / g4[2], v[3] / g4[3]); *(u32x2*)(XB + 4 * lane + 256 * j) = w; }
    }
}

__device__ __forceinline__ void sample_attn(LAS unsigned char* lds, const Args& a, int l, int tid, int lane, int wave) {
    unsigned char* ws = a.ws;
    const bf16_t* Q = (const bf16_t*)(ws + OFF_Q); bf16_t* O = (bf16_t*)(ws + OFF_O);
    LAS float* sc = (LAS float*)lds;
    LAS float* part = sc + 256;
    for (int q = blockIdx.x; q < NS * 4; q += gridDim.x) {
        const int i = q >> 2, h = q & 3;
        const u32x2 qw = *(const u32x2*)(Q + (size_t)(MP + i) * 1024 + h * 256 + lane * 4);
        const float q0 = bflo(qw.x), q1 = bfhi(qw.x), q2 = bflo(qw.y), q3 = bfhi(qw.y);
        const float* Kb = a.in[I_CK] + ((size_t)((l * NS + i) * 256) * 4 + h) * 256 + lane * 4;
        const float* Vb = a.in[I_CV] + ((size_t)((l * NS + i) * 256) * 4 + h) * 256 + lane * 4;
        {
            f32x4 kx[8], kn[8];
#pragma unroll
            for (int e = 0; e < 8; ++e) kx[e] = __builtin_nontemporal_load((const f32x4*)(Kb + (size_t)(wave * 32 + e) * 1024));
#pragma unroll
            for (int g8 = 0; g8 < 4; ++g8) {
                if (g8 < 3) {
#pragma unroll
                    for (int e = 0; e < 8; ++e) kn[e] = __builtin_nontemporal_load((const f32x4*)(Kb + (size_t)(wave * 32 + (g8 + 1) * 8 + e) * 1024));
                }
#pragma unroll
                for (int e = 0; e < 8; ++e) { float p = kx[e][0] * q0 + kx[e][1] * q1 + kx[e][2] * q2 + kx[e][3] * q3; p = wave_sum(p); if (lane == 0) sc[wave * 32 + g8 * 8 + e] = p; }
#pragma unroll
                for (int e = 0; e < 8; ++e) kx[e] = kn[e];
            }
        }
        __syncthreads();
        if (wave == 0) {
            const f32x4 s4 = *(const LAS f32x4*)(sc + lane * 4);
            const float mx = wave_max(fmaxf(fmaxf(s4[0], s4[1]), fmaxf(s4[2], s4[3])));
            f32x4 e4; e4[0] = __expf(s4[0] - mx); e4[1] = __expf(s4[1] - mx); e4[2] = __expf(s4[2] - mx); e4[3] = __expf(s4[3] - mx);
            const float inv = 1.f / wave_sum((e4[0] + e4[1]) + (e4[2] + e4[3]));
            *(LAS f32x4*)(sc + lane * 4) = e4 * inv;
        }
        __syncthreads();
        f32x4 acc = (f32x4){0.f, 0.f, 0.f, 0.f};
        {
            f32x4 vx[8], vn[8];
#pragma unroll
            for (int e = 0; e < 8; ++e) vx[e] = __builtin_nontemporal_load((const f32x4*)(Vb + (size_t)(wave * 32 + e) * 1024));
#pragma unroll
            for (int g8 = 0; g8 < 4; ++g8) {
                if (g8 < 3) {
#pragma unroll
                    for (int e = 0; e < 8; ++e) vn[e] = __builtin_nontemporal_load((const f32x4*)(Vb + (size_t)(wave * 32 + (g8 + 1) * 8 + e) * 1024));
                }
#pragma unroll
                for (int e = 0; e < 8; ++e) acc += vx[e] * sc[wave * 32 + g8 * 8 + e];
#pragma unroll
                for (int e = 0; e < 8; ++e) vx[e] = vn[e];
            }
        }
        *(LAS f32x4*)(part + wave * 256 + lane * 4) = acc;
        __syncthreads();
        if (tid < 256) {
            float s = 0.f;
#pragma unroll
            for (int w = 0; w < 8; ++w) s += part[w * 256 + tid];
            O[(size_t)(MP + i) * 1024 + h * 256 + tid] = (bf16_t)f2bf(s);
        }
        __syncthreads();
    }
}

__device__ __forceinline__ void ffnconv_phase(const Args& a, int l, int tid) {
    unsigned char* ws = a.ws;
    const bf16_t* __restrict__ UP = (const bf16_t*)(ws + OFF_UP); bf16_t* __restrict__ H = (bf16_t*)(ws + OFF_H);
    const float* __restrict__ cw = a.in[I_FCW] + (size_t)l * 3 * FW2;
    constexpr int CH = FW / 8;
    for (int rb = blockIdx.x; rb < MP / 64; rb += gridDim.x) {
        if (tid < CH) {
            const int c = tid * 8, r0 = rb * 64, t0 = r0 & 2047;
            float wu[3][8], wg[3][8];
#pragma unroll
            for (int k = 0; k < 3; ++k) {
                const f32x4 a0 = *(const f32x4*)(cw + k * FW2 + c), a1 = *(const f32x4*)(cw + k * FW2 + c + 4), b0 = *(const f32x4*)(cw + k * FW2 + FW + c), b1 = *(const f32x4*)(cw + k * FW2 + FW + c + 4);
#pragma unroll
                for (int j = 0; j < 4; ++j) { wu[k][j] = a0[j]; wu[k][4 + j] = a1[j]; wg[k][j] = b0[j]; wg[k][4 + j] = b1[j]; }
            }
            float u2[8], u1[8], g2[8], g1[8];
#pragma unroll
            for (int j = 0; j < 8; ++j) { u2[j] = 0.f; u1[j] = 0.f; g2[j] = 0.f; g1[j] = 0.f; }
            if (t0 >= 2) {
                const bf16_t* p = UP + (size_t)(r0 - 2) * FW2 + c;
                unpack8(*(const u32x4*)p, u2); unpack8(*(const u32x4*)(p + FW), g2); unpack8(*(const u32x4*)(p + FW2), u1); unpack8(*(const u32x4*)(p + FW2 + FW), g1);
            }
            const bf16_t* p = UP + (size_t)r0 * FW2 + c; bf16_t* hp = H + (size_t)r0 * FW + c;
#pragma unroll 1
            for (int r = 0; r < 64; r += 4) {
                u32x4 lu[4], lg[4];
#pragma unroll
                for (int e = 0; e < 4; ++e) { lu[e] = __builtin_nontemporal_load((const u32x4*)(p + (size_t)(r + e) * FW2)); lg[e] = __builtin_nontemporal_load((const u32x4*)(p + (size_t)(r + e) * FW2 + FW)); }
#pragma unroll
                for (int e = 0; e < 4; ++e) {
                    float u0[8], g0[8], hh[8]; unpack8(lu[e], u0); unpack8(lg[e], g0);
#pragma unroll
                    for (int j = 0; j < 8; ++j) {
                        const float uu = wu[0][j] * u2[j] + wu[1][j] * u1[j] + wu[2][j] * u0[j], gg = wg[0][j] * g2[j] + wg[1][j] * g1[j] + wg[2][j] * g0[j];
                        hh[j] = gg * __builtin_amdgcn_rcpf(1.f + __expf(-gg)) * uu;
                        u2[j] = u1[j]; u1[j] = u0[j]; g2[j] = g1[j]; g1[j] = g0[j];
                    }
                    u32x4 w; w.x = cvt_pk_bf16(hh[0], hh[1]); w.y = cvt_pk_bf16(hh[2], hh[3]); w.z = cvt_pk_bf16(hh[4], hh[5]); w.w = cvt_pk_bf16(hh[6], hh[7]);
                    *(u32x4*)(hp + (size_t)(r + e) * FW) = w;
                }
            }
        }
    }
    for (int it = blockIdx.x * 512 + tid; it < NS * CH; it += gridDim.x * 512) {
        const int i = it / CH, c = (it % CH) * 8, m = MP + i;
        const bf16_t* r0 = UP + (size_t)m * FW2;
        float u[8], g[8], t0[8], t1[8];
        unpack8(*(const u32x4*)(r0 + c), t0); unpack8(*(const u32x4*)(r0 + FW + c), t1);
        const float* sf = a.in[I_SFFN] + (size_t)(l * NS + i) * 2 * FW2;
        float* dst = a.out + O_FFNS + (size_t)(l * NS + i) * 2 * FW2;
        float hh[8];
#pragma unroll
        for (int q = 0; q < 2; ++q) {
            const int cc = c + 4 * q;
            const f32x4 p0u = *(const f32x4*)(sf + cc), p0g = *(const f32x4*)(sf + FW + cc), p1u = *(const f32x4*)(sf + FW2 + cc), p1g = *(const f32x4*)(sf + FW2 + FW + cc);
            const f32x4 w0u = *(const f32x4*)(cw + cc), w1u = *(const f32x4*)(cw + FW2 + cc), w2u = *(const f32x4*)(cw + 2 * FW2 + cc);
            const f32x4 w0g = *(const f32x4*)(cw + FW + cc), w1g = *(const f32x4*)(cw + FW2 + FW + cc), w2g = *(const f32x4*)(cw + 2 * FW2 + FW + cc);
            *(f32x4*)(dst + cc) = p1u; *(f32x4*)(dst + FW + cc) = p1g;
#pragma unroll
            for (int j = 0; j < 4; ++j) {
                u[4 * q + j] = w2u[j] * t0[4 * q + j] + w0u[j] * p0u[j] + w1u[j] * p1u[j]; g[4 * q + j] = w2g[j] * t1[4 * q + j] + w0g[j] * p0g[j] + w1g[j] * p1g[j];
                hh[4 * q + j] = g[4 * q + j] * sigmoidf_(g[4 * q + j]) * u[4 * q + j];
            }
        }
        u32x4 w; w.x = pk2(hh[0], hh[1]); w.y = pk2(hh[2], hh[3]); w.z = pk2(hh[4], hh[5]); w.w = pk2(hh[6], hh[7]);
        *(u32x4*)(H + (size_t)m * FW + c) = w;
    }
}

__device__ __forceinline__ void final_phase(const Args& a, int lane, int gw, int NGW) {
    unsigned char* ws = a.ws;
    const bf16_t* __restrict__ X = (const bf16_t*)(ws + OFF_XB); const float* __restrict__ SS = (const float*)(ws + OFF_SS) + (size_t)6 * MROWS;
    float* __restrict__ outp = a.out;
#pragma unroll 4
    for (int m = gw; m < MTOK; m += NGW) {
        const float rs = rsqrtf(SS[m] * (1.f / 1024.f) + EPS);
        float* __restrict__ dst = m < MP ? outp + O_YP + (size_t)m * D : outp + O_YS + (size_t)(m - MP) * D;
#pragma unroll
        for (int j = 0; j < 4; ++j) { const u32x2 xw = __builtin_nontemporal_load((const u32x2*)(X + (size_t)m * D + 4 * lane + 256 * j)); const f32x4 v = (f32x4){bflo(xw.x), bfhi(xw.x), bflo(xw.y), bfhi(xw.y)}, gn = *(const f32x4*)(a.in[I_NFIN] + 4 * lane + 256 * j);
            __builtin_nontemporal_store(v * rs * gn, (f32x4*)(dst + 4 * lane + 256 * j)); }
    }
}

__device__ __forceinline__ void skinny_gemm(LAS unsigned char* lds, const bf16_t* __restrict__ A, int lda, const bf16_t* __restrict__ Wt, int K, int mode, float* X, bf16_t* O, float* ssn, const float* ss, int lane, int wave) {
    LAS f32x4* part = (LAS f32x4*)lds;
    for (int item = blockIdx.x; item < 256; item += gridDim.x) {
        const int n0 = (item & 63) * 16, r0 = MP + (item >> 6) * 32, fr = lane & 15, fq = lane >> 4;
        const bf16_t* ap = A + (size_t)(r0 + fr) * lda + fq * 8;
        const bf16_t* bp = Wt + (size_t)(n0 + fr) * K + fq * 8;
        f32x4 acc0 = (f32x4){0.f, 0.f, 0.f, 0.f}, acc1 = acc0;
#pragma unroll 4
        for (int ks = wave; ks < K / 32; ks += 8) {
            const bf16x8 bf = *(const bf16x8*)(bp + ks * 32), a0 = *(const bf16x8*)(ap + ks * 32), a1 = *(const bf16x8*)(ap + (size_t)16 * lda + ks * 32);
            acc0 = __builtin_amdgcn_mfma_f32_16x16x32_bf16(bf, a0, acc0, 0, 0, 0);
            acc1 = __builtin_amdgcn_mfma_f32_16x16x32_bf16(bf, a1, acc1, 0, 0, 0);
        }
        part[(wave * 2 + 0) * 64 + lane] = acc0; part[(wave * 2 + 1) * 64 + lane] = acc1;
        __syncthreads();
        if (wave < 2) {
            f32x4 acc = part[wave * 64 + lane];
#pragma unroll
            for (int w = 1; w < 8; ++w) acc += part[(w * 2 + wave) * 64 + lane];
            const int row = r0 + wave * 16 + fr, col = n0 + fq * 4;
            const size_t idx = (size_t)row * 1024 + col;
            if (mode == 1) {
                const u32x2 xi = *(const u32x2*)(O + idx);
                const f32x4 x = (f32x4){bflo(xi.x), bfhi(xi.x), bflo(xi.y), bfhi(xi.y)} + acc;
                u32x2 w; w.x = cvt_pk_bf16(x[0], x[1]); w.y = cvt_pk_bf16(x[2], x[3]); *(u32x2*)(O + idx) = w;
                float sq = (x[0] * x[0] + x[1] * x[1]) + (x[2] * x[2] + x[3] * x[3]);
                sq += __shfl_xor(sq, 16); sq += __shfl_xor(sq, 32);
                if (fq == 0) atomicAdd(ssn + row, sq);
            } else {
                const float rs = rsqrtf(ss[row] * (1.f / 1024.f) + EPS);
                u32x2 w; w.x = cvt_pk_bf16(acc[0] * rs, acc[1] * rs); w.y = cvt_pk_bf16(acc[2] * rs, acc[3] * rs); *(u32x2*)(O + idx) = w;
            }
        }
        __syncthreads();
    }
}

#define XB_TMO      128
#define XB_XCNT(j)  (256  + 64 * (j))
#define XB_XSUB(j)  (1280 + 64 * (j))
#define XB_XGEN(j)  (2304 + 64 * (j))
#define XB_TOP      3328
#define XB_TOPGEN   3392
#define XCD_BAR_WORDS 3456
#define XB_SPIN_CAP (1u << 22)
__device__ __forceinline__ unsigned xb_ld(unsigned* p)              { return __hip_atomic_load(p, __ATOMIC_RELAXED, __HIP_MEMORY_SCOPE_AGENT); }
__device__ __forceinline__ unsigned xb_add(unsigned* p, unsigned v) { return __hip_atomic_fetch_add(p, v, __ATOMIC_RELAXED, __HIP_MEMORY_SCOPE_AGENT); }
__device__ __forceinline__ unsigned xb_xcc_id() { return (unsigned)__builtin_amdgcn_s_getreg((3 << 11) | 20) & 0xFu; }
#define XB_SPIN(cond, bar) do { unsigned _sp = 0; while (cond) { __builtin_amdgcn_s_sleep(1); \
    if ((++_sp & 255u) == 0u) { if (xb_ld(&(bar)[XB_TMO])) break; if (_sp > XB_SPIN_CAP) { atomicAdd(&(bar)[XB_TMO], 1u); break; } } } } while (0)
struct XcdBarrier { unsigned* bar; unsigned x; volatile LAS unsigned* st; };
__device__ __forceinline__ XcdBarrier xcd_barrier_post(unsigned* bar, volatile LAS unsigned* st) {
    XcdBarrier b; b.bar = bar; b.x = xb_xcc_id(); b.st = st;
    if (threadIdx.x == 0) (void)xb_add(&bar[XB_XCNT(b.x)], 1u);
    return b;
}
__device__ __forceinline__ void xcd_barrier_complete(unsigned* bar, unsigned x, unsigned& nloc, unsigned& nx) {
    const unsigned G = gridDim.x * gridDim.y * gridDim.z;
    unsigned sum, cnt, mine, sp = 0u;
    for (;;) {
        sum = 0u; cnt = 0u; mine = 0u;
#pragma unroll
        for (unsigned j = 0; j < 16; ++j) { const unsigned c = xb_ld(&bar[XB_XCNT(j)]); sum += c; cnt += (c > 0u) ? 1u : 0u; mine = (j == x) ? c : mine; }
        if (sum == G) break;
        __builtin_amdgcn_s_sleep(1);
        if ((++sp & 255u) == 0u) { if (xb_ld(&bar[XB_TMO])) break; if (sp > XB_SPIN_CAP) { atomicAdd(&bar[XB_TMO], 1u); break; } }
    }
    nloc = mine > 0u ? mine : 1u; nx = cnt > 0u ? cnt : 1u;
}
__device__ __forceinline__ void xcd_barrier(const XcdBarrier& b) {
    asm volatile("s_waitcnt vmcnt(0)" ::: "memory");
    __syncthreads();
    if (threadIdx.x == 0) {
        unsigned* bar = b.bar;
        __builtin_amdgcn_s_waitcnt(0);
        unsigned nloc = b.st[0], nx = b.st[1];
        if (nloc == 0u) { xcd_barrier_complete(bar, b.x, nloc, nx); b.st[0] = nloc; b.st[1] = nx; }
        const unsigned old = xb_add(&bar[XB_XSUB(b.x)], 1u);
        const unsigned gen = old / nloc;
        if (old + 1u == (gen + 1u) * nloc) {
            __builtin_amdgcn_fence(__ATOMIC_RELEASE, "agent");
            asm volatile("s_waitcnt vmcnt(0)" ::: "memory");
            const unsigned og = xb_add(&bar[XB_TOP], 1u);
            const unsigned tg = og / nx;
            if (og + 1u == (tg + 1u) * nx) xb_add(&bar[XB_TOPGEN], 1u);
            else XB_SPIN(xb_ld(&bar[XB_TOPGEN]) == tg, bar);
            __builtin_amdgcn_fence(__ATOMIC_ACQUIRE, "agent");
            xb_add(&bar[XB_XGEN(b.x)], 1u);
            asm volatile("s_waitcnt vmcnt(0)" ::: "memory");
        } else {
            XB_SPIN(xb_ld(&bar[XB_XGEN(b.x)]) == gen, bar);
            __builtin_amdgcn_fence(__ATOMIC_ACQUIRE, "agent");
            asm volatile("s_waitcnt vmcnt(0)" ::: "memory");
        }
    }
    __syncthreads();
}

__global__ void __launch_bounds__(512, 2) mega(Args a) {
    extern __shared__ __attribute__((aligned(16))) unsigned char lds_raw[];
    LAS unsigned char* lds = (LAS unsigned char*)lds_raw;
    cg::grid_group grid = cg::this_grid();
    volatile LAS unsigned* bst = (volatile LAS unsigned*)(lds + 131072 + 64);
    if (threadIdx.x == 0) { bst[0] = 0u; bst[1] = 0u; }
    __syncthreads();
    const XcdBarrier xbar = xcd_barrier_post((unsigned*)(a.ws + OFF_BAR), bst);
    for (int ph2 = 2 * a.ph_lo; ph2 < 2 * a.ph_hi; ++ph2) {
        const int ph = ph2 >> 1;
        if (ph2 & 1) { const int spx = (ph == 0) ? 12 : (ph == NPHASE - 1) ? 13 : (ph - 1) % 12; if (!((REP_MASK >> spx) & 1)) continue; }
        int tid = threadIdx.x; asm volatile("" : "+v"(tid));
        const int lane = tid & 63, wave = __builtin_amdgcn_readfirstlane(tid >> 6);
        const int G = gridDim.x, gw = blockIdx.x * 8 + wave, NGW = G * 8;
        unsigned char* ws = a.ws; asm volatile("" : "+s"(ws));
        float* SS = (float*)(ws + OFF_SS);
        bf16_t* XB = (bf16_t*)(ws + OFF_XB); float* X = (float*)(ws + OFF_X);
        if (ph == 0) {
            if (PHON(12)) p0_prologue(lds, a, tid, lane, wave, gw, NGW);
        } else if (ph == NPHASE - 1) {
            if (PHON(13)) final_phase(a, lane, gw, NGW);
        } else {
            const int l = (ph - 1) / 12, sp = (ph - 1) % 12;
            const bool is_gemm = (sp == 0 || sp == 4 || sp == 5 || sp == 7 || sp == 8 || sp == 9 || sp == 11);
            if (is_gemm && PHON(0)) {
                const int njobs = (l == 0 && (sp == 0 || sp == 9)) ? 3 : 1;
                for (int jb = 0; jb < njobs; ++jb) {
                    pg8::Gemm g; pg8::GenOrder S; pg8::Epi E;
                    E.mode = 0; E.O = nullptr; E.ldc = D; E.ss = nullptr; E.X = nullptr; E.ssn = nullptr; E.F = nullptr; E.l = l; E.dry = (ph2 & 1);
                    if (sp == 0 && jb == 0) {
                        g = pg8::Gemm{XB, (const bf16_t*)(ws + OFF_WIN) + (size_t)l * LDP * D, D, D, D};
                        S.init(0, MROWS, LDP, D, D, G, (int)blockIdx.x);
                        E.O = (bf16_t*)(ws + OFF_PROJ); E.ldc = LDP; E.ss = SS + (size_t)3 * l * MROWS;
                    } else if (jb > 0) {
                        const int kv = (sp == 0 ? 0 : 2) + jb - 1, ll = kv >> 1, isv = kv & 1;
                        g = pg8::Gemm{(const bf16_t*)(ws + OFF_MNB), (const bf16_t*)(ws + (isv ? OFF_WV : OFF_WK)) + (size_t)ll * D * D, D, D, D};
                        S.init(0, MMEM, D, D, D, G, (int)((blockIdx.x + G - 160 - 32 * (jb - 1)) % G));
                        E.mode = isv ? 3 : 2; E.O = (bf16_t*)(ws + (isv ? OFF_MVT : OFF_MK)) + (size_t)ll * MMEM * D; E.ss = (const float*)(ws + OFF_SSM);
                        E.F = a.out + (isv ? O_MVP : O_MKP) + (size_t)ll * MMEM * D; E.l = ll;
                    } else if (sp == 4 || sp == 8 || sp == 11) {
                        const bf16_t* A = (const bf16_t*)(ws + (sp == 4 ? OFF_YAB : sp == 8 ? OFF_O : OFF_H));
                        const bf16_t* B = sp == 4 ? (const bf16_t*)(ws + OFF_WOUT) + (size_t)l * D * D : sp == 8 ? (const bf16_t*)(ws + OFF_WO) + (size_t)l * D * D : (const bf16_t*)(ws + OFF_WDN) + (size_t)l * D * FW;
                        const int K = sp == 11 ? FW : D;
                        const int nrm = 3 * l + (sp == 4 ? 1 : sp == 8 ? 2 : 3);
                        g = pg8::Gemm{A, B, K, K, K};
                        S.init(0, MP, D, K, K, G, (int)blockIdx.x);
                        E.mode = 1; E.O = XB; E.X = X; E.ssn = SS + (size_t)nrm * MROWS;
                    } else if (sp == 5) {
                        g = pg8::Gemm{XB, (const bf16_t*)(ws + OFF_WQ) + (size_t)l * D * D, D, D, D};
                        S.init(0, MP, D, D, D, G, (int)blockIdx.x);
                        E.O = (bf16_t*)(ws + OFF_Q); E.ss = SS + (size_t)(3 * l + 1) * MROWS;
                    } else if (sp == 7) {
                        g = pg8::Gemm{(const bf16_t*)(ws + OFF_P), (const bf16_t*)(ws + OFF_MVT) + (size_t)l * MMEM * D, D, 256, 256};
                        S.init(2, MP, D, D, 256, G, (int)blockIdx.x);
                        E.O = (bf16_t*)(ws + OFF_O);
                    } else {
                        g = pg8::Gemm{XB, (const bf16_t*)(ws + OFF_WUP) + (size_t)l * FW2 * D, D, D, D};
                        S.init(0, MROWS, FW2, D, D, G, (int)blockIdx.x);
                        E.mode = 4; E.O = (bf16_t*)(ws + OFF_UP); E.ldc = FW2; E.ss = SS + (size_t)(3 * l + 2) * MROWS; E.F = a.out;
                    }
                    pg8::gemm_phase<pg8::Epi, pg8::GenOrder, true>(lds, g, S, E);
                    if (jb == 0 && !(ph2 & 1) && (sp == 4 || sp == 5 || sp == 8 || sp == 11))
                        skinny_gemm(lds, g.A, g.lda, g.Bt, g.K, E.mode, X, E.O, E.ssn, E.ss, lane, wave);
                }
            } else if (sp == 1 && PHON(1)) {
                prep_phase(lds, a, l, tid, lane, wave, gw);
            } else if (sp == 2 && PHON(2)) {
                scan_phase(lds, a, l, tid, lane, wave);
            } else if (sp == 3 && PHON(3)) {
                post_phase(a, l, lane, gw, NGW);
            } else if (sp == 6 && PHON(6)) {
                {
                    pg8::Gemm g{(const bf16_t*)(ws + OFF_Q), (const bf16_t*)(ws + OFF_MK) + (size_t)l * MMEM * D, D, D, 256};
                    pg8::GenOrder S; S.init(1, MP, D, D, D, G, (int)blockIdx.x);
                    pg8::EpiSm E{(bf16_t*)(ws + OFF_P)};
                    pg8::gemm_phase<pg8::EpiSm, pg8::GenOrder, false>(lds, g, S, E);
                }
                __syncthreads();
                sample_attn(lds, a, l, tid, lane, wave);
            } else if (sp == 10 && PHON(10)) {
                ffnconv_phase(a, l, tid);
            }
        }
        if (ph2 + 1 < 2 * a.ph_hi) { if (a.ph_lo < 0) grid.sync(); else xcd_barrier(xbar); }
        if (((REP_MASK >> 14) & 1) && ph2 == 0) { for (int q = 0; q < 40; ++q) xcd_barrier(xbar); }
    }
}

extern "C" void kernel_launch(void* const* d_in, const int* in_sizes, int n_in, void* d_out, int out_size, void* d_ws, size_t ws_size, hipStream_t stream) {
    static int grid = 0;
    if (grid == 0) {
        if (n_in != 38 || ws_size < WS_END) { fprintf(stderr, "kernel_launch: expected 38 inputs and >= %zu bytes of workspace (got %d, %zu)\n", (size_t)WS_END, n_in, ws_size); grid = -1; return; }
        int dev = 0, cus = 0, per_cu = 0;
        hipGetDevice(&dev);
        hipDeviceGetAttribute(&cus, hipDeviceAttributeMultiprocessorCount, dev);
        if (hipFuncSetAttribute((const void*)mega, hipFuncAttributeMaxDynamicSharedMemorySize, LDS_BYTES) != hipSuccess) { fprintf(stderr, "kernel_launch: hipFuncSetAttribute failed\n"); grid = -1; return; }
        hipOccupancyMaxActiveBlocksPerMultiprocessor(&per_cu, (const void*)mega, 512, LDS_BYTES);
        if (per_cu < 1) { fprintf(stderr, "kernel_launch: occupancy query says %d blocks per CU\n", per_cu); per_cu = 1; }
        (void)hipGetLastError();
        grid = cus;
        if (grid != 256) fprintf(stderr, "kernel_launch: built for 256 CUs, got %d\n", grid);
    }
    if (grid < 0) return;
    if (hipMemsetAsync((char*)d_ws + OFF_BAR, 0, BAR_BYTES, stream) != hipSuccess) { fprintf(stderr, "kernel_launch: hipMemsetAsync failed\n"); return; }
    Args a{};
    for (int i = 0; i < 38; ++i) a.in[i] = (const float*)d_in[i];
    a.out = (float*)d_out; a.ws = (unsigned char*)d_ws;
#if MK_PER_PHASE
    for (int ph = 0; ph < NPHASE; ++ph) {
        a.ph_lo = ph; a.ph_hi = ph + 1;
        void* args[] = {&a};
        hipError_t e = hipLaunchCooperativeKernel((const void*)mega, dim3(grid), dim3(512), args, LDS_BYTES, stream);
        if (e != hipSuccess) { fprintf(stderr, "cooperative launch failed: %s\n", hipGetErrorString(e)); break; }
    }
#else
    a.ph_lo = 0; a.ph_hi = NPHASE;
    void* args[] = {&a};
    hipError_t e = hipLaunchCooperativeKernel((const void*)mega, dim3(grid), dim3(512), args, LDS_BYTES, stream);
    if (e != hipSuccess) fprintf(stderr, "cooperative launch failed: %s (grid %d)\n", hipGetErrorString(e), grid);
#endif
    (void)in_sizes; (void)out_size;
}
```

```cpp
#include <hip/hip_runtime.h>
#include <hip/hip_cooperative_groups.h>
#include <cstdio>
#include <cstdint>
namespace cg = cooperative_groups;

#ifndef PH_MASK
#define PH_MASK 0xFFFFF
#endif
#define PHON(k) (((PH_MASK) >> (k)) & 1)
#ifndef REP_MASK
#define REP_MASK 0
#endif
#ifndef MK_PER_PHASE
#define MK_PER_PHASE 0
#endif

#define LAS __attribute__((address_space(3)))
typedef unsigned short bf16_t;
typedef short bf16x8 __attribute__((ext_vector_type(8)));
typedef float f32x4 __attribute__((ext_vector_type(4)));
typedef unsigned u32x4 __attribute__((ext_vector_type(4)));
typedef unsigned u32x2 __attribute__((ext_vector_type(2)));
#define LDS_WAIT() asm volatile("s_waitcnt lgkmcnt(0)" ::: "memory")

constexpr int D = 1024, NB = 8, TT = 2048, MP = NB * TT, NS = 128, MTOK = MP + NS, MROWS = 16640;
constexpr int INC = 3328, LDP = 3584, FW = 2816, FW2 = 5632, NMEM = 256, MMEM = NB * NMEM;
constexpr float EPS = 1e-6f, GN_EPS = 64e-5f;
constexpr int NPHASE = 26;
constexpr int LDS_BYTES = 147456;

constexpr size_t O_YP = 0, O_YS = 16777216, O_SHP = 16908288, O_WKVP = 16924672, O_CONVP = 17448960, O_FFNP = 17465344,
                 O_MKP = 17645568, O_MVP = 21839872, O_SHS = 26034176, O_WKVS = 26296320, O_CONVS = 34684928, O_FFNS = 34947072;

constexpr size_t al256(size_t x) { return (x + 255) & ~(size_t)255; }
constexpr size_t OFF_SS = 0;
constexpr size_t OFF_SSM = al256(OFF_SS + (size_t)7 * MROWS * 4);
constexpr size_t OFF_WIN = al256(OFF_SSM + 2048 * 4);
constexpr size_t OFF_WOUT = OFF_WIN + (size_t)2 * LDP * D * 2;
constexpr size_t OFF_WQ = OFF_WOUT + (size_t)2 * D * D * 2;
constexpr size_t OFF_WK = OFF_WQ + (size_t)2 * D * D * 2;
constexpr size_t OFF_WV = OFF_WK + (size_t)2 * D * D * 2;
constexpr size_t OFF_WO = OFF_WV + (size_t)2 * D * D * 2;
constexpr size_t OFF_WUP = OFF_WO + (size_t)2 * D * D * 2;
constexpr size_t OFF_WDN = OFF_WUP + (size_t)2 * FW2 * D * 2;
constexpr size_t OFF_W2 = OFF_WDN + (size_t)2 * D * FW * 2;
constexpr size_t OFF_A2 = OFF_W2 + (size_t)2 * 512 * 64 * 2;
constexpr size_t OFF_G2 = OFF_A2 + (size_t)2 * 512 * 64 * 2;
constexpr size_t OFF_V1 = OFF_G2 + (size_t)2 * 512 * 128 * 2;
constexpr size_t OFF_V2 = OFF_V1 + (size_t)32 * 512 * 2;
constexpr size_t OFF_X = al256(OFF_V2 + (size_t)512 * 32 * 2);
constexpr size_t OFF_XB = OFF_X + (size_t)MROWS * D * 4;
constexpr size_t OFF_MNB = OFF_XB + (size_t)MROWS * D * 2;
constexpr size_t OFF_MK = OFF_MNB + (size_t)MMEM * D * 2;
constexpr size_t OFF_MVT = OFF_MK + (size_t)2 * MMEM * D * 2;
constexpr size_t OFF_PROJ = OFF_MVT + (size_t)2 * MMEM * D * 2;
constexpr size_t OFF_H = OFF_PROJ;
constexpr size_t SCN = (size_t)MTOK * 512 * 4;
constexpr size_t OFF_SA = OFF_PROJ + (size_t)MROWS * LDP * 2;
constexpr size_t OFF_SB = OFF_SA + SCN, OFF_SD = OFF_SB + SCN, OFF_SK = OFF_SD + SCN, OFF_SRD = OFF_SK + SCN, OFF_G = OFF_SRD + SCN;
constexpr size_t OFF_UP = OFF_SA;
constexpr size_t OFF_SV0 = OFF_G + SCN, OFF_SV1 = OFF_SV0 + SCN;
constexpr size_t OFF_SBR = OFF_SV1 + SCN;
constexpr size_t OFF_SKR = OFF_SBR + (size_t)MTOK * 8 * 4, OFF_RKR = OFF_SKR + (size_t)MTOK * 8 * 4;
constexpr size_t OFF_Y = al256(OFF_RKR + (size_t)MTOK * 8 * 4);
constexpr size_t OFF_YAB = OFF_Y + SCN;
constexpr size_t OFF_Q = OFF_YAB + (size_t)MROWS * D * 2;
constexpr size_t OFF_P = OFF_Q + (size_t)MROWS * D * 2;
constexpr size_t OFF_O = OFF_P + (size_t)MROWS * D * 2;
constexpr size_t OFF_BAR = OFF_O + (size_t)MROWS * D * 2;
constexpr size_t BAR_BYTES = 16384;
constexpr size_t WS_END = OFF_BAR + BAR_BYTES;
static_assert((size_t)MROWS * FW2 * 2 <= 6 * SCN, "UP overlay");
static_assert((size_t)MROWS * FW * 2 <= (size_t)MROWS * LDP * 2, "H overlay");
static_assert(WS_END < (size_t)1050000000, "workspace");

__device__ __forceinline__ unsigned f2bf(float f) { unsigned u = __builtin_bit_cast(unsigned, f); return (u + 0x7fffu + ((u >> 16) & 1u)) >> 16; }
__device__ __forceinline__ unsigned pk2(float lo, float hi) { return f2bf(lo) | (f2bf(hi) << 16); }
__device__ __forceinline__ unsigned cvt_pk_bf16(float lo, float hi) { unsigned r; asm volatile("v_cvt_pk_bf16_f32 %0, %1, %2" : "=v"(r) : "v"(lo), "v"(hi)); return r; }
__device__ __forceinline__ float bflo(unsigned w) { return __builtin_bit_cast(float, w << 16); }
__device__ __forceinline__ float bfhi(unsigned w) { return __builtin_bit_cast(float, w & 0xffff0000u); }
__device__ __forceinline__ float wave_sum(float v) {
#pragma unroll
    for (int o = 1; o < 64; o <<= 1) v += __shfl_xor(v, o);
    return v;
}
__device__ __forceinline__ float wave_max(float v) {
#pragma unroll
    for (int o = 1; o < 64; o <<= 1) v = fmaxf(v, __shfl_xor(v, o));
    return v;
}
__device__ __forceinline__ float sigmoidf_(float x) { return 1.f / (1.f + __expf(-x)); }
__device__ __forceinline__ void unpack8(u32x4 w, float* f) { f[0] = bflo(w.x); f[1] = bfhi(w.x); f[2] = bflo(w.y); f[3] = bfhi(w.y); f[4] = bflo(w.z); f[5] = bfhi(w.z); f[6] = bflo(w.w); f[7] = bfhi(w.w); }
__device__ __forceinline__ f32x4 ld_bf4(const bf16_t* p) { const u32x2 w = *(const u32x2*)p; return (f32x4){bflo(w.x), bfhi(w.x), bflo(w.y), bfhi(w.y)}; }
__device__ __forceinline__ void st_bf4(bf16_t* p, const f32x4 v) { u32x2 w; w.x = cvt_pk_bf16(v[0], v[1]); w.y = cvt_pk_bf16(v[2], v[3]); *(u32x2*)p = w; }
__device__ __forceinline__ float bf2f(bf16_t h) { return __builtin_bit_cast(float, (unsigned)h << 16); }
template <int CTRL> __device__ __forceinline__ float dppf(float v) { return __builtin_bit_cast(float, __builtin_amdgcn_update_dpp(0, __builtin_bit_cast(int, v), CTRL, 0xF, 0xF, true)); }
__device__ __forceinline__ float red16(float v) { v += dppf<0xB1>(v); v += dppf<0x4E>(v); v += dppf<0x124>(v); v += dppf<0x128>(v); return v; }

namespace pg8 {
constexpr int BM = 256, BK = 64, HALF = 128, HTB = HALF * BK * 2, STAGE_BYTES = 8 * HTB, NXCD = 8, WGM = 8;
__host__ __device__ __forceinline__ int lds_byte(int r, int c) { const int st = (r >> 4) * 2 + (c >> 5), rr = r & 15, cc = c & 31, ob = rr * 64 + cc * 2; return st * 1024 + (ob ^ (((ob >> 9) & 1) << 5)); }
__host__ __device__ __forceinline__ void stage_rc(int b, int& R, int& C) { const int st = b / 1024, sb = b % 1024, swz = sb ^ (((sb >> 9) & 1) << 5); R = (st >> 1) * 16 + swz / 64; C = (st & 1) * 32 + (swz % 64) / 2; }
__host__ __device__ __forceinline__ int perm32(int rho) { const int n = rho >> 4, i = rho & 15; return 8 * (i >> 2) + 4 * n + (i & 3); }

struct Unit { int pm, pn; size_t offA, offB; };
struct Gemm { const bf16_t* A; const bf16_t* Bt; int lda, ldb, K; };

struct GenOrder {
    int mode, nM, nN, nwg, G, c; size_t sA, sB;
    __device__ void init(int mode_, int M, int N, int lda, int ldb, int G_, int c_) { mode = mode_; nM = M / BM; nN = N / BM; nwg = nM * nN; G = G_; c = c_; sA = (size_t)BM * lda * 2; sB = (size_t)BM * ldb * 2; }
    __device__ bool next(int i, Unit& u) const {
        const long L = (long)i * G + c; if (L >= nwg) return false;
        if (mode == 0) {
            int wgid = (int)L; { const int q = nwg / NXCD, r = nwg % NXCD, xcd = wgid % NXCD, off = wgid / NXCD; wgid = (xcd < r ? xcd * (q + 1) : r * (q + 1) + (xcd - r) * q) + off; }
            const int nig = WGM * nN, gid = wgid / nig, fm = gid * WGM, gsz = (nM - fm) < WGM ? (nM - fm) : WGM;
            u.pm = fm + ((wgid % nig) % gsz); u.pn = (wgid % nig) / gsz; u.offA = (size_t)u.pm * sA; u.offB = (size_t)u.pn * sB;
        } else {
            const int b = (int)L >> 5, qb = ((int)L >> 2) & 7, h = (int)L & 3;
            u.pm = b * 8 + qb; u.pn = h;
            u.offA = ((size_t)(b * 2048 + qb * 256) * 1024 + h * 256) * 2;
            u.offB = mode == 1 ? ((size_t)(b * 256) * 1024 + h * 256) * 2 : ((size_t)(b * 4 + h) * 256 * 256) * 2;
        }
        return true;
    }
};

template <class Epi, class Sched, bool ALIGN_EPI>
__device__ __forceinline__ void gemm_phase(LAS unsigned char* lds, const Gemm g, const Sched& S, const Epi& E) {
    int tid = threadIdx.x; asm volatile("" : "+v"(tid));
    const int wid = __builtin_amdgcn_readfirstlane(tid >> 6), lane = tid & 63, wr = wid >> 2, wc = wid & 3, fr = lane & 15, fq = lane >> 4;
    const int K = g.K, nt = K / BK;
    unsigned voffA[2], voffB[2];
#pragma unroll
    for (int i = 0; i < 2; ++i) { int R, C; stage_rc(tid * 16 + i * 8192, R, C); const int Rb = Epi::PERM ? ((R & ~31) + perm32(R & 31)) : R;
        voffA[i] = (unsigned)(R * g.lda + C) * 2u; voffB[i] = (unsigned)(Rb * g.ldb + C) * 2u; }
    const size_t kstep = (size_t)(BK * 2);
    const size_t hstepA = (size_t)HALF * g.lda * 2, hstepB = (size_t)HALF * g.ldb * 2;
    const unsigned ldsw = (unsigned)wid * 1024u;
    const int aoff = lds_byte(wr * 64 + fr, fq * 8), boff = lds_byte(wc * 32 + fr, fq * 8);
#define PG8_SA(b, h) (((b) * 2 + (h)) * HTB)
#define PG8_SB(b, h) ((4 + (b) * 2 + (h)) * HTB)
#define PG8_STAGE(bufoff, gbase, voff) do { _Pragma("unroll") for (int _i = 0; _i < 2; ++_i) \
        __builtin_amdgcn_global_load_lds((const unsigned*)((const char*)(gbase) + (voff)[_i]), (LAS unsigned*)(lds + (bufoff) + ldsw + _i * 8192), 16, 0, 0); } while (0)
#define PG8_LDA(dst, b, h) do { _Pragma("unroll") for (int m = 0; m < 4; ++m) _Pragma("unroll") for (int k = 0; k < 2; ++k) dst[m][k] = *(const LAS bf16x8*)(lds + PG8_SA(b, h) + aoff + m * 2048 + k * 1024); } while (0)
#define PG8_LDB(dst, b, h) do { _Pragma("unroll") for (int n = 0; n < 2; ++n) _Pragma("unroll") for (int k = 0; k < 2; ++k) dst[n][k] = *(const LAS bf16x8*)(lds + PG8_SB(b, h) + boff + n * 2048 + k * 1024); } while (0)
#define PG8_MMA(ai, bj, At, Bt) do { __builtin_amdgcn_s_setprio(1); _Pragma("unroll") for (int m = 0; m < 4; ++m) _Pragma("unroll") for (int n = 0; n < 2; ++n) _Pragma("unroll") for (int k = 0; k < 2; ++k) \
        acc[ai][bj][m][n] = __builtin_amdgcn_mfma_f32_16x16x32_bf16(Bt[n][k], At[m][k], acc[ai][bj][m][n], 0, 0, 0); __builtin_amdgcn_s_setprio(0); } while (0)
#define PG8_WAIT_V(n) asm volatile("s_waitcnt vmcnt(" #n ")" ::: "memory")
#define PG8_WAIT_L(n) asm volatile("s_waitcnt lgkmcnt(" #n ")" ::: "memory")
#define PG8_BAR __builtin_amdgcn_s_barrier()
#define PG8_SCHED __builtin_amdgcn_sched_barrier(0)
    Unit cur, nxt; int ui = 0;
    if (!S.next(0, cur)) return;
    f32x4 acc[2][2][4][2];
#pragma unroll
    for (int a = 0; a < 2; ++a)
#pragma unroll
        for (int b = 0; b < 2; ++b)
#pragma unroll
            for (int m = 0; m < 4; ++m)
#pragma unroll
                for (int n = 0; n < 2; ++n) acc[a][b][m][n] = (f32x4){0.f, 0.f, 0.f, 0.f};
    bf16x8 At[4][2], B0[2][2], B1[2][2];
    const char* cA = (const char*)g.A + cur.offA; const char* cB = (const char*)g.Bt + cur.offB;
    PG8_STAGE(PG8_SB(0, 0), cB, voffB); PG8_STAGE(PG8_SB(0, 1), cB + hstepB, voffB); PG8_STAGE(PG8_SA(0, 0), cA, voffA); PG8_STAGE(PG8_SA(0, 1), cA + hstepA, voffA);
    if (wr == 1) PG8_BAR;
    PG8_WAIT_V(2); PG8_BAR;
    PG8_STAGE(PG8_SB(1, 0), cB + kstep, voffB); PG8_STAGE(PG8_SA(1, 0), cA + kstep, voffA); PG8_STAGE(PG8_SB(1, 1), cB + hstepB + kstep, voffB);
    PG8_WAIT_V(6); PG8_BAR;
    for (;;) {
        const bool has_next = S.next(ui + 1, nxt);
        const char* nA = has_next ? (const char*)g.A + nxt.offA : cA; const char* nB = has_next ? (const char*)g.Bt + nxt.offB : cB;
        for (int t = 0; t < nt; t += 2) {
            const bool last = (t == nt - 2);
            const char* a1 = cA + (size_t)(t + 1) * kstep;
            const char* a2 = last ? nA : cA + (size_t)(t + 2) * kstep; const char* b2 = last ? nB : cB + (size_t)(t + 2) * kstep;
            const char* a3 = a2 + kstep; const char* b3 = b2 + kstep;
            PG8_LDB(B0, 0, 0); PG8_LDB(B1, 0, 1); PG8_SCHED; PG8_LDA(At, 0, 0); PG8_STAGE(PG8_SA(1, 1), a1 + hstepA, voffA);
            PG8_WAIT_V(8); PG8_WAIT_L(0); PG8_BAR; PG8_MMA(0, 0, At, B0); PG8_MMA(0, 1, At, B1); PG8_BAR; PG8_SCHED;
            PG8_LDA(At, 0, 1); PG8_STAGE(PG8_SB(0, 0), b2, voffB); PG8_STAGE(PG8_SB(0, 1), b2 + hstepB, voffB); PG8_STAGE(PG8_SA(0, 0), a2, voffA);
            PG8_WAIT_V(8); PG8_WAIT_L(0); PG8_BAR; PG8_MMA(1, 0, At, B0); PG8_MMA(1, 1, At, B1); PG8_BAR; PG8_SCHED;
            PG8_LDB(B0, 1, 0); PG8_LDB(B1, 1, 1); PG8_SCHED; PG8_LDA(At, 1, 0); PG8_STAGE(PG8_SA(0, 1), a2 + hstepA, voffA);
            PG8_WAIT_V(8); PG8_WAIT_L(0); PG8_BAR; PG8_MMA(0, 0, At, B0); PG8_MMA(0, 1, At, B1); PG8_BAR; PG8_SCHED;
            PG8_LDA(At, 1, 1); PG8_STAGE(PG8_SB(1, 0), b3, voffB); PG8_STAGE(PG8_SB(1, 1), b3 + hstepB, voffB); PG8_STAGE(PG8_SA(1, 0), a3, voffA);
            PG8_WAIT_V(8); PG8_WAIT_L(0); PG8_BAR; PG8_MMA(1, 0, At, B0); PG8_MMA(1, 1, At, B1); PG8_BAR; PG8_SCHED;
        }
        if constexpr (ALIGN_EPI) { if (wr == 0) PG8_BAR; }
        if constexpr (!Epi::AFTER_DRAIN) { E(acc, cur, wr, wc, fr, fq); }
        if (!has_next) break;
#pragma unroll
        for (int a = 0; a < 2; ++a)
#pragma unroll
            for (int b = 0; b < 2; ++b)
#pragma unroll
                for (int m = 0; m < 4; ++m)
#pragma unroll
                    for (int n = 0; n < 2; ++n) acc[a][b][m][n] = (f32x4){0.f, 0.f, 0.f, 0.f};
        cur = nxt; cA = nA; cB = nB; ++ui;
        if constexpr (ALIGN_EPI) { if (wr == 1) PG8_BAR; }
    }
    PG8_WAIT_V(0);
    if constexpr (!ALIGN_EPI) { if (wr == 0) PG8_BAR; }
    PG8_BAR;
    if constexpr (Epi::AFTER_DRAIN) { E.fused(acc, cur, wr, wc, fr, fq, lds, wid, lane); }
#undef PG8_SA
#undef PG8_SB
#undef PG8_STAGE
#undef PG8_LDA
#undef PG8_LDB
#undef PG8_MMA
#undef PG8_WAIT_V
#undef PG8_WAIT_L
#undef PG8_BAR
#undef PG8_SCHED
}

struct Epi {
    static constexpr bool PERM = true, AFTER_DRAIN = false;
    int mode;
    bf16_t* O; int ldc;
    const float* ss;
    float* X;
    float* ssn;
    float* F;
    int l; int dry;
    __device__ __forceinline__ void operator()(const f32x4 (&acc)[2][2][4][2], const Unit& u, int wr, int wc, int fr, int fq) const {
        const int row0 = u.pm * 256 + wr * 64 + fr, col0 = u.pn * 256 + wc * 32 + 8 * fq;
        if (dry) return;
        if (mode == 1) {
#pragma unroll
            for (int ai = 0; ai < 2; ++ai)
#pragma unroll
                for (int m = 0; m < 4; ++m) {
                    const int row = row0 + ai * 128 + m * 16; const bool valid = row < MTOK; float sq = 0.f;
#pragma unroll
                    for (int bj = 0; bj < 2; ++bj) {
                        const size_t idx = (size_t)row * 1024 + col0 + bj * 128;
                        if (valid) {
                            float xf[8]; unpack8(*(const u32x4*)(O + idx), xf);
                            const f32x4 x0 = (f32x4){xf[0], xf[1], xf[2], xf[3]} + acc[ai][bj][m][0], x1 = (f32x4){xf[4], xf[5], xf[6], xf[7]} + acc[ai][bj][m][1];
                            sq += (x0[0] * x0[0] + x0[1] * x0[1]) + (x0[2] * x0[2] + x0[3] * x0[3]) + (x1[0] * x1[0] + x1[1] * x1[1]) + (x1[2] * x1[2] + x1[3] * x1[3]);
                            u32x4 w; w.x = cvt_pk_bf16(x0[0], x0[1]); w.y = cvt_pk_bf16(x0[2], x0[3]); w.z = cvt_pk_bf16(x1[0], x1[1]); w.w = cvt_pk_bf16(x1[2], x1[3]);
                            *(u32x4*)(O + idx) = w;
                        }
                    }
                    sq += __shfl_xor(sq, 16); sq += __shfl_xor(sq, 32);
                    if (valid && fq == 0) atomicAdd(ssn + row, sq);
                }
        } else {
#pragma unroll
            for (int ai = 0; ai < 2; ++ai)
#pragma unroll
                for (int m = 0; m < 4; ++m) {
                    const int row = row0 + ai * 128 + m * 16;
                    float rs = 1.f;
                    if (ss != nullptr && (mode == 2 || mode == 3 || row < MTOK)) rs = rsqrtf(ss[row] * (1.f / 1024.f) + EPS);
#pragma unroll
                    for (int bj = 0; bj < 2; ++bj) {
                        const int col = col0 + bj * 128;
                        const f32x4 v0 = acc[ai][bj][m][0] * rs, v1 = acc[ai][bj][m][1] * rs;
                        u32x4 w; w.x = cvt_pk_bf16(v0[0], v0[1]); w.y = cvt_pk_bf16(v0[2], v0[3]); w.z = cvt_pk_bf16(v1[0], v1[1]); w.w = cvt_pk_bf16(v1[2], v1[3]);
                        if (mode == 3) {
                            const int b = row >> 8, mem = row & 255;
                            bf16_t* o = O + ((size_t)(b * 1024 + col)) * 256 + mem;
                            o[0] = (bf16_t)(w.x & 0xffff); o[256] = (bf16_t)(w.x >> 16); o[512] = (bf16_t)(w.y & 0xffff); o[768] = (bf16_t)(w.y >> 16);
                            o[1024] = (bf16_t)(w.z & 0xffff); o[1280] = (bf16_t)(w.z >> 16); o[1536] = (bf16_t)(w.w & 0xffff); o[1792] = (bf16_t)(w.w >> 16);
                        } else {
                            *(u32x4*)(O + (size_t)row * ldc + col) = w;
                        }
                        if (mode == 2 || mode == 3) { float* f = F + (size_t)row * 1024 + col; *(f32x4*)f = v0; *(f32x4*)(f + 4) = v1; }
                        if (mode == 4) {
                            float* f = nullptr;
                            if (row < MP) { const int t = row & 2047; if (t >= 2046) f = F + O_FFNP + ((size_t)((l * 8 + (row >> 11)) * 2 + (t - 2046))) * FW2 + col; }
                            else if (row < MTOK) f = F + O_FFNS + ((size_t)((l * 128 + (row - MP)) * 2 + 1)) * FW2 + col;
                            if (f) { *(f32x4*)f = v0; *(f32x4*)(f + 4) = v1; }
                        }
                    }
                }
        }
    }
};

struct EpiSm {
    static constexpr bool PERM = true, AFTER_DRAIN = true;
    bf16_t* P;
    __device__ __forceinline__ void operator()(const f32x4 (&)[2][2][4][2], const Unit&, int, int, int, int) const {}
    __device__ __forceinline__ void fused(f32x4 (&acc)[2][2][4][2], const Unit& u, int wr, int wc, int fr, int fq, LAS unsigned char* lds, int wid, int lane) const {
        LAS float* red = (LAS float*)lds; LAS float* red2 = red + 1024;
        float mx[2][4];
#pragma unroll
        for (int ai = 0; ai < 2; ++ai)
#pragma unroll
            for (int m = 0; m < 4; ++m) {
                float v = -3.0e38f;
#pragma unroll
                for (int bj = 0; bj < 2; ++bj)
#pragma unroll
                    for (int n = 0; n < 2; ++n) { const f32x4 x = acc[ai][bj][m][n]; v = fmaxf(v, fmaxf(fmaxf(x[0], x[1]), fmaxf(x[2], x[3]))); }
                v = fmaxf(v, __shfl_xor(v, 16)); v = fmaxf(v, __shfl_xor(v, 32));
                if (fq == 0) red[(ai * 128 + wr * 64 + m * 16 + fr) * 4 + wc] = v;
            }
        __syncthreads();
#pragma unroll
        for (int ai = 0; ai < 2; ++ai)
#pragma unroll
            for (int m = 0; m < 4; ++m) {
                const f32x4 r = *(const LAS f32x4*)(red + (ai * 128 + wr * 64 + m * 16 + fr) * 4);
                const float M = fmaxf(fmaxf(r[0], r[1]), fmaxf(r[2], r[3])); mx[ai][m] = M;
                float s = 0.f;
#pragma unroll
                for (int bj = 0; bj < 2; ++bj)
#pragma unroll
                    for (int n = 0; n < 2; ++n) { f32x4 x = acc[ai][bj][m][n];
                        x[0] = __expf(x[0] - M); x[1] = __expf(x[1] - M); x[2] = __expf(x[2] - M); x[3] = __expf(x[3] - M); acc[ai][bj][m][n] = x; s += (x[0] + x[1]) + (x[2] + x[3]); }
                s += __shfl_xor(s, 16); s += __shfl_xor(s, 32);
                if (fq == 0) red2[(ai * 128 + wr * 64 + m * 16 + fr) * 4 + wc] = s;
            }
        __syncthreads();
#pragma unroll
        for (int ai = 0; ai < 2; ++ai)
#pragma unroll
            for (int m = 0; m < 4; ++m) {
                const int rl = ai * 128 + wr * 64 + m * 16 + fr;
                const f32x4 r = *(const LAS f32x4*)(red2 + rl * 4);
                const float inv = 1.f / ((r[0] + r[1]) + (r[2] + r[3]));
#pragma unroll
                for (int bj = 0; bj < 2; ++bj) {
                    const f32x4 v0 = acc[ai][bj][m][0] * inv, v1 = acc[ai][bj][m][1] * inv;
                    u32x4 w; w.x = cvt_pk_bf16(v0[0], v0[1]); w.y = cvt_pk_bf16(v0[2], v0[3]); w.z = cvt_pk_bf16(v1[0], v1[1]); w.w = cvt_pk_bf16(v1[2], v1[3]);
                    *(u32x4*)(P + (size_t)(u.pm * 256 + rl) * 1024 + u.pn * 256 + bj * 128 + wc * 32 + 8 * fq) = w;
                }
            }
        (void)mx; (void)wid; (void)lane;
    }
};
}

struct Args { const float* in[38]; float* out; unsigned char* ws; int ph_lo, ph_hi; };
enum { I_XP = 0, I_XS, I_MEM, I_SSHIFT, I_SWKV, I_SCONV, I_SFFN, I_CK, I_CV, I_NMIX, I_WIN, I_MU, I_W0, I_W2, I_A0, I_A2, I_G2, I_V0, I_V1, I_V2,
       I_KK, I_KA, I_RK, I_LNW, I_LNB, I_CONVW, I_WOUT, I_NX, I_NMEM, I_WQ, I_WK, I_WV, I_WO, I_NFFN, I_WUP, I_FCW, I_WDN, I_NFIN };

__device__ __forceinline__ void tr_item(const float* W, int K, int N, bf16_t* WT, const float* gain, float scale, LAS float* scr, int item, int lane) {
    const int nblk = N / 32, kb = item / nblk, nb = item % nblk, k0 = 64 * kb, n0 = 32 * nb;
#pragma unroll
    for (int i = 0; i < 8; ++i) { const int kk = 8 * i + (lane >> 3); const float gk = gain ? gain[k0 + kk] * scale : scale;
        const f32x4 v = __builtin_nontemporal_load((const f32x4*)(W + (size_t)(k0 + kk) * N + n0 + (lane & 7) * 4)) * gk;
        LAS float* d = scr + kk * 33 + (lane & 7) * 4; d[0] = v[0]; d[1] = v[1]; d[2] = v[2]; d[3] = v[3]; }
    LDS_WAIT();
    const int c = lane & 7;
#pragma unroll
    for (int j = 0; j < 4; ++j) { const int n = (lane >> 3) + 8 * j; const LAS float* s = scr + (8 * c) * 33 + n;
        u32x4 o; o.x = pk2(s[0 * 33], s[1 * 33]); o.y = pk2(s[2 * 33], s[3 * 33]); o.z = pk2(s[4 * 33], s[5 * 33]); o.w = pk2(s[6 * 33], s[7 * 33]);
        *(u32x4*)(WT + (size_t)(n0 + n) * K + k0 + 8 * c) = o; }
    LDS_WAIT();
}

constexpr int TR_NL = 8512;
__device__ __forceinline__ void tr_dispatch(const Args& a, unsigned char* ws, int l, int r, LAS float* scr, int lane) {
    constexpr int I_IN_ = 16 * 104, I_SQ_ = 16 * 32, I_UP_ = 16 * 176, I_DN_ = 44 * 32, I_L64 = 16;
    if (r < I_IN_) { tr_item(a.in[I_WIN] + (size_t)l * D * INC, D, INC, (bf16_t*)(ws + OFF_WIN) + (size_t)l * LDP * D, a.in[I_NMIX] + l * D, 1.f, scr, r, lane); return; } r -= I_IN_;
    if (r < I_SQ_) { tr_item(a.in[I_WOUT] + (size_t)l * D * D, D, D, (bf16_t*)(ws + OFF_WOUT) + (size_t)l * D * D, nullptr, 1.f, scr, r, lane); return; } r -= I_SQ_;
    if (r < I_SQ_) { tr_item(a.in[I_WQ] + (size_t)l * D * D, D, D, (bf16_t*)(ws + OFF_WQ) + (size_t)l * D * D, a.in[I_NX] + l * D, 0.0625f, scr, r, lane); return; } r -= I_SQ_;
    if (r < I_SQ_) { tr_item(a.in[I_WK] + (size_t)l * D * D, D, D, (bf16_t*)(ws + OFF_WK) + (size_t)l * D * D, a.in[I_NMEM] + l * D, 1.f, scr, r, lane); return; } r -= I_SQ_;
    if (r < I_SQ_) { tr_item(a.in[I_WV] + (size_t)l * D * D, D, D, (bf16_t*)(ws + OFF_WV) + (size_t)l * D * D, a.in[I_NMEM] + l * D, 1.f, scr, r, lane); return; } r -= I_SQ_;
    if (r < I_SQ_) { tr_item(a.in[I_WO] + (size_t)l * D * D, D, D, (bf16_t*)(ws + OFF_WO) + (size_t)l * D * D, nullptr, 1.f, scr, r, lane); return; } r -= I_SQ_;
    if (r < I_UP_) { tr_item(a.in[I_WUP] + (size_t)l * D * FW2, D, FW2, (bf16_t*)(ws + OFF_WUP) + (size_t)l * FW2 * D, a.in[I_NFFN] + l * D, 1.f, scr, r, lane); return; } r -= I_UP_;
    if (r < I_DN_) { tr_item(a.in[I_WDN] + (size_t)l * FW * D, FW, D, (bf16_t*)(ws + OFF_WDN) + (size_t)l * D * FW, nullptr, 1.f, scr, r, lane); return; } r -= I_DN_;
    if (r < I_L64) { tr_item(a.in[I_W2] + (size_t)l * 64 * 512, 64, 512, (bf16_t*)(ws + OFF_W2) + (size_t)l * 512 * 64, nullptr, 1.f, scr, r, lane); return; } r -= I_L64;
    if (r < I_L64) { tr_item(a.in[I_A2] + (size_t)l * 64 * 512, 64, 512, (bf16_t*)(ws + OFF_A2) + (size_t)l * 512 * 64, nullptr, 1.f, scr, r, lane); return; } r -= I_L64;
    tr_item(a.in[I_G2] + (size_t)l * 128 * 512, 128, 512, (bf16_t*)(ws + OFF_G2) + (size_t)l * 512 * 128, nullptr, 1.f, scr, r, lane);
}
constexpr int TR_DEFERRED = TR_NL + 5760;
__device__ __forceinline__ void tr_deferred(const Args& a, unsigned char* ws, int d, LAS float* scr, int lane) {
    if (d < TR_NL) { tr_dispatch(a, ws, 1, d, scr, lane); return; }
    const int e = d - TR_NL;
    const int r = e < 1024 ? 1664 + e : (e < 1536 ? 3712 + (e - 1024) : 4224 + (e - 1536));
    tr_dispatch(a, ws, 0, r, scr, lane);
}

__device__ __forceinline__ void p0_prologue(LAS unsigned char* lds, const Args& a, int tid, int lane, int wave, int gw, int NGW) {
    unsigned char* ws = a.ws;
    LAS float* scr = (LAS float*)(lds + wave * 16384);
    for (int it = gw; it < 1664 + 1024 + 64; it += NGW) {
        const int r = it < 1664 ? it : (it < 2688 ? 2688 + (it - 1664) : 8448 + (it - 2688));
        tr_dispatch(a, ws, 0, r, scr, lane);
    }
    float* X = (float*)(ws + OFF_X); bf16_t* XB = (bf16_t*)(ws + OFF_XB); float* SS = (float*)(ws + OFF_SS);
    bf16_t* MNB = (bf16_t*)(ws + OFF_MNB); float* SSM = (float*)(ws + OFF_SSM);
    for (int m = gw; m < MROWS + MMEM; m += NGW) {
        const float* src; bf16_t* dstb; float* dstx = nullptr; float* dss = nullptr; bool shiftrow = false;
        if (m < MP) { src = a.in[I_XP] + (size_t)m * D; dstb = XB + (size_t)m * D; dstx = X + (size_t)m * D; dss = SS + m; }
        else if (m < MTOK) { src = a.in[I_XS] + (size_t)(m - MP) * D; dstb = XB + (size_t)m * D; dstx = X + (size_t)m * D; dss = SS + m; }
        else if (m < MROWS) { src = a.in[I_SSHIFT] + (size_t)(m - MTOK) * D; dstb = XB + (size_t)m * D; shiftrow = true; }
        else { src = a.in[I_MEM] + (size_t)(m - MROWS) * D; dstb = MNB + (size_t)(m - MROWS) * D; dss = SSM + (m - MROWS); }
        float s = 0.f;
#pragma unroll
        for (int j = 0; j < 4; ++j) {
            f32x4 v = *(const f32x4*)(src + 4 * lane + 256 * j);
            if (shiftrow) { const f32x4 gn = *(const f32x4*)(a.in[I_NMIX] + 4 * lane + 256 * j); v[0] /= gn[0]; v[1] /= gn[1]; v[2] /= gn[2]; v[3] /= gn[3]; }
            s += (v[0] * v[0] + v[1] * v[1]) + (v[2] * v[2] + v[3] * v[3]);
            u32x2 w; w.x = pk2(v[0], v[1]); w.y = pk2(v[2], v[3]);
            *(u32x2*)(dstb + 4 * lane + 256 * j) = w;
        }
        s = wave_sum(s);
        if (dss && lane == 0) *dss = s;
    }
    if (blockIdx.x * 8 < D) {
        __syncthreads();
        LAS float* M = (LAS float*)lds;
        const float* muv = a.in[I_MU] + 1792 + 1024; const float* v1 = a.in[I_V1];
#pragma unroll 8
        for (int i = tid; i < 512 * 64; i += 512) { const int c = i >> 6, o = i & 63; const float mv = muv[c]; M[i] = ((o >> 5) ? mv : 1.f - mv) * v1[c * 32 + (o & 31)]; }
        __syncthreads();
        for (int k = gw; k < D; k += NGW) {
            const float* wrow = a.in[I_WIN] + (size_t)1 * D * INC + (size_t)k * INC + 1024;
            float acc = 0.f;
#pragma unroll 4
            for (int c = 0; c < 512; c += 4) {
                const f32x4 w4 = *(const f32x4*)(wrow + c);
                acc += w4[0] * M[c * 64 + lane] + w4[1] * M[(c + 1) * 64 + lane] + w4[2] * M[(c + 2) * 64 + lane] + w4[3] * M[(c + 3) * 64 + lane];
            }
            ((bf16_t*)(ws + OFF_WIN))[(size_t)1 * LDP * D + (size_t)(INC + lane) * D + k] = (bf16_t)f2bf(acc * a.in[I_NMIX][D + k]);
        }
    }
    const int gt = blockIdx.x * 512 + tid, NGT = gridDim.x * 512;
    for (int i = gt; i < 6 * MROWS; i += NGT) SS[MROWS + i] = 0.f;
    bf16_t* V2T = (bf16_t*)(ws + OFF_V2);
    for (int i = gt; i < 512 * 32; i += NGT) { const int n = i >> 5, k = i & 31; V2T[i] = (bf16_t)f2bf(a.in[I_V2][k * 512 + n]); }
}

__device__ __forceinline__ const bf16_t* prev_row(const bf16_t* PROJ, int m) {
    if (m < MP) { if ((m & 2047) == 0) return nullptr; return PROJ + (size_t)(m - 1) * LDP; }
    return PROJ + (size_t)(m + NS) * LDP;
}
__device__ __forceinline__ void mix4(const bf16_t* cur, const bf16_t* prv, const float* mu, int col, float* z) {
    const u32x2 c = *(const u32x2*)(cur + col); const f32x4 m4 = *(const f32x4*)(mu + col);
    float cf[4] = {bflo(c.x), bfhi(c.x), bflo(c.y), bfhi(c.y)}; float pf[4] = {0.f, 0.f, 0.f, 0.f};
    if (prv) { const u32x2 p = *(const u32x2*)(prv + col); pf[0] = bflo(p.x); pf[1] = bfhi(p.x); pf[2] = bflo(p.y); pf[3] = bfhi(p.y); }
#pragma unroll
    for (int j = 0; j < 4; ++j) z[j] = cf[j] + (pf[j] - cf[j]) * m4[j];
}
__device__ __forceinline__ void mix8(const bf16_t* cur, const bf16_t* prv, const float* mu, int col, float* z) {
    const u32x4 c = *(const u32x4*)(cur + col); float cf[8], pf[8]; unpack8(c, cf);
#pragma unroll
    for (int j = 0; j < 8; ++j) pf[j] = 0.f;
    if (prv) { const u32x4 p = *(const u32x4*)(prv + col); unpack8(p, pf); }
    const f32x4 m0 = *(const f32x4*)(mu + col), m1 = *(const f32x4*)(mu + col + 4);
#pragma unroll
    for (int j = 0; j < 4; ++j) { z[j] = cf[j] + (pf[j] - cf[j]) * m0[j]; z[4 + j] = cf[4 + j] + (pf[4 + j] - cf[4 + j]) * m1[j]; }
}

__device__ __forceinline__ float fsig(float x) { return __builtin_amdgcn_rcpf(1.f + __expf(-x)); }
__device__ __forceinline__ void mixw(u32x2 c, u32x2 p, const LAS float* mu, float* z) {
    const f32x4 m4 = *(const LAS f32x4*)mu;
    const float cf[4] = {bflo(c.x), bfhi(c.x), bflo(c.y), bfhi(c.y)}, pf[4] = {bflo(p.x), bfhi(p.x), bflo(p.y), bfhi(p.y)};
#pragma unroll
    for (int j = 0; j < 4; ++j) z[j] = cf[j] + (pf[j] - cf[j]) * m4[j];
}
__device__ __forceinline__ void prep_phase(LAS unsigned char* lds, const Args& a, int l, int tid, int lane, int wave, int gw) {
    unsigned char* ws = a.ws;
    const bf16_t* PROJ = (const bf16_t*)(ws + OFF_PROJ);
    const float* mu = a.in[I_MU] + l * 1792;
    if (gw < NB + NS) {
        const int row = gw < NB ? gw * 2048 + 2047 : MP + (gw - NB);
        float* dst = gw < NB ? a.out + O_SHP + (size_t)(l * NB + gw) * D : a.out + O_SHS + (size_t)(l * NS + (gw - NB)) * D;
        const bf16_t* Xr = (const bf16_t*)(ws + OFF_XB) + (size_t)row * D;
        const float rs = rsqrtf(((const float*)(ws + OFF_SS))[3 * l * MROWS + row] * (1.f / 1024.f) + EPS);
#pragma unroll
        for (int j = 0; j < 4; ++j) { const u32x2 xw = *(const u32x2*)(Xr + 4 * lane + 256 * j); const f32x4 v = (f32x4){bflo(xw.x), bfhi(xw.x), bflo(xw.y), bfhi(xw.y)}, gn = *(const f32x4*)(a.in[I_NMIX] + l * D + 4 * lane + 256 * j);
            *(f32x4*)(dst + 4 * lane + 256 * j) = v * rs * gn; }
    }
    LAS bf16_t* WL2 = (LAS bf16_t*)lds;
    LAS bf16_t* WLA = (LAS bf16_t*)(lds + 18432);
    LAS bf16_t* WLG = (LAS bf16_t*)(lds + 36864);
    LAS bf16_t* WLV = (LAS bf16_t*)(lds + 71680);
    LAS float* PAR = (LAS float*)(lds + 81920);
    LAS bf16_t* LA = (LAS bf16_t*)(lds + 88064);
    LAS bf16_t* LW = (LAS bf16_t*)(lds + 121856);
    const int hp = blockIdx.x & 3;
    {
        const bf16_t* W2T = (const bf16_t*)(ws + OFF_W2) + (size_t)l * 512 * 64 + (size_t)hp * 128 * 64;
        const bf16_t* A2T = (const bf16_t*)(ws + OFF_A2) + (size_t)l * 512 * 64 + (size_t)hp * 128 * 64;
        const bf16_t* G2T = (const bf16_t*)(ws + OFF_G2) + (size_t)l * 512 * 128 + (size_t)hp * 128 * 128;
        const bf16_t* V2T = (const bf16_t*)(ws + OFF_V2) + (size_t)hp * 128 * 32;
#pragma unroll
        for (int q = 0; q < 2; ++q) { const int i = tid + 512 * q, n = i >> 3, c = (i & 7) * 8;
            *(LAS u32x4*)(WL2 + n * 72 + c) = *(const u32x4*)(W2T + n * 64 + c); *(LAS u32x4*)(WLA + n * 72 + c) = *(const u32x4*)(A2T + n * 64 + c); }
#pragma unroll
        for (int q = 0; q < 4; ++q) { const int i = tid + 512 * q, n = i >> 4, c = (i & 15) * 8; *(LAS u32x4*)(WLG + n * 136 + c) = *(const u32x4*)(G2T + n * 128 + c); }
        { const int n = tid >> 2, c = (tid & 3) * 8; *(LAS u32x4*)(WLV + n * 40 + c) = *(const u32x4*)(V2T + n * 32 + c); }
        if (tid < 128) {
            const int ch = hp * 128 + tid;
            PAR[tid] = a.in[I_W0][l * 512 + ch]; PAR[128 + tid] = a.in[I_A0][l * 512 + ch]; PAR[256 + tid] = a.in[I_KK][l * 512 + ch]; PAR[384 + tid] = a.in[I_KA][l * 512 + ch];
            PAR[512 + tid] = a.in[I_RK][l * 512 + ch]; PAR[640 + tid] = l == 1 ? a.in[I_V0][ch] : 0.f; PAR[768 + tid] = mu[ch]; PAR[896 + tid] = mu[512 + ch]; PAR[1024 + tid] = mu[1024 + ch];
        }
    }
    float* SA = (float*)(ws + OFF_SA); float* SB = (float*)(ws + OFF_SB); float* SD = (float*)(ws + OFF_SD); float* SK = (float*)(ws + OFF_SK);
    float* SRD = (float*)(ws + OFF_SRD); float* GG = (float*)(ws + OFF_G); float* SV = (float*)(ws + (l == 0 ? OFF_SV0 : OFF_SV1));
    const float* SV0 = (const float*)(ws + OFF_SV0);
    float* SBR = (float*)(ws + OFF_SBR); float* SKR = (float*)(ws + OFF_SKR); float* RKR = (float*)(ws + OFF_RKR);
    const int mt = wave & 3, hh = wave >> 2, h = hp * 2 + hh, fr = lane & 15, fq = lane >> 4;
    const int grp = blockIdx.x >> 2;
    const int nit = 4 + (blockIdx.x < 32 ? 1 : 0);
    for (int it = 0; it < nit; ++it) {
        const bool tailit = it >= 4;
        const int m0 = tailit ? MP + grp * 16 : (grp + 64 * it) * 64;
        const int nq = tailit ? 1 : 4;
        {
            u32x4 cu[4], pv[4];
#pragma unroll
            for (int q = 0; q < 4; ++q) {
                cu[q] = (u32x4){0u, 0u, 0u, 0u}; pv[q] = cu[q];
                if (q < nq) {
                    const int row = (tid >> 5) + 16 * q, ch = tid & 31, m = m0 + row;
                    const bf16_t* prv = prev_row(PROJ, m);
                    cu[q] = *(const u32x4*)(PROJ + (size_t)m * LDP + 1536 + ch * 8);
                    if (prv) pv[q] = *(const u32x4*)(prv + 1536 + ch * 8);
                }
            }
            u32x2 vc = (u32x2){0u, 0u}, vp = vc;
            if (l == 1 && (tid >> 3) < 16 * nq) {
                const int m = m0 + (tid >> 3), j4 = (tid & 7) * 4; const bf16_t* prv = prev_row(PROJ, m);
                vc = *(const u32x2*)(PROJ + (size_t)m * LDP + INC + j4); if (prv) vp = *(const u32x2*)(prv + INC + 32 + j4);
            }
            const int ch = tid & 31;
            const f32x4 m0v = *(const f32x4*)(mu + 1536 + ch * 8), m1v = *(const f32x4*)(mu + 1536 + ch * 8 + 4);
#pragma unroll
            for (int q = 0; q < 4; ++q) {
                if (q >= nq) continue;
                const int row = (tid >> 5) + 16 * q;
                float cf[8], pf[8], z[8]; unpack8(cu[q], cf); unpack8(pv[q], pf);
#pragma unroll
                for (int j = 0; j < 4; ++j) { z[j] = cf[j] + (pf[j] - cf[j]) * m0v[j]; z[4 + j] = cf[4 + j] + (pf[4 + j] - cf[4 + j]) * m1v[j]; }
                if (ch < 8) {
#pragma unroll
                    for (int j = 0; j < 8; ++j) z[j] = 2.f * fsig(2.f * z[j]) - 1.f;
                } else if (ch >= 16) {
#pragma unroll
                    for (int j = 0; j < 8; ++j) z[j] = fsig(z[j]);
                }
                u32x4 w; w.x = pk2(z[0], z[1]); w.y = pk2(z[2], z[3]); w.z = pk2(z[4], z[5]); w.w = pk2(z[6], z[7]);
                *(LAS u32x4*)(LA + row * 264 + ch * 8) = w;
            }
            if (l == 1 && (tid >> 3) < 16 * nq) {
                u32x2 w; w.x = pk2(bflo(vc.x) + bflo(vp.x), bfhi(vc.x) + bfhi(vp.x)); w.y = pk2(bflo(vc.y) + bflo(vp.y), bfhi(vc.y) + bfhi(vp.y));
                *(LAS u32x2*)(LW + (tid >> 3) * 40 + (tid & 7) * 4) = w;
            }
        }
        __syncthreads();
        if (mt < nq) {
        const int m = m0 + mt * 16 + fr;
        const bf16_t* cur = PROJ + (size_t)m * LDP; const bf16_t* prv = prev_row(PROJ, m);
        u32x2 cR[4], cK[4], cV[4], pR[4], pK[4], pV[4]; f32x4 vf[4];
#pragma unroll
        for (int nt = 0; nt < 4; ++nt) {
            const int ch = h * 64 + nt * 16 + fq * 4;
            cR[nt] = *(const u32x2*)(cur + ch); cK[nt] = *(const u32x2*)(cur + 512 + ch); cV[nt] = *(const u32x2*)(cur + 1024 + ch);
            pR[nt] = (u32x2){0u, 0u}; pK[nt] = pR[nt]; pV[nt] = pR[nt];
            if (prv) { pR[nt] = *(const u32x2*)(prv + ch); pK[nt] = *(const u32x2*)(prv + 512 + ch); pV[nt] = *(const u32x2*)(prv + 1024 + ch); }
            vf[nt] = (f32x4){0.f, 0.f, 0.f, 0.f};
            if (l == 1) vf[nt] = ld_bf4((const bf16_t*)SV0 + (size_t)m * 512 + ch);
        }
        float ssq = 0.f;
#pragma unroll
        for (int nt = 0; nt < 4; ++nt) {
            const int cl = hh * 64 + nt * 16 + fq * 4; float kz[4]; mixw(cK[nt], pK[nt], PAR + 896 + cl, kz);
            const f32x4 kk4 = *(const LAS f32x4*)(PAR + 256 + cl);
#pragma unroll
            for (int j = 0; j < 4; ++j) { const float kk = kz[j] * kk4[j]; ssq += kk * kk; }
        }
        ssq += __shfl_xor(ssq, 16); ssq += __shfl_xor(ssq, 32);
        const float inv = 1.f / fmaxf(sqrtf(ssq), 1e-12f);
        float br = 0.f, kr = 0.f, rkr = 0.f;
#pragma unroll
        for (int nt = 0; nt < 4; ++nt) {
            const int cl = hh * 64 + nt * 16 + fq * 4, ch = h * 64 + nt * 16 + fq * 4, nl = hh * 64 + nt * 16 + fr;
            f32x4 dl = (f32x4){0.f, 0.f, 0.f, 0.f}, al = dl, gl = dl, vm = dl;
            bf16x8 af[8];
#pragma unroll
            for (int ks = 0; ks < 8; ++ks) af[ks] = *(const LAS bf16x8*)(LA + (mt * 16 + fr) * 264 + ks * 32 + fq * 8);
            const bf16x8 avv = *(const LAS bf16x8*)(LW + (mt * 16 + fr) * 40 + fq * 8);
#pragma unroll
            for (int ks = 0; ks < 2; ++ks) {
                dl = __builtin_amdgcn_mfma_f32_16x16x32_bf16(*(const LAS bf16x8*)(WL2 + nl * 72 + ks * 32 + fq * 8), af[ks], dl, 0, 0, 0);
                al = __builtin_amdgcn_mfma_f32_16x16x32_bf16(*(const LAS bf16x8*)(WLA + nl * 72 + ks * 32 + fq * 8), af[2 + ks], al, 0, 0, 0);
            }
#pragma unroll
            for (int ks = 0; ks < 4; ++ks) gl = __builtin_amdgcn_mfma_f32_16x16x32_bf16(*(const LAS bf16x8*)(WLG + nl * 136 + ks * 32 + fq * 8), af[4 + ks], gl, 0, 0, 0);
            if (l == 1) vm = __builtin_amdgcn_mfma_f32_16x16x32_bf16(*(const LAS bf16x8*)(WLV + nl * 40 + fq * 8), avv, vm, 0, 0, 0);
            float rz[4], kz[4], vz[4];
            mixw(cR[nt], pR[nt], PAR + 768 + cl, rz); mixw(cK[nt], pK[nt], PAR + 896 + cl, kz); mixw(cV[nt], pV[nt], PAR + 1024 + cl, vz);
            const f32x4 w0 = *(const LAS f32x4*)(PAR + cl), a0 = *(const LAS f32x4*)(PAR + 128 + cl), kk4 = *(const LAS f32x4*)(PAR + 256 + cl);
            const f32x4 ka4 = *(const LAS f32x4*)(PAR + 384 + cl), rk4 = *(const LAS f32x4*)(PAR + 512 + cl), v04 = *(const LAS f32x4*)(PAR + 640 + cl);
            f32x4 oa, ob, od, ok, ord_, ov;
#pragma unroll
            for (int j = 0; j < 4; ++j) {
                const float dcy = __expf(-0.60653065971f * fsig(w0[j] + dl[j]));
                const float av_ = fsig(a0[j] + al[j]);
                float vj = vz[j];
                if (l == 1) { const float vmix = fsig(v04[j] + vm[j]); vj = vj + (vf[nt][j] - vj) * vmix; }
                const float kk = kz[j] * kk4[j] * inv, k2 = kz[j] * (1.f + (av_ - 1.f) * ka4[j]);
                oa[j] = -kk; ob[j] = kk * av_; od[j] = dcy; ok[j] = k2; ord_[j] = rz[j] * dcy; ov[j] = vj;
                br += ob[j] * rz[j]; kr += k2 * rz[j]; rkr += rz[j] * k2 * rk4[j];
            }
            const size_t o = (size_t)m * 512 + ch;
            st_bf4((bf16_t*)SA + o, oa); st_bf4((bf16_t*)SB + o, ob); *(f32x4*)(SD + o) = od; st_bf4((bf16_t*)SK + o, ok); st_bf4((bf16_t*)SRD + o, ord_); st_bf4((bf16_t*)SV + o, ov); { u32x2 gw2; gw2.x = cvt_pk_bf16(gl[0], gl[1]); gw2.y = cvt_pk_bf16(gl[2], gl[3]); *(u32x2*)((bf16_t*)GG + o) = gw2; }
            __builtin_amdgcn_sched_barrier(0);
        }
        br += __shfl_xor(br, 16); br += __shfl_xor(br, 32); kr += __shfl_xor(kr, 16); kr += __shfl_xor(kr, 32); rkr += __shfl_xor(rkr, 16); rkr += __shfl_xor(rkr, 32);
        if (fq == 0) { SBR[m * 8 + h] = br; SKR[m * 8 + h] = kr; RKR[m * 8 + h] = rkr; }
        }
        __syncthreads();
    }
}

__device__ __forceinline__ void convB_token(const Args& a, int l, int m, int lane) {
    unsigned char* ws = a.ws;
    const bf16_t* __restrict__ PROJ = (const bf16_t*)(ws + OFF_PROJ);
    bf16_t* __restrict__ YAB = (bf16_t*)(ws + OFF_YAB);
    const int cb = lane * 8;
        const bf16_t* pr = PROJ + (size_t)m * LDP;
        float gb[8], gc[8], hi[8], u0[8], u1[8], u2[8];
        unpack8(*(const u32x4*)(pr + 1792 + cb), gb); unpack8(*(const u32x4*)(pr + 2304 + cb), gc); unpack8(*(const u32x4*)(pr + 2816 + cb), hi);
#pragma unroll
        for (int j = 0; j < 8; ++j) { u0[j] = gc[j] * hi[j]; u1[j] = 0.f; u2[j] = 0.f; }
        if (m < MP) {
            const int t = m & 2047;
            if (t >= 1) { unpack8(*(const u32x4*)(pr - LDP + 2304 + cb), gc); unpack8(*(const u32x4*)(pr - LDP + 2816 + cb), hi);
#pragma unroll
                for (int j = 0; j < 8; ++j) u1[j] = gc[j] * hi[j]; }
            if (t >= 2) { unpack8(*(const u32x4*)(pr - 2 * LDP + 2304 + cb), gc); unpack8(*(const u32x4*)(pr - 2 * LDP + 2816 + cb), hi);
#pragma unroll
                for (int j = 0; j < 8; ++j) u2[j] = gc[j] * hi[j]; }
            if (t >= 2046) { float* dst = a.out + O_CONVP + (size_t)((l * NB + (m >> 11)) * 2 + (t - 2046)) * 512 + cb;
                *(f32x4*)dst = (f32x4){u0[0], u0[1], u0[2], u0[3]}; *(f32x4*)(dst + 4) = (f32x4){u0[4], u0[5], u0[6], u0[7]}; }
        } else {
            const int i = m - MP; const float* sc = a.in[I_SCONV] + (size_t)(l * NS + i) * 2 * 512 + cb;
            const f32x4 a0 = *(const f32x4*)sc, a1 = *(const f32x4*)(sc + 4), b0 = *(const f32x4*)(sc + 512), b1 = *(const f32x4*)(sc + 516);
#pragma unroll
            for (int j = 0; j < 4; ++j) { u2[j] = a0[j]; u2[4 + j] = a1[j]; u1[j] = b0[j]; u1[4 + j] = b1[j]; }
            float* dst = a.out + O_CONVS + (size_t)(l * NS + i) * 2 * 512 + cb;
            *(f32x4*)dst = b0; *(f32x4*)(dst + 4) = b1;
            *(f32x4*)(dst + 512) = (f32x4){u0[0], u0[1], u0[2], u0[3]}; *(f32x4*)(dst + 516) = (f32x4){u0[4], u0[5], u0[6], u0[7]};
        }
        const float* cw = a.in[I_CONVW] + (size_t)l * 3 * 512 + cb;
        float ob[8];
#pragma unroll
        for (int j = 0; j < 8; ++j) ob[j] = gb[j] * (cw[j] * u2[j] + cw[512 + j] * u1[j] + cw[1024 + j] * u0[j]);
        u32x4 w2; w2.x = pk2(ob[0], ob[1]); w2.y = pk2(ob[2], ob[3]); w2.z = pk2(ob[4], ob[5]); w2.w = pk2(ob[6], ob[7]);
        *(u32x4*)(YAB + (size_t)m * 1024 + 512 + cb) = w2;
}

typedef float f32x2 __attribute__((ext_vector_type(2)));
__device__ __forceinline__ float scan_step(float (&s)[4], const f32x4 av, const f32x4 bv, const f32x4 dv, const f32x4 kv, const f32x4 rd, float vi, float br, float kr) {
    f32x2 s01 = (f32x2){s[0], s[1]}, s23 = (f32x2){s[2], s[3]};
    f32x2 t = s01 * (f32x2){av[0], av[1]}; t = __builtin_elementwise_fma(s23, (f32x2){av[2], av[3]}, t);
    f32x2 u = s01 * (f32x2){rd[0], rd[1]}; u = __builtin_elementwise_fma(s23, (f32x2){rd[2], rd[3]}, u);
    float pa = t.x + t.y, py = u.x + u.y;
    pa = red16(pa); py = red16(py);
    const f32x2 pav = (f32x2){pa, pa}, viv = (f32x2){vi, vi};
    f32x2 w01 = (f32x2){kv[0], kv[1]} * viv; w01 = __builtin_elementwise_fma((f32x2){bv[0], bv[1]}, pav, w01);
    f32x2 w23 = (f32x2){kv[2], kv[3]} * viv; w23 = __builtin_elementwise_fma((f32x2){bv[2], bv[3]}, pav, w23);
    s01 = __builtin_elementwise_fma(s01, (f32x2){dv[0], dv[1]}, w01);
    s23 = __builtin_elementwise_fma(s23, (f32x2){dv[2], dv[3]}, w23);
    s[0] = s01.x; s[1] = s01.y; s[2] = s23.x; s[3] = s23.y;
    return py + pa * br + vi * kr;
}

__device__ __forceinline__ void scan_phase(LAS unsigned char* lds, const Args& a, int l, int tid, int lane, int wave) {
    unsigned char* ws = a.ws;
    const float* SA = (const float*)(ws + OFF_SA); const float* SB = (const float*)(ws + OFF_SB); const float* SD = (const float*)(ws + OFF_SD); const float* SK = (const float*)(ws + OFF_SK);
    const float* SRD = (const float*)(ws + OFF_SRD); const float* SV = (const float*)(ws + (l == 0 ? OFF_SV0 : OFF_SV1));
    const float* SBR = (const float*)(ws + OFF_SBR); const float* SKR = (const float*)(ws + OFF_SKR);
    float* Y = (float*)(ws + OFF_Y);
    constexpr int TC = 32, CB = 5 * TC * 64 + TC * 16 + 2 * TC;
    LAS float* L = (LAS float*)lds;
    const int j4 = lane >> 4, c = lane & 15;
    for (int ci = blockIdx.x; ci < 256; ci += gridDim.x) {
        const int hc = ci >> 2, rg = ci & 3, b = hc >> 3, h = hc & 7;
        const int st = tid >> 4, c16 = tid & 15;
        const int rl = (wave & 3) * 4 + j4;
        float s[4] = {0.f, 0.f, 0.f, 0.f};
        u32x2 pa, pb, pk, pr; f32x4 pd; bf16_t pv; float ps = 0.f;
        {
            const size_t m = (size_t)b * 2048 + st; const size_t o = m * 512 + h * 64 + c16 * 4;
            pa = *(const u32x2*)((const bf16_t*)SA + o); pb = *(const u32x2*)((const bf16_t*)SB + o); pd = *(const f32x4*)(SD + o); pk = *(const u32x2*)((const bf16_t*)SK + o); pr = *(const u32x2*)((const bf16_t*)SRD + o);
            pv = ((const bf16_t*)SV)[m * 512 + h * 64 + rg * 16 + c16];
            if (tid < 32) ps = SBR[((size_t)b * 2048 + tid) * 8 + h]; else if (tid < 64) ps = SKR[((size_t)b * 2048 + tid - 32) * 8 + h];
        }
        {
            LAS float* B0 = L;
            *(LAS f32x4*)(B0 + st * 64 + c16 * 4) = (f32x4){bflo(pa.x), bfhi(pa.x), bflo(pa.y), bfhi(pa.y)}; *(LAS f32x4*)(B0 + 2048 + st * 64 + c16 * 4) = (f32x4){bflo(pb.x), bfhi(pb.x), bflo(pb.y), bfhi(pb.y)}; *(LAS f32x4*)(B0 + 4096 + st * 64 + c16 * 4) = pd;
            *(LAS f32x4*)(B0 + 6144 + st * 64 + c16 * 4) = (f32x4){bflo(pk.x), bfhi(pk.x), bflo(pk.y), bfhi(pk.y)}; *(LAS f32x4*)(B0 + 8192 + st * 64 + c16 * 4) = (f32x4){bflo(pr.x), bfhi(pr.x), bflo(pr.y), bfhi(pr.y)}; B0[10240 + st * 16 + c16] = bf2f(pv);
            if (tid < 64) B0[10752 + tid] = ps;
        }
        __syncthreads();
        for (int n = 0; n < TT / TC; ++n) {
            LAS float* Bc = L + (n & 1) * CB; LAS float* Bn = L + ((n + 1) & 1) * CB; LAS float* yb = L + 2 * CB + (n & 1) * 512;
            const bool more = n + 1 < TT / TC;
            if (more) {
                const size_t m = (size_t)b * 2048 + (n + 1) * TC + st; const size_t o = m * 512 + h * 64 + c16 * 4;
                pa = *(const u32x2*)((const bf16_t*)SA + o); pb = *(const u32x2*)((const bf16_t*)SB + o); pd = *(const f32x4*)(SD + o); pk = *(const u32x2*)((const bf16_t*)SK + o); pr = *(const u32x2*)((const bf16_t*)SRD + o);
                pv = ((const bf16_t*)SV)[m * 512 + h * 64 + rg * 16 + c16];
                if (tid < 32) ps = SBR[((size_t)b * 2048 + (n + 1) * TC + tid) * 8 + h]; else if (tid < 64) ps = SKR[((size_t)b * 2048 + (n + 1) * TC + tid - 32) * 8 + h];
            }
            if (wave < 4) {
                LAS float* ybase = (c == 0) ? (yb + rl) : (L + 2 * CB + 1024 + lane);
                const LAS float* p0 = Bc + c * 4;
                f32x4 av = *(const LAS f32x4*)p0, bv = *(const LAS f32x4*)(p0 + 2048), dv = *(const LAS f32x4*)(p0 + 4096), kv = *(const LAS f32x4*)(p0 + 6144), rd = *(const LAS f32x4*)(p0 + 8192);
                float vi = Bc[10240 + rl], br = Bc[10752], kr = Bc[10784];
#pragma unroll 32
                for (int t = 0; t < TC; ++t) {
                    const int tn = (t + 1 < TC) ? t + 1 : t;
                    const LAS float* p = Bc + tn * 64 + c * 4;
                    const f32x4 av2 = *(const LAS f32x4*)p, bv2 = *(const LAS f32x4*)(p + 2048), dv2 = *(const LAS f32x4*)(p + 4096), kv2 = *(const LAS f32x4*)(p + 6144), rd2 = *(const LAS f32x4*)(p + 8192);
                    const float vi2 = Bc[10240 + tn * 16 + rl], br2 = Bc[10752 + tn], kr2 = Bc[10784 + tn];
                    const float y = scan_step(s, av, bv, dv, kv, rd, vi, br, kr);
                    ybase[t * 16] = y;
                    av = av2; bv = bv2; dv = dv2; kv = kv2; rd = rd2; vi = vi2; br = br2; kr = kr2;
                }
            }
            else {
                const int hw4 = wave - 4;
                if (l == 0 && n < 14) {
                    const int d = (blockIdx.x * 4 + hw4) + 1024 * n;
                    if (d < TR_DEFERRED) tr_deferred(a, ws, d, (LAS float*)(lds + 94208 + hw4 * 8448), lane);
                } else if (n >= 24 && n < 41) {
                    const int tt = (n - 24) * 4 + hw4;
                    int mB = -1;
                    if (tt < 64) mB = blockIdx.x * 64 + tt; else if (tt == 64 && blockIdx.x < NS) mB = MP + blockIdx.x;
                    if (mB >= 0) convB_token(a, l, mB, lane);
                } else if (n >= 20 && n < 24) {
                    const int q = blockIdx.x + gridDim.x * (n - 20);
                    if (q < NS * 8) {
                        const int i = q >> 3, hs = q & 7; const size_t ms = MP + i;
                        const size_t o = ms * 512 + hs * 64 + c * 4;
                        const f32x4 av = ld_bf4((const bf16_t*)SA + o), bv = ld_bf4((const bf16_t*)SB + o), dv = *(const f32x4*)(SD + o), kv = ld_bf4((const bf16_t*)SK + o), rd = ld_bf4((const bf16_t*)SRD + o);
                        const float br = SBR[ms * 8 + hs], kr = SKR[ms * 8 + hs];
#pragma unroll 1
                        for (int p4 = 0; p4 < 4; ++p4) {
                            const int row = p4 * 16 + hw4 * 4 + j4;
                            const size_t so = ((size_t)((l * NS + i) * 8 + hs)) * 4096 + row * 64 + c * 4;
                            const f32x4 s4 = *(const f32x4*)(a.in[I_SWKV] + so);
                            const float vi = bf2f(((const bf16_t*)SV)[ms * 512 + hs * 64 + row]);
                            float ss_[4] = {s4[0], s4[1], s4[2], s4[3]};
                            const float y = scan_step(ss_, av, bv, dv, kv, rd, vi, br, kr);
                            *(f32x4*)(a.out + O_WKVS + so) = (f32x4){ss_[0], ss_[1], ss_[2], ss_[3]};
                            if (c == 0) ((bf16_t*)Y)[ms * 512 + hs * 64 + row] = (bf16_t)f2bf(y);
                        }
                    }
                }
            }
            if (more) {
                *(LAS f32x4*)(Bn + st * 64 + c16 * 4) = (f32x4){bflo(pa.x), bfhi(pa.x), bflo(pa.y), bfhi(pa.y)}; *(LAS f32x4*)(Bn + 2048 + st * 64 + c16 * 4) = (f32x4){bflo(pb.x), bfhi(pb.x), bflo(pb.y), bfhi(pb.y)}; *(LAS f32x4*)(Bn + 4096 + st * 64 + c16 * 4) = pd;
                *(LAS f32x4*)(Bn + 6144 + st * 64 + c16 * 4) = (f32x4){bflo(pk.x), bfhi(pk.x), bflo(pk.y), bfhi(pk.y)}; *(LAS f32x4*)(Bn + 8192 + st * 64 + c16 * 4) = (f32x4){bflo(pr.x), bfhi(pr.x), bflo(pr.y), bfhi(pr.y)}; Bn[10240 + st * 16 + c16] = bf2f(pv);
                if (tid < 64) Bn[10752 + tid] = ps;
            }
            __syncthreads();
            ((bf16_t*)Y)[((size_t)b * 2048 + n * TC + st) * 512 + h * 64 + rg * 16 + c16] = (bf16_t)f2bf(yb[st * 16 + c16]);
        }
        if (wave < 4) {
            float* o = a.out + O_WKVP + ((size_t)((l * 8 + b) * 8 + h)) * 4096 + (rg * 16 + rl) * 64 + c * 4;
            *(f32x4*)o = (f32x4){s[0], s[1], s[2], s[3]};
        }
        __syncthreads();
    }
}

__device__ __forceinline__ void post_phase(const Args& a, int l, int lane, int gw, int NGW) {
    unsigned char* ws = a.ws;
    const bf16_t* __restrict__ PROJ = (const bf16_t*)(ws + OFF_PROJ);
    const float* __restrict__ Y = (const float*)(ws + OFF_Y); const float* __restrict__ SV = (const float*)(ws + (l == 0 ? OFF_SV0 : OFF_SV1)); const float* __restrict__ GG = (const float*)(ws + OFF_G);
    const float* __restrict__ RKR = (const float*)(ws + OFF_RKR);
    bf16_t* __restrict__ YAB = (bf16_t*)(ws + OFF_YAB);
    const int cb = lane * 8, h = lane >> 3;
#pragma unroll 4
    for (int m = gw; m < MTOK; m += NGW) {
        const size_t o = (size_t)m * 512 + cb;
        f32x4 y0, y1; { const u32x4 yq = __builtin_nontemporal_load((const u32x4*)((const bf16_t*)Y + o)); y0 = (f32x4){bflo(yq.x), bfhi(yq.x), bflo(yq.y), bfhi(yq.y)}; y1 = (f32x4){bflo(yq.z), bfhi(yq.z), bflo(yq.w), bfhi(yq.w)}; }
        float s = (y0[0] + y0[1]) + (y0[2] + y0[3]) + (y1[0] + y1[1]) + (y1[2] + y1[3]);
        s += __shfl_xor(s, 1); s += __shfl_xor(s, 2); s += __shfl_xor(s, 4);
        const float mean = s * (1.f / 64.f);
        const f32x4 d0 = y0 - mean, d1 = y1 - mean;
        float q = (d0[0] * d0[0] + d0[1] * d0[1]) + (d0[2] * d0[2] + d0[3] * d0[3]) + (d1[0] * d1[0] + d1[1] * d1[1]) + (d1[2] * d1[2] + d1[3] * d1[3]);
        q += __shfl_xor(q, 1); q += __shfl_xor(q, 2); q += __shfl_xor(q, 4);
        const float rstd = rsqrtf(q * (1.f / 64.f) + GN_EPS);
        const float rkr = RKR[m * 8 + h];
        f32x4 v0, v1; { const u32x4 vq = __builtin_nontemporal_load((const u32x4*)((const bf16_t*)SV + o)); v0 = (f32x4){bflo(vq.x), bfhi(vq.x), bflo(vq.y), bfhi(vq.y)}; v1 = (f32x4){bflo(vq.z), bfhi(vq.z), bflo(vq.w), bfhi(vq.w)}; } f32x4 g0, g1; { const u32x4 gq = __builtin_nontemporal_load((const u32x4*)((const bf16_t*)GG + o)); g0 = (f32x4){bflo(gq.x), bfhi(gq.x), bflo(gq.y), bfhi(gq.y)}; g1 = (f32x4){bflo(gq.z), bfhi(gq.z), bflo(gq.w), bfhi(gq.w)}; }
        const f32x4 lw0 = *(const f32x4*)(a.in[I_LNW] + l * 512 + cb), lw1 = *(const f32x4*)(a.in[I_LNW] + l * 512 + cb + 4);
        const f32x4 lb0 = *(const f32x4*)(a.in[I_LNB] + l * 512 + cb), lb1 = *(const f32x4*)(a.in[I_LNB] + l * 512 + cb + 4);
        const f32x4 r0 = (d0 * rstd * lw0 + lb0 + v0 * rkr) * g0, r1 = (d1 * rstd * lw1 + lb1 + v1 * rkr) * g1;
        u32x4 w; w.x = pk2(r0[0], r0[1]); w.y = pk2(r0[2], r0[3]); w.z = pk2(r1[0], r1[1]); w.w = pk2(r1[2], r1[3]);
        *(u32x4*)(YAB + (size_t)m * 1024 + cb) = w;
    }
    if (l + 1 < 2 && gw < NS) {
        bf16_t* XB = (bf16_t*)(ws + OFF_XB) + (size_t)(MTOK + gw) * D;
        const float* src = a.in[I_SSHIFT] + (size_t)((l + 1) * NS + gw) * D; const float* gn = a.in[I_NMIX] + (l + 1) * D;
#pragma unroll
        for (int j = 0; j < 4; ++j) { const f32x4 v = *(const f32x4*)(src + 4 * lane + 256 * j), g4 = *(const f32x4*)(gn + 4 * lane + 256 * j);
            u32x2 w; w.x = pk2(v[0] / g4[0], v[1] / g4[1]); w.y = pk2(v[2] / g4[2], v[3] / g4[3]); *(u32x2*)(XB + 4 * lane + 256 * j) = w; }
    }
}

__device__ __forceinline__ void sample_attn(LAS unsigned char* lds, const Args& a, int l, int tid, int lane, int wave) {
    unsigned char* ws = a.ws;
    const bf16_t* Q = (const bf16_t*)(ws + OFF_Q); bf16_t* O = (bf16_t*)(ws + OFF_O);
    LAS float* sc = (LAS float*)lds;
    LAS float* part = sc + 256;
    for (int q = blockIdx.x; q < NS * 4; q += gridDim.x) {
        const int i = q >> 2, h = q & 3;
        const u32x2 qw = *(const u32x2*)(Q + (size_t)(MP + i) * 1024 + h * 256 + lane * 4);
        const float q0 = bflo(qw.x), q1 = bfhi(qw.x), q2 = bflo(qw.y), q3 = bfhi(qw.y);
        const float* Kb = a.in[I_CK] + ((size_t)((l * NS + i) * 256) * 4 + h) * 256 + lane * 4;
        const float* Vb = a.in[I_CV] + ((size_t)((l * NS + i) * 256) * 4 + h) * 256 + lane * 4;
        {
            f32x4 kx[8], kn[8];
#pragma unroll
            for (int e = 0; e < 8; ++e) kx[e] = __builtin_nontemporal_load((const f32x4*)(Kb + (size_t)(wave * 32 + e) * 1024));
#pragma unroll
            for (int g8 = 0; g8 < 4; ++g8) {
                if (g8 < 3) {
#pragma unroll
                    for (int e = 0; e < 8; ++e) kn[e] = __builtin_nontemporal_load((const f32x4*)(Kb + (size_t)(wave * 32 + (g8 + 1) * 8 + e) * 1024));
                }
#pragma unroll
                for (int e = 0; e < 8; ++e) { float p = kx[e][0] * q0 + kx[e][1] * q1 + kx[e][2] * q2 + kx[e][3] * q3; p = wave_sum(p); if (lane == 0) sc[wave * 32 + g8 * 8 + e] = p; }
#pragma unroll
                for (int e = 0; e < 8; ++e) kx[e] = kn[e];
            }
        }
        __syncthreads();
        if (wave == 0) {
            const f32x4 s4 = *(const LAS f32x4*)(sc + lane * 4);
            const float mx = wave_max(fmaxf(fmaxf(s4[0], s4[1]), fmaxf(s4[2], s4[3])));
            f32x4 e4; e4[0] = __expf(s4[0] - mx); e4[1] = __expf(s4[1] - mx); e4[2] = __expf(s4[2] - mx); e4[3] = __expf(s4[3] - mx);
            const float inv = 1.f / wave_sum((e4[0] + e4[1]) + (e4[2] + e4[3]));
            *(LAS f32x4*)(sc + lane * 4) = e4 * inv;
        }
        __syncthreads();
        f32x4 acc = (f32x4){0.f, 0.f, 0.f, 0.f};
        {
            f32x4 vx[8], vn[8];
#pragma unroll
            for (int e = 0; e < 8; ++e) vx[e] = __builtin_nontemporal_load((const f32x4*)(Vb + (size_t)(wave * 32 + e) * 1024));
#pragma unroll
            for (int g8 = 0; g8 < 4; ++g8) {
                if (g8 < 3) {
#pragma unroll
                    for (int e = 0; e < 8; ++e) vn[e] = __builtin_nontemporal_load((const f32x4*)(Vb + (size_t)(wave * 32 + (g8 + 1) * 8 + e) * 1024));
                }
#pragma unroll
                for (int e = 0; e < 8; ++e) acc += vx[e] * sc[wave * 32 + g8 * 8 + e];
#pragma unroll
                for (int e = 0; e < 8; ++e) vx[e] = vn[e];
            }
        }
        *(LAS f32x4*)(part + wave * 256 + lane * 4) = acc;
        __syncthreads();
        if (tid < 256) {
            float s = 0.f;
#pragma unroll
            for (int w = 0; w < 8; ++w) s += part[w * 256 + tid];
            O[(size_t)(MP + i) * 1024 + h * 256 + tid] = (bf16_t)f2bf(s);
        }
        __syncthreads();
    }
}

__device__ __forceinline__ void ffnconv_phase(const Args& a, int l, int tid) {
    unsigned char* ws = a.ws;
    const bf16_t* __restrict__ UP = (const bf16_t*)(ws + OFF_UP); bf16_t* __restrict__ H = (bf16_t*)(ws + OFF_H);
    const float* __restrict__ cw = a.in[I_FCW] + (size_t)l * 3 * FW2;
    constexpr int CH = FW / 8;
    for (int rb = blockIdx.x; rb < MP / 64; rb += gridDim.x) {
        if (tid < CH) {
            const int c = tid * 8, r0 = rb * 64, t0 = r0 & 2047;
            float wu[3][8], wg[3][8];
#pragma unroll
            for (int k = 0; k < 3; ++k) {
                const f32x4 a0 = *(const f32x4*)(cw + k * FW2 + c), a1 = *(const f32x4*)(cw + k * FW2 + c + 4), b0 = *(const f32x4*)(cw + k * FW2 + FW + c), b1 = *(const f32x4*)(cw + k * FW2 + FW + c + 4);
#pragma unroll
                for (int j = 0; j < 4; ++j) { wu[k][j] = a0[j]; wu[k][4 + j] = a1[j]; wg[k][j] = b0[j]; wg[k][4 + j] = b1[j]; }
            }
            float u2[8], u1[8], g2[8], g1[8];
#pragma unroll
            for (int j = 0; j < 8; ++j) { u2[j] = 0.f; u1[j] = 0.f; g2[j] = 0.f; g1[j] = 0.f; }
            if (t0 >= 2) {
                const bf16_t* p = UP + (size_t)(r0 - 2) * FW2 + c;
                unpack8(*(const u32x4*)p, u2); unpack8(*(const u32x4*)(p + FW), g2); unpack8(*(const u32x4*)(p + FW2), u1); unpack8(*(const u32x4*)(p + FW2 + FW), g1);
            }
            const bf16_t* p = UP + (size_t)r0 * FW2 + c; bf16_t* hp = H + (size_t)r0 * FW + c;
#pragma unroll 1
            for (int r = 0; r < 64; r += 4) {
                u32x4 lu[4], lg[4];
#pragma unroll
                for (int e = 0; e < 4; ++e) { lu[e] = __builtin_nontemporal_load((const u32x4*)(p + (size_t)(r + e) * FW2)); lg[e] = __builtin_nontemporal_load((const u32x4*)(p + (size_t)(r + e) * FW2 + FW)); }
#pragma unroll
                for (int e = 0; e < 4; ++e) {
                    float u0[8], g0[8], hh[8]; unpack8(lu[e], u0); unpack8(lg[e], g0);
#pragma unroll
                    for (int j = 0; j < 8; ++j) {
                        const float uu = wu[0][j] * u2[j] + wu[1][j] * u1[j] + wu[2][j] * u0[j], gg = wg[0][j] * g2[j] + wg[1][j] * g1[j] + wg[2][j] * g0[j];
                        hh[j] = gg * __builtin_amdgcn_rcpf(1.f + __expf(-gg)) * uu;
                        u2[j] = u1[j]; u1[j] = u0[j]; g2[j] = g1[j]; g1[j] = g0[j];
                    }
                    u32x4 w; w.x = cvt_pk_bf16(hh[0], hh[1]); w.y = cvt_pk_bf16(hh[2], hh[3]); w.z = cvt_pk_bf16(hh[4], hh[5]); w.w = cvt_pk_bf16(hh[6], hh[7]);
                    *(u32x4*)(hp + (size_t)(r + e) * FW) = w;
                }
            }
        }
    }
    for (int it = blockIdx.x * 512 + tid; it < NS * CH; it += gridDim.x * 512) {
        const int i = it / CH, c = (it % CH) * 8, m = MP + i;
        const bf16_t* r0 = UP + (size_t)m * FW2;
        float u[8], g[8], t0[8], t1[8];
        unpack8(*(const u32x4*)(r0 + c), t0); unpack8(*(const u32x4*)(r0 + FW + c), t1);
        const float* sf = a.in[I_SFFN] + (size_t)(l * NS + i) * 2 * FW2;
        float* dst = a.out + O_FFNS + (size_t)(l * NS + i) * 2 * FW2;
        float hh[8];
#pragma unroll
        for (int q = 0; q < 2; ++q) {
            const int cc = c + 4 * q;
            const f32x4 p0u = *(const f32x4*)(sf + cc), p0g = *(const f32x4*)(sf + FW + cc), p1u = *(const f32x4*)(sf + FW2 + cc), p1g = *(const f32x4*)(sf + FW2 + FW + cc);
            const f32x4 w0u = *(const f32x4*)(cw + cc), w1u = *(const f32x4*)(cw + FW2 + cc), w2u = *(const f32x4*)(cw + 2 * FW2 + cc);
            const f32x4 w0g = *(const f32x4*)(cw + FW + cc), w1g = *(const f32x4*)(cw + FW2 + FW + cc), w2g = *(const f32x4*)(cw + 2 * FW2 + FW + cc);
            *(f32x4*)(dst + cc) = p1u; *(f32x4*)(dst + FW + cc) = p1g;
#pragma unroll
            for (int j = 0; j < 4; ++j) {
                u[4 * q + j] = w2u[j] * t0[4 * q + j] + w0u[j] * p0u[j] + w1u[j] * p1u[j]; g[4 * q + j] = w2g[j] * t1[4 * q + j] + w0g[j] * p0g[j] + w1g[j] * p1g[j];
                hh[4 * q + j] = g[4 * q + j] * sigmoidf_(g[4 * q + j]) * u[4 * q + j];
            }
        }
        u32x4 w; w.x = pk2(hh[0], hh[1]); w.y = pk2(hh[2], hh[3]); w.z = pk2(hh[4], hh[5]); w.w = pk2(hh[6], hh[7]);
        *(u32x4*)(H + (size_t)m * FW + c) = w;
    }
}

__device__ __forceinline__ void final_phase(const Args& a, int lane, int gw, int NGW) {
    unsigned char* ws = a.ws;
    const bf16_t* __restrict__ X = (const bf16_t*)(ws + OFF_XB); const float* __restrict__ SS = (const float*)(ws + OFF_SS) + (size_t)6 * MROWS;
    float* __restrict__ outp = a.out;
#pragma unroll 4
    for (int m = gw; m < MTOK; m += NGW) {
        const float rs = rsqrtf(SS[m] * (1.f / 1024.f) + EPS);
        float* __restrict__ dst = m < MP ? outp + O_YP + (size_t)m * D : outp + O_YS + (size_t)(m - MP) * D;
#pragma unroll
        for (int j = 0; j < 4; ++j) { const u32x2 xw = __builtin_nontemporal_load((const u32x2*)(X + (size_t)m * D + 4 * lane + 256 * j)); const f32x4 v = (f32x4){bflo(xw.x), bfhi(xw.x), bflo(xw.y), bfhi(xw.y)}, gn = *(const f32x4*)(a.in[I_NFIN] + 4 * lane + 256 * j);
            __builtin_nontemporal_store(v * rs * gn, (f32x4*)(dst + 4 * lane + 256 * j)); }
    }
}

__device__ __forceinline__ void skinny_gemm(LAS unsigned char* lds, const bf16_t* __restrict__ A, int lda, const bf16_t* __restrict__ Wt, int K, int mode, float* X, bf16_t* O, float* ssn, const float* ss, int lane, int wave) {
    LAS f32x4* part = (LAS f32x4*)lds;
    for (int item = blockIdx.x; item < 256; item += gridDim.x) {
        const int n0 = (item & 63) * 16, r0 = MP + (item >> 6) * 32, fr = lane & 15, fq = lane >> 4;
        const bf16_t* ap = A + (size_t)(r0 + fr) * lda + fq * 8;
        const bf16_t* bp = Wt + (size_t)(n0 + fr) * K + fq * 8;
        f32x4 acc0 = (f32x4){0.f, 0.f, 0.f, 0.f}, acc1 = acc0;
#pragma unroll 4
        for (int ks = wave; ks < K / 32; ks += 8) {
            const bf16x8 bf = *(const bf16x8*)(bp + ks * 32), a0 = *(const bf16x8*)(ap + ks * 32), a1 = *(const bf16x8*)(ap + (size_t)16 * lda + ks * 32);
            acc0 = __builtin_amdgcn_mfma_f32_16x16x32_bf16(bf, a0, acc0, 0, 0, 0);
            acc1 = __builtin_amdgcn_mfma_f32_16x16x32_bf16(bf, a1, acc1, 0, 0, 0);
        }
        part[(wave * 2 + 0) * 64 + lane] = acc0; part[(wave * 2 + 1) * 64 + lane] = acc1;
        __syncthreads();
        if (wave < 2) {
            f32x4 acc = part[wave * 64 + lane];
#pragma unroll
            for (int w = 1; w < 8; ++w) acc += part[(w * 2 + wave) * 64 + lane];
            const int row = r0 + wave * 16 + fr, col = n0 + fq * 4;
            const size_t idx = (size_t)row * 1024 + col;
            if (mode == 1) {
                const u32x2 xi = *(const u32x2*)(O + idx);
                const f32x4 x = (f32x4){bflo(xi.x), bfhi(xi.x), bflo(xi.y), bfhi(xi.y)} + acc;
                u32x2 w; w.x = cvt_pk_bf16(x[0], x[1]); w.y = cvt_pk_bf16(x[2], x[3]); *(u32x2*)(O + idx) = w;
                float sq = (x[0] * x[0] + x[1] * x[1]) + (x[2] * x[2] + x[3] * x[3]);
                sq += __shfl_xor(sq, 16); sq += __shfl_xor(sq, 32);
                if (fq == 0) atomicAdd(ssn + row, sq);
            } else {
                const float rs = rsqrtf(ss[row] * (1.f / 1024.f) + EPS);
                u32x2 w; w.x = cvt_pk_bf16(acc[0] * rs, acc[1] * rs); w.y = cvt_pk_bf16(acc[2] * rs, acc[3] * rs); *(u32x2*)(O + idx) = w;
            }
        }
        __syncthreads();
    }
}

#define XB_TMO      128
#define XB_XCNT(j)  (256  + 64 * (j))
#define XB_XSUB(j)  (1280 + 64 * (j))
#define XB_XGEN(j)  (2304 + 64 * (j))
#define XB_TOP      3328
#define XB_TOPGEN   3392
#define XCD_BAR_WORDS 3456
#define XB_SPIN_CAP (1u << 22)
__device__ __forceinline__ unsigned xb_ld(unsigned* p)              { return __hip_atomic_load(p, __ATOMIC_RELAXED, __HIP_MEMORY_SCOPE_AGENT); }
__device__ __forceinline__ unsigned xb_add(unsigned* p, unsigned v) { return __hip_atomic_fetch_add(p, v, __ATOMIC_RELAXED, __HIP_MEMORY_SCOPE_AGENT); }
__device__ __forceinline__ unsigned xb_xcc_id() { return (unsigned)__builtin_amdgcn_s_getreg((3 << 11) | 20) & 0xFu; }
#define XB_SPIN(cond, bar) do { unsigned _sp = 0; while (cond) { __builtin_amdgcn_s_sleep(1); \
    if ((++_sp & 255u) == 0u) { if (xb_ld(&(bar)[XB_TMO])) break; if (_sp > XB_SPIN_CAP) { atomicAdd(&(bar)[XB_TMO], 1u); break; } } } } while (0)
struct XcdBarrier { unsigned* bar; unsigned x; volatile LAS unsigned* st; };
__device__ __forceinline__ XcdBarrier xcd_barrier_post(unsigned* bar, volatile LAS unsigned* st) {
    XcdBarrier b; b.bar = bar; b.x = xb_xcc_id(); b.st = st;
    if (threadIdx.x == 0) (void)xb_add(&bar[XB_XCNT(b.x)], 1u);
    return b;
}
__device__ __forceinline__ void xcd_barrier_complete(unsigned* bar, unsigned x, unsigned& nloc, unsigned& nx) {
    const unsigned G = gridDim.x * gridDim.y * gridDim.z;
    unsigned sum, cnt, mine, sp = 0u;
    for (;;) {
        sum = 0u; cnt = 0u; mine = 0u;
#pragma unroll
        for (unsigned j = 0; j < 16; ++j) { const unsigned c = xb_ld(&bar[XB_XCNT(j)]); sum += c; cnt += (c > 0u) ? 1u : 0u; mine = (j == x) ? c : mine; }
        if (sum == G) break;
        __builtin_amdgcn_s_sleep(1);
        if ((++sp & 255u) == 0u) { if (xb_ld(&bar[XB_TMO])) break; if (sp > XB_SPIN_CAP) { atomicAdd(&bar[XB_TMO], 1u); break; } }
    }
    nloc = mine > 0u ? mine : 1u; nx = cnt > 0u ? cnt : 1u;
}
__device__ __forceinline__ void xcd_barrier(const XcdBarrier& b) {
    asm volatile("s_waitcnt vmcnt(0)" ::: "memory");
    __syncthreads();
    if (threadIdx.x == 0) {
        unsigned* bar = b.bar;
        __builtin_amdgcn_s_waitcnt(0);
        unsigned nloc = b.st[0], nx = b.st[1];
        if (nloc == 0u) { xcd_barrier_complete(bar, b.x, nloc, nx); b.st[0] = nloc; b.st[1] = nx; }
        const unsigned old = xb_add(&bar[XB_XSUB(b.x)], 1u);
        const unsigned gen = old / nloc;
        if (old + 1u == (gen + 1u) * nloc) {
            __builtin_amdgcn_fence(__ATOMIC_RELEASE, "agent");
            asm volatile("s_waitcnt vmcnt(0)" ::: "memory");
            const unsigned og = xb_add(&bar[XB_TOP], 1u);
            const unsigned tg = og / nx;
            if (og + 1u == (tg + 1u) * nx) xb_add(&bar[XB_TOPGEN], 1u);
            else XB_SPIN(xb_ld(&bar[XB_TOPGEN]) == tg, bar);
            __builtin_amdgcn_fence(__ATOMIC_ACQUIRE, "agent");
            xb_add(&bar[XB_XGEN(b.x)], 1u);
            asm volatile("s_waitcnt vmcnt(0)" ::: "memory");
        } else {
            XB_SPIN(xb_ld(&bar[XB_XGEN(b.x)]) == gen, bar);
            __builtin_amdgcn_fence(__ATOMIC_ACQUIRE, "agent");
            asm volatile("s_waitcnt vmcnt(0)" ::: "memory");
        }
    }
    __syncthreads();
}

__global__ void __launch_bounds__(512, 2) mega(Args a) {
    extern __shared__ __attribute__((aligned(16))) unsigned char lds_raw[];
    LAS unsigned char* lds = (LAS unsigned char*)lds_raw;
    cg::grid_group grid = cg::this_grid();
    volatile LAS unsigned* bst = (volatile LAS unsigned*)(lds + 131072 + 64);
    if (threadIdx.x == 0) { bst[0] = 0u; bst[1] = 0u; }
    __syncthreads();
    const XcdBarrier xbar = xcd_barrier_post((unsigned*)(a.ws + OFF_BAR), bst);
    for (int ph2 = 2 * a.ph_lo; ph2 < 2 * a.ph_hi; ++ph2) {
        const int ph = ph2 >> 1;
        if (ph2 & 1) { const int spx = (ph == 0) ? 12 : (ph == NPHASE - 1) ? 13 : (ph - 1) % 12; if (!((REP_MASK >> spx) & 1)) continue; }
        int tid = threadIdx.x; asm volatile("" : "+v"(tid));
        const int lane = tid & 63, wave = __builtin_amdgcn_readfirstlane(tid >> 6);
        const int G = gridDim.x, gw = blockIdx.x * 8 + wave, NGW = G * 8;
        unsigned char* ws = a.ws; asm volatile("" : "+s"(ws));
        float* SS = (float*)(ws + OFF_SS);
        bf16_t* XB = (bf16_t*)(ws + OFF_XB); float* X = (float*)(ws + OFF_X);
        if (ph == 0) {
            if (PHON(12)) p0_prologue(lds, a, tid, lane, wave, gw, NGW);
        } else if (ph == NPHASE - 1) {
            if (PHON(13)) final_phase(a, lane, gw, NGW);
        } else {
            const int l = (ph - 1) / 12, sp = (ph - 1) % 12;
            const bool is_gemm = (sp == 0 || sp == 4 || sp == 5 || sp == 7 || sp == 8 || sp == 9 || sp == 11);
            if (is_gemm && PHON(0)) {
                const int njobs = (l == 0 && (sp == 0 || sp == 9)) ? 3 : 1;
                for (int jb = 0; jb < njobs; ++jb) {
                    pg8::Gemm g; pg8::GenOrder S; pg8::Epi E;
                    E.mode = 0; E.O = nullptr; E.ldc = D; E.ss = nullptr; E.X = nullptr; E.ssn = nullptr; E.F = nullptr; E.l = l; E.dry = (ph2 & 1);
                    if (sp == 0 && jb == 0) {
                        g = pg8::Gemm{XB, (const bf16_t*)(ws + OFF_WIN) + (size_t)l * LDP * D, D, D, D};
                        S.init(0, MROWS, LDP, D, D, G, (int)blockIdx.x);
                        E.O = (bf16_t*)(ws + OFF_PROJ); E.ldc = LDP; E.ss = SS + (size_t)3 * l * MROWS;
                    } else if (jb > 0) {
                        const int kv = (sp == 0 ? 0 : 2) + jb - 1, ll = kv >> 1, isv = kv & 1;
                        g = pg8::Gemm{(const bf16_t*)(ws + OFF_MNB), (const bf16_t*)(ws + (isv ? OFF_WV : OFF_WK)) + (size_t)ll * D * D, D, D, D};
                        S.init(0, MMEM, D, D, D, G, (int)((blockIdx.x + G - 160 - 32 * (jb - 1)) % G));
                        E.mode = isv ? 3 : 2; E.O = (bf16_t*)(ws + (isv ? OFF_MVT : OFF_MK)) + (size_t)ll * MMEM * D; E.ss = (const float*)(ws + OFF_SSM);
                        E.F = a.out + (isv ? O_MVP : O_MKP) + (size_t)ll * MMEM * D; E.l = ll;
                    } else if (sp == 4 || sp == 8 || sp == 11) {
                        const bf16_t* A = (const bf16_t*)(ws + (sp == 4 ? OFF_YAB : sp == 8 ? OFF_O : OFF_H));
                        const bf16_t* B = sp == 4 ? (const bf16_t*)(ws + OFF_WOUT) + (size_t)l * D * D : sp == 8 ? (const bf16_t*)(ws + OFF_WO) + (size_t)l * D * D : (const bf16_t*)(ws + OFF_WDN) + (size_t)l * D * FW;
                        const int K = sp == 11 ? FW : D;
                        const int nrm = 3 * l + (sp == 4 ? 1 : sp == 8 ? 2 : 3);
                        g = pg8::Gemm{A, B, K, K, K};
                        S.init(0, MP, D, K, K, G, (int)blockIdx.x);
                        E.mode = 1; E.O = XB; E.X = X; E.ssn = SS + (size_t)nrm * MROWS;
                    } else if (sp == 5) {
                        g = pg8::Gemm{XB, (const bf16_t*)(ws + OFF_WQ) + (size_t)l * D * D, D, D, D};
                        S.init(0, MP, D, D, D, G, (int)blockIdx.x);
                        E.O = (bf16_t*)(ws + OFF_Q); E.ss = SS + (size_t)(3 * l + 1) * MROWS;
                    } else if (sp == 7) {
                        g = pg8::Gemm{(const bf16_t*)(ws + OFF_P), (const bf16_t*)(ws + OFF_MVT) + (size_t)l * MMEM * D, D, 256, 256};
                        S.init(2, MP, D, D, 256, G, (int)blockIdx.x);
                        E.O = (bf16_t*)(ws + OFF_O);
                    } else {
                        g = pg8::Gemm{XB, (const bf16_t*)(ws + OFF_WUP) + (size_t)l * FW2 * D, D, D, D};
                        S.init(0, MROWS, FW2, D, D, G, (int)blockIdx.x);
                        E.mode = 4; E.O = (bf16_t*)(ws + OFF_UP); E.ldc = FW2; E.ss = SS + (size_t)(3 * l + 2) * MROWS; E.F = a.out;
                    }
                    pg8::gemm_phase<pg8::Epi, pg8::GenOrder, true>(lds, g, S, E);
                    if (jb == 0 && !(ph2 & 1) && (sp == 4 || sp == 5 || sp == 8 || sp == 11))
                        skinny_gemm(lds, g.A, g.lda, g.Bt, g.K, E.mode, X, E.O, E.ssn, E.ss, lane, wave);
                }
            } else if (sp == 1 && PHON(1)) {
                prep_phase(lds, a, l, tid, lane, wave, gw);
            } else if (sp == 2 && PHON(2)) {
                scan_phase(lds, a, l, tid, lane, wave);
            } else if (sp == 3 && PHON(3)) {
                post_phase(a, l, lane, gw, NGW);
            } else if (sp == 6 && PHON(6)) {
                {
                    pg8::Gemm g{(const bf16_t*)(ws + OFF_Q), (const bf16_t*)(ws + OFF_MK) + (size_t)l * MMEM * D, D, D, 256};
                    pg8::GenOrder S; S.init(1, MP, D, D, D, G, (int)blockIdx.x);
                    pg8::EpiSm E{(bf16_t*)(ws + OFF_P)};
                    pg8::gemm_phase<pg8::EpiSm, pg8::GenOrder, false>(lds, g, S, E);
                }
                __syncthreads();
                sample_attn(lds, a, l, tid, lane, wave);
            } else if (sp == 10 && PHON(10)) {
                ffnconv_phase(a, l, tid);
            }
        }
        if (ph2 + 1 < 2 * a.ph_hi) { if (a.ph_lo < 0) grid.sync(); else xcd_barrier(xbar); }
        if (((REP_MASK >> 14) & 1) && ph2 == 0) { for (int q = 0; q < 40; ++q) xcd_barrier(xbar); }
    }
}

extern "C" void kernel_launch(void* const* d_in, const int* in_sizes, int n_in, void* d_out, int out_size, void* d_ws, size_t ws_size, hipStream_t stream) {
    static int grid = 0;
    if (grid == 0) {
        if (n_in != 38 || ws_size < WS_END) { fprintf(stderr, "kernel_launch: expected 38 inputs and >= %zu bytes of workspace (got %d, %zu)\n", (size_t)WS_END, n_in, ws_size); grid = -1; return; }
        int dev = 0, cus = 0, per_cu = 0;
        hipGetDevice(&dev);
        hipDeviceGetAttribute(&cus, hipDeviceAttributeMultiprocessorCount, dev);
        if (hipFuncSetAttribute((const void*)mega, hipFuncAttributeMaxDynamicSharedMemorySize, LDS_BYTES) != hipSuccess) { fprintf(stderr, "kernel_launch: hipFuncSetAttribute failed\n"); grid = -1; return; }
        hipOccupancyMaxActiveBlocksPerMultiprocessor(&per_cu, (const void*)mega, 512, LDS_BYTES);
        if (per_cu < 1) { fprintf(stderr, "kernel_launch: occupancy query says %d blocks per CU\n", per_cu); per_cu = 1; }
        (void)hipGetLastError();
        grid = cus;
        if (grid != 256) fprintf(stderr, "kernel_launch: built for 256 CUs, got %d\n", grid);
    }
    if (grid < 0) return;
    if (hipMemsetAsync((char*)d_ws + OFF_BAR, 0, BAR_BYTES, stream) != hipSuccess) { fprintf(stderr, "kernel_launch: hipMemsetAsync failed\n"); return; }
    Args a{};
    for (int i = 0; i < 38; ++i) a.in[i] = (const float*)d_in[i];
    a.out = (float*)d_out; a.ws = (unsigned char*)d_ws;
#if MK_PER_PHASE
    for (int ph = 0; ph < NPHASE; ++ph) {
        a.ph_lo = ph; a.ph_hi = ph + 1;
        void* args[] = {&a};
        hipError_t e = hipLaunchCooperativeKernel((const void*)mega, dim3(grid), dim3(512), args, LDS_BYTES, stream);
        if (e != hipSuccess) { fprintf(stderr, "cooperative launch failed: %s\n", hipGetErrorString(e)); break; }
    }
#else
    a.ph_lo = 0; a.ph_hi = NPHASE;
    void* args[] = {&a};
    hipError_t e = hipLaunchCooperativeKernel((const void*)mega, dim3(grid), dim3(512), args, LDS_BYTES, stream);
    if (e != hipSuccess) fprintf(stderr, "cooperative launch failed: %s (grid %d)\n", hipGetErrorString(e), grid);
#endif
    (void)in_sizes; (void)out_size;
}
```
